# Optimizing an MI355X kernel written in HIP

```python
import math
import jax
import jax.numpy as jnp
from jax import lax
import numpy as np

D_MODEL = 1024
BATCH = 16
SEQ = 4096
DEPTH = 2

CTX_LEN = 256
GRID_W = 64

FNET_HEADS = 4
FNET_HEAD_DIM = 64
D_FNET = FNET_HEADS * FNET_HEAD_DIM
HYENA_HEADS = 6
HYENA_HEAD_DIM = 64
D_HYENA = HYENA_HEADS * HYENA_HEAD_DIM
HYENA_ORDER = 2
HYENA_EMB = 33
HYENA_BANDS = (HYENA_EMB - 1) // 2
HYENA_FILTER_HIDDEN = 64
HYENA_FAST_DECAY_PCT = 0.3
HYENA_SLOW_DECAY_PCT = 1.5
HYENA_DECAY_TARGET = 0.01
S5_GROUP = 16
S5_GROUPS = 24
D_S5 = S5_GROUPS * S5_GROUP
S5_STATE = 64
S5_DT_MIN = 0.001
S5_DT_MAX = 0.1
D_MIX = D_FNET + D_HYENA + D_S5
HYENA_OFF = D_FNET
S5_OFF = D_FNET + (HYENA_ORDER + 1) * D_HYENA
D_IN_PROJ = S5_OFF + D_S5
N_MOD = 6
D_FF = 2816
N_EXPERTS = 8
TOP_K = 2
D_FF_EXPERT = 3584
N_DENSE = (DEPTH + 1) // 2
N_MOE = DEPTH // 2
RMS_EPS = 1e-6

kernel_name = 'hybrid_fnet_hyena_s5_moe_dit'


def rmsnorm(x, g):
    xf = x.astype(jnp.float32)
    y = xf * lax.rsqrt(jnp.mean(xf * xf, axis=-1, keepdims=True) + RMS_EPS)
    return (y * g.astype(jnp.float32)).astype(x.dtype)


def modulate(h, shift, scale):
    return h * (1.0 + scale) + shift


def fourier_mix(u, w_f):
    b, l, _ = u.shape
    uh = u.astype(jnp.float32).reshape(b, l, FNET_HEADS, FNET_HEAD_DIM)
    f = jnp.fft.fft2(uh, axes=(1, 3), norm='ortho').real
    y = jnp.einsum('blhd,hde->blhe', f, w_f.astype(jnp.float32))
    return y.reshape(b, l, D_FNET).astype(u.dtype)


def short_conv_seq(u, w, bias):
    up = jnp.pad(u, ((0, 0), (1, 1), (0, 0)))
    return up[:, :-2] * w[0] + up[:, 1:-1] * w[1] + up[:, 2:] * w[2] + bias


def short_conv_grid(u, w, bias):
    b, l, ch = u.shape
    rows = l // GRID_W
    ug = jnp.pad(u.reshape(b, rows, GRID_W, ch), ((0, 0), (0, 0), (1, 1), (0, 0)))
    y = ug[:, :, :-2] * w[0] + ug[:, :, 1:-1] * w[1] + ug[:, :, 2:] * w[2] + bias
    return y.reshape(b, l, ch)


def hyena_filters(l, fw1, fb1, freq1, fw2, fb2, freq2, fw3):
    f32 = jnp.float32
    t = jnp.linspace(0.0, 1.0, l, dtype=f32)[:, None]
    w = (2.0 * math.pi / l) * jnp.arange(l, dtype=f32)[:, None]
    bands = jnp.linspace(1e-4, HYENA_BANDS - 1, HYENA_BANDS, dtype=f32)[None, :]
    z = jnp.concatenate([t, jnp.cos(bands * w), -jnp.sin(bands * w)], axis=-1)
    h = jnp.sin(freq1.astype(f32) * (z @ fw1.astype(f32) + fb1.astype(f32)))
    h = jnp.sin(freq2.astype(f32) * (h @ fw2.astype(f32) + fb2.astype(f32)))
    h = (h @ fw3.astype(f32)).reshape(l, 2, HYENA_ORDER, D_HYENA)
    max_decay = math.log(HYENA_DECAY_TARGET) / HYENA_FAST_DECAY_PCT
    min_decay = math.log(HYENA_DECAY_TARGET) / HYENA_SLOW_DECAY_PCT
    deltas = jnp.abs(jnp.linspace(min_decay, max_decay, D_HYENA, dtype=f32))
    h = h * jnp.exp(-t[:, :, None, None] * deltas)
    h_fwd, h_bwd = h[:, 0], h[:, 1]
    k = jnp.concatenate([h_fwd, jnp.zeros_like(h_fwd[:1]), h_bwd[:0:-1]], axis=0)
    return k / jnp.sum(jnp.abs(k), axis=0, keepdims=True)


def fft_long_conv(u, k, bias):
    l = u.shape[1]
    uf = jnp.fft.rfft(u, n=2 * l, axis=1)
    kf = jnp.fft.rfft(k, n=2 * l, axis=0)
    y = jnp.fft.irfft(uf * kf[None], n=2 * l, axis=1)[:, :l]
    return y + u * bias


def hyena_mix(p, grid, conv_w, conv_b, k, f_bias):
    f32 = jnp.float32
    conv = short_conv_grid if grid else short_conv_seq
    q = conv(p.astype(f32), conv_w.astype(f32), conv_b.astype(f32))
    parts = jnp.split(q, HYENA_ORDER + 1, axis=-1)
    z = parts[0]
    for o in range(HYENA_ORDER):
        z = parts[o + 1] * fft_long_conv(z, k[:, o], f_bias[o].astype(f32))
    return z.astype(p.dtype)


def _ssm_combine(e1, e2):
    a1, b1 = e1
    a2, b2 = e2
    return a2 * a1, a2 * b1 + b2


def s5_discretize(a_re, a_im, log_dt, b_re, b_im):
    f32 = jnp.float32
    lam = lax.complex(a_re.astype(f32), a_im.astype(f32))
    dt = jnp.exp(log_dt.astype(f32))[:, None]
    a_bar = jnp.exp(lam * dt)
    b_c = lax.complex(b_re.astype(f32), b_im.astype(f32))
    b_bar = ((a_bar - 1.0) / lam)[..., None] * b_c
    return a_bar, b_bar


def s5_scan(bu, a_bar, s0, reverse):
    l = bu.shape[1]
    if s0 is not None:
        edge = l - 1 if reverse else 0
        bu = bu.at[:, edge].add(a_bar * s0)
    a = jnp.broadcast_to(a_bar, (1, l) + a_bar.shape)
    _, h = lax.associative_scan(_ssm_combine, (a, bu), axis=1, reverse=reverse)
    return h


def s5_trajectories(u, a_re, a_im, log_dt, b_re, b_im, s0_fwd, s0_bwd):
    b, l, _ = u.shape
    ug = u.astype(jnp.float32).reshape(b, l, S5_GROUPS, S5_GROUP)
    states = []
    for d, (s0, rev) in enumerate(((s0_fwd, False), (s0_bwd, True))):
        a_bar, b_bar = s5_discretize(a_re[d], a_im[d], log_dt[d], b_re[d], b_im[d])
        bu = lax.complex(jnp.einsum('blgh,gph->blgp', ug, b_bar.real),
                         jnp.einsum('blgh,gph->blgp', ug, b_bar.imag))
        states.append(s5_scan(bu, a_bar, s0, rev))
    return states[0], states[1]


def s5_readout(u, h_fwd, h_bwd, c_re, c_im, d_skip, glu_w, glu_b):
    f32 = jnp.float32
    b, l, _ = u.shape
    y = u.astype(f32) * d_skip.astype(f32)
    for d, h in enumerate((h_fwd, h_bwd)):
        yd = (jnp.einsum('blgp,ghp->blgh', h.real, c_re[d].astype(f32))
              - jnp.einsum('blgp,ghp->blgh', h.imag, c_im[d].astype(f32)))
        y = y + yd.reshape(b, l, D_S5)
    y = jax.nn.gelu(y)
    y = y * jax.nn.sigmoid(y @ glu_w.astype(f32) + glu_b.astype(f32))
    return y.astype(u.dtype)


def swiglu(h, w_gate, w_up, w_down):
    return (jax.nn.silu(h @ w_gate) * (h @ w_up)) @ w_down


def moe_swiglu(h, router_w, router_b, w_gate, w_up, w_down):
    logits = (h @ router_w).astype(jnp.float32) + router_b.astype(jnp.float32)
    top_vals, top_idx = lax.top_k(logits, TOP_K)
    top_gates = jax.nn.softmax(top_vals, axis=-1)
    combine = jnp.sum(top_gates[..., None] * jax.nn.one_hot(top_idx, N_EXPERTS, dtype=jnp.float32), axis=-2)
    out = jnp.zeros_like(h)
    for e in range(N_EXPERTS):
        out = out + combine[..., e:e + 1].astype(h.dtype) * swiglu(h, w_gate[e], w_up[e], w_down[e])
    return out


def setup_inputs(seed: int = 0) -> dict:
    key = jax.random.key(seed)
    keys = iter(jax.random.split(key, 64))
    f32 = jnp.float32

    def nrm(shape, std):
        return std * jax.random.normal(next(keys), shape, f32)

    def gain(shape):
        return 1.0 + 0.01 * jax.random.normal(next(keys), shape, f32)

    s5_n = jnp.arange(S5_STATE, dtype=f32)
    hy_proj = (HYENA_ORDER + 1) * D_HYENA
    return {
        'x': nrm((BATCH, SEQ, D_MODEL), 1.0),
        'c': nrm((BATCH, D_MODEL), 1.0),
        'ctx': nrm((BATCH, CTX_LEN, D_MODEL), 1.0),
        'c_ctx': nrm((D_MODEL,), 1.0),
        'ada_w': nrm((DEPTH, D_MODEL, N_MOD * D_MODEL), 0.5 / math.sqrt(D_MODEL)),
        'ada_b': nrm((DEPTH, N_MOD * D_MODEL), 0.01),
        'norm_mix_g': gain((DEPTH, D_MODEL)),
        'norm_ffn_g': gain((DEPTH, D_MODEL)),
        'w_in': nrm((DEPTH, D_MODEL, D_IN_PROJ), D_MODEL ** -0.5),
        'w_out': nrm((DEPTH, D_MIX, D_MODEL), D_MIX ** -0.5),
        'fnet_w': nrm((DEPTH, FNET_HEADS, FNET_HEAD_DIM, FNET_HEAD_DIM), FNET_HEAD_DIM ** -0.5),
        'hy_conv_w': nrm((DEPTH, 3, hy_proj), 3 ** -0.5),
        'hy_conv_b': nrm((DEPTH, hy_proj), 0.01),
        'hy_fw1': nrm((DEPTH, HYENA_EMB, HYENA_FILTER_HIDDEN), HYENA_EMB ** -0.5),
        'hy_fb1': nrm((DEPTH, HYENA_FILTER_HIDDEN), 0.1),
        'hy_freq1': gain((DEPTH, HYENA_FILTER_HIDDEN)),
        'hy_fw2': nrm((DEPTH, HYENA_FILTER_HIDDEN, HYENA_FILTER_HIDDEN), HYENA_FILTER_HIDDEN ** -0.5),
        'hy_fb2': nrm((DEPTH, HYENA_FILTER_HIDDEN), 0.1),
        'hy_freq2': gain((DEPTH, HYENA_FILTER_HIDDEN)),
        'hy_fw3': nrm((DEPTH, HYENA_FILTER_HIDDEN, 2 * HYENA_ORDER * D_HYENA), HYENA_FILTER_HIDDEN ** -0.5),
        'hy_bias': 1.0 + nrm((DEPTH, HYENA_ORDER, D_HYENA), 0.1),
        's5_a_re': -0.5 + nrm((DEPTH, 2, S5_GROUPS, S5_STATE), 0.01),
        's5_a_im': math.pi * s5_n + nrm((DEPTH, 2, S5_GROUPS, S5_STATE), 0.01),
        's5_log_dt': jax.random.uniform(next(keys), (DEPTH, 2, S5_GROUPS), f32,
                                        math.log(S5_DT_MIN), math.log(S5_DT_MAX)),
        's5_b_re': nrm((DEPTH, 2, S5_GROUPS, S5_STATE, S5_GROUP), (2 * S5_GROUP) ** -0.5),
        's5_b_im': nrm((DEPTH, 2, S5_GROUPS, S5_STATE, S5_GROUP), (2 * S5_GROUP) ** -0.5),
        's5_c_re': nrm((DEPTH, 2, S5_GROUPS, S5_GROUP, S5_STATE), 0.25),
        's5_c_im': nrm((DEPTH, 2, S5_GROUPS, S5_GROUP, S5_STATE), 0.25),
        's5_d': nrm((DEPTH, D_S5), 1.0),
        's5_glu_w': nrm((DEPTH, D_S5, D_S5), D_S5 ** -0.5),
        's5_glu_b': nrm((DEPTH, D_S5), 0.01),
        'ffn_w_gate': nrm((N_DENSE, D_MODEL, D_FF), D_MODEL ** -0.5),
        'ffn_w_up': nrm((N_DENSE, D_MODEL, D_FF), D_MODEL ** -0.5),
        'ffn_w_down': nrm((N_DENSE, D_FF, D_MODEL), D_FF ** -0.5),
        'moe_router_w': nrm((N_MOE, D_MODEL, N_EXPERTS), D_MODEL ** -0.5),
        'moe_router_b': nrm((N_MOE, N_EXPERTS), 0.01),
        'moe_w_gate': nrm((N_MOE, N_EXPERTS, D_MODEL, D_FF_EXPERT), D_MODEL ** -0.5),
        'moe_w_up': nrm((N_MOE, N_EXPERTS, D_MODEL, D_FF_EXPERT), D_MODEL ** -0.5),
        'moe_w_down': nrm((N_MOE, N_EXPERTS, D_FF_EXPERT, D_MODEL), D_FF_EXPERT ** -0.5),
        'final_g': gain((D_MODEL,)),
    }


def reference(x, c, ctx, c_ctx, ada_w, ada_b, norm_mix_g, norm_ffn_g, w_in, w_out, fnet_w,
              hy_conv_w, hy_conv_b, hy_fw1, hy_fb1, hy_freq1, hy_fw2, hy_fb2, hy_freq2, hy_fw3, hy_bias,
              s5_a_re, s5_a_im, s5_log_dt, s5_b_re, s5_b_im, s5_c_re, s5_c_im, s5_d, s5_glu_w, s5_glu_b,
              ffn_w_gate, ffn_w_up, ffn_w_down, moe_router_w, moe_router_b, moe_w_gate, moe_w_up,
              moe_w_down, final_g):

    def mix(l, p, grid, s0_fwd, s0_bwd):
        n_tok = p.shape[1]
        p_f, p_h, p_s = jnp.split(p, [HYENA_OFF, S5_OFF], axis=-1)
        y_f = fourier_mix(p_f, fnet_w[l])
        k = hyena_filters(n_tok, hy_fw1[l], hy_fb1[l], hy_freq1[l], hy_fw2[l], hy_fb2[l], hy_freq2[l], hy_fw3[l])
        y_h = hyena_mix(p_h, grid, hy_conv_w[l], hy_conv_b[l], k, hy_bias[l])
        h_fwd, h_bwd = s5_trajectories(p_s, s5_a_re[l], s5_a_im[l], s5_log_dt[l], s5_b_re[l], s5_b_im[l],
                                       s0_fwd, s0_bwd)
        y_s = s5_readout(p_s, h_fwd, h_bwd, s5_c_re[l], s5_c_im[l], s5_d[l], s5_glu_w[l], s5_glu_b[l])
        y = jnp.concatenate([y_f, y_h, y_s], axis=-1) @ w_out[l]
        return y, h_fwd, h_bwd

    def channel_mix(l, h):
        i = l // 2
        if l % 2 == 0:
            return swiglu(h, ffn_w_gate[i], ffn_w_up[i], ffn_w_down[i])
        return moe_swiglu(h, moe_router_w[i], moe_router_b[i], moe_w_gate[i], moe_w_up[i], moe_w_down[i])

    ctx_s = ctx
    for l in range(DEPTH):
        last = l == DEPTH - 1
        mod_lat = (jax.nn.silu(c) @ ada_w[l] + ada_b[l])[:, None, :]
        mod_ctx = (jax.nn.silu(c_ctx) @ ada_w[l] + ada_b[l])[None, None, :]
        sh_m, sc_m, g_m, sh_f, sc_f, g_f = jnp.split(mod_lat, N_MOD, axis=-1)
        csh_m, csc_m, cg_m, csh_f, csc_f, cg_f = jnp.split(mod_ctx, N_MOD, axis=-1)

        hc = modulate(rmsnorm(ctx_s, norm_mix_g[l]), csh_m, csc_m)
        if last:
            hf_c, hb_c = s5_trajectories(hc @ w_in[l][:, S5_OFF:], s5_a_re[l], s5_a_im[l], s5_log_dt[l],
                                         s5_b_re[l], s5_b_im[l], None, None)
        else:
            yc, hf_c, hb_c = mix(l, hc @ w_in[l], False, None, None)
            ctx_s = ctx_s + cg_m * yc
            hcf = modulate(rmsnorm(ctx_s, norm_ffn_g[l]), csh_f, csc_f)
            ctx_s = ctx_s + cg_f * channel_mix(l, hcf)

        hx = modulate(rmsnorm(x, norm_mix_g[l]), sh_m, sc_m)
        yx, _, _ = mix(l, hx @ w_in[l], True, hf_c[:, -1], hb_c[:, 0])
        x = x + g_m * yx
        hxf = modulate(rmsnorm(x, norm_ffn_g[l]), sh_f, sc_f)
        x = x + g_f * channel_mix(l, hxf)

    return rmsnorm(x, final_g)
```

```cpp
#include <hip/hip_runtime.h>
#include <cstdio>
#include <cstdint>

#ifndef MK_ONE_LAUNCH
#define MK_ONE_LAUNCH 0
#endif

#define LAS __attribute__((address_space(3)))
typedef unsigned short bf16;
typedef short bf16x8 __attribute__((ext_vector_type(8)));
typedef float f32x4 __attribute__((ext_vector_type(4)));
typedef float f32x2 __attribute__((ext_vector_type(2)));
typedef unsigned v4u __attribute__((ext_vector_type(4)));
typedef unsigned v2u __attribute__((ext_vector_type(2)));

constexpr int D = 1024, NB = 16, L = 4096, LC = 256, NL = NB * L, NCX = NB * LC, MT = NL + NCX;
constexpr int DIN = 1792, DFF = 2816, NE = 8, DFE = 3584;
constexpr int PTROWS = 2048, R_HY = 512, R_S5 = 1664;
constexpr int NCHUNK = MT / 16;
constexpr int NTHR = 512, NWAVES = 8;
constexpr int MAXSLOT = NL + NE * 256;

constexpr size_t MiB = 1u << 20;
constexpr size_t WS_CTL = 0, CTL_ZERO_BYTES = 1 * MiB;
constexpr size_t WS_MOD = 1 * MiB;
constexpr size_t WS_WIN = 2 * MiB;
constexpr size_t WS_WOUT = 10 * MiB;
constexpr size_t WS_GLU = 14 * MiB;
constexpr size_t WS_FGU = 15 * MiB;
constexpr size_t WS_FD = 26 * MiB;
constexpr size_t WS_DFT = 32 * MiB;
constexpr size_t WS_DFTC = 96 * MiB;
constexpr size_t WS_S5M = 97 * MiB;
constexpr size_t S5M_STRIDE = 256 * 256 * 2 + 256 * 512 * 2;
constexpr size_t WS_A16 = 115 * MiB;
constexpr size_t WS_KT = 116 * MiB;
constexpr size_t WS_KTC = 164 * MiB;
constexpr size_t WS_PS = 167 * MiB;
constexpr size_t WS_TOPK = 171 * MiB;
constexpr size_t WS_META = 172 * MiB;
constexpr size_t META_CNT = 0, META_IDX = 64 * 1024, META_TE = META_IDX + 2 * MAXSLOT * 4, META_NT = META_TE + 2 * 272 * 4;
constexpr size_t WS_HMOD = 173 * MiB;
constexpr size_t WS_BUFA = 309 * MiB;
constexpr size_t WS_R = 581 * MiB;
constexpr size_t WS_END = 1024 * MiB;
constexpr size_t WS_PT = WS_R;
constexpr size_t WS_HT = WS_R;
constexpr size_t WS_ACT = WS_R;
constexpr size_t WS_MOEW = WS_BUFA;
constexpr size_t MOE_GU_BYTES = (size_t)2 * DFE * D * 2, MOE_D_BYTES = (size_t)D * DFE * 2, MOE_E_STRIDE = MOE_GU_BYTES + MOE_D_BYTES;
constexpr size_t WS_ACT2 = WS_BUFA + 168 * MiB;
static_assert(NE * MOE_E_STRIDE <= 168 * MiB, "moe weights");
static_assert(WS_ACT2 + (size_t)MAXSLOT * DFE * 2 <= WS_END, "act2");
static_assert(WS_PT + (size_t)PTROWS * MT * 2 <= WS_END, "pt");
static_assert(WS_ACT + (size_t)MT * DFF * 2 <= WS_END, "act");
static_assert(WS_HMOD + (size_t)MT * D * 2 <= WS_BUFA && WS_BUFA + (size_t)MT * D * 4 <= WS_R, "bufs");
constexpr size_t DO_E = 0, DO_HS = 102 * MiB, DO_YS = 153 * MiB;
static_assert(DO_YS + (size_t)MT * 384 * 2 <= (size_t)NL * D * 4, "d_out scratch");

constexpr int LDS_BYTES = 147456;
constexpr int LDS_MISC = 131072 + 8192;

__device__ __forceinline__ unsigned f2bf(float f) { unsigned u = __builtin_bit_cast(unsigned, f); return (u + 0x7fffu + ((u >> 16) & 1u)) >> 16; }
__device__ __forceinline__ unsigned pk2(float lo, float hi) { return f2bf(lo) | (f2bf(hi) << 16); }
__device__ __forceinline__ float bf2f(unsigned short b) { return __builtin_bit_cast(float, ((unsigned)b) << 16); }
__device__ __forceinline__ float wave_sum(float v) {
#pragma unroll
    for (int o = 1; o < 64; o <<= 1) v += __shfl_xor(v, o);
    return v;
}
__device__ __forceinline__ float silu_f(float x) { return x / (1.0f + __expf(-x)); }
__device__ __forceinline__ float sigmoid_f(float x) { return 1.0f / (1.0f + __expf(-x)); }
__device__ __forceinline__ float gelu_tanh_f(float x) { const float u = 0.7978845608028654f * (x + 0.044715f * x * x * x); return 0.5f * x * (1.0f + tanhf(u)); }
__device__ __forceinline__ int bidx_of(int r) { return r < NL ? (r >> 12) : 16; }

#define XB_TMO      128
#define XB_XCNT(j)  (256  + 64 * (j))
#define XB_XSUB(j)  (1280 + 64 * (j))
#define XB_XGEN(j)  (2304 + 64 * (j))
#define XB_TOP      3328
#define XB_TOPGEN   3392
#define XCD_BAR_WORDS 3456
#define XB_SPIN_CAP (1u << 22)
__device__ __forceinline__ unsigned xb_ld(unsigned* p)              { return __hip_atomic_load(p, __ATOMIC_RELAXED, __HIP_MEMORY_SCOPE_AGENT); }
__device__ __forceinline__ unsigned xb_add(unsigned* p, unsigned v) { return __hip_atomic_fetch_add(p, v, __ATOMIC_RELAXED, __HIP_MEMORY_SCOPE_AGENT); }
__device__ __forceinline__ unsigned xb_xcc_id() { return (unsigned)__builtin_amdgcn_s_getreg((3 << 11) | 20) & 0xFu; }
#define XB_SPIN(cond, bar) do { unsigned _sp = 0; while (cond) { __builtin_amdgcn_s_sleep(1); \
    if ((++_sp & 255u) == 0u) { if (xb_ld(&(bar)[XB_TMO])) break; if (_sp > XB_SPIN_CAP) { atomicAdd(&(bar)[XB_TMO], 1u); break; } } } } while (0)
struct XcdBarrier { unsigned* bar; unsigned x; volatile LAS unsigned* st; };
__device__ __forceinline__ XcdBarrier xcd_barrier_post(unsigned* bar, volatile LAS unsigned* st) {
    XcdBarrier b; b.bar = bar; b.x = xb_xcc_id(); b.st = st;
    if (threadIdx.x == 0) (void)xb_add(&bar[XB_XCNT(b.x)], 1u);
    return b;
}
__device__ __forceinline__ void xcd_barrier_complete(unsigned* bar, unsigned x, unsigned& nloc, unsigned& nx) {
    const unsigned G = gridDim.x * gridDim.y * gridDim.z;
    unsigned sum, cnt, mine, sp = 0u;
    for (;;) {
        sum = 0u; cnt = 0u; mine = 0u;
#pragma unroll
        for (unsigned j = 0; j < 16; ++j) { const unsigned c = xb_ld(&bar[XB_XCNT(j)]); sum += c; cnt += (c > 0u) ? 1u : 0u; mine = (j == x) ? c : mine; }
        if (sum == G) break;
        __builtin_amdgcn_s_sleep(1);
        if ((++sp & 255u) == 0u) { if (xb_ld(&bar[XB_TMO])) break; if (sp > XB_SPIN_CAP) { atomicAdd(&bar[XB_TMO], 1u); break; } }
    }
    nloc = mine > 0u ? mine : 1u; nx = cnt > 0u ? cnt : 1u;
}
__device__ __forceinline__ void xcd_barrier(const XcdBarrier& b) {
    asm volatile("s_waitcnt vmcnt(0)" ::: "memory");
    __syncthreads();
    if (threadIdx.x == 0) {
        unsigned* bar = b.bar;
        __builtin_amdgcn_s_waitcnt(0);
        unsigned nloc = b.st[0], nx = b.st[1];
        if (nloc == 0u) { xcd_barrier_complete(bar, b.x, nloc, nx); b.st[0] = nloc; b.st[1] = nx; }
        const unsigned old = xb_add(&bar[XB_XSUB(b.x)], 1u);
        const unsigned gen = old / nloc;
        if (old + 1u == (gen + 1u) * nloc) {
            __builtin_amdgcn_fence(__ATOMIC_RELEASE, "agent");
            asm volatile("s_waitcnt vmcnt(0)" ::: "memory");
            const unsigned og = xb_add(&bar[XB_TOP], 1u);
            const unsigned tg = og / nx;
            if (og + 1u == (tg + 1u) * nx) xb_add(&bar[XB_TOPGEN], 1u);
            else XB_SPIN(xb_ld(&bar[XB_TOPGEN]) == tg, bar);
            __builtin_amdgcn_fence(__ATOMIC_ACQUIRE, "agent");
            xb_add(&bar[XB_XGEN(b.x)], 1u);
            asm volatile("s_waitcnt vmcnt(0)" ::: "memory");
        } else {
            XB_SPIN(xb_ld(&bar[XB_XGEN(b.x)]) == gen, bar);
            __builtin_amdgcn_fence(__ATOMIC_ACQUIRE, "agent");
            asm volatile("s_waitcnt vmcnt(0)" ::: "memory");
        }
    }
    __syncthreads();
}

template <class AF, class BF, class EP>
__device__ __forceinline__ void gemm_simple(int nbatch, int mtiles, int ntiles, int K, const AF& af, const BF& bf, const EP& ep, int vcu, int G) {
    int tid = threadIdx.x; asm volatile("" : "+v"(tid)); asm volatile("" : "+s"(vcu)); const int wid = tid >> 6, lane = tid & 63, wr = wid >> 2, wc = wid & 3, fr = lane & 15, fq = lane >> 4;
    const int per = mtiles * ntiles, nunits = nbatch * per;
    for (int u = vcu; u < nunits; u += G) {
        const int bt = u / per, rem = u - bt * per, pm = rem / ntiles, pn = rem - pm * ntiles;
        const int row0 = pm * 128 + wr * 64, col0 = pn * 128 + wc * 32;
        f32x4 acc[4][2];
#pragma unroll
        for (int m = 0; m < 4; ++m) { acc[m][0] = (f32x4){0.f, 0.f, 0.f, 0.f}; acc[m][1] = (f32x4){0.f, 0.f, 0.f, 0.f}; }
#pragma unroll 2
        for (int k = 0; k < K; k += 32) {
            bf16x8 a[4], b[2];
#pragma unroll
            for (int m = 0; m < 4; ++m) a[m] = *(const bf16x8*)af(bt, row0 + m * 16 + fr, k + fq * 8);
#pragma unroll
            for (int n = 0; n < 2; ++n) b[n] = *(const bf16x8*)bf(bt, col0 + n * 16 + fr, k + fq * 8);
#pragma unroll
            for (int m = 0; m < 4; ++m)
#pragma unroll
                for (int n = 0; n < 2; ++n) acc[m][n] = __builtin_amdgcn_mfma_f32_16x16x32_bf16(b[n], a[m], acc[m][n], 0, 0, 0);
        }
#pragma unroll
        for (int m = 0; m < 4; ++m) ep(bt, row0 + m * 16 + fr, col0 + 4 * fq, acc[m][0], acc[m][1]);
    }
}
struct RowMajor { const bf16* p; long ld; __device__ __forceinline__ const bf16* operator()(int, int r, int k) const { return p + (long)r * ld + k; } };

struct Args { const float* in[40]; float* out; unsigned char* ws; int ph_lo, ph_hi; };
struct Frame {
    LAS unsigned char* lds; int tid, lane, wave, vcu, G;
    const float* const* in; float* out; unsigned char* ws;
};
#define WSP(T, off) ((T*)(F.ws + (off)))
__device__ __forceinline__ Frame relocal(const Frame& F0) { Frame F = F0; int t = threadIdx.x; asm volatile("" : "+v"(t)); F.tid = t; F.lane = t & 63; F.wave = __builtin_amdgcn_readfirstlane(t >> 6); int v = F0.vcu; asm volatile("" : "+s"(v)); F.vcu = v; return F; }

constexpr int PH_P0 = 0, PH_P1 = 1, PH_L = 2, PH_PER = 20, N_PHASES = PH_L + 2 * PH_PER;
enum { S_NORM1 = 0, S_G1, S_FNET, S_HY1, S_S5E, S_CARRY, S_HY2, S_S5O, S_GLU, S_HYT, S_WOUT, S_NORM2, S_F0, S_F1, S_F2, S_F3, S_F4, S_F5 };

__device__ __forceinline__ int rowmap(int mode, int row_off, int n) { return mode == 0 ? row_off + n : (32 * (n >> 4) + (n & 15) + (mode == 2 ? 16 : 0)); }
__device__ __forceinline__ void transpose_item(const float* W, int ldw, int col0, int N, bf16* WT, int ldk, int mode, int row_off, LAS float* scr, int item, int lane) {
    const int nblk = N / 32, kb = item / nblk, nb = item % nblk, k0 = 64 * kb, n0 = 32 * nb;
#pragma unroll 8
    for (int i = 0; i < 32; ++i) { const int kk = 2 * i + (lane >> 5); scr[kk * 33 + (lane & 31)] = W[(size_t)(k0 + kk) * ldw + col0 + n0 + (lane & 31)]; }
    asm volatile("s_waitcnt lgkmcnt(0)" ::: "memory");
    const int c = lane & 7;
#pragma unroll
    for (int j = 0; j < 4; ++j) { const int n = (lane >> 3) + 8 * j; const LAS float* s = scr + (8 * c) * 33 + n;
        v4u o; o.x = pk2(s[0 * 33], s[1 * 33]); o.y = pk2(s[2 * 33], s[3 * 33]); o.z = pk2(s[4 * 33], s[5 * 33]); o.w = pk2(s[6 * 33], s[7 * 33]);
        *(v4u*)(WT + (size_t)rowmap(mode, row_off, n0 + n) * ldk + k0 + 8 * c) = o; }
    asm volatile("s_waitcnt lgkmcnt(0)" ::: "memory");
}

__device__ __forceinline__ void p0_transposes(Frame& F) {
    LAS float* scr = (LAS float*)(F.lds + F.wave * 16384);
    const int gw = F.vcu * NWAVES + F.wave, NGW = F.G * NWAVES;
    constexpr int I_IN = 16 * 48, I_OUT = 16 * 32, I_GLU = 6 * 12, I_FG = 16 * 88, I_FD = 44 * 32;
    constexpr int NIT = 2 * (I_IN + I_OUT + I_GLU) + 2 * I_FG + I_FD;
    for (int it = gw; it < NIT; it += NGW) {
        int r = it;
        if (r < 2 * I_IN) { const int l = r / I_IN; transpose_item(F.in[8] + (size_t)l * D * DIN, DIN, 256, 1536, WSP(bf16, WS_WIN) + (size_t)l * PTROWS * D, D, 0, 512, scr, r % I_IN, F.lane); continue; } r -= 2 * I_IN;
        if (r < 2 * I_OUT) { const int l = r / I_OUT; transpose_item(F.in[9] + (size_t)l * D * D, D, 0, D, WSP(bf16, WS_WOUT) + (size_t)l * D * D, D, 0, 0, scr, r % I_OUT, F.lane); continue; } r -= 2 * I_OUT;
        if (r < 2 * I_GLU) { const int l = r / I_GLU; transpose_item(F.in[29] + (size_t)l * 384 * 384, 384, 0, 384, WSP(bf16, WS_GLU) + (size_t)l * 512 * 384, 384, 0, 0, scr, r % I_GLU, F.lane); continue; } r -= 2 * I_GLU;
        if (r < I_FG) { transpose_item(F.in[31], DFF, 0, DFF, WSP(bf16, WS_FGU), D, 1, 0, scr, r, F.lane); continue; } r -= I_FG;
        if (r < I_FG) { transpose_item(F.in[32], DFF, 0, DFF, WSP(bf16, WS_FGU), D, 2, 0, scr, r, F.lane); continue; } r -= I_FG;
        transpose_item(F.in[33], D, 0, D, WSP(bf16, WS_FD), DFF, 0, 0, scr, r, F.lane);
    }
}
__device__ __forceinline__ void moe_transposes(Frame& F_) { Frame F = relocal(F_);
    LAS float* scr = (LAS float*)(F.lds + F.wave * 16384);
    const int gw = F.vcu * NWAVES + F.wave, NGW = F.G * NWAVES;
    constexpr int I_G = 16 * 112, I_D = 56 * 32, PER_E = 2 * I_G + I_D;
    for (int it = gw; it < NE * PER_E; it += NGW) {
        const int e = it / PER_E; int r = it % PER_E;
        bf16* gu = (bf16*)(F.ws + WS_MOEW + (size_t)e * MOE_E_STRIDE); bf16* dn = (bf16*)(F.ws + WS_MOEW + (size_t)e * MOE_E_STRIDE + MOE_GU_BYTES);
        if (r < I_G) { transpose_item(F.in[36] + (size_t)e * D * DFE, DFE, 0, DFE, gu, D, 1, 0, scr, r, F.lane); continue; } r -= I_G;
        if (r < I_G) { transpose_item(F.in[37] + (size_t)e * D * DFE, DFE, 0, DFE, gu, D, 2, 0, scr, r, F.lane); continue; } r -= I_G;
        transpose_item(F.in[38] + (size_t)e * DFE * D, D, 0, D, dn, DFE, 0, 0, scr, r, F.lane);
    }
}

__device__ __forceinline__ void p0_mod_item(Frame& F, int item) {
    const int l = item / 48, cb = item % 48, tid = F.tid;
    LAS float* sc = (LAS float*)F.lds;
    LAS float* red = sc + 17 * 1024;
    for (int i = tid; i < 17 * 1024; i += NTHR) { const int r = i >> 10, k = i & 1023; const float v = r < 16 ? F.in[1][r * D + k] : F.in[3][k]; sc[i] = silu_f(v); }
    __syncthreads();
    const int col = cb * 128 + (tid & 127), kg = tid >> 7;
    const float* W = F.in[4] + (size_t)l * D * 6144 + col;
    float acc[17];
#pragma unroll
    for (int r = 0; r < 17; ++r) acc[r] = 0.f;
    for (int k = kg * 256; k < kg * 256 + 256; ++k) { const float w = W[(size_t)k * 6144];
#pragma unroll
        for (int r = 0; r < 17; ++r) acc[r] += sc[r * 1024 + k] * w; }
#pragma unroll
    for (int r = 0; r < 17; ++r) red[(kg * 17 + r) * 128 + (tid & 127)] = acc[r];
    __syncthreads();
    for (int i = tid; i < 17 * 128; i += NTHR) { const int r = i >> 7, c = i & 127;
        const float s = red[(0 * 17 + r) * 128 + c] + red[(1 * 17 + r) * 128 + c] + red[(2 * 17 + r) * 128 + c] + red[(3 * 17 + r) * 128 + c];
        WSP(float, WS_MOD)[((size_t)l * 17 + r) * 6144 + cb * 128 + c] = s + F.in[5][l * 6144 + cb * 128 + c]; }
    __syncthreads();
}
__device__ __forceinline__ void p0_fold_item(Frame& F, int item) {
    const int kb = item & 7, cs = (item >> 3) & 1, h = (item >> 4) & 3, l = item >> 6, tid = F.tid;
    LAS float* A = (LAS float*)F.lds;
    const float* wf = F.in[10] + ((size_t)l * 4 + h) * 64 * 64;
    for (int i = tid; i < 4096; i += NTHR) { const int d = i >> 6, e2 = i & 63; float s = 0.f;
        for (int e = 0; e < 64; ++e) { const int m = (e * d) & 63; const float tr = cs ? sinpif((float)m * (1.0f / 32.0f)) : cospif((float)m * (1.0f / 32.0f)); s += tr * wf[e * 64 + e2]; }
        A[i] = s * 0.125f; }
    __syncthreads();
    const int e2 = tid & 63;
    const float* win = F.in[8] + (size_t)l * D * DIN + h * 64;
    bf16* wt = WSP(bf16, WS_WIN) + (size_t)l * PTROWS * D + (size_t)(cs * 256 + h * 64 + e2) * D;
    for (int i = 0; i < 16; ++i) { const int kk = kb * 128 + (tid >> 6) + 8 * i; float s = 0.f;
        for (int d = 0; d < 64; ++d) s += win[(size_t)kk * DIN + d] * A[d * 64 + e2];
        wt[kk] = (bf16)f2bf(s); }
    __syncthreads();
}
__device__ __forceinline__ void gen_dft_rows(bf16* dst, int LL, int row0, int nrows, float scale, int tid) {
    const int cpr = 2 * LL / 8;
    for (int i = tid; i < nrows * cpr; i += NTHR) { const int k = row0 + i / cpr, j0 = (i % cpr) * 8; unsigned w[4];
#pragma unroll
        for (int q = 0; q < 4; ++q) { float v[2];
#pragma unroll
            for (int z = 0; z < 2; ++z) { const int j = j0 + 2 * q + z; const int jj = j < LL ? j : j - LL; const int m = (k * jj) & (LL - 1); const float x = (float)m * (2.0f / (float)LL);
                v[z] = (j < LL ? cospif(x) : -sinpif(x)) * scale; }
            w[q] = pk2(v[0], v[1]); }
        *(v4u*)(dst + (size_t)k * 2 * LL + j0) = (v4u){w[0], w[1], w[2], w[3]}; }
}
__device__ __forceinline__ void p0_filter_item(Frame& F, int item) {
    const int l = item / 272, pb = item % 272, tid = F.tid;
    const int LL = pb < 256 ? L : LC, p0 = pb < 256 ? pb * 16 : (pb - 256) * 16;
    LAS float* z = (LAS float*)F.lds;
    LAS float* h1 = z + 16 * 36;
    LAS float* h2 = h1 + 16 * 64;
    for (int i = tid; i < 16 * 33; i += NTHR) { const int pp = i / 33, j = i % 33; const int pos = p0 + pp;
        const double w = 6.283185307179586 * (double)pos / (double)LL; double v;
        if (j == 0) v = (double)pos / (double)(LL - 1);
        else { const int bj = (j - 1) & 15; const double band = 1e-4 + (double)bj * ((15.0 - 1e-4) / 15.0); v = j <= 16 ? cos(band * w) : -sin(band * w); }
        z[pp * 36 + j] = (float)v; }
    __syncthreads();
    for (int i = tid; i < 1024; i += NTHR) { const int pp = i >> 6, o = i & 63; float s = F.in[14][l * 64 + o];
        for (int j = 0; j < 33; ++j) s += z[pp * 36 + j] * F.in[13][((size_t)l * 33 + j) * 64 + o];
        h1[i] = sinf(F.in[15][l * 64 + o] * s); }
    __syncthreads();
    for (int i = tid; i < 1024; i += NTHR) { const int pp = i >> 6, o = i & 63; float s = F.in[17][l * 64 + o];
        for (int j = 0; j < 64; ++j) s += h1[pp * 64 + j] * F.in[16][((size_t)l * 64 + j) * 64 + o];
        h2[i] = sinf(F.in[18][l * 64 + o] * s); }
    __syncthreads();
    float* HT = WSP(float, WS_HT) + ((size_t)l * 4352 + (pb < 256 ? 0 : 4096)) * 1536;
    float* PS = WSP(float, WS_PS) + ((size_t)l * 272 + pb) * 1536;
    const float* fw3 = F.in[19] + (size_t)l * 64 * 1536;
    const float dmin = 3.0701134573253945f, dstep = (15.350567286626973f - 3.0701134573253945f) / 383.0f;
#pragma unroll 1
    for (int cc = 0; cc < 3; ++cc) { const int col = tid + 512 * cc; float acc[16];
#pragma unroll
        for (int pp = 0; pp < 16; ++pp) acc[pp] = 0.f;
        for (int j = 0; j < 64; ++j) { const float w = fw3[(size_t)j * 1536 + col];
#pragma unroll
            for (int pp = 0; pp < 16; ++pp) acc[pp] += h2[pp * 64 + j] * w; }
        const int c = col % 384, dir = col / 768; const float delta = dmin + (float)c * dstep; float ps = 0.f;
#pragma unroll
        for (int pp = 0; pp < 16; ++pp) { const int pos = p0 + pp; const float t = (float)pos / (float)(LL - 1); const float v = acc[pp] * __expf(-t * delta);
            HT[(size_t)pos * 1536 + col] = v; if (!(dir == 1 && pos == 0)) ps += fabsf(v); }
        PS[col] = ps; }
    __syncthreads();
}
__device__ __forceinline__ void p0_s5_item(Frame& F, int item) {
    const int l = item / 24, g = item % 24, tid = F.tid;
    LAS f32x2* apow = (LAS f32x2*)F.lds;
    LAS f32x2* bbar = apow + 2 * 17 * 64;
    LAS f32x2* Cc = bbar + 2 * 64 * 16;
    LAS float* Kd = (LAS float*)(Cc + 2 * 16 * 64);
    if (tid < 128) { const int dir = tid >> 6, p = tid & 63; const size_t ix = (((size_t)l * 2 + dir) * 24 + g) * 64 + p;
        const double are = F.in[21][ix], aim = F.in[22][ix], dt = exp((double)F.in[23][((size_t)l * 2 + dir) * 24 + g]);
        for (int tau = 0; tau <= 16; ++tau) { const double mg = exp(are * dt * tau), an = aim * dt * tau; apow[(dir * 17 + tau) * 64 + p] = (f32x2){(float)(mg * cos(an)), (float)(mg * sin(an))}; }
        const double mg = exp(are * dt), an = aim * dt; const double nr = mg * cos(an) - 1.0, ni = mg * sin(an); const double den = are * are + aim * aim;
        const double qr = (nr * are + ni * aim) / den, qi = (ni * are - nr * aim) / den;
        for (int h = 0; h < 16; ++h) { const double br = F.in[24][ix * 16 + h], bi = F.in[25][ix * 16 + h]; bbar[(dir * 64 + p) * 16 + h] = (f32x2){(float)(qr * br - qi * bi), (float)(qr * bi + qi * br)}; }
        const double m16 = exp(are * dt * 16.0), a16 = aim * dt * 16.0;
        WSP(float, WS_A16)[ix * 2 + 0] = (float)(m16 * cos(a16)); WSP(float, WS_A16)[ix * 2 + 1] = (float)(m16 * sin(a16)); }
    for (int i = tid; i < 2 * 16 * 64; i += NTHR) { const int dir = i >> 10, h = (i >> 6) & 15, p = i & 63; const size_t ix = ((((size_t)l * 2 + dir) * 24 + g) * 16 + h) * 64 + p;
        Cc[i] = (f32x2){F.in[26][ix], F.in[27][ix]}; }
    __syncthreads();
    for (int i = tid; i < 2 * 16 * 256; i += NTHR) { const int dir = i >> 12, tau = (i >> 8) & 15, h = (i >> 4) & 15, h2 = i & 15; float s = 0.f;
        for (int p = 0; p < 64; ++p) { const f32x2 a = apow[(dir * 17 + tau) * 64 + p], b = bbar[(dir * 64 + p) * 16 + h2], c = Cc[(dir * 16 + h) * 64 + p];
            const float tr = a.x * b.x - a.y * b.y, ti = a.x * b.y + a.y * b.x; s += c.x * tr - c.y * ti; }
        Kd[i] = s; }
    __syncthreads();
    bf16* EST = (bf16*)(F.ws + WS_S5M + (size_t)item * S5M_STRIDE); bf16* MOUT = EST + 256 * 256;
    for (int i = tid; i < 256 * 256; i += NTHR) { const int n = i >> 8, k = i & 255; const int dir = n >> 7, p = (n >> 1) & 63, ri = n & 1, hh = k >> 4, j = k & 15;
        const int tau = dir == 0 ? 15 - j : j; const f32x2 a = apow[(dir * 17 + tau) * 64 + p], b = bbar[(dir * 64 + p) * 16 + hh];
        const float v = ri == 0 ? a.x * b.x - a.y * b.y : a.x * b.y + a.y * b.x; EST[i] = (bf16)f2bf(v); }
    const float* dsk = F.in[28] + (size_t)l * 384 + g * 16;
    for (int i = tid; i < 256 * 512; i += NTHR) { const int n = i >> 9, k = i & 511; const int j = n >> 4, h = n & 15; float v;
        if (k < 256) { const int hh = k >> 4, ii = k & 15; v = 0.f;
            if (ii <= j) v += Kd[((0 * 16 + (j - ii)) * 16 + h) * 16 + hh];
            if (ii >= j) v += Kd[((1 * 16 + (ii - j)) * 16 + h) * 16 + hh];
            if (ii == j && h == hh) v += dsk[h]; }
        else { const int comp = k - 256, dir = comp >> 7, p = (comp >> 1) & 63, ri = comp & 1; const int tau = dir == 0 ? j + 1 : 16 - j;
            const f32x2 a = apow[(dir * 17 + tau) * 64 + p], c = Cc[(dir * 16 + h) * 64 + p];
            v = ri == 0 ? (c.x * a.x - c.y * a.y) : -(c.x * a.y + c.y * a.x); }
        MOUT[i] = (bf16)f2bf(v); }
    __syncthreads();
}
__device__ __forceinline__ void p0_prologue(Frame& F_) { Frame F = relocal(F_);
    p0_transposes(F);
    __syncthreads();
    for (int i = F.vcu * NTHR + F.tid; i < 2 * 128 * 384 / 8; i += F.G * NTHR) { const int l = i / (128 * 384 / 8), r = i % (128 * 384 / 8);
        *(v4u*)(WSP(bf16, WS_GLU) + (size_t)l * 512 * 384 + 384 * 384 + (size_t)r * 8) = (v4u){0u, 0u, 0u, 0u}; }
    constexpr int I_MOD = 96, I_FOLD = 128, I_DFT = 512, I_DFTC = 4, I_FIL = 544, I_S5 = 48, NIT = I_MOD + I_FOLD + I_DFT + I_DFTC + I_FIL + I_S5;
    for (int it = F.vcu; it < NIT; it += F.G) {
        int r = it;
        if (r < I_FIL) { p0_filter_item(F, r); continue; } r -= I_FIL;
        if (r < I_MOD) { p0_mod_item(F, r); continue; } r -= I_MOD;
        if (r < I_FOLD) { p0_fold_item(F, r); continue; } r -= I_FOLD;
        if (r < I_S5) { p0_s5_item(F, r); continue; } r -= I_S5;
        if (r < I_DFT) { gen_dft_rows(WSP(bf16, WS_DFT), L, r * 8, 8, 1.0f / 64.0f, F.tid); continue; } r -= I_DFT;
        gen_dft_rows(WSP(bf16, WS_DFTC), LC, r * 64, 64, 1.0f / 16.0f, F.tid);
    }
}
__device__ __forceinline__ void p1_item(Frame& F_, int item) { Frame F = relocal(F_);
    const int l = item / 1632; int r = item % 1632; const int set = r < 1536 ? 0 : 1; if (set) r -= 1536;
    const int npb = set ? 4 : 64, LL = set ? LC : L, pb = r % npb, ocb = r / npb, o = ocb / 12, cb = ocb % 12, tid = F.tid;
    LAS float* red = (LAS float*)F.lds;
    LAS float* inv = red + 512;
    LAS float* T = inv + 32;
    const float* PS = WSP(float, WS_PS) + ((size_t)l * 272 + (set ? 256 : 0)) * 1536;
    { const int ch = tid & 31, part = tid >> 5; float s = 0.f; const int nblk = LL / 16;
      for (int b = part; b < nblk; b += 16) s += PS[(size_t)b * 1536 + o * 384 + cb * 32 + ch] + PS[(size_t)b * 1536 + 768 + o * 384 + cb * 32 + ch];
      red[part * 32 + ch] = s; }
    __syncthreads();
    if (tid < 32) { float s = 0.f; for (int p = 0; p < 16; ++p) s += red[p * 32 + tid]; inv[tid] = 1.0f / s; }
    const float* HT = WSP(float, WS_HT) + ((size_t)l * 4352 + (set ? 4096 : 0)) * 1536;
    { const int ch = tid & 31, dir = (tid >> 5) & 1;
      for (int i = 0; i < 8; ++i) { const int pp = (tid >> 6) + 8 * i; T[(dir * 64 + pp) * 33 + ch] = HT[(size_t)(pb * 64 + pp) * 1536 + dir * 768 + o * 384 + cb * 32 + ch]; } }
    __syncthreads();
    float* KT = set ? WSP(float, WS_KTC) + ((size_t)(l * 2 + o) * 384) * 512 : WSP(float, WS_KT) + ((size_t)(l * 2 + o) * 384) * 8192;
    { const int pp = tid & 63;
      for (int i = 0; i < 4; ++i) { const int ch = (tid >> 6) + 8 * i; const int pos = pb * 64 + pp; float* kt = KT + (size_t)(cb * 32 + ch) * 2 * LL;
          kt[LL + pos] = T[(0 * 64 + pp) * 33 + ch] * inv[ch];
          if (pos > 0) kt[LL - pos] = T[(1 * 64 + pp) * 33 + ch] * inv[ch]; else kt[0] = 0.f; } }
    __syncthreads();
}

__device__ __forceinline__ void norm_rows(Frame& F_, const float* xlat, const float* xctx, int nrows, const float* gain, const float* mod, int sh_off, int sc_off, bf16* out) { Frame F = relocal(F_);
    const int gw = F.vcu * NWAVES + F.wave, NGW = F.G * NWAVES, lane = F.lane;
    for (int r = gw; r < nrows; r += NGW) {
        const float* xr = r < NL ? xlat + (size_t)r * D : xctx + (size_t)(r - NL) * D;
        const float* md = mod + (size_t)bidx_of(r) * 6144;
        f32x4 v[4]; float ss = 0.f;
#pragma unroll
        for (int j = 0; j < 4; ++j) { v[j] = ((const f32x4*)xr)[64 * j + lane]; ss += (v[j].x * v[j].x + v[j].y * v[j].y) + (v[j].z * v[j].z + v[j].w * v[j].w); }
        const float rstd = 1.0f / sqrtf(wave_sum(ss) * (1.0f / D) + 1e-6f);
#pragma unroll
        for (int j = 0; j < 4; ++j) { const int col = (64 * j + lane) * 4; const f32x4 g4 = *(const f32x4*)(gain + col), sc = *(const f32x4*)(md + sc_off + col), sh = *(const f32x4*)(md + sh_off + col);
            const f32x4 h = v[j] * rstd * g4 * (sc + 1.0f) + sh;
            *(v2u*)(out + (size_t)r * D + col) = (v2u){pk2(h.x, h.y), pk2(h.z, h.w)}; }
    }
}
__device__ __forceinline__ void norm2_router(Frame& F_, const float* x, const float* gain, const float* mod, bf16* out) { Frame F = relocal(F_);
    LAS int* hist = (LAS int*)F.lds;
    const float* rw = F.in[34]; const float* rb = F.in[35];
    for (int tile = F.vcu; tile < NL / 256; tile += F.G) {
        if (F.tid < 16) hist[F.tid] = 0;
        __syncthreads();
        for (int i = 0; i < 32; ++i) { const int r = tile * 256 + F.wave * 32 + i, lane = F.lane;
            const float* xr = x + (size_t)r * D; const float* md = mod + (size_t)(r >> 12) * 6144;
            f32x4 v[4]; float ss = 0.f;
#pragma unroll
            for (int j = 0; j < 4; ++j) { v[j] = ((const f32x4*)xr)[64 * j + lane]; ss += (v[j].x * v[j].x + v[j].y * v[j].y) + (v[j].z * v[j].z + v[j].w * v[j].w); }
            const float rstd = 1.0f / sqrtf(wave_sum(ss) * (1.0f / D) + 1e-6f);
            float lg[8];
#pragma unroll
            for (int e = 0; e < 8; ++e) lg[e] = 0.f;
#pragma unroll
            for (int j = 0; j < 4; ++j) { const int col = (64 * j + lane) * 4; const f32x4 g4 = *(const f32x4*)(gain + col), sc = *(const f32x4*)(md + 4096 + col), sh = *(const f32x4*)(md + 3072 + col);
                const f32x4 h = v[j] * rstd * g4 * (sc + 1.0f) + sh;
                *(v2u*)(out + (size_t)r * D + col) = (v2u){pk2(h.x, h.y), pk2(h.z, h.w)};
#pragma unroll
                for (int q = 0; q < 4; ++q) { const f32x4 w0 = *(const f32x4*)(rw + (size_t)(col + q) * 8), w1 = *(const f32x4*)(rw + (size_t)(col + q) * 8 + 4); const float hv = h[q];
                    lg[0] += hv * w0.x; lg[1] += hv * w0.y; lg[2] += hv * w0.z; lg[3] += hv * w0.w; lg[4] += hv * w1.x; lg[5] += hv * w1.y; lg[6] += hv * w1.z; lg[7] += hv * w1.w; } }
#pragma unroll
            for (int e = 0; e < 8; ++e) lg[e] = wave_sum(lg[e]) + rb[e];
            if (lane == 0) {
                int e1 = 0; float v1 = lg[0];
#pragma unroll
                for (int e = 1; e < 8; ++e) if (lg[e] > v1) { v1 = lg[e]; e1 = e; }
                int e2 = -1; float v2 = -3.4e38f;
#pragma unroll
                for (int e = 0; e < 8; ++e) if (e != e1 && lg[e] > v2) { v2 = lg[e]; e2 = e; }
                const float ex = __expf(v2 - v1), w1 = 1.0f / (1.0f + ex), w2 = ex / (1.0f + ex);
                *(v4u*)(F.ws + WS_TOPK + (size_t)r * 16) = (v4u){(unsigned)(e1 | (e2 << 8)), __builtin_bit_cast(unsigned, w1), __builtin_bit_cast(unsigned, w2), 0u};
                __hip_atomic_fetch_add(hist + e1, 1, __ATOMIC_RELAXED, __HIP_MEMORY_SCOPE_WORKGROUP); __hip_atomic_fetch_add(hist + 8 + e2, 1, __ATOMIC_RELAXED, __HIP_MEMORY_SCOPE_WORKGROUP);
            } }
        __syncthreads();
        if (F.tid < 16) ((int*)(F.ws + WS_META + META_CNT))[tile * 16 + F.tid] = hist[F.tid];
        __syncthreads();
    }
}
__device__ __forceinline__ void moe_slots(Frame& F_) { Frame F = relocal(F_);
    LAS int* tot = (LAS int*)F.lds;
    LAS int* es = tot + 32;
    const int* CNT = (const int*)(F.ws + WS_META + META_CNT); int* IDX = (int*)(F.ws + WS_META + META_IDX); int* TE = (int*)(F.ws + WS_META + META_TE); int* NT = (int*)(F.ws + WS_META + META_NT);
    for (int it = F.vcu; it < 512; it += F.G) { const int k = it >> 8, tile = it & 255, tid = F.tid;
        if (tid < 8) { int t = 0, b = 0; for (int i = 0; i < 256; ++i) { const int c = CNT[i * 16 + k * 8 + tid]; if (i < tile) b += c; t += c; } tot[tid] = t; tot[8 + tid] = b; }
        __syncthreads();
        if (tid == 0) { int s = 0; for (int e = 0; e < 8; ++e) { tot[16 + e] = s; s += (tot[e] + 255) & ~255; } tot[24] = s; }
        if (tid < 256) { const unsigned pk = *(const unsigned*)(F.ws + WS_TOPK + (size_t)(tile * 256 + tid) * 16); es[tid] = k == 0 ? (int)(pk & 255u) : (int)((pk >> 8) & 255u); }
        __syncthreads();
        if (tid < 256) { const int e = es[tid]; int rank = 0; for (int j = 0; j < tid; ++j) rank += (es[j] == e) ? 1 : 0;
            IDX[k * MAXSLOT + tot[16 + e] + tot[8 + e] + rank] = tile * 256 + tid; }
        if (tile == 0) {
            for (int e = 0; e < 8; ++e) { const int n = tot[e], np = (n + 255) & ~255, sb = tot[16 + e];
                for (int i = n + tid; i < np; i += NTHR) IDX[k * MAXSLOT + sb + i] = -1;
                for (int i = tid; i < np / 256; i += NTHR) TE[k * 272 + sb / 256 + i] = e; }
            if (tid == 0) NT[k] = tot[24] / 256; }
        __syncthreads();
    }
}
__device__ __forceinline__ void final_norm(Frame& F_) { Frame F = relocal(F_);
    const int gw = F.vcu * NWAVES + F.wave, NGW = F.G * NWAVES, lane = F.lane; const float* gain = F.in[39];
    for (int r = gw; r < NL; r += NGW) { float* xr = F.out + (size_t)r * D; f32x4 v[4]; float ss = 0.f;
#pragma unroll
        for (int j = 0; j < 4; ++j) { v[j] = ((const f32x4*)xr)[64 * j + lane]; ss += (v[j].x * v[j].x + v[j].y * v[j].y) + (v[j].z * v[j].z + v[j].w * v[j].w); }
        const float rstd = 1.0f / sqrtf(wave_sum(ss) * (1.0f / D) + 1e-6f);
#pragma unroll
        for (int j = 0; j < 4; ++j) { const int col = (64 * j + lane) * 4; ((f32x4*)xr)[64 * j + lane] = v[j] * rstd * *(const f32x4*)(gain + col); } }
}

__device__ __forceinline__ float sconv(const bf16* prow, int colbase, int t, int LL, bool grid, float w0, float w1, float w2, float bias) {
    const bool hasl = grid ? ((t & 63) != 0) : (t > 0), hasr = grid ? ((t & 63) != 63) : (t < LL - 1);
    const float c = bf2f(prow[colbase + t]), a = hasl ? bf2f(prow[colbase + t - 1]) : 0.f, b = hasr ? bf2f(prow[colbase + t + 1]) : 0.f;
    return a * w0 + c * w1 + b * w2 + bias;
}
template <int LL, int NT, int NBT>
__device__ __forceinline__ void hyena_unit(Frame& F, int l, int o, int c, int b0, bool latent) {
    constexpr int TPB = LL / NT, BG = NTHR / TPB, NBU = BG * NBT;
    LAS float* kk = (LAS float*)F.lds;
    LAS float* us = kk + 2 * LL;
    const int tid = F.tid;
    const bf16* PT = WSP(bf16, WS_PT);
    const float* cw = F.in[11] + (size_t)l * 3 * 1152; const float* cb = F.in[12] + (size_t)l * 1152;
    const int in_row = R_HY + c;
    const int mul_row = R_HY + 384 * (o + 1) + c, mul_ch = 384 * (o + 1) + c;
    const int out_row = o == 0 ? R_HY + c : R_HY + 384 + c;
    const float* KT = latent ? WSP(float, WS_KT) + ((size_t)(l * 2 + o) * 384 + c) * 8192 : WSP(float, WS_KTC) + ((size_t)(l * 2 + o) * 384 + c) * 512;
    for (int i = tid; i < 2 * LL; i += NTHR) kk[i] = KT[i];
    { const float w0 = cw[c], w1 = cw[1152 + c], w2 = cw[2304 + c], bs = cb[c];
      for (int i = tid; i < NBU * LL; i += NTHR) { const int bb = i / LL, t = i % LL; const int colbase = latent ? (b0 + bb) * L : NL + (b0 + bb) * LC;
          us[i] = o == 0 ? sconv(PT + (size_t)in_row * MT, colbase, t, LL, latent, w0, w1, w2, bs) : bf2f(PT[(size_t)in_row * MT + colbase + t]); } }
    __syncthreads();
    float acc[NBT][NT];
#pragma unroll
    for (int bj = 0; bj < NBT; ++bj)
#pragma unroll
        for (int tj = 0; tj < NT; ++tj) acc[bj][tj] = 0.f;
    const int tb = tid % TPB, bg = tid / TPB;
#pragma unroll 4
    for (int s = 0; s < LL; ++s) { float kv[NT], uv[NBT];
#pragma unroll
        for (int tj = 0; tj < NT; ++tj) kv[tj] = kk[LL + tb + TPB * tj - s];
#pragma unroll
        for (int bj = 0; bj < NBT; ++bj) uv[bj] = us[(bg + BG * bj) * LL + s];
#pragma unroll
        for (int bj = 0; bj < NBT; ++bj)
#pragma unroll
            for (int tj = 0; tj < NT; ++tj) acc[bj][tj] += kv[tj] * uv[bj]; }
    const float hb = F.in[20][((size_t)l * 2 + o) * 384 + c];
    const float m0 = cw[mul_ch], m1 = cw[1152 + mul_ch], m2 = cw[2304 + mul_ch], mb = cb[mul_ch];
    bf16* PTw = WSP(bf16, WS_PT);
#pragma unroll
    for (int bj = 0; bj < NBT; ++bj)
#pragma unroll
        for (int tj = 0; tj < NT; ++tj) { const int bb = bg + BG * bj, t = tb + TPB * tj; const int colbase = latent ? (b0 + bb) * L : NL + (b0 + bb) * LC;
            const float uval = us[bb * LL + t]; const float xm = sconv(PT + (size_t)mul_row * MT, colbase, t, LL, latent, m0, m1, m2, mb);
            PTw[(size_t)out_row * MT + colbase + t] = (bf16)f2bf(xm * (acc[bj][tj] + hb * uval)); asm volatile("" ::: "memory"); }
    __syncthreads();
}
__device__ __forceinline__ void hyena_stage(Frame& F_, int l, int o) { Frame F = relocal(F_);
    const int nlat = 384 * 4, nctx = l == 0 ? 384 : 0;
    for (int u = F.vcu; u < nlat + nctx; u += F.G) {
        if (u < nlat) hyena_unit<L, 8, 4>(F, l, o, u >> 2, (u & 3) * 4, true);
        else hyena_unit<LC, 1, 8>(F, l, o, u - nlat, 0, false);
    }
}
__device__ __forceinline__ void hyena_transpose(Frame& F_, int nrows) { Frame F = relocal(F_);
    LAS bf16* T = (LAS bf16*)F.lds; constexpr int PITCH = 258;
    const bf16* PT = WSP(bf16, WS_PT); bf16* Y = WSP(bf16, WS_HMOD); const int tid = F.tid;
    const int nrt = nrows / 256;
    for (int it = F.vcu; it < 6 * nrt; it += F.G) { const int cb = it % 6, rt = it / 6;
        { const int c = tid >> 3, seg = tid & 7; const bf16* src = PT + (size_t)(R_HY + 384 + cb * 64 + c) * MT + rt * 256 + seg * 32;
#pragma unroll
          for (int q = 0; q < 4; ++q) { const v4u v = *(const v4u*)(src + q * 8); LAS unsigned* d = (LAS unsigned*)(T + c * PITCH + seg * 32 + q * 8); d[0] = v.x; d[1] = v.y; d[2] = v.z; d[3] = v.w; } }
        __syncthreads();
        { const int r = tid >> 1, half = tid & 1; unsigned w[16];
#pragma unroll
          for (int q = 0; q < 16; ++q) { const unsigned lo = T[(half * 32 + 2 * q) * PITCH + r], hi = T[(half * 32 + 2 * q + 1) * PITCH + r]; w[q] = lo | (hi << 16); }
          bf16* dst = Y + (size_t)(rt * 256 + r) * D + 256 + cb * 64 + half * 32;
#pragma unroll
          for (int q = 0; q < 4; ++q) *(v4u*)(dst + q * 8) = (v4u){w[4 * q], w[4 * q + 1], w[4 * q + 2], w[4 * q + 3]}; }
        __syncthreads();
    }
}

__device__ __forceinline__ void s5_carry(Frame& F_, int l) { Frame F = relocal(F_);
    const float* E = (const float*)((unsigned char*)F.out + DO_E); bf16* HS = (bf16*)((unsigned char*)F.out + DO_HS);
    const int id = F.vcu * NTHR + F.tid;
    if (id >= NB * 24 * 128) return;
    const int p = id & 63, dir = (id >> 6) & 1, g = (id >> 7) % 24, b = id / (128 * 24);
    const size_t ix = (((size_t)l * 2 + dir) * 24 + g) * 64 + p; const float ar = WSP(float, WS_A16)[ix * 2], ai = WSP(float, WS_A16)[ix * 2 + 1];
    const int comp = dir * 128 + 2 * p, q = comp >> 4, i0 = comp & 15;
    float sr = 0.f, si = 0.f;
    for (int step = 0; step < 272; ++step) {
        int cidx;
        if (dir == 0) cidx = step < 16 ? NL / 16 + b * 16 + step : b * 256 + (step - 16);
        else cidx = step < 16 ? NL / 16 + b * 16 + (15 - step) : b * 256 + (255 - (step - 16));
        *(unsigned*)(HS + (size_t)(g * 16 + q) * MT + (size_t)cidx * 16 + i0) = pk2(sr, si);
        const f32x2 e = *(const f32x2*)(E + ((size_t)g * NCHUNK + cidx) * 256 + comp);
        const float nr = ar * sr - ai * si + e.x, ni = ar * si + ai * sr + e.y; sr = nr; si = ni;
    }
}

struct A_WinT { const bf16* w; __device__ __forceinline__ const bf16* operator()(int, int r, int k) const { return w + (size_t)r * D + k; } };
struct E_PT { bf16* pt; __device__ __forceinline__ void operator()(int, int r, int c, f32x4 v0, f32x4 v1) const {
    *(v2u*)(pt + (size_t)r * MT + c) = (v2u){pk2(v0.x, v0.y), pk2(v0.z, v0.w)}; *(v2u*)(pt + (size_t)r * MT + c + 16) = (v2u){pk2(v1.x, v1.y), pk2(v1.z, v1.w)}; } };
struct A_Dft { const bf16* d; int ld; __device__ __forceinline__ const bf16* operator()(int, int r, int k) const { return d + (size_t)r * ld + k; } };
struct B_FnetLat { const bf16* pt; __device__ __forceinline__ const bf16* operator()(int bt, int n, int k) const { return pt + (size_t)((k >> 12) * 256 + n) * MT + bt * L + (k & 4095); } };
struct B_FnetCtx { const bf16* pt; __device__ __forceinline__ const bf16* operator()(int bt, int n, int k) const { return pt + (size_t)((k >> 8) * 256 + n) * MT + NL + bt * LC + (k & 255); } };
struct E_Fnet { bf16* y; int rowbase, rows_per; __device__ __forceinline__ void operator()(int bt, int r, int c, f32x4 v0, f32x4 v1) const { bf16* p = y + (size_t)(rowbase + bt * rows_per + r) * D + c;
    *(v2u*)p = (v2u){pk2(v0.x, v0.y), pk2(v0.z, v0.w)}; *(v2u*)(p + 16) = (v2u){pk2(v1.x, v1.y), pk2(v1.z, v1.w)}; } };
struct A_S5 { const bf16* pt; const bf16* hs; __device__ __forceinline__ const bf16* operator()(int g, int r, int k) const {
    return k < 256 ? pt + (size_t)(R_S5 + g * 16 + (k >> 4)) * MT + (size_t)r * 16 + (k & 15) : hs + (size_t)(g * 16 + ((k - 256) >> 4)) * MT + (size_t)r * 16 + (k & 15); } };
struct B_S5 { const bf16* m; int off, ld; __device__ __forceinline__ const bf16* operator()(int g, int n, int k) const { return (const bf16*)((const unsigned char*)m + (size_t)g * S5M_STRIDE) + off + (size_t)n * ld + k; } };
struct E_S5E { float* e; __device__ __forceinline__ void operator()(int g, int r, int c, f32x4 v0, f32x4 v1) const { float* p = e + ((size_t)g * NCHUNK + r) * 256 + c; *(f32x4*)p = v0; *(f32x4*)(p + 16) = v1; } };
struct E_S5O { bf16* ys; __device__ __forceinline__ void operator()(int g, int r, int c, f32x4 v0, f32x4 v1) const {
    { const int j = c >> 4, h = c & 15; bf16* p = ys + ((size_t)r * 16 + j) * 384 + g * 16 + h; *(v2u*)p = (v2u){pk2(gelu_tanh_f(v0.x), gelu_tanh_f(v0.y)), pk2(gelu_tanh_f(v0.z), gelu_tanh_f(v0.w))}; }
    { const int c1 = c + 16, j = c1 >> 4, h = c1 & 15; bf16* p = ys + ((size_t)r * 16 + j) * 384 + g * 16 + h; *(v2u*)p = (v2u){pk2(gelu_tanh_f(v1.x), gelu_tanh_f(v1.y)), pk2(gelu_tanh_f(v1.z), gelu_tanh_f(v1.w))}; } } };
struct E_Glu { const bf16* ys; bf16* y; const float* gb; __device__ __forceinline__ void one(int r, int c, f32x4 v) const { if (c >= 384) return;
    const v2u yv = *(const v2u*)(ys + (size_t)r * 384 + c); const f32x4 b = *(const f32x4*)(gb + c);
    const float y0 = bf2f(yv.x & 0xffffu), y1 = bf2f(yv.x >> 16), y2 = bf2f(yv.y & 0xffffu), y3 = bf2f(yv.y >> 16);
    *(v2u*)(y + (size_t)r * D + 640 + c) = (v2u){pk2(y0 * sigmoid_f(v.x + b.x), y1 * sigmoid_f(v.y + b.y)), pk2(y2 * sigmoid_f(v.z + b.z), y3 * sigmoid_f(v.w + b.w))}; }
    __device__ __forceinline__ void operator()(int, int r, int c, f32x4 v0, f32x4 v1) const { one(r, c, v0); one(r, c + 16, v1); } };
struct E_Res { const float* xlat; const float* xctx; float* xo; const float* mod; int goff; __device__ __forceinline__ void one(int r, int c, f32x4 v) const {
    const float* xi = r < NL ? xlat + (size_t)r * D + c : xctx + (size_t)(r - NL) * D + c; const f32x4 g = *(const f32x4*)(mod + (size_t)bidx_of(r) * 6144 + goff + c);
    *(f32x4*)(xo + (size_t)r * D + c) = *(const f32x4*)xi + g * v; }
    __device__ __forceinline__ void operator()(int, int r, int c, f32x4 v0, f32x4 v1) const { one(r, c, v0); one(r, c + 16, v1); } };
struct E_Swi { bf16* act; int ld; __device__ __forceinline__ void operator()(int, int r, int c, f32x4 v0, f32x4 v1) const {
    const int f = 16 * (c >> 5) + (c & 15); *(v2u*)(act + (size_t)r * ld + f) = (v2u){pk2(silu_f(v0.x) * v1.x, silu_f(v0.y) * v1.y), pk2(silu_f(v0.z) * v1.z, silu_f(v0.w) * v1.w)}; } };
struct A_MoeUp { const bf16* h; const int* idx; __device__ __forceinline__ const bf16* operator()(int, int r, int k) const { int t = idx[r]; t = t < 0 ? 0 : t; return h + (size_t)t * D + k; } };
struct E_MoeDown { float* x; const int* idx; const unsigned char* topk; const float* mod; int k; __device__ __forceinline__ void one(int r, int c, f32x4 v) const {
    const int t = idx[r]; if (t < 0) return; const float w = *(const float*)(topk + (size_t)t * 16 + 4 + 4 * k); const f32x4 g = *(const f32x4*)(mod + (size_t)(t >> 12) * 6144 + 5120 + c);
    float* p = x + (size_t)t * D + c; *(f32x4*)p = *(const f32x4*)p + g * (v * w); }
    __device__ __forceinline__ void operator()(int, int r, int c, f32x4 v0, f32x4 v1) const { one(r, c, v0); one(r, c + 16, v1); } };

template <class AF, class EP>
__device__ __forceinline__ void gemm_moe(int mtiles, int ntiles, int K, const AF& af, const unsigned char* wbase, size_t woff, int ldb, const int* te, const EP& ep, int vcu, int G) {
    int tid = threadIdx.x; asm volatile("" : "+v"(tid)); asm volatile("" : "+s"(vcu)); const int wid = tid >> 6, lane = tid & 63, wr = wid >> 2, wc = wid & 3, fr = lane & 15, fq = lane >> 4;
    const int nunits = mtiles * ntiles;
    for (int u = vcu; u < nunits; u += G) {
        const int pm = u / ntiles, pn = u - pm * ntiles;
        const int row0 = pm * 128 + wr * 64, col0 = pn * 128 + wc * 32;
        const bf16* B = (const bf16*)(wbase + (size_t)te[pm >> 1] * MOE_E_STRIDE + woff);
        f32x4 acc[4][2];
#pragma unroll
        for (int m = 0; m < 4; ++m) { acc[m][0] = (f32x4){0.f, 0.f, 0.f, 0.f}; acc[m][1] = (f32x4){0.f, 0.f, 0.f, 0.f}; }
#pragma unroll 2
        for (int k = 0; k < K; k += 32) {
            bf16x8 a[4], b[2];
#pragma unroll
            for (int m = 0; m < 4; ++m) a[m] = *(const bf16x8*)af(0, row0 + m * 16 + fr, k + fq * 8);
#pragma unroll
            for (int n = 0; n < 2; ++n) b[n] = *(const bf16x8*)(B + (size_t)(col0 + n * 16 + fr) * ldb + k + fq * 8);
#pragma unroll
            for (int m = 0; m < 4; ++m)
#pragma unroll
                for (int n = 0; n < 2; ++n) acc[m][n] = __builtin_amdgcn_mfma_f32_16x16x32_bf16(b[n], a[m], acc[m][n], 0, 0, 0);
        }
#pragma unroll
        for (int m = 0; m < 4; ++m) ep(0, row0 + m * 16 + fr, col0 + 4 * fq, acc[m][0], acc[m][1]);
    }
}

__global__ void __launch_bounds__(NTHR, 2) mega(Args args) {
    extern __shared__ __attribute__((aligned(16))) unsigned char lds[];
    Frame F;
    F.lds = (LAS unsigned char*)lds; F.tid = threadIdx.x; F.lane = F.tid & 63; F.wave = __builtin_amdgcn_readfirstlane(F.tid >> 6);
    F.G = gridDim.x; { const int bx = blockIdx.x; F.vcu = (F.G % 8 == 0) ? (bx % 8) * (F.G / 8) + bx / 8 : bx; }
    F.in = args.in; F.out = args.out; F.ws = args.ws;
    volatile LAS unsigned* MISC = (volatile LAS unsigned*)(F.lds + LDS_MISC);
    if (F.tid < 16) MISC[F.tid] = 0u;
    __syncthreads();
    XcdBarrier bar; bar.bar = (unsigned*)(F.ws + WS_CTL) + 4096; bar.x = 0; bar.st = nullptr;
    const int lo = args.ph_lo, hi = args.ph_hi;
    if (hi - lo > 1) bar = xcd_barrier_post((unsigned*)(F.ws + WS_CTL) + 4096, MISC + 8);
#define IN(k) (lo <= (k) && (k) < hi)
#define SEAM(k) do { if (IN(k) && IN((k) + 1)) xcd_barrier(bar); } while (0)

    if (IN(PH_P0)) { p0_prologue(F); } SEAM(PH_P0);
    if (IN(PH_P1)) { for (int it = F.vcu; it < 2 * 1632; it += F.G) p1_item(F, it); } SEAM(PH_P1);

    const float* MOD = WSP(float, WS_MOD);
    bf16* HM = WSP(bf16, WS_HMOD); bf16* PT = WSP(bf16, WS_PT); float* BUFA = WSP(float, WS_BUFA);
    float* E = (float*)((unsigned char*)F.out + DO_E); bf16* HS = (bf16*)((unsigned char*)F.out + DO_HS); bf16* YS = (bf16*)((unsigned char*)F.out + DO_YS);
#pragma unroll 1
    for (int l = 0; l < 2; ++l) {
        const int pb = PH_L + l * PH_PER;
        const float* mod = MOD + (size_t)l * 17 * 6144;
        const float* xlat = l == 0 ? F.in[0] : BUFA; const float* xctx = l == 0 ? F.in[2] : BUFA + (size_t)NL * D;
        if (IN(pb + S_NORM1)) norm_rows(F, xlat, xctx, MT, F.in[6] + l * D, mod, 0, 1024, HM);
        SEAM(pb + S_NORM1);
        if (IN(pb + S_G1)) { A_WinT af{WSP(bf16, WS_WIN) + (size_t)l * PTROWS * D}; RowMajor bf{HM, D}; E_PT ep{PT};
            gemm_simple(1, PTROWS / 128, MT / 128, D, af, bf, ep, F.vcu, F.G); }
        SEAM(pb + S_G1);
        if (IN(pb + S_FNET)) {
            { A_Dft af{WSP(bf16, WS_DFT), 2 * L}; B_FnetLat bf{PT}; E_Fnet ep{HM, 0, L}; gemm_simple(NB, L / 128, 2, 2 * L, af, bf, ep, F.vcu, F.G); }
            if (l == 0) { A_Dft af{WSP(bf16, WS_DFTC), 2 * LC}; B_FnetCtx bf{PT}; E_Fnet ep{HM, NL, LC}; gemm_simple(NB, LC / 128, 2, 2 * LC, af, bf, ep, F.vcu, F.G); }
        }
        SEAM(pb + S_FNET);
        if (IN(pb + S_HY1)) hyena_stage(F, l, 0);
        SEAM(pb + S_HY1);
        if (IN(pb + S_S5E)) { A_S5 af{PT, HS}; B_S5 bf{(const bf16*)(F.ws + WS_S5M + (size_t)l * 24 * S5M_STRIDE), 0, 256}; E_S5E ep{E};
            gemm_simple(24, NCHUNK / 128, 2, 256, af, bf, ep, F.vcu, F.G); }
        SEAM(pb + S_S5E);
        if (IN(pb + S_CARRY)) s5_carry(F, l);
        SEAM(pb + S_CARRY);
        if (IN(pb + S_HY2)) hyena_stage(F, l, 1);
        SEAM(pb + S_HY2);
        if (IN(pb + S_S5O)) { A_S5 af{PT, HS}; B_S5 bf{(const bf16*)(F.ws + WS_S5M + (size_t)l * 24 * S5M_STRIDE), 256 * 256, 512}; E_S5O ep{YS};
            gemm_simple(24, NCHUNK / 128, 2, 512, af, bf, ep, F.vcu, F.G); }
        SEAM(pb + S_S5O);
        if (IN(pb + S_GLU)) { RowMajor af{YS, 384}; RowMajor bf{WSP(bf16, WS_GLU) + (size_t)l * 512 * 384, 384}; E_Glu ep{YS, HM, F.in[30] + l * 384};
            gemm_simple(1, MT / 128, 3, 384, af, bf, ep, F.vcu, F.G); }
        SEAM(pb + S_GLU);
        if (IN(pb + S_HYT)) hyena_transpose(F, l == 0 ? MT : NL);
        SEAM(pb + S_HYT);
        if (IN(pb + S_WOUT)) { RowMajor af{HM, D}; RowMajor bf{WSP(bf16, WS_WOUT) + (size_t)l * D * D, D};
            E_Res ep{xlat, xctx, l == 0 ? BUFA : F.out, mod, 2048}; gemm_simple(1, (l == 0 ? MT : NL) / 128, D / 128, D, af, bf, ep, F.vcu, F.G); }
        SEAM(pb + S_WOUT);
        if (l == 0) {
            if (IN(pb + S_NORM2)) norm_rows(F, BUFA, BUFA + (size_t)NL * D, MT, F.in[7], mod, 3072, 4096, HM);
            SEAM(pb + S_NORM2);
            if (IN(pb + S_F0)) { RowMajor af{HM, D}; RowMajor bf{WSP(bf16, WS_FGU), D}; E_Swi ep{WSP(bf16, WS_ACT), DFF}; gemm_simple(1, MT / 128, 2 * DFF / 128, D, af, bf, ep, F.vcu, F.G); }
            SEAM(pb + S_F0);
            if (IN(pb + S_F1)) { RowMajor af{WSP(bf16, WS_ACT), DFF}; RowMajor bf{WSP(bf16, WS_FD), DFF}; E_Res ep{BUFA, BUFA + (size_t)NL * D, BUFA, mod, 5120};
                gemm_simple(1, MT / 128, D / 128, DFF, af, bf, ep, F.vcu, F.G); }
            SEAM(pb + S_F1);
        } else {
            if (IN(pb + S_NORM2)) { norm2_router(F, F.out, F.in[7] + D, mod, HM); moe_transposes(F); }
            SEAM(pb + S_NORM2);
            if (IN(pb + S_F0)) moe_slots(F);
            SEAM(pb + S_F0);
            const int* IDX = (const int*)(F.ws + WS_META + META_IDX); const int* TE = (const int*)(F.ws + WS_META + META_TE); const int* NT = (const int*)(F.ws + WS_META + META_NT);
#pragma unroll 1
            for (int k = 0; k < 2; ++k) {
                if (IN(pb + S_F1 + 2 * k)) { const int nt = NT[k]; A_MoeUp af{HM, IDX + k * MAXSLOT}; E_Swi ep{WSP(bf16, WS_ACT2), DFE};
                    gemm_moe(nt * 2, 2 * DFE / 128, D, af, F.ws + WS_MOEW, 0, D, TE + k * 272, ep, F.vcu, F.G); }
                SEAM(pb + S_F1 + 2 * k);
                if (IN(pb + S_F2 + 2 * k)) { const int nt = NT[k]; RowMajor af{WSP(bf16, WS_ACT2), DFE}; E_MoeDown ep{F.out, IDX + k * MAXSLOT, F.ws + WS_TOPK, mod, k};
                    gemm_moe(nt * 2, D / 128, DFE, af, F.ws + WS_MOEW, MOE_GU_BYTES, DFE, TE + k * 272, ep, F.vcu, F.G); }
                SEAM(pb + S_F2 + 2 * k);
            }
            if (IN(pb + S_F5)) final_norm(F);
        }
    }
#undef IN
#undef SEAM
}

extern "C" void kernel_launch(void* const* d_in, const int* in_sizes, int n_in, void* d_out, int out_size, void* d_ws, size_t ws_size, hipStream_t stream) {
    static int grid = 0;
    if (grid == 0) {
        if (n_in != 40 || out_size != NL * D || ws_size < WS_END) { fprintf(stderr, "kernel_launch: unexpected shapes n_in %d out %d ws %zu (need %zu)\n", n_in, out_size, ws_size, (size_t)WS_END); grid = -1; return; }
        int dev = 0, cus = 0, per_cu = 0;
        if (hipGetDevice(&dev) != hipSuccess || hipDeviceGetAttribute(&cus, hipDeviceAttributeMultiprocessorCount, dev) != hipSuccess) { grid = -1; return; }
        if (hipFuncSetAttribute((const void*)mega, hipFuncAttributeMaxDynamicSharedMemorySize, LDS_BYTES) != hipSuccess) { fprintf(stderr, "kernel_launch: hipFuncSetAttribute failed\n"); grid = -1; return; }
        if (hipOccupancyMaxActiveBlocksPerMultiprocessor(&per_cu, (const void*)mega, NTHR, LDS_BYTES) != hipSuccess || per_cu < 1) fprintf(stderr, "kernel_launch: occupancy query says %d\n", per_cu);
        (void)hipGetLastError();
        grid = cus;
    }
    if (grid < 0) return;
    (void)hipMemsetAsync((char*)d_ws + WS_CTL, 0, CTL_ZERO_BYTES, stream);
    Args a{};
    for (int i = 0; i < 40; ++i) a.in[i] = (const float*)d_in[i];
    a.out = (float*)d_out; a.ws = (unsigned char*)d_ws;
#if MK_ONE_LAUNCH
    a.ph_lo = 0; a.ph_hi = N_PHASES;
    hipLaunchKernelGGL(mega, dim3(grid), dim3(NTHR), LDS_BYTES, stream, a);
#else
    for (int ph = 0; ph < N_PHASES; ++ph) {
        const int s = ph - PH_L;
        if (ph >= PH_L && s < PH_PER && s > S_F1) continue;
        if (ph >= PH_L + PH_PER && (ph - PH_L - PH_PER) > S_F5) continue;
        a.ph_lo = ph; a.ph_hi = ph + 1;
        hipLaunchKernelGGL(mega, dim3(grid), dim3(NTHR), LDS_BYTES, stream, a);
    }
#endif
}
```

```cpp
#include <hip/hip_runtime.h>
#include <cstdio>
#include <cstdint>

#ifndef MK_ONE_LAUNCH
#define MK_ONE_LAUNCH 1
#endif

#define LAS __attribute__((address_space(3)))
typedef unsigned short bf16;
typedef short bf16x8 __attribute__((ext_vector_type(8)));
typedef float f32x4 __attribute__((ext_vector_type(4)));
typedef float f32x2 __attribute__((ext_vector_type(2)));
typedef unsigned v4u __attribute__((ext_vector_type(4)));
typedef unsigned v2u __attribute__((ext_vector_type(2)));

constexpr int D = 1024, NB = 16, L = 4096, LC = 256, NL = NB * L, NCX = NB * LC, MT = NL + NCX;
constexpr int DIN = 1792, DFF = 2816, NE = 8, DFE = 3584;
constexpr int PTROWS = 2048, R_HY = 512, R_S5 = 1664;
constexpr int NCHUNK = MT / 16;
constexpr int NTHR = 512, NWAVES = 8;
constexpr int MAXSLOT = NL + NE * 256;

constexpr size_t MiB = 1u << 20;
constexpr size_t WS_CTL = 0, CTL_ZERO_BYTES = 1 * MiB;
constexpr size_t WS_MOD = 1 * MiB;
constexpr size_t WS_WIN = 2 * MiB;
constexpr size_t WS_WOUT = 10 * MiB;
constexpr size_t WS_GLU = 14 * MiB;
constexpr size_t WS_FGU = 15 * MiB;
constexpr size_t WS_FD = 26 * MiB;
constexpr size_t WS_DFT = 32 * MiB;
constexpr size_t WS_DFTC = 96 * MiB;
constexpr size_t WS_S5M = 97 * MiB;
constexpr size_t S5M_STRIDE = 256 * 256 * 2 + 256 * 512 * 2;
constexpr size_t WS_A16 = 115 * MiB;
constexpr size_t WS_KT = 116 * MiB;
constexpr size_t WS_KTC = 164 * MiB;
constexpr size_t WS_PS = 167 * MiB;
constexpr size_t WS_TOPK = 171 * MiB;
constexpr size_t WS_META = 172 * MiB;
constexpr size_t META_CNT = 0, META_IDX = 64 * 1024, META_TE = META_IDX + 2 * MAXSLOT * 4, META_NT = META_TE + 2 * 272 * 4;
constexpr size_t WS_HMOD = 173 * MiB;
constexpr size_t WS_BUFA = 309 * MiB;
constexpr size_t WS_R = 581 * MiB;
constexpr size_t WS_END = 1024 * MiB;
constexpr size_t WS_PT = WS_R;
constexpr size_t WS_HT = WS_R;
constexpr size_t WS_ACT = WS_R;
constexpr size_t WS_MOEW = WS_BUFA;
constexpr size_t MOE_GU_BYTES = (size_t)2 * DFE * D * 2, MOE_D_BYTES = (size_t)D * DFE * 2, MOE_E_STRIDE = MOE_GU_BYTES + MOE_D_BYTES;
constexpr size_t WS_ACT2 = WS_BUFA + 168 * MiB;
static_assert(NE * MOE_E_STRIDE <= 168 * MiB, "moe weights");
static_assert(WS_ACT2 + (size_t)MAXSLOT * DFE * 2 <= WS_END, "act2");
static_assert(WS_PT + (size_t)PTROWS * MT * 2 <= WS_END, "pt");
static_assert(WS_ACT + (size_t)MT * DFF * 2 <= WS_END, "act");
static_assert(WS_HMOD + (size_t)MT * D * 2 <= WS_BUFA && WS_BUFA + (size_t)MT * D * 4 <= WS_R, "bufs");
constexpr size_t DO_E = 0, DO_HS = 102 * MiB, DO_YS = 153 * MiB;
static_assert(DO_YS + (size_t)MT * 384 * 2 <= (size_t)NL * D * 4, "d_out scratch");

constexpr int LDS_BYTES = 147456;
constexpr int LDS_MISC = 131072 + 8192;

__device__ __forceinline__ unsigned f2bf(float f) { unsigned u = __builtin_bit_cast(unsigned, f); return (u + 0x7fffu + ((u >> 16) & 1u)) >> 16; }
__device__ __forceinline__ unsigned pk2(float lo, float hi) { return f2bf(lo) | (f2bf(hi) << 16); }
__device__ __forceinline__ float bf2f(unsigned short b) { return __builtin_bit_cast(float, ((unsigned)b) << 16); }
__device__ __forceinline__ float wave_sum(float v) {
#pragma unroll
    for (int o = 1; o < 64; o <<= 1) v += __shfl_xor(v, o);
    return v;
}
__device__ __forceinline__ float silu_f(float x) { return x / (1.0f + __expf(-x)); }
__device__ __forceinline__ float sigmoid_f(float x) { return 1.0f / (1.0f + __expf(-x)); }
__device__ __forceinline__ float gelu_tanh_f(float x) { const float u = 0.7978845608028654f * (x + 0.044715f * x * x * x); return 0.5f * x * (1.0f + tanhf(u)); }
__device__ __forceinline__ int bidx_of(int r) { return r < NL ? (r >> 12) : 16; }

#define XB_TMO      128
#define XB_XCNT(j)  (256  + 64 * (j))
#define XB_XSUB(j)  (1280 + 64 * (j))
#define XB_XGEN(j)  (2304 + 64 * (j))
#define XB_TOP      3328
#define XB_TOPGEN   3392
#define XCD_BAR_WORDS 3456
#define XB_SPIN_CAP (1u << 22)
__device__ __forceinline__ unsigned xb_ld(unsigned* p)              { return __hip_atomic_load(p, __ATOMIC_RELAXED, __HIP_MEMORY_SCOPE_AGENT); }
__device__ __forceinline__ unsigned xb_add(unsigned* p, unsigned v) { return __hip_atomic_fetch_add(p, v, __ATOMIC_RELAXED, __HIP_MEMORY_SCOPE_AGENT); }
__device__ __forceinline__ unsigned xb_xcc_id() { return (unsigned)__builtin_amdgcn_s_getreg((3 << 11) | 20) & 0xFu; }
#define XB_SPIN(cond, bar) do { unsigned _sp = 0; while (cond) { __builtin_amdgcn_s_sleep(1); \
    if ((++_sp & 255u) == 0u) { if (xb_ld(&(bar)[XB_TMO])) break; if (_sp > XB_SPIN_CAP) { atomicAdd(&(bar)[XB_TMO], 1u); break; } } } } while (0)
struct XcdBarrier { unsigned* bar; unsigned x; volatile LAS unsigned* st; };
__device__ __forceinline__ XcdBarrier xcd_barrier_post(unsigned* bar, volatile LAS unsigned* st) {
    XcdBarrier b; b.bar = bar; b.x = xb_xcc_id(); b.st = st;
    if (threadIdx.x == 0) (void)xb_add(&bar[XB_XCNT(b.x)], 1u);
    return b;
}
__device__ __forceinline__ void xcd_barrier_complete(unsigned* bar, unsigned x, unsigned& nloc, unsigned& nx) {
    const unsigned G = gridDim.x * gridDim.y * gridDim.z;
    unsigned sum, cnt, mine, sp = 0u;
    for (;;) {
        sum = 0u; cnt = 0u; mine = 0u;
#pragma unroll
        for (unsigned j = 0; j < 16; ++j) { const unsigned c = xb_ld(&bar[XB_XCNT(j)]); sum += c; cnt += (c > 0u) ? 1u : 0u; mine = (j == x) ? c : mine; }
        if (sum == G) break;
        __builtin_amdgcn_s_sleep(1);
        if ((++sp & 255u) == 0u) { if (xb_ld(&bar[XB_TMO])) break; if (sp > XB_SPIN_CAP) { atomicAdd(&bar[XB_TMO], 1u); break; } }
    }
    nloc = mine > 0u ? mine : 1u; nx = cnt > 0u ? cnt : 1u;
}
__device__ __forceinline__ void xcd_barrier(const XcdBarrier& b) {
    asm volatile("s_waitcnt vmcnt(0)" ::: "memory");
    __syncthreads();
    if (threadIdx.x == 0) {
        unsigned* bar = b.bar;
        __builtin_amdgcn_s_waitcnt(0);
        unsigned nloc = b.st[0], nx = b.st[1];
        if (nloc == 0u) { xcd_barrier_complete(bar, b.x, nloc, nx); b.st[0] = nloc; b.st[1] = nx; }
        const unsigned old = xb_add(&bar[XB_XSUB(b.x)], 1u);
        const unsigned gen = old / nloc;
        if (old + 1u == (gen + 1u) * nloc) {
            __builtin_amdgcn_fence(__ATOMIC_RELEASE, "agent");
            asm volatile("s_waitcnt vmcnt(0)" ::: "memory");
            const unsigned og = xb_add(&bar[XB_TOP], 1u);
            const unsigned tg = og / nx;
            if (og + 1u == (tg + 1u) * nx) xb_add(&bar[XB_TOPGEN], 1u);
            else XB_SPIN(xb_ld(&bar[XB_TOPGEN]) == tg, bar);
            __builtin_amdgcn_fence(__ATOMIC_ACQUIRE, "agent");
            xb_add(&bar[XB_XGEN(b.x)], 1u);
            asm volatile("s_waitcnt vmcnt(0)" ::: "memory");
        } else {
            XB_SPIN(xb_ld(&bar[XB_XGEN(b.x)]) == gen, bar);
            __builtin_amdgcn_fence(__ATOMIC_ACQUIRE, "agent");
            asm volatile("s_waitcnt vmcnt(0)" ::: "memory");
        }
    }
    __syncthreads();
}

template <class AF, class BF, class EP>
__device__ __forceinline__ void gemm_simple(int nbatch, int mtiles, int ntiles, int K, const AF& af, const BF& bf, const EP& ep, int vcu, int G) {
    int tid = threadIdx.x; asm volatile("" : "+v"(tid)); asm volatile("" : "+s"(vcu)); const int wid = tid >> 6, lane = tid & 63, wr = wid >> 2, wc = wid & 3, fr = lane & 15, fq = lane >> 4;
    const int per = mtiles * ntiles, nunits = nbatch * per;
    for (int u = vcu; u < nunits; u += G) {
        const int bt = u / per, rem = u - bt * per, pm = rem / ntiles, pn = rem - pm * ntiles;
        const int row0 = pm * 128 + wr * 64, col0 = pn * 128 + wc * 32;
        f32x4 acc[4][2];
#pragma unroll
        for (int m = 0; m < 4; ++m) { acc[m][0] = (f32x4){0.f, 0.f, 0.f, 0.f}; acc[m][1] = (f32x4){0.f, 0.f, 0.f, 0.f}; }
#pragma unroll 2
        for (int k = 0; k < K; k += 32) {
            bf16x8 a[4], b[2];
#pragma unroll
            for (int m = 0; m < 4; ++m) a[m] = *(const bf16x8*)af(bt, row0 + m * 16 + fr, k + fq * 8);
#pragma unroll
            for (int n = 0; n < 2; ++n) b[n] = *(const bf16x8*)bf(bt, col0 + n * 16 + fr, k + fq * 8);
#pragma unroll
            for (int m = 0; m < 4; ++m)
#pragma unroll
                for (int n = 0; n < 2; ++n) acc[m][n] = __builtin_amdgcn_mfma_f32_16x16x32_bf16(b[n], a[m], acc[m][n], 0, 0, 0);
        }
#pragma unroll
        for (int m = 0; m < 4; ++m) ep(bt, row0 + m * 16 + fr, col0 + 4 * fq, acc[m][0], acc[m][1]);
    }
}
struct RowMajor { const bf16* p; long ld; __device__ __forceinline__ const bf16* operator()(int, int r, int k) const { return p + (long)r * ld + k; } };

struct Args { const float* in[40]; float* out; unsigned char* ws; int ph_lo, ph_hi; };
struct Frame {
    LAS unsigned char* lds; int tid, lane, wave, vcu, G;
    const float* const* in; float* out; unsigned char* ws;
};
#define WSP(T, off) ((T*)(F.ws + (off)))
__device__ __forceinline__ Frame relocal(const Frame& F0) { Frame F = F0; int t = threadIdx.x; asm volatile("" : "+v"(t)); F.tid = t; F.lane = t & 63; F.wave = __builtin_amdgcn_readfirstlane(t >> 6); int v = F0.vcu; asm volatile("" : "+s"(v)); F.vcu = v; return F; }

constexpr int PH_P0 = 0, PH_P1 = 1, PH_L = 2, PH_PER = 20, N_PHASES = PH_L + 2 * PH_PER;
enum { S_NORM1 = 0, S_G1, S_FNET, S_HY1, S_S5E, S_CARRY, S_HY2, S_S5O, S_GLU, S_HYT, S_WOUT, S_NORM2, S_F0, S_F1, S_F2, S_F3, S_F4, S_F5 };

__device__ __forceinline__ int rowmap(int mode, int row_off, int n) { return mode == 0 ? row_off + n : (32 * (n >> 4) + (n & 15) + (mode == 2 ? 16 : 0)); }
__device__ __forceinline__ void transpose_item(const float* W, int ldw, int col0, int N, bf16* WT, int ldk, int mode, int row_off, LAS float* scr, int item, int lane) {
    const int nblk = N / 32, kb = item / nblk, nb = item % nblk, k0 = 64 * kb, n0 = 32 * nb;
#pragma unroll 8
    for (int i = 0; i < 32; ++i) { const int kk = 2 * i + (lane >> 5); scr[kk * 33 + (lane & 31)] = W[(size_t)(k0 + kk) * ldw + col0 + n0 + (lane & 31)]; }
    asm volatile("s_waitcnt lgkmcnt(0)" ::: "memory");
    const int c = lane & 7;
#pragma unroll
    for (int j = 0; j < 4; ++j) { const int n = (lane >> 3) + 8 * j; const LAS float* s = scr + (8 * c) * 33 + n;
        v4u o; o.x = pk2(s[0 * 33], s[1 * 33]); o.y = pk2(s[2 * 33], s[3 * 33]); o.z = pk2(s[4 * 33], s[5 * 33]); o.w = pk2(s[6 * 33], s[7 * 33]);
        *(v4u*)(WT + (size_t)rowmap(mode, row_off, n0 + n) * ldk + k0 + 8 * c) = o; }
    asm volatile("s_waitcnt lgkmcnt(0)" ::: "memory");
}

__device__ __forceinline__ void p0_transposes(Frame& F) {
    LAS float* scr = (LAS float*)(F.lds + F.wave * 16384);
    const int gw = F.vcu * NWAVES + F.wave, NGW = F.G * NWAVES;
    constexpr int I_IN = 16 * 48, I_OUT = 16 * 32, I_GLU = 6 * 12, I_FG = 16 * 88, I_FD = 44 * 32;
    constexpr int NIT = 2 * (I_IN + I_OUT + I_GLU) + 2 * I_FG + I_FD;
    for (int it = gw; it < NIT; it += NGW) {
        int r = it;
        if (r < 2 * I_IN) { const int l = r / I_IN; transpose_item(F.in[8] + (size_t)l * D * DIN, DIN, 256, 1536, WSP(bf16, WS_WIN) + (size_t)l * PTROWS * D, D, 0, 512, scr, r % I_IN, F.lane); continue; } r -= 2 * I_IN;
        if (r < 2 * I_OUT) { const int l = r / I_OUT; transpose_item(F.in[9] + (size_t)l * D * D, D, 0, D, WSP(bf16, WS_WOUT) + (size_t)l * D * D, D, 0, 0, scr, r % I_OUT, F.lane); continue; } r -= 2 * I_OUT;
        if (r < 2 * I_GLU) { const int l = r / I_GLU; transpose_item(F.in[29] + (size_t)l * 384 * 384, 384, 0, 384, WSP(bf16, WS_GLU) + (size_t)l * 512 * 384, 384, 0, 0, scr, r % I_GLU, F.lane); continue; } r -= 2 * I_GLU;
        if (r < I_FG) { transpose_item(F.in[31], DFF, 0, DFF, WSP(bf16, WS_FGU), D, 1, 0, scr, r, F.lane); continue; } r -= I_FG;
        if (r < I_FG) { transpose_item(F.in[32], DFF, 0, DFF, WSP(bf16, WS_FGU), D, 2, 0, scr, r, F.lane); continue; } r -= I_FG;
        transpose_item(F.in[33], D, 0, D, WSP(bf16, WS_FD), DFF, 0, 0, scr, r, F.lane);
    }
}
__device__ __forceinline__ void moe_transposes(Frame& F_) { Frame F = relocal(F_);
    LAS float* scr = (LAS float*)(F.lds + F.wave * 16384);
    const int gw = F.vcu * NWAVES + F.wave, NGW = F.G * NWAVES;
    constexpr int I_G = 16 * 112, I_D = 56 * 32, PER_E = 2 * I_G + I_D;
    for (int it = gw; it < NE * PER_E; it += NGW) {
        const int e = it / PER_E; int r = it % PER_E;
        bf16* gu = (bf16*)(F.ws + WS_MOEW + (size_t)e * MOE_E_STRIDE); bf16* dn = (bf16*)(F.ws + WS_MOEW + (size_t)e * MOE_E_STRIDE + MOE_GU_BYTES);
        if (r < I_G) { transpose_item(F.in[36] + (size_t)e * D * DFE, DFE, 0, DFE, gu, D, 1, 0, scr, r, F.lane); continue; } r -= I_G;
        if (r < I_G) { transpose_item(F.in[37] + (size_t)e * D * DFE, DFE, 0, DFE, gu, D, 2, 0, scr, r, F.lane); continue; } r -= I_G;
        transpose_item(F.in[38] + (size_t)e * DFE * D, D, 0, D, dn, DFE, 0, 0, scr, r, F.lane);
    }
}

__device__ __forceinline__ void p0_mod_item(Frame& F, int item) {
    const int l = item / 48, cb = item % 48, tid = F.tid;
    LAS float* sc = (LAS float*)F.lds;
    LAS float* red = sc + 17 * 1024;
    for (int i = tid; i < 17 * 1024; i += NTHR) { const int r = i >> 10, k = i & 1023; const float v = r < 16 ? F.in[1][r * D + k] : F.in[3][k]; sc[i] = silu_f(v); }
    __syncthreads();
    const int col = cb * 128 + (tid & 127), kg = tid >> 7;
    const float* W = F.in[4] + (size_t)l * D * 6144 + col;
    float acc[17];
#pragma unroll
    for (int r = 0; r < 17; ++r) acc[r] = 0.f;
    for (int k = kg * 256; k < kg * 256 + 256; ++k) { const float w = W[(size_t)k * 6144];
#pragma unroll
        for (int r = 0; r < 17; ++r) acc[r] += sc[r * 1024 + k] * w; }
#pragma unroll
    for (int r = 0; r < 17; ++r) red[(kg * 17 + r) * 128 + (tid & 127)] = acc[r];
    __syncthreads();
    for (int i = tid; i < 17 * 128; i += NTHR) { const int r = i >> 7, c = i & 127;
        const float s = red[(0 * 17 + r) * 128 + c] + red[(1 * 17 + r) * 128 + c] + red[(2 * 17 + r) * 128 + c] + red[(3 * 17 + r) * 128 + c];
        WSP(float, WS_MOD)[((size_t)l * 17 + r) * 6144 + cb * 128 + c] = s + F.in[5][l * 6144 + cb * 128 + c]; }
    __syncthreads();
}
__device__ __forceinline__ void p0_fold_item(Frame& F, int item) {
    const int kb = item & 7, cs = (item >> 3) & 1, h = (item >> 4) & 3, l = item >> 6, tid = F.tid;
    LAS float* A = (LAS float*)F.lds;
    const float* wf = F.in[10] + ((size_t)l * 4 + h) * 64 * 64;
    for (int i = tid; i < 4096; i += NTHR) { const int d = i >> 6, e2 = i & 63; float s = 0.f;
        for (int e = 0; e < 64; ++e) { const int m = (e * d) & 63; const float tr = cs ? sinpif((float)m * (1.0f / 32.0f)) : cospif((float)m * (1.0f / 32.0f)); s += tr * wf[e * 64 + e2]; }
        A[i] = s * 0.125f; }
    __syncthreads();
    const int e2 = tid & 63;
    const float* win = F.in[8] + (size_t)l * D * DIN + h * 64;
    bf16* wt = WSP(bf16, WS_WIN) + (size_t)l * PTROWS * D + (size_t)(cs * 256 + h * 64 + e2) * D;
    for (int i = 0; i < 16; ++i) { const int kk = kb * 128 + (tid >> 6) + 8 * i; float s = 0.f;
        for (int d = 0; d < 64; ++d) s += win[(size_t)kk * DIN + d] * A[d * 64 + e2];
        wt[kk] = (bf16)f2bf(s); }
    __syncthreads();
}
__device__ __forceinline__ void gen_dft_rows(bf16* dst, int LL, int row0, int nrows, float scale, int tid) {
    const int cpr = 2 * LL / 8;
    for (int i = tid; i < nrows * cpr; i += NTHR) { const int k = row0 + i / cpr, j0 = (i % cpr) * 8; unsigned w[4];
#pragma unroll
        for (int q = 0; q < 4; ++q) { float v[2];
#pragma unroll
            for (int z = 0; z < 2; ++z) { const int j = j0 + 2 * q + z; const int jj = j < LL ? j : j - LL; const int m = (k * jj) & (LL - 1); const float x = (float)m * (2.0f / (float)LL);
                v[z] = (j < LL ? cospif(x) : -sinpif(x)) * scale; }
            w[q] = pk2(v[0], v[1]); }
        *(v4u*)(dst + (size_t)k * 2 * LL + j0) = (v4u){w[0], w[1], w[2], w[3]}; }
}
__device__ __forceinline__ void p0_filter_item(Frame& F, int item) {
    const int l = item / 272, pb = item % 272, tid = F.tid;
    const int LL = pb < 256 ? L : LC, p0 = pb < 256 ? pb * 16 : (pb - 256) * 16;
    LAS float* z = (LAS float*)F.lds;
    LAS float* h1 = z + 16 * 36;
    LAS float* h2 = h1 + 16 * 64;
    for (int i = tid; i < 16 * 33; i += NTHR) { const int pp = i / 33, j = i % 33; const int pos = p0 + pp;
        const double w = 6.283185307179586 * (double)pos / (double)LL; double v;
        if (j == 0) v = (double)pos / (double)(LL - 1);
        else { const int bj = (j - 1) & 15; const double band = 1e-4 + (double)bj * ((15.0 - 1e-4) / 15.0); v = j <= 16 ? cos(band * w) : -sin(band * w); }
        z[pp * 36 + j] = (float)v; }
    __syncthreads();
    for (int i = tid; i < 1024; i += NTHR) { const int pp = i >> 6, o = i & 63; float s = F.in[14][l * 64 + o];
        for (int j = 0; j < 33; ++j) s += z[pp * 36 + j] * F.in[13][((size_t)l * 33 + j) * 64 + o];
        h1[i] = sinf(F.in[15][l * 64 + o] * s); }
    __syncthreads();
    for (int i = tid; i < 1024; i += NTHR) { const int pp = i >> 6, o = i & 63; float s = F.in[17][l * 64 + o];
        for (int j = 0; j < 64; ++j) s += h1[pp * 64 + j] * F.in[16][((size_t)l * 64 + j) * 64 + o];
        h2[i] = sinf(F.in[18][l * 64 + o] * s); }
    __syncthreads();
    float* HT = WSP(float, WS_HT) + ((size_t)l * 4352 + (pb < 256 ? 0 : 4096)) * 1536;
    float* PS = WSP(float, WS_PS) + ((size_t)l * 272 + pb) * 1536;
    const float* fw3 = F.in[19] + (size_t)l * 64 * 1536;
    const float dmin = 3.0701134573253945f, dstep = (15.350567286626973f - 3.0701134573253945f) / 383.0f;
#pragma unroll 1
    for (int cc = 0; cc < 3; ++cc) { const int col = tid + 512 * cc; float acc[16];
#pragma unroll
        for (int pp = 0; pp < 16; ++pp) acc[pp] = 0.f;
        for (int j = 0; j < 64; ++j) { const float w = fw3[(size_t)j * 1536 + col];
#pragma unroll
            for (int pp = 0; pp < 16; ++pp) acc[pp] += h2[pp * 64 + j] * w; }
        const int c = col % 384, dir = col / 768; const float delta = dmin + (float)c * dstep; float ps = 0.f;
#pragma unroll
        for (int pp = 0; pp < 16; ++pp) { const int pos = p0 + pp; const float t = (float)pos / (float)(LL - 1); const float v = acc[pp] * __expf(-t * delta);
            HT[(size_t)pos * 1536 + col] = v; if (!(dir == 1 && pos == 0)) ps += fabsf(v); }
        PS[col] = ps; }
    __syncthreads();
}
__device__ __forceinline__ void p0_s5_item(Frame& F, int item) {
    const int l = item / 24, g = item % 24, tid = F.tid;
    LAS f32x2* apow = (LAS f32x2*)F.lds;
    LAS f32x2* bbar = apow + 2 * 17 * 64;
    LAS f32x2* Cc = bbar + 2 * 64 * 16;
    LAS float* Kd = (LAS float*)(Cc + 2 * 16 * 64);
    if (tid < 128) { const int dir = tid >> 6, p = tid & 63; const size_t ix = (((size_t)l * 2 + dir) * 24 + g) * 64 + p;
        const double are = F.in[21][ix], aim = F.in[22][ix], dt = exp((double)F.in[23][((size_t)l * 2 + dir) * 24 + g]);
        for (int tau = 0; tau <= 16; ++tau) { const double mg = exp(are * dt * tau), an = aim * dt * tau; apow[(dir * 17 + tau) * 64 + p] = (f32x2){(float)(mg * cos(an)), (float)(mg * sin(an))}; }
        const double mg = exp(are * dt), an = aim * dt; const double nr = mg * cos(an) - 1.0, ni = mg * sin(an); const double den = are * are + aim * aim;
        const double qr = (nr * are + ni * aim) / den, qi = (ni * are - nr * aim) / den;
        for (int h = 0; h < 16; ++h) { const double br = F.in[24][ix * 16 + h], bi = F.in[25][ix * 16 + h]; bbar[(dir * 64 + p) * 16 + h] = (f32x2){(float)(qr * br - qi * bi), (float)(qr * bi + qi * br)}; }
        const double m16 = exp(are * dt * 16.0), a16 = aim * dt * 16.0;
        WSP(float, WS_A16)[ix * 2 + 0] = (float)(m16 * cos(a16)); WSP(float, WS_A16)[ix * 2 + 1] = (float)(m16 * sin(a16)); }
    for (int i = tid; i < 2 * 16 * 64; i += NTHR) { const int dir = i >> 10, h = (i >> 6) & 15, p = i & 63; const size_t ix = ((((size_t)l * 2 + dir) * 24 + g) * 16 + h) * 64 + p;
        Cc[i] = (f32x2){F.in[26][ix], F.in[27][ix]}; }
    __syncthreads();
    for (int i = tid; i < 2 * 16 * 256; i += NTHR) { const int dir = i >> 12, tau = (i >> 8) & 15, h = (i >> 4) & 15, h2 = i & 15; float s = 0.f;
        for (int p = 0; p < 64; ++p) { const f32x2 a = apow[(dir * 17 + tau) * 64 + p], b = bbar[(dir * 64 + p) * 16 + h2], c = Cc[(dir * 16 + h) * 64 + p];
            const float tr = a.x * b.x - a.y * b.y, ti = a.x * b.y + a.y * b.x; s += c.x * tr - c.y * ti; }
        Kd[i] = s; }
    __syncthreads();
    bf16* EST = (bf16*)(F.ws + WS_S5M + (size_t)item * S5M_STRIDE); bf16* MOUT = EST + 256 * 256;
    for (int i = tid; i < 256 * 256; i += NTHR) { const int n = i >> 8, k = i & 255; const int dir = n >> 7, p = (n >> 1) & 63, ri = n & 1, hh = k >> 4, j = k & 15;
        const int tau = dir == 0 ? 15 - j : j; const f32x2 a = apow[(dir * 17 + tau) * 64 + p], b = bbar[(dir * 64 + p) * 16 + hh];
        const float v = ri == 0 ? a.x * b.x - a.y * b.y : a.x * b.y + a.y * b.x; EST[i] = (bf16)f2bf(v); }
    const float* dsk = F.in[28] + (size_t)l * 384 + g * 16;
    for (int i = tid; i < 256 * 512; i += NTHR) { const int n = i >> 9, k = i & 511; const int j = n >> 4, h = n & 15; float v;
        if (k < 256) { const int hh = k >> 4, ii = k & 15; v = 0.f;
            if (ii <= j) v += Kd[((0 * 16 + (j - ii)) * 16 + h) * 16 + hh];
            if (ii >= j) v += Kd[((1 * 16 + (ii - j)) * 16 + h) * 16 + hh];
            if (ii == j && h == hh) v += dsk[h]; }
        else { const int comp = k - 256, dir = comp >> 7, p = (comp >> 1) & 63, ri = comp & 1; const int tau = dir == 0 ? j + 1 : 16 - j;
            const f32x2 a = apow[(dir * 17 + tau) * 64 + p], c = Cc[(dir * 16 + h) * 64 + p];
            v = ri == 0 ? (c.x * a.x - c.y * a.y) : -(c.x * a.y + c.y * a.x); }
        MOUT[i] = (bf16)f2bf(v); }
    __syncthreads();
}
__device__ __forceinline__ void p0_prologue(Frame& F_) { Frame F = relocal(F_);
    p0_transposes(F);
    __syncthreads();
    for (int i = F.vcu * NTHR + F.tid; i < 2 * 128 * 384 / 8; i += F.G * NTHR) { const int l = i / (128 * 384 / 8), r = i % (128 * 384 / 8);
        *(v4u*)(WSP(bf16, WS_GLU) + (size_t)l * 512 * 384 + 384 * 384 + (size_t)r * 8) = (v4u){0u, 0u, 0u, 0u}; }
    constexpr int I_MOD = 96, I_FOLD = 128, I_DFT = 512, I_DFTC = 4, I_FIL = 544, I_S5 = 48, NIT = I_MOD + I_FOLD + I_DFT + I_DFTC + I_FIL + I_S5;
    for (int it = F.vcu; it < NIT; it += F.G) {
        int r = it;
        if (r < I_FIL) { p0_filter_item(F, r); continue; } r -= I_FIL;
        if (r < I_MOD) { p0_mod_item(F, r); continue; } r -= I_MOD;
        if (r < I_FOLD) { p0_fold_item(F, r); continue; } r -= I_FOLD;
        if (r < I_S5) { p0_s5_item(F, r); continue; } r -= I_S5;
        if (r < I_DFT) { gen_dft_rows(WSP(bf16, WS_DFT), L, r * 8, 8, 1.0f / 64.0f, F.tid); continue; } r -= I_DFT;
        gen_dft_rows(WSP(bf16, WS_DFTC), LC, r * 64, 64, 1.0f / 16.0f, F.tid);
    }
}
__device__ __forceinline__ void p1_item(Frame& F_, int item) { Frame F = relocal(F_);
    const int l = item / 1632; int r = item % 1632; const int set = r < 1536 ? 0 : 1; if (set) r -= 1536;
    const int npb = set ? 4 : 64, LL = set ? LC : L, pb = r % npb, ocb = r / npb, o = ocb / 12, cb = ocb % 12, tid = F.tid;
    LAS float* red = (LAS float*)F.lds;
    LAS float* inv = red + 512;
    LAS float* T = inv + 32;
    const float* PS = WSP(float, WS_PS) + ((size_t)l * 272 + (set ? 256 : 0)) * 1536;
    { const int ch = tid & 31, part = tid >> 5; float s = 0.f; const int nblk = LL / 16;
      for (int b = part; b < nblk; b += 16) s += PS[(size_t)b * 1536 + o * 384 + cb * 32 + ch] + PS[(size_t)b * 1536 + 768 + o * 384 + cb * 32 + ch];
      red[part * 32 + ch] = s; }
    __syncthreads();
    if (tid < 32) { float s = 0.f; for (int p = 0; p < 16; ++p) s += red[p * 32 + tid]; inv[tid] = 1.0f / s; }
    const float* HT = WSP(float, WS_HT) + ((size_t)l * 4352 + (set ? 4096 : 0)) * 1536;
    { const int ch = tid & 31, dir = (tid >> 5) & 1;
      for (int i = 0; i < 8; ++i) { const int pp = (tid >> 6) + 8 * i; T[(dir * 64 + pp) * 33 + ch] = HT[(size_t)(pb * 64 + pp) * 1536 + dir * 768 + o * 384 + cb * 32 + ch]; } }
    __syncthreads();
    float* KT = set ? WSP(float, WS_KTC) + ((size_t)(l * 2 + o) * 384) * 512 : WSP(float, WS_KT) + ((size_t)(l * 2 + o) * 384) * 8192;
    { const int pp = tid & 63;
      for (int i = 0; i < 4; ++i) { const int ch = (tid >> 6) + 8 * i; const int pos = pb * 64 + pp; float* kt = KT + (size_t)(cb * 32 + ch) * 2 * LL;
          kt[LL + pos] = T[(0 * 64 + pp) * 33 + ch] * inv[ch];
          if (pos > 0) kt[LL - pos] = T[(1 * 64 + pp) * 33 + ch] * inv[ch]; else kt[0] = 0.f; } }
    __syncthreads();
}

__device__ __forceinline__ void norm_rows(Frame& F_, const float* xlat, const float* xctx, int nrows, const float* gain, const float* mod, int sh_off, int sc_off, bf16* out) { Frame F = relocal(F_);
    const int gw = F.vcu * NWAVES + F.wave, NGW = F.G * NWAVES, lane = F.lane;
    for (int r = gw; r < nrows; r += NGW) {
        const float* xr = r < NL ? xlat + (size_t)r * D : xctx + (size_t)(r - NL) * D;
        const float* md = mod + (size_t)bidx_of(r) * 6144;
        f32x4 v[4]; float ss = 0.f;
#pragma unroll
        for (int j = 0; j < 4; ++j) { v[j] = ((const f32x4*)xr)[64 * j + lane]; ss += (v[j].x * v[j].x + v[j].y * v[j].y) + (v[j].z * v[j].z + v[j].w * v[j].w); }
        const float rstd = 1.0f / sqrtf(wave_sum(ss) * (1.0f / D) + 1e-6f);
#pragma unroll
        for (int j = 0; j < 4; ++j) { const int col = (64 * j + lane) * 4; const f32x4 g4 = *(const f32x4*)(gain + col), sc = *(const f32x4*)(md + sc_off + col), sh = *(const f32x4*)(md + sh_off + col);
            const f32x4 h = v[j] * rstd * g4 * (sc + 1.0f) + sh;
            *(v2u*)(out + (size_t)r * D + col) = (v2u){pk2(h.x, h.y), pk2(h.z, h.w)}; }
    }
}
__device__ __forceinline__ void norm2_router(Frame& F_, const float* x, const float* gain, const float* mod, bf16* out) { Frame F = relocal(F_);
    LAS int* hist = (LAS int*)F.lds;
    const float* rw = F.in[34]; const float* rb = F.in[35];
    for (int tile = F.vcu; tile < NL / 256; tile += F.G) {
        if (F.tid < 16) hist[F.tid] = 0;
        __syncthreads();
        for (int i = 0; i < 32; ++i) { const int r = tile * 256 + F.wave * 32 + i, lane = F.lane;
            const float* xr = x + (size_t)r * D; const float* md = mod + (size_t)(r >> 12) * 6144;
            f32x4 v[4]; float ss = 0.f;
#pragma unroll
            for (int j = 0; j < 4; ++j) { v[j] = ((const f32x4*)xr)[64 * j + lane]; ss += (v[j].x * v[j].x + v[j].y * v[j].y) + (v[j].z * v[j].z + v[j].w * v[j].w); }
            const float rstd = 1.0f / sqrtf(wave_sum(ss) * (1.0f / D) + 1e-6f);
            float lg[8];
#pragma unroll
            for (int e = 0; e < 8; ++e) lg[e] = 0.f;
#pragma unroll
            for (int j = 0; j < 4; ++j) { const int col = (64 * j + lane) * 4; const f32x4 g4 = *(const f32x4*)(gain + col), sc = *(const f32x4*)(md + 4096 + col), sh = *(const f32x4*)(md + 3072 + col);
                const f32x4 h = v[j] * rstd * g4 * (sc + 1.0f) + sh;
                *(v2u*)(out + (size_t)r * D + col) = (v2u){pk2(h.x, h.y), pk2(h.z, h.w)};
#pragma unroll
                for (int q = 0; q < 4; ++q) { const f32x4 w0 = *(const f32x4*)(rw + (size_t)(col + q) * 8), w1 = *(const f32x4*)(rw + (size_t)(col + q) * 8 + 4); const float hv = h[q];
                    lg[0] += hv * w0.x; lg[1] += hv * w0.y; lg[2] += hv * w0.z; lg[3] += hv * w0.w; lg[4] += hv * w1.x; lg[5] += hv * w1.y; lg[6] += hv * w1.z; lg[7] += hv * w1.w; } }
#pragma unroll
            for (int e = 0; e < 8; ++e) lg[e] = wave_sum(lg[e]) + rb[e];
            if (lane == 0) {
                int e1 = 0; float v1 = lg[0];
#pragma unroll
                for (int e = 1; e < 8; ++e) if (lg[e] > v1) { v1 = lg[e]; e1 = e; }
                int e2 = -1; float v2 = -3.4e38f;
#pragma unroll
                for (int e = 0; e < 8; ++e) if (e != e1 && lg[e] > v2) { v2 = lg[e]; e2 = e; }
                const float ex = __expf(v2 - v1), w1 = 1.0f / (1.0f + ex), w2 = ex / (1.0f + ex);
                *(v4u*)(F.ws + WS_TOPK + (size_t)r * 16) = (v4u){(unsigned)(e1 | (e2 << 8)), __builtin_bit_cast(unsigned, w1), __builtin_bit_cast(unsigned, w2), 0u};
                __hip_atomic_fetch_add(hist + e1, 1, __ATOMIC_RELAXED, __HIP_MEMORY_SCOPE_WORKGROUP); __hip_atomic_fetch_add(hist + 8 + e2, 1, __ATOMIC_RELAXED, __HIP_MEMORY_SCOPE_WORKGROUP);
            } }
        __syncthreads();
        if (F.tid < 16) ((int*)(F.ws + WS_META + META_CNT))[tile * 16 + F.tid] = hist[F.tid];
        __syncthreads();
    }
}
__device__ __forceinline__ void moe_slots(Frame& F_) { Frame F = relocal(F_);
    LAS int* tot = (LAS int*)F.lds;
    LAS int* es = tot + 32;
    const int* CNT = (const int*)(F.ws + WS_META + META_CNT); int* IDX = (int*)(F.ws + WS_META + META_IDX); int* TE = (int*)(F.ws + WS_META + META_TE); int* NT = (int*)(F.ws + WS_META + META_NT);
    for (int it = F.vcu; it < 512; it += F.G) { const int k = it >> 8, tile = it & 255, tid = F.tid;
        if (tid < 8) { int t = 0, b = 0; for (int i = 0; i < 256; ++i) { const int c = CNT[i * 16 + k * 8 + tid]; if (i < tile) b += c; t += c; } tot[tid] = t; tot[8 + tid] = b; }
        __syncthreads();
        if (tid == 0) { int s = 0; for (int e = 0; e < 8; ++e) { tot[16 + e] = s; s += (tot[e] + 255) & ~255; } tot[24] = s; }
        if (tid < 256) { const unsigned pk = *(const unsigned*)(F.ws + WS_TOPK + (size_t)(tile * 256 + tid) * 16); es[tid] = k == 0 ? (int)(pk & 255u) : (int)((pk >> 8) & 255u); }
        __syncthreads();
        if (tid < 256) { const int e = es[tid]; int rank = 0; for (int j = 0; j < tid; ++j) rank += (es[j] == e) ? 1 : 0;
            IDX[k * MAXSLOT + tot[16 + e] + tot[8 + e] + rank] = tile * 256 + tid; }
        if (tile == 0) {
            for (int e = 0; e < 8; ++e) { const int n = tot[e], np = (n + 255) & ~255, sb = tot[16 + e];
                for (int i = n + tid; i < np; i += NTHR) IDX[k * MAXSLOT + sb + i] = -1;
                for (int i = tid; i < np / 256; i += NTHR) TE[k * 272 + sb / 256 + i] = e; }
            if (tid == 0) NT[k] = tot[24] / 256; }
        __syncthreads();
    }
}
__device__ __forceinline__ void final_norm(Frame& F_) { Frame F = relocal(F_);
    const int gw = F.vcu * NWAVES + F.wave, NGW = F.G * NWAVES, lane = F.lane; const float* gain = F.in[39];
    for (int r = gw; r < NL; r += NGW) { float* xr = F.out + (size_t)r * D; f32x4 v[4]; float ss = 0.f;
#pragma unroll
        for (int j = 0; j < 4; ++j) { v[j] = ((const f32x4*)xr)[64 * j + lane]; ss += (v[j].x * v[j].x + v[j].y * v[j].y) + (v[j].z * v[j].z + v[j].w * v[j].w); }
        const float rstd = 1.0f / sqrtf(wave_sum(ss) * (1.0f / D) + 1e-6f);
#pragma unroll
        for (int j = 0; j < 4; ++j) { const int col = (64 * j + lane) * 4; ((f32x4*)xr)[64 * j + lane] = v[j] * rstd * *(const f32x4*)(gain + col); } }
}

__device__ __forceinline__ float sconv(const bf16* prow, int colbase, int t, int LL, bool grid, float w0, float w1, float w2, float bias) {
    const bool hasl = grid ? ((t & 63) != 0) : (t > 0), hasr = grid ? ((t & 63) != 63) : (t < LL - 1);
    const float c = bf2f(prow[colbase + t]), a = hasl ? bf2f(prow[colbase + t - 1]) : 0.f, b = hasr ? bf2f(prow[colbase + t + 1]) : 0.f;
    return a * w0 + c * w1 + b * w2 + bias;
}
template <int LL, int NT, int NBT>
__device__ __forceinline__ void hyena_unit(Frame& F, int l, int o, int c, int b0, bool latent) {
    constexpr int TPB = LL / NT, BG = NTHR / TPB, NBU = BG * NBT;
    LAS float* kk = (LAS float*)F.lds;
    LAS float* us = kk + 2 * LL;
    const int tid = F.tid;
    const bf16* PT = WSP(bf16, WS_PT);
    const float* cw = F.in[11] + (size_t)l * 3 * 1152; const float* cb = F.in[12] + (size_t)l * 1152;
    const int in_row = R_HY + c;
    const int mul_row = R_HY + 384 * (o + 1) + c, mul_ch = 384 * (o + 1) + c;
    const int out_row = o == 0 ? R_HY + c : R_HY + 384 + c;
    const float* KT = latent ? WSP(float, WS_KT) + ((size_t)(l * 2 + o) * 384 + c) * 8192 : WSP(float, WS_KTC) + ((size_t)(l * 2 + o) * 384 + c) * 512;
    for (int i = tid; i < 2 * LL; i += NTHR) kk[i] = KT[i];
    { const float w0 = cw[c], w1 = cw[1152 + c], w2 = cw[2304 + c], bs = cb[c];
      for (int i = tid; i < NBU * LL; i += NTHR) { const int bb = i / LL, t = i % LL; const int colbase = latent ? (b0 + bb) * L : NL + (b0 + bb) * LC;
          us[i] = o == 0 ? sconv(PT + (size_t)in_row * MT, colbase, t, LL, latent, w0, w1, w2, bs) : bf2f(PT[(size_t)in_row * MT + colbase + t]); } }
    __syncthreads();
    float acc[NBT][NT];
#pragma unroll
    for (int bj = 0; bj < NBT; ++bj)
#pragma unroll
        for (int tj = 0; tj < NT; ++tj) acc[bj][tj] = 0.f;
    const int tb = tid % TPB, bg = tid / TPB;
#pragma unroll 4
    for (int s = 0; s < LL; ++s) { float kv[NT], uv[NBT];
#pragma unroll
        for (int tj = 0; tj < NT; ++tj) kv[tj] = kk[LL + tb + TPB * tj - s];
#pragma unroll
        for (int bj = 0; bj < NBT; ++bj) uv[bj] = us[(bg + BG * bj) * LL + s];
#pragma unroll
        for (int bj = 0; bj < NBT; ++bj)
#pragma unroll
            for (int tj = 0; tj < NT; ++tj) acc[bj][tj] += kv[tj] * uv[bj]; }
    const float hb = F.in[20][((size_t)l * 2 + o) * 384 + c];
    const float m0 = cw[mul_ch], m1 = cw[1152 + mul_ch], m2 = cw[2304 + mul_ch], mb = cb[mul_ch];
    bf16* PTw = WSP(bf16, WS_PT);
#pragma unroll
    for (int bj = 0; bj < NBT; ++bj)
#pragma unroll
        for (int tj = 0; tj < NT; ++tj) { const int bb = bg + BG * bj, t = tb + TPB * tj; const int colbase = latent ? (b0 + bb) * L : NL + (b0 + bb) * LC;
            const float uval = us[bb * LL + t]; const float xm = sconv(PT + (size_t)mul_row * MT, colbase, t, LL, latent, m0, m1, m2, mb);
            PTw[(size_t)out_row * MT + colbase + t] = (bf16)f2bf(xm * (acc[bj][tj] + hb * uval)); asm volatile("" ::: "memory"); }
    __syncthreads();
}
__device__ __forceinline__ void hyena_stage(Frame& F_, int l, int o) { Frame F = relocal(F_);
    const int nlat = 384 * 4, nctx = l == 0 ? 384 : 0;
    for (int u = F.vcu; u < nlat + nctx; u += F.G) {
        if (u < nlat) hyena_unit<L, 8, 4>(F, l, o, u >> 2, (u & 3) * 4, true);
        else hyena_unit<LC, 1, 8>(F, l, o, u - nlat, 0, false);
    }
}
__device__ __forceinline__ void hyena_transpose(Frame& F_, int nrows) { Frame F = relocal(F_);
    LAS bf16* T = (LAS bf16*)F.lds; constexpr int PITCH = 258;
    const bf16* PT = WSP(bf16, WS_PT); bf16* Y = WSP(bf16, WS_HMOD); const int tid = F.tid;
    const int nrt = nrows / 256;
    for (int it = F.vcu; it < 6 * nrt; it += F.G) { const int cb = it % 6, rt = it / 6;
        { const int c = tid >> 3, seg = tid & 7; const bf16* src = PT + (size_t)(R_HY + 384 + cb * 64 + c) * MT + rt * 256 + seg * 32;
#pragma unroll
          for (int q = 0; q < 4; ++q) { const v4u v = *(const v4u*)(src + q * 8); LAS unsigned* d = (LAS unsigned*)(T + c * PITCH + seg * 32 + q * 8); d[0] = v.x; d[1] = v.y; d[2] = v.z; d[3] = v.w; } }
        __syncthreads();
        { const int r = tid >> 1, half = tid & 1; unsigned w[16];
#pragma unroll
          for (int q = 0; q < 16; ++q) { const unsigned lo = T[(half * 32 + 2 * q) * PITCH + r], hi = T[(half * 32 + 2 * q + 1) * PITCH + r]; w[q] = lo | (hi << 16); }
          bf16* dst = Y + (size_t)(rt * 256 + r) * D + 256 + cb * 64 + half * 32;
#pragma unroll
          for (int q = 0; q < 4; ++q) *(v4u*)(dst + q * 8) = (v4u){w[4 * q], w[4 * q + 1], w[4 * q + 2], w[4 * q + 3]}; }
        __syncthreads();
    }
}

__device__ __forceinline__ void s5_carry(Frame& F_, int l) { Frame F = relocal(F_);
    const float* E = (const float*)((unsigned char*)F.out + DO_E); bf16* HS = (bf16*)((unsigned char*)F.out + DO_HS);
    const int id = F.vcu * NTHR + F.tid;
    if (id >= NB * 24 * 128) return;
    const int p = id & 63, dir = (id >> 6) & 1, g = (id >> 7) % 24, b = id / (128 * 24);
    const size_t ix = (((size_t)l * 2 + dir) * 24 + g) * 64 + p; const float ar = WSP(float, WS_A16)[ix * 2], ai = WSP(float, WS_A16)[ix * 2 + 1];
    const int comp = dir * 128 + 2 * p, q = comp >> 4, i0 = comp & 15;
    float sr = 0.f, si = 0.f;
    for (int step = 0; step < 272; ++step) {
        int cidx;
        if (dir == 0) cidx = step < 16 ? NL / 16 + b * 16 + step : b * 256 + (step - 16);
        else cidx = step < 16 ? NL / 16 + b * 16 + (15 - step) : b * 256 + (255 - (step - 16));
        *(unsigned*)(HS + (size_t)(g * 16 + q) * MT + (size_t)cidx * 16 + i0) = pk2(sr, si);
        const f32x2 e = *(const f32x2*)(E + ((size_t)g * NCHUNK + cidx) * 256 + comp);
        const float nr = ar * sr - ai * si + e.x, ni = ar * si + ai * sr + e.y; sr = nr; si = ni;
    }
}

struct A_WinT { const bf16* w; __device__ __forceinline__ const bf16* operator()(int, int r, int k) const { return w + (size_t)r * D + k; } };
struct E_PT { bf16* pt; __device__ __forceinline__ void operator()(int, int r, int c, f32x4 v0, f32x4 v1) const {
    *(v2u*)(pt + (size_t)r * MT + c) = (v2u){pk2(v0.x, v0.y), pk2(v0.z, v0.w)}; *(v2u*)(pt + (size_t)r * MT + c + 16) = (v2u){pk2(v1.x, v1.y), pk2(v1.z, v1.w)}; } };
struct A_Dft { const bf16* d; int ld; __device__ __forceinline__ const bf16* operator()(int, int r, int k) const { return d + (size_t)r * ld + k; } };
struct B_FnetLat { const bf16* pt; __device__ __forceinline__ const bf16* operator()(int bt, int n, int k) const { return pt + (size_t)((k >> 12) * 256 + n) * MT + bt * L + (k & 4095); } };
struct B_FnetCtx { const bf16* pt; __device__ __forceinline__ const bf16* operator()(int bt, int n, int k) const { return pt + (size_t)((k >> 8) * 256 + n) * MT + NL + bt * LC + (k & 255); } };
struct E_Fnet { bf16* y; int rowbase, rows_per; __device__ __forceinline__ void operator()(int bt, int r, int c, f32x4 v0, f32x4 v1) const { bf16* p = y + (size_t)(rowbase + bt * rows_per + r) * D + c;
    *(v2u*)p = (v2u){pk2(v0.x, v0.y), pk2(v0.z, v0.w)}; *(v2u*)(p + 16) = (v2u){pk2(v1.x, v1.y), pk2(v1.z, v1.w)}; } };
struct A_S5 { const bf16* pt; const bf16* hs; __device__ __forceinline__ const bf16* operator()(int g, int r, int k) const {
    return k < 256 ? pt + (size_t)(R_S5 + g * 16 + (k >> 4)) * MT + (size_t)r * 16 + (k & 15) : hs + (size_t)(g * 16 + ((k - 256) >> 4)) * MT + (size_t)r * 16 + (k & 15); } };
struct B_S5 { const bf16* m; int off, ld; __device__ __forceinline__ const bf16* operator()(int g, int n, int k) const { return (const bf16*)((const unsigned char*)m + (size_t)g * S5M_STRIDE) + off + (size_t)n * ld + k; } };
struct E_S5E { float* e; __device__ __forceinline__ void operator()(int g, int r, int c, f32x4 v0, f32x4 v1) const { float* p = e + ((size_t)g * NCHUNK + r) * 256 + c; *(f32x4*)p = v0; *(f32x4*)(p + 16) = v1; } };
struct E_S5O { bf16* ys; __device__ __forceinline__ void operator()(int g, int r, int c, f32x4 v0, f32x4 v1) const {
    { const int j = c >> 4, h = c & 15; bf16* p = ys + ((size_t)r * 16 + j) * 384 + g * 16 + h; *(v2u*)p = (v2u){pk2(gelu_tanh_f(v0.x), gelu_tanh_f(v0.y)), pk2(gelu_tanh_f(v0.z), gelu_tanh_f(v0.w))}; }
    { const int c1 = c + 16, j = c1 >> 4, h = c1 & 15; bf16* p = ys + ((size_t)r * 16 + j) * 384 + g * 16 + h; *(v2u*)p = (v2u){pk2(gelu_tanh_f(v1.x), gelu_tanh_f(v1.y)), pk2(gelu_tanh_f(v1.z), gelu_tanh_f(v1.w))}; } } };
struct E_Glu { const bf16* ys; bf16* y; const float* gb; __device__ __forceinline__ void one(int r, int c, f32x4 v) const { if (c >= 384) return;
    const v2u yv = *(const v2u*)(ys + (size_t)r * 384 + c); const f32x4 b = *(const f32x4*)(gb + c);
    const float y0 = bf2f(yv.x & 0xffffu), y1 = bf2f(yv.x >> 16), y2 = bf2f(yv.y & 0xffffu), y3 = bf2f(yv.y >> 16);
    *(v2u*)(y + (size_t)r * D + 640 + c) = (v2u){pk2(y0 * sigmoid_f(v.x + b.x), y1 * sigmoid_f(v.y + b.y)), pk2(y2 * sigmoid_f(v.z + b.z), y3 * sigmoid_f(v.w + b.w))}; }
    __device__ __forceinline__ void operator()(int, int r, int c, f32x4 v0, f32x4 v1) const { one(r, c, v0); one(r, c + 16, v1); } };
struct E_Res { const float* xlat; const float* xctx; float* xo; const float* mod; int goff; __device__ __forceinline__ void one(int r, int c, f32x4 v) const {
    const float* xi = r < NL ? xlat + (size_t)r * D + c : xctx + (size_t)(r - NL) * D + c; const f32x4 g = *(const f32x4*)(mod + (size_t)bidx_of(r) * 6144 + goff + c);
    *(f32x4*)(xo + (size_t)r * D + c) = *(const f32x4*)xi + g * v; }
    __device__ __forceinline__ void operator()(int, int r, int c, f32x4 v0, f32x4 v1) const { one(r, c, v0); one(r, c + 16, v1); } };
struct E_Swi { bf16* act; int ld; __device__ __forceinline__ void operator()(int, int r, int c, f32x4 v0, f32x4 v1) const {
    const int f = 16 * (c >> 5) + (c & 15); *(v2u*)(act + (size_t)r * ld + f) = (v2u){pk2(silu_f(v0.x) * v1.x, silu_f(v0.y) * v1.y), pk2(silu_f(v0.z) * v1.z, silu_f(v0.w) * v1.w)}; } };
struct A_MoeUp { const bf16* h; const int* idx; __device__ __forceinline__ const bf16* operator()(int, int r, int k) const { int t = idx[r]; t = t < 0 ? 0 : t; return h + (size_t)t * D + k; } };
struct E_MoeDown { float* x; const int* idx; const unsigned char* topk; const float* mod; int k; __device__ __forceinline__ void one(int r, int c, f32x4 v) const {
    const int t = idx[r]; if (t < 0) return; const float w = *(const float*)(topk + (size_t)t * 16 + 4 + 4 * k); const f32x4 g = *(const f32x4*)(mod + (size_t)(t >> 12) * 6144 + 5120 + c);
    float* p = x + (size_t)t * D + c; *(f32x4*)p = *(const f32x4*)p + g * (v * w); }
    __device__ __forceinline__ void operator()(int, int r, int c, f32x4 v0, f32x4 v1) const { one(r, c, v0); one(r, c + 16, v1); } };

template <class AF, class EP>
__device__ __forceinline__ void gemm_moe(int mtiles, int ntiles, int K, const AF& af, const unsigned char* wbase, size_t woff, int ldb, const int* te, const EP& ep, int vcu, int G) {
    int tid = threadIdx.x; asm volatile("" : "+v"(tid)); asm volatile("" : "+s"(vcu)); const int wid = tid >> 6, lane = tid & 63, wr = wid >> 2, wc = wid & 3, fr = lane & 15, fq = lane >> 4;
    const int nunits = mtiles * ntiles;
    for (int u = vcu; u < nunits; u += G) {
        const int pm = u / ntiles, pn = u - pm * ntiles;
        const int row0 = pm * 128 + wr * 64, col0 = pn * 128 + wc * 32;
        const bf16* B = (const bf16*)(wbase + (size_t)te[pm >> 1] * MOE_E_STRIDE + woff);
        f32x4 acc[4][2];
#pragma unroll
        for (int m = 0; m < 4; ++m) { acc[m][0] = (f32x4){0.f, 0.f, 0.f, 0.f}; acc[m][1] = (f32x4){0.f, 0.f, 0.f, 0.f}; }
#pragma unroll 2
        for (int k = 0; k < K; k += 32) {
            bf16x8 a[4], b[2];
#pragma unroll
            for (int m = 0; m < 4; ++m) a[m] = *(const bf16x8*)af(0, row0 + m * 16 + fr, k + fq * 8);
#pragma unroll
            for (int n = 0; n < 2; ++n) b[n] = *(const bf16x8*)(B + (size_t)(col0 + n * 16 + fr) * ldb + k + fq * 8);
#pragma unroll
            for (int m = 0; m < 4; ++m)
#pragma unroll
                for (int n = 0; n < 2; ++n) acc[m][n] = __builtin_amdgcn_mfma_f32_16x16x32_bf16(b[n], a[m], acc[m][n], 0, 0, 0);
        }
#pragma unroll
        for (int m = 0; m < 4; ++m) ep(0, row0 + m * 16 + fr, col0 + 4 * fq, acc[m][0], acc[m][1]);
    }
}

__global__ void __launch_bounds__(NTHR, 2) mega(Args args) {
    extern __shared__ __attribute__((aligned(16))) unsigned char lds[];
    Frame F;
    F.lds = (LAS unsigned char*)lds; F.tid = threadIdx.x; F.lane = F.tid & 63; F.wave = __builtin_amdgcn_readfirstlane(F.tid >> 6);
    F.G = gridDim.x; { const int bx = blockIdx.x; F.vcu = (F.G % 8 == 0) ? (bx % 8) * (F.G / 8) + bx / 8 : bx; }
    F.in = args.in; F.out = args.out; F.ws = args.ws;
    volatile LAS unsigned* MISC = (volatile LAS unsigned*)(F.lds + LDS_MISC);
    if (F.tid < 16) MISC[F.tid] = 0u;
    __syncthreads();
    XcdBarrier bar; bar.bar = (unsigned*)(F.ws + WS_CTL) + 4096; bar.x = 0; bar.st = nullptr;
    const int lo = args.ph_lo, hi = args.ph_hi;
    if (hi - lo > 1) bar = xcd_barrier_post((unsigned*)(F.ws + WS_CTL) + 4096, MISC + 8);
#define IN(k) (lo <= (k) && (k) < hi)
#define SEAM(k) do { if (IN(k) && IN((k) + 1)) xcd_barrier(bar); } while (0)

    if (IN(PH_P0)) { p0_prologue(F); } SEAM(PH_P0);
    if (IN(PH_P1)) { for (int it = F.vcu; it < 2 * 1632; it += F.G) p1_item(F, it); } SEAM(PH_P1);

    const float* MOD = WSP(float, WS_MOD);
    bf16* HM = WSP(bf16, WS_HMOD); bf16* PT = WSP(bf16, WS_PT); float* BUFA = WSP(float, WS_BUFA);
    float* E = (float*)((unsigned char*)F.out + DO_E); bf16* HS = (bf16*)((unsigned char*)F.out + DO_HS); bf16* YS = (bf16*)((unsigned char*)F.out + DO_YS);
#pragma unroll 1
    for (int l = 0; l < 2; ++l) {
        const int pb = PH_L + l * PH_PER;
        const float* mod = MOD + (size_t)l * 17 * 6144;
        const float* xlat = l == 0 ? F.in[0] : BUFA; const float* xctx = l == 0 ? F.in[2] : BUFA + (size_t)NL * D;
        if (IN(pb + S_NORM1)) norm_rows(F, xlat, xctx, MT, F.in[6] + l * D, mod, 0, 1024, HM);
        SEAM(pb + S_NORM1);
        if (IN(pb + S_G1)) { A_WinT af{WSP(bf16, WS_WIN) + (size_t)l * PTROWS * D}; RowMajor bf{HM, D}; E_PT ep{PT};
            gemm_simple(1, PTROWS / 128, MT / 128, D, af, bf, ep, F.vcu, F.G); }
        SEAM(pb + S_G1);
        if (IN(pb + S_FNET)) {
            { A_Dft af{WSP(bf16, WS_DFT), 2 * L}; B_FnetLat bf{PT}; E_Fnet ep{HM, 0, L}; gemm_simple(NB, L / 128, 2, 2 * L, af, bf, ep, F.vcu, F.G); }
            if (l == 0) { A_Dft af{WSP(bf16, WS_DFTC), 2 * LC}; B_FnetCtx bf{PT}; E_Fnet ep{HM, NL, LC}; gemm_simple(NB, LC / 128, 2, 2 * LC, af, bf, ep, F.vcu, F.G); }
        }
        SEAM(pb + S_FNET);
        if (IN(pb + S_HY1)) hyena_stage(F, l, 0);
        SEAM(pb + S_HY1);
        if (IN(pb + S_S5E)) { A_S5 af{PT, HS}; B_S5 bf{(const bf16*)(F.ws + WS_S5M + (size_t)l * 24 * S5M_STRIDE), 0, 256}; E_S5E ep{E};
            gemm_simple(24, NCHUNK / 128, 2, 256, af, bf, ep, F.vcu, F.G); }
        SEAM(pb + S_S5E);
        if (IN(pb + S_CARRY)) s5_carry(F, l);
        SEAM(pb + S_CARRY);
        if (IN(pb + S_HY2)) hyena_stage(F, l, 1);
        SEAM(pb + S_HY2);
        if (IN(pb + S_S5O)) { A_S5 af{PT, HS}; B_S5 bf{(const bf16*)(F.ws + WS_S5M + (size_t)l * 24 * S5M_STRIDE), 256 * 256, 512}; E_S5O ep{YS};
            gemm_simple(24, NCHUNK / 128, 2, 512, af, bf, ep, F.vcu, F.G); }
        SEAM(pb + S_S5O);
        if (IN(pb + S_GLU)) { RowMajor af{YS, 384}; RowMajor bf{WSP(bf16, WS_GLU) + (size_t)l * 512 * 384, 384}; E_Glu ep{YS, HM, F.in[30] + l * 384};
            gemm_simple(1, MT / 128, 3, 384, af, bf, ep, F.vcu, F.G); }
        SEAM(pb + S_GLU);
        if (IN(pb + S_HYT)) hyena_transpose(F, l == 0 ? MT : NL);
        SEAM(pb + S_HYT);
        if (IN(pb + S_WOUT)) { RowMajor af{HM, D}; RowMajor bf{WSP(bf16, WS_WOUT) + (size_t)l * D * D, D};
            E_Res ep{xlat, xctx, l == 0 ? BUFA : F.out, mod, 2048}; gemm_simple(1, (l == 0 ? MT : NL) / 128, D / 128, D, af, bf, ep, F.vcu, F.G); }
        SEAM(pb + S_WOUT);
        if (l == 0) {
            if (IN(pb + S_NORM2)) norm_rows(F, BUFA, BUFA + (size_t)NL * D, MT, F.in[7], mod, 3072, 4096, HM);
            SEAM(pb + S_NORM2);
            if (IN(pb + S_F0)) { RowMajor af{HM, D}; RowMajor bf{WSP(bf16, WS_FGU), D}; E_Swi ep{WSP(bf16, WS_ACT), DFF}; gemm_simple(1, MT / 128, 2 * DFF / 128, D, af, bf, ep, F.vcu, F.G); }
            SEAM(pb + S_F0);
            if (IN(pb + S_F1)) { RowMajor af{WSP(bf16, WS_ACT), DFF}; RowMajor bf{WSP(bf16, WS_FD), DFF}; E_Res ep{BUFA, BUFA + (size_t)NL * D, BUFA, mod, 5120};
                gemm_simple(1, MT / 128, D / 128, DFF, af, bf, ep, F.vcu, F.G); }
            SEAM(pb + S_F1);
        } else {
            if (IN(pb + S_NORM2)) { norm2_router(F, F.out, F.in[7] + D, mod, HM); moe_transposes(F); }
            SEAM(pb + S_NORM2);
            if (IN(pb + S_F0)) moe_slots(F);
            SEAM(pb + S_F0);
            const int* IDX = (const int*)(F.ws + WS_META + META_IDX); const int* TE = (const int*)(F.ws + WS_META + META_TE); const int* NT = (const int*)(F.ws + WS_META + META_NT);
#pragma unroll 1
            for (int k = 0; k < 2; ++k) {
                if (IN(pb + S_F1 + 2 * k)) { const int nt = NT[k]; A_MoeUp af{HM, IDX + k * MAXSLOT}; E_Swi ep{WSP(bf16, WS_ACT2), DFE};
                    gemm_moe(nt * 2, 2 * DFE / 128, D, af, F.ws + WS_MOEW, 0, D, TE + k * 272, ep, F.vcu, F.G); }
                SEAM(pb + S_F1 + 2 * k);
                if (IN(pb + S_F2 + 2 * k)) { const int nt = NT[k]; RowMajor af{WSP(bf16, WS_ACT2), DFE}; E_MoeDown ep{F.out, IDX + k * MAXSLOT, F.ws + WS_TOPK, mod, k};
                    gemm_moe(nt * 2, D / 128, DFE, af, F.ws + WS_MOEW, MOE_GU_BYTES, DFE, TE + k * 272, ep, F.vcu, F.G); }
                SEAM(pb + S_F2 + 2 * k);
            }
            if (IN(pb + S_F5)) final_norm(F);
        }
    }
#undef IN
#undef SEAM
}

extern "C" void kernel_launch(void* const* d_in, const int* in_sizes, int n_in, void* d_out, int out_size, void* d_ws, size_t ws_size, hipStream_t stream) {
    static int grid = 0;
    if (grid == 0) {
        if (n_in != 40 || out_size != NL * D || ws_size < WS_END) { fprintf(stderr, "kernel_launch: unexpected shapes n_in %d out %d ws %zu (need %zu)\n", n_in, out_size, ws_size, (size_t)WS_END); grid = -1; return; }
        int dev = 0, cus = 0, per_cu = 0;
        if (hipGetDevice(&dev) != hipSuccess || hipDeviceGetAttribute(&cus, hipDeviceAttributeMultiprocessorCount, dev) != hipSuccess) { grid = -1; return; }
        if (hipFuncSetAttribute((const void*)mega, hipFuncAttributeMaxDynamicSharedMemorySize, LDS_BYTES) != hipSuccess) { fprintf(stderr, "kernel_launch: hipFuncSetAttribute failed\n"); grid = -1; return; }
        if (hipOccupancyMaxActiveBlocksPerMultiprocessor(&per_cu, (const void*)mega, NTHR, LDS_BYTES) != hipSuccess || per_cu < 1) fprintf(stderr, "kernel_launch: occupancy query says %d\n", per_cu);
        (void)hipGetLastError();
        grid = cus;
    }
    if (grid < 0) return;
    (void)hipMemsetAsync((char*)d_ws + WS_CTL, 0, CTL_ZERO_BYTES, stream);
    Args a{};
    for (int i = 0; i < 40; ++i) a.in[i] = (const float*)d_in[i];
    a.out = (float*)d_out; a.ws = (unsigned char*)d_ws;
#if MK_ONE_LAUNCH
    a.ph_lo = 0; a.ph_hi = N_PHASES;
    hipLaunchKernelGGL(mega, dim3(grid), dim3(NTHR), LDS_BYTES, stream, a);
#else
    for (int ph = 0; ph < N_PHASES; ++ph) {
        const int s = ph - PH_L;
        if (ph >= PH_L && s < PH_PER && s > S_F1) continue;
        if (ph >= PH_L + PH_PER && (ph - PH_L - PH_PER) > S_F5) continue;
        a.ph_lo = ph; a.ph_hi = ph + 1;
        hipLaunchKernelGGL(mega, dim3(grid), dim3(NTHR), LDS_BYTES, stream, a);
    }
#endif
}
```

```cpp
#include <hip/hip_runtime.h>
#include <cstdio>
#include <cstdint>

#ifndef G8_ALL
#define G8_ALL 1
#endif
#define G8_G1 G8_ALL
#define G8_FNET G8_ALL
#define G8_S5 G8_ALL
#define G8_GLU G8_ALL
#define G8_WOUT G8_ALL
#define G8_FFN G8_ALL
#define G8_MOE G8_ALL
#ifndef MK_ONE_LAUNCH
#define MK_ONE_LAUNCH 1
#endif

#define LAS __attribute__((address_space(3)))
typedef unsigned short bf16;
typedef short bf16x8 __attribute__((ext_vector_type(8)));
typedef float f32x4 __attribute__((ext_vector_type(4)));
typedef float f32x2 __attribute__((ext_vector_type(2)));
typedef unsigned v4u __attribute__((ext_vector_type(4)));
typedef unsigned v2u __attribute__((ext_vector_type(2)));

constexpr int D = 1024, NB = 16, L = 4096, LC = 256, NL = NB * L, NCX = NB * LC, MT = NL + NCX;
constexpr int DIN = 1792, DFF = 2816, NE = 8, DFE = 3584;
constexpr int PTROWS = 2048, R_HY = 512, R_S5 = 1664;
constexpr int NCHUNK = MT / 16;
constexpr int NTHR = 512, NWAVES = 8;
constexpr int MAXSLOT = NL + NE * 256;

constexpr size_t MiB = 1u << 20;
constexpr size_t WS_CTL = 0, CTL_ZERO_BYTES = 1 * MiB;
constexpr size_t WS_MOD = 1 * MiB;
constexpr size_t WS_WIN = 2 * MiB;
constexpr size_t WS_WOUT = 10 * MiB;
constexpr size_t WS_GLU = 14 * MiB;
constexpr size_t WS_FGU = 15 * MiB;
constexpr size_t WS_FD = 26 * MiB;
constexpr size_t WS_DFT = 32 * MiB;
constexpr size_t WS_DFTC = 96 * MiB;
constexpr size_t WS_S5M = 97 * MiB;
constexpr size_t S5M_STRIDE = 256 * 256 * 2 + 256 * 512 * 2;
constexpr size_t WS_A16 = 115 * MiB;
constexpr size_t WS_KT = 116 * MiB;
constexpr size_t WS_KTC = 164 * MiB;
constexpr size_t WS_PS = 167 * MiB;
constexpr size_t WS_TOPK = 171 * MiB;
constexpr size_t WS_META = 172 * MiB;
constexpr size_t META_CNT = 0, META_IDX = 64 * 1024, META_TE = META_IDX + 2 * MAXSLOT * 4, META_NT = META_TE + 2 * 272 * 4;
constexpr size_t WS_HMOD = 173 * MiB;
constexpr size_t WS_BUFA = 309 * MiB;
constexpr size_t WS_R = 581 * MiB;
constexpr size_t WS_END = 1024 * MiB;
constexpr size_t WS_PT = WS_R;
constexpr size_t WS_HT = WS_R;
constexpr size_t WS_ACT = WS_R;
constexpr size_t WS_MOEW = WS_BUFA;
constexpr size_t MOE_GU_BYTES = (size_t)2 * DFE * D * 2, MOE_D_BYTES = (size_t)D * DFE * 2, MOE_E_STRIDE = MOE_GU_BYTES + MOE_D_BYTES;
constexpr size_t WS_ACT2 = WS_BUFA + 168 * MiB;
static_assert(NE * MOE_E_STRIDE <= 168 * MiB, "moe weights");
static_assert(WS_ACT2 + (size_t)MAXSLOT * DFE * 2 <= WS_END, "act2");
static_assert(WS_PT + (size_t)PTROWS * MT * 2 <= WS_END, "pt");
static_assert(WS_ACT + (size_t)MT * DFF * 2 <= WS_END, "act");
static_assert(WS_HMOD + (size_t)MT * D * 2 <= WS_BUFA && WS_BUFA + (size_t)MT * D * 4 <= WS_R, "bufs");
constexpr size_t DO_E = 0, DO_HS = 102 * MiB, DO_YS = 153 * MiB;
static_assert(DO_YS + (size_t)MT * 384 * 2 <= (size_t)NL * D * 4, "d_out scratch");

constexpr int LDS_BYTES = 147456;
constexpr int LDS_MISC = 131072 + 8192;

__device__ __forceinline__ unsigned f2bf(float f) { unsigned u = __builtin_bit_cast(unsigned, f); return (u + 0x7fffu + ((u >> 16) & 1u)) >> 16; }
__device__ __forceinline__ unsigned pk2(float lo, float hi) { return f2bf(lo) | (f2bf(hi) << 16); }
__device__ __forceinline__ float bf2f(unsigned short b) { return __builtin_bit_cast(float, ((unsigned)b) << 16); }
__device__ __forceinline__ float wave_sum(float v, int lane) {
#pragma unroll
    for (int o = 1; o < 64; o <<= 1) v += __builtin_bit_cast(float, __builtin_amdgcn_ds_bpermute((lane ^ o) << 2, __builtin_bit_cast(int, v)));
    return v;
}
__device__ __forceinline__ float silu_f(float x) { return x / (1.0f + __expf(-x)); }
__device__ __forceinline__ float sigmoid_f(float x) { return 1.0f / (1.0f + __expf(-x)); }
__device__ __forceinline__ float gelu_tanh_f(float x) { const float u = 0.7978845608028654f * (x + 0.044715f * x * x * x); return 0.5f * x * (1.0f + tanhf(u)); }
__device__ __forceinline__ int bidx_of(int r) { return r < NL ? (r >> 12) : 16; }

#define XB_TMO      128
#define XB_XCNT(j)  (256  + 64 * (j))
#define XB_XSUB(j)  (1280 + 64 * (j))
#define XB_XGEN(j)  (2304 + 64 * (j))
#define XB_TOP      3328
#define XB_TOPGEN   3392
#define XCD_BAR_WORDS 3456
#define XB_SPIN_CAP (1u << 22)
__device__ __forceinline__ unsigned xb_ld(unsigned* p)              { return __hip_atomic_load(p, __ATOMIC_RELAXED, __HIP_MEMORY_SCOPE_AGENT); }
__device__ __forceinline__ unsigned xb_add(unsigned* p, unsigned v) { return __hip_atomic_fetch_add(p, v, __ATOMIC_RELAXED, __HIP_MEMORY_SCOPE_AGENT); }
__device__ __forceinline__ unsigned xb_xcc_id() { return (unsigned)__builtin_amdgcn_s_getreg((3 << 11) | 20) & 0xFu; }
#define XB_SPIN(cond, bar) do { unsigned _sp = 0; while (cond) { __builtin_amdgcn_s_sleep(1); \
    if ((++_sp & 255u) == 0u) { if (xb_ld(&(bar)[XB_TMO])) break; if (_sp > XB_SPIN_CAP) { atomicAdd(&(bar)[XB_TMO], 1u); break; } } } } while (0)
struct XcdBarrier { unsigned* bar; unsigned x; volatile LAS unsigned* st; };
__device__ __forceinline__ XcdBarrier xcd_barrier_post(unsigned* bar, volatile LAS unsigned* st) {
    XcdBarrier b; b.bar = bar; b.x = xb_xcc_id(); b.st = st;
    if (threadIdx.x == 0) (void)xb_add(&bar[XB_XCNT(b.x)], 1u);
    return b;
}
__device__ __forceinline__ void xcd_barrier_complete(unsigned* bar, unsigned x, unsigned& nloc, unsigned& nx) {
    const unsigned G = gridDim.x * gridDim.y * gridDim.z;
    unsigned sum, cnt, mine, sp = 0u;
    for (;;) {
        sum = 0u; cnt = 0u; mine = 0u;
#pragma unroll
        for (unsigned j = 0; j < 16; ++j) { const unsigned c = xb_ld(&bar[XB_XCNT(j)]); sum += c; cnt += (c > 0u) ? 1u : 0u; mine = (j == x) ? c : mine; }
        if (sum == G) break;
        __builtin_amdgcn_s_sleep(1);
        if ((++sp & 255u) == 0u) { if (xb_ld(&bar[XB_TMO])) break; if (sp > XB_SPIN_CAP) { atomicAdd(&bar[XB_TMO], 1u); break; } }
    }
    nloc = mine > 0u ? mine : 1u; nx = cnt > 0u ? cnt : 1u;
}
__device__ __noinline__ void xcd_barrier(const XcdBarrier b) {
    asm volatile("s_waitcnt vmcnt(0)" ::: "memory");
    __syncthreads();
    if (threadIdx.x == 0) {
        unsigned* bar = b.bar;
        __builtin_amdgcn_s_waitcnt(0);
        unsigned nloc = b.st[0], nx = b.st[1];
        if (nloc == 0u) { xcd_barrier_complete(bar, b.x, nloc, nx); b.st[0] = nloc; b.st[1] = nx; }
        const unsigned old = xb_add(&bar[XB_XSUB(b.x)], 1u);
        const unsigned gen = old / nloc;
        if (old + 1u == (gen + 1u) * nloc) {
            __builtin_amdgcn_fence(__ATOMIC_RELEASE, "agent");
            asm volatile("s_waitcnt vmcnt(0)" ::: "memory");
            const unsigned og = xb_add(&bar[XB_TOP], 1u);
            const unsigned tg = og / nx;
            if (og + 1u == (tg + 1u) * nx) xb_add(&bar[XB_TOPGEN], 1u);
            else XB_SPIN(xb_ld(&bar[XB_TOPGEN]) == tg, bar);
            __builtin_amdgcn_fence(__ATOMIC_ACQUIRE, "agent");
            xb_add(&bar[XB_XGEN(b.x)], 1u);
            asm volatile("s_waitcnt vmcnt(0)" ::: "memory");
        } else {
            XB_SPIN(xb_ld(&bar[XB_XGEN(b.x)]) == gen, bar);
            __builtin_amdgcn_fence(__ATOMIC_ACQUIRE, "agent");
            asm volatile("s_waitcnt vmcnt(0)" ::: "memory");
        }
    }
    __syncthreads();
}

template <class AF, class BF, class EP>
__device__ __forceinline__ void gemm_simple(int nbatch, int mtiles, int ntiles, int K, const AF& af, const BF& bf, const EP& ep, int vcu, int G) {
    int tid = threadIdx.x; asm volatile("" : "+v"(tid)); asm volatile("" : "+s"(vcu)); const int wid = tid >> 6, lane = tid & 63, wr = wid >> 2, wc = wid & 3, fr = lane & 15, fq = lane >> 4;
    const int per = mtiles * ntiles, nunits = nbatch * per;
    for (int u = vcu; u < nunits; u += G) {
        const int bt = u / per, rem = u - bt * per, pm = rem / ntiles, pn = rem - pm * ntiles;
        const int row0 = pm * 128 + wr * 64, col0 = pn * 128 + wc * 32;
        f32x4 acc[4][2];
#pragma unroll
        for (int m = 0; m < 4; ++m) { acc[m][0] = (f32x4){0.f, 0.f, 0.f, 0.f}; acc[m][1] = (f32x4){0.f, 0.f, 0.f, 0.f}; }
#pragma unroll 2
        for (int k = 0; k < K; k += 32) {
            bf16x8 a[4], b[2];
#pragma unroll
            for (int m = 0; m < 4; ++m) a[m] = *(const bf16x8*)af(bt, row0 + m * 16 + fr, k + fq * 8);
#pragma unroll
            for (int n = 0; n < 2; ++n) b[n] = *(const bf16x8*)bf(bt, col0 + n * 16 + fr, k + fq * 8);
#pragma unroll
            for (int m = 0; m < 4; ++m)
#pragma unroll
                for (int n = 0; n < 2; ++n) acc[m][n] = __builtin_amdgcn_mfma_f32_16x16x32_bf16(b[n], a[m], acc[m][n], 0, 0, 0);
        }
#pragma unroll
        for (int m = 0; m < 4; ++m) ep(bt, row0 + m * 16 + fr, col0 + 4 * fq, acc[m][0], acc[m][1]);
    }
}
struct RowMajor { const bf16* p; long ld; __device__ __forceinline__ const bf16* operator()(int, int r, int k) const { return p + (long)r * ld + k; } };

namespace g8 {
constexpr int BM = 256, BK = 64, HALF = 128, HTB = HALF * BK * 2, NXCD = 8, WGM = 8;
__device__ __forceinline__ int lds_byte(int r, int c) { const int st = (r >> 4) * 2 + (c >> 5), rr = r & 15, cc = c & 31, ob = rr * 64 + cc * 2; return st * 1024 + (ob ^ (((ob >> 9) & 1) << 5)); }
__device__ __forceinline__ void stage_rc(int b, int& R, int& C) { const int st = b / 1024, sb = b % 1024, swz = sb ^ (((sb >> 9) & 1) << 5); R = (st >> 1) * 16 + swz / 64; C = (st & 1) * 32 + (swz % 64) / 2; }
struct Unit { int bt, pm, pn; };
struct Order {
    int nM, nN, per, nwg, G, c;
    __device__ __forceinline__ void init(int nb, int nM_, int nN_, int G_, int c_) { nM = nM_; nN = nN_; per = nM_ * nN_; nwg = nb * per; G = G_; c = c_; }
    __device__ __forceinline__ bool next(int i, Unit& u) const {
        const long Lx = (long)i * G + c; if (Lx >= nwg) return false;
        int wgid = (int)Lx; { const int q = nwg / NXCD, r = nwg % NXCD, xcd = wgid % NXCD, off = wgid / NXCD; wgid = (xcd < r ? xcd * (q + 1) : r * (q + 1) + (xcd - r) * q) + off; }
        u.bt = wgid / per; const int rem = wgid - u.bt * per;
        const int nig = WGM * nN, gid = rem / nig, fm = gid * WGM, gsz = (nM - fm) < WGM ? (nM - fm) : WGM;
        u.pm = fm + ((rem % nig) % gsz); u.pn = (rem % nig) / gsz; return true;
    }
};
template <bool ISA> struct OpRow {
    static constexpr bool GATHER = false;
    const char* p; long ld2; long bstride;
    __device__ __forceinline__ unsigned off(int R, int C) const { return (unsigned)(R * (int)ld2 + C * 2); }
    __device__ __forceinline__ const char* base(const Unit& u) const { return p + (long)u.bt * bstride + (long)(ISA ? u.pm : u.pn) * 256 * ld2; }
    __device__ __forceinline__ long koff(int t) const { return (long)t * 128; }
    __device__ __forceinline__ long hstep() const { return 128 * ld2; }
};
struct OpS5A {
    static constexpr bool GATHER = false;
    const char* ptb; long delta;
    __device__ __forceinline__ unsigned off(int R, int C) const { return (unsigned)((C >> 4) * (MT * 2) + R * 32 + (C & 15) * 2); }
    __device__ __forceinline__ const char* base(const Unit& u) const { return ptb + ((long)u.bt * 16 * MT + (long)u.pm * 4096) * 2; }
    __device__ __forceinline__ long koff(int t) const { return t < 4 ? (long)t * 4 * MT * 2 : delta + (long)(t - 4) * 4 * MT * 2; }
    __device__ __forceinline__ long hstep() const { return 4096; }
};
struct OpFnetB {
    static constexpr bool GATHER = false;
    const char* p; int seq2; int sh;
    __device__ __forceinline__ unsigned off(int R, int C) const { return (unsigned)(R * (MT * 2) + C * 2); }
    __device__ __forceinline__ const char* base(const Unit& u) const { return p + (long)u.bt * seq2 + (long)u.pn * 256 * MT * 2; }
    __device__ __forceinline__ long koff(int t) const { return (long)(t >> sh) * 256 * MT * 2 + (long)(t & ((1 << sh) - 1)) * 128; }
    __device__ __forceinline__ long hstep() const { return (long)128 * MT * 2; }
};
struct OpMoeA {
    static constexpr bool GATHER = true;
    const char* h; const int* idx;
    __device__ __forceinline__ unsigned off(int, int) const { return 0u; }
    __device__ __forceinline__ unsigned goff(const Unit& u, int R, int C) const { int t = idx[u.pm * 256 + R]; t = t < 0 ? 0 : t; return (unsigned)t * 2048u + (unsigned)C * 2u; }
    __device__ __forceinline__ const char* base(const Unit&) const { return h; }
    __device__ __forceinline__ long koff(int t) const { return (long)t * 128; }
    __device__ __forceinline__ long hstep() const { return 0; }
};
struct OpMoeB {
    static constexpr bool GATHER = false;
    const char* w; const int* te; long ld2;
    __device__ __forceinline__ unsigned off(int R, int C) const { return (unsigned)(R * (int)ld2 + C * 2); }
    __device__ __forceinline__ const char* base(const Unit& u) const { return w + (long)te[u.pm] * (long)MOE_E_STRIDE + (long)u.pn * 256 * ld2; }
    __device__ __forceinline__ long koff(int t) const { return (long)t * 128; }
    __device__ __forceinline__ long hstep() const { return 128 * ld2; }
};

template <class OA, class OB, class Epi>
__device__ __forceinline__ void gemm8(LAS unsigned char* lds, const int nt, const OA& oa, const OB& ob, const Order& S, const Epi& E) {
    int tid = threadIdx.x; asm volatile("" : "+v"(tid));
    const int wid = __builtin_amdgcn_readfirstlane(tid >> 6), lane = tid & 63, wr = wid >> 2, wc = wid & 3, fr = lane & 15, fq = lane >> 4;
    unsigned voffA[2][2], voffB[2]; int RR[2], CC[2];
#pragma unroll
    for (int i = 0; i < 2; ++i) { stage_rc(tid * 16 + i * 8192, RR[i], CC[i]); voffB[i] = ob.off(RR[i], CC[i]); voffA[0][i] = oa.off(RR[i], CC[i]); voffA[1][i] = 0u; }
    const long hA = oa.hstep(), hB = ob.hstep();
    const unsigned ldsw = (unsigned)wid * 1024u;
    const int aoff = lds_byte(wr * 64 + fr, fq * 8), boff = lds_byte(wc * 32 + fr, fq * 8);
#define G8_SA(b, h) (((b) * 2 + (h)) * HTB)
#define G8_SB(b, h) ((4 + (b) * 2 + (h)) * HTB)
#define G8_STAGE_B(bufoff, gbase) do { _Pragma("unroll") for (int _i = 0; _i < 2; ++_i) \
        __builtin_amdgcn_global_load_lds((const unsigned*)((const char*)(gbase) + voffB[_i]), (LAS unsigned*)(lds + (bufoff) + ldsw + _i * 8192), 16, 0, 0); } while (0)
#define G8_STAGE_A(bufoff, gbase, h) do { _Pragma("unroll") for (int _i = 0; _i < 2; ++_i) \
        __builtin_amdgcn_global_load_lds((const unsigned*)((const char*)(gbase) + (OA::GATHER ? 0 : (h) * hA) + voffA[OA::GATHER ? (h) : 0][_i]), (LAS unsigned*)(lds + (bufoff) + ldsw + _i * 8192), 16, 0, 0); } while (0)
#define G8_LDA(dst, b, h) do { _Pragma("unroll") for (int m = 0; m < 4; ++m) _Pragma("unroll") for (int k = 0; k < 2; ++k) dst[m][k] = *(const LAS bf16x8*)(lds + G8_SA(b, h) + aoff + m * 2048 + k * 1024); } while (0)
#define G8_LDB(dst, b, h) do { _Pragma("unroll") for (int n = 0; n < 2; ++n) _Pragma("unroll") for (int k = 0; k < 2; ++k) dst[n][k] = *(const LAS bf16x8*)(lds + G8_SB(b, h) + boff + n * 2048 + k * 1024); } while (0)
#define G8_MMA(ai, bj, At, Bt) do { __builtin_amdgcn_s_setprio(1); _Pragma("unroll") for (int m = 0; m < 4; ++m) _Pragma("unroll") for (int n = 0; n < 2; ++n) _Pragma("unroll") for (int k = 0; k < 2; ++k) \
        acc[ai][bj][m][n] = __builtin_amdgcn_mfma_f32_16x16x32_bf16(Bt[n][k], At[m][k], acc[ai][bj][m][n], 0, 0, 0); __builtin_amdgcn_s_setprio(0); } while (0)
#define G8_WAIT_V(n) asm volatile("s_waitcnt vmcnt(" #n ")" ::: "memory")
#define G8_WAIT_L(n) asm volatile("s_waitcnt lgkmcnt(" #n ")" ::: "memory")
#define G8_BAR __builtin_amdgcn_s_barrier()
#define G8_SCHED __builtin_amdgcn_sched_barrier(0)
#define G8_GOFF(u) do { if constexpr (OA::GATHER) { _Pragma("unroll") for (int _h = 0; _h < 2; ++_h) _Pragma("unroll") for (int _i = 0; _i < 2; ++_i) voffA[_h][_i] = oa.goff(u, RR[_i] + 128 * _h, CC[_i]); } } while (0)
    Unit cur, nxt; int ui = 0;
    if (!S.next(0, cur)) return;
    f32x4 acc[2][2][4][2];
#pragma unroll
    for (int a = 0; a < 2; ++a)
#pragma unroll
        for (int b = 0; b < 2; ++b)
#pragma unroll
            for (int m = 0; m < 4; ++m)
#pragma unroll
                for (int n = 0; n < 2; ++n) acc[a][b][m][n] = (f32x4){0.f, 0.f, 0.f, 0.f};
    bf16x8 At[4][2], B0[2][2], B1[2][2];
    const char* cA = oa.base(cur); const char* cB = ob.base(cur);
    G8_GOFF(cur);
    {   const long ka0 = oa.koff(0), ka1 = oa.koff(1), kb0 = ob.koff(0), kb1 = ob.koff(1);
        G8_STAGE_B(G8_SB(0, 0), cB + kb0); G8_STAGE_B(G8_SB(0, 1), cB + kb0 + hB); G8_STAGE_A(G8_SA(0, 0), cA + ka0, 0); G8_STAGE_A(G8_SA(0, 1), cA + ka0, 1);
        if (wr == 1) G8_BAR;
        G8_WAIT_V(2); G8_BAR;
        G8_STAGE_B(G8_SB(1, 0), cB + kb1); G8_STAGE_A(G8_SA(1, 0), cA + ka1, 0); G8_STAGE_B(G8_SB(1, 1), cB + kb1 + hB);
        G8_WAIT_V(6); G8_BAR; }
    for (;;) {
        const bool has_next = S.next(ui + 1, nxt);
        const char* nA = has_next ? oa.base(nxt) : cA; const char* nB = has_next ? ob.base(nxt) : cB;
        for (int t = 0; t < nt; t += 2) {
            const bool last = (t == nt - 2);
            const char* a1 = cA + oa.koff(t + 1);
            const char* a2 = last ? nA + oa.koff(0) : cA + oa.koff(t + 2); const char* b2 = last ? nB + ob.koff(0) : cB + ob.koff(t + 2);
            const char* a3 = last ? nA + oa.koff(1) : cA + oa.koff(t + 3); const char* b3 = last ? nB + ob.koff(1) : cB + ob.koff(t + 3);
            G8_LDB(B0, 0, 0); G8_LDB(B1, 0, 1); G8_SCHED; G8_LDA(At, 0, 0); G8_STAGE_A(G8_SA(1, 1), a1, 1);
            if (last && has_next) G8_GOFF(nxt);
            G8_WAIT_V(8); G8_WAIT_L(0); G8_BAR; G8_MMA(0, 0, At, B0); G8_MMA(0, 1, At, B1); G8_BAR; G8_SCHED;
            G8_LDA(At, 0, 1); G8_STAGE_B(G8_SB(0, 0), b2); G8_STAGE_B(G8_SB(0, 1), b2 + hB); G8_STAGE_A(G8_SA(0, 0), a2, 0);
            G8_WAIT_V(8); G8_WAIT_L(0); G8_BAR; G8_MMA(1, 0, At, B0); G8_MMA(1, 1, At, B1); G8_BAR; G8_SCHED;
            G8_LDB(B0, 1, 0); G8_LDB(B1, 1, 1); G8_SCHED; G8_LDA(At, 1, 0); G8_STAGE_A(G8_SA(0, 1), a2, 1);
            G8_WAIT_V(8); G8_WAIT_L(0); G8_BAR; G8_MMA(0, 0, At, B0); G8_MMA(0, 1, At, B1); G8_BAR; G8_SCHED;
            G8_LDA(At, 1, 1); G8_STAGE_B(G8_SB(1, 0), b3); G8_STAGE_B(G8_SB(1, 1), b3 + hB); G8_STAGE_A(G8_SA(1, 0), a3, 0);
            G8_WAIT_V(8); G8_WAIT_L(0); G8_BAR; G8_MMA(1, 0, At, B0); G8_MMA(1, 1, At, B1); G8_BAR; G8_SCHED;
        }
        if (wr == 0) G8_BAR;
        {   const int row0 = cur.pm * BM + wr * 64 + fr, col0 = cur.pn * BM + wc * 32 + 4 * fq;
#pragma unroll
            for (int ai = 0; ai < 2; ++ai)
#pragma unroll
                for (int m = 0; m < 4; ++m)
#pragma unroll
                    for (int bj = 0; bj < 2; ++bj) E(cur.bt, row0 + ai * HALF + m * 16, col0 + bj * HALF, acc[ai][bj][m][0], acc[ai][bj][m][1]); }
        if (!has_next) break;
#pragma unroll
        for (int a = 0; a < 2; ++a)
#pragma unroll
            for (int b = 0; b < 2; ++b)
#pragma unroll
                for (int m = 0; m < 4; ++m)
#pragma unroll
                    for (int n = 0; n < 2; ++n) acc[a][b][m][n] = (f32x4){0.f, 0.f, 0.f, 0.f};
        cur = nxt; cA = nA; cB = nB; ++ui;
        if (wr == 1) G8_BAR;
    }
    G8_WAIT_V(0);
    G8_BAR;
#undef G8_SA
#undef G8_SB
#undef G8_STAGE_A
#undef G8_STAGE_B
#undef G8_LDA
#undef G8_LDB
#undef G8_MMA
#undef G8_WAIT_V
#undef G8_WAIT_L
#undef G8_BAR
#undef G8_SCHED
#undef G8_GOFF
}
}

struct Args { const float* in[40]; float* out; unsigned char* ws; int ph_lo, ph_hi; };
struct Frame {
    LAS unsigned char* lds; int tid, lane, wave, vcu, G;
    const float* const* in; float* out; unsigned char* ws;
};
#define WSP(T, off) ((T*)(F.ws + (off)))
__device__ __forceinline__ Frame relocal(const Frame& F0) { Frame F = F0; int t = threadIdx.x; asm volatile("" : "+v"(t)); F.tid = t; F.lane = t & 63; F.wave = __builtin_amdgcn_readfirstlane(t >> 6); int v = F0.vcu; asm volatile("" : "+s"(v)); F.vcu = v; return F; }

constexpr int PH_P0 = 0, PH_P1 = 1, PH_L = 2, PH_PER = 20, N_PHASES = PH_L + 2 * PH_PER;
enum { S_NORM1 = 0, S_G1, S_FNET, S_HY1, S_S5E, S_CARRY, S_HY2, S_S5O, S_GLU, S_HYT, S_WOUT, S_NORM2, S_F0, S_F1, S_F2, S_F3, S_F4, S_F5 };

__device__ __forceinline__ int rowmap(int mode, int row_off, int n) { return mode == 0 ? row_off + n : (32 * (n >> 4) + (n & 15) + (mode == 2 ? 16 : 0)); }
__device__ __forceinline__ void transpose_item(const float* W, int ldw, int col0, int N, bf16* WT, int ldk, int mode, int row_off, LAS float* scr, int item, int lane) {
    const int nblk = N / 32, kb = item / nblk, nb = item % nblk, k0 = 64 * kb, n0 = 32 * nb;
#pragma unroll 8
    for (int i = 0; i < 32; ++i) { const int kk = 2 * i + (lane >> 5); scr[kk * 33 + (lane & 31)] = W[(size_t)(k0 + kk) * ldw + col0 + n0 + (lane & 31)]; }
    asm volatile("s_waitcnt lgkmcnt(0)" ::: "memory");
    const int c = lane & 7;
#pragma unroll
    for (int j = 0; j < 4; ++j) { const int n = (lane >> 3) + 8 * j; const LAS float* s = scr + (8 * c) * 33 + n;
        v4u o; o.x = pk2(s[0 * 33], s[1 * 33]); o.y = pk2(s[2 * 33], s[3 * 33]); o.z = pk2(s[4 * 33], s[5 * 33]); o.w = pk2(s[6 * 33], s[7 * 33]);
        *(v4u*)(WT + (size_t)rowmap(mode, row_off, n0 + n) * ldk + k0 + 8 * c) = o; }
    asm volatile("s_waitcnt lgkmcnt(0)" ::: "memory");
}

__device__ __forceinline__ void p0_transposes(Frame& F) {
    LAS float* scr = (LAS float*)(F.lds + F.wave * 16384);
    const int gw = F.vcu * NWAVES + F.wave, NGW = F.G * NWAVES;
    constexpr int I_IN = 16 * 48, I_OUT = 16 * 32, I_GLU = 6 * 12, I_FG = 16 * 88, I_FD = 44 * 32;
    constexpr int NIT = 2 * (I_IN + I_OUT + I_GLU) + 2 * I_FG + I_FD;
    for (int it = gw; it < NIT; it += NGW) {
        int r = it;
        if (r < 2 * I_IN) { const int l = r / I_IN; transpose_item(F.in[8] + (size_t)l * D * DIN, DIN, 256, 1536, WSP(bf16, WS_WIN) + (size_t)l * PTROWS * D, D, 0, 512, scr, r % I_IN, F.lane); continue; } r -= 2 * I_IN;
        if (r < 2 * I_OUT) { const int l = r / I_OUT; transpose_item(F.in[9] + (size_t)l * D * D, D, 0, D, WSP(bf16, WS_WOUT) + (size_t)l * D * D, D, 0, 0, scr, r % I_OUT, F.lane); continue; } r -= 2 * I_OUT;
        if (r < 2 * I_GLU) { const int l = r / I_GLU; transpose_item(F.in[29] + (size_t)l * 384 * 384, 384, 0, 384, WSP(bf16, WS_GLU) + (size_t)l * 512 * 384, 384, 0, 0, scr, r % I_GLU, F.lane); continue; } r -= 2 * I_GLU;
        if (r < I_FG) { transpose_item(F.in[31], DFF, 0, DFF, WSP(bf16, WS_FGU), D, 1, 0, scr, r, F.lane); continue; } r -= I_FG;
        if (r < I_FG) { transpose_item(F.in[32], DFF, 0, DFF, WSP(bf16, WS_FGU), D, 2, 0, scr, r, F.lane); continue; } r -= I_FG;
        transpose_item(F.in[33], D, 0, D, WSP(bf16, WS_FD), DFF, 0, 0, scr, r, F.lane);
    }
}
__device__ __forceinline__ void moe_transposes(Frame& F_) { Frame F = relocal(F_);
    LAS float* scr = (LAS float*)(F.lds + F.wave * 16384);
    const int gw = F.vcu * NWAVES + F.wave, NGW = F.G * NWAVES;
    constexpr int I_G = 16 * 112, I_D = 56 * 32, PER_E = 2 * I_G + I_D;
    for (int it = gw; it < NE * PER_E; it += NGW) {
        const int e = it / PER_E; int r = it % PER_E;
        bf16* gu = (bf16*)(F.ws + WS_MOEW + (size_t)e * MOE_E_STRIDE); bf16* dn = (bf16*)(F.ws + WS_MOEW + (size_t)e * MOE_E_STRIDE + MOE_GU_BYTES);
        if (r < I_G) { transpose_item(F.in[36] + (size_t)e * D * DFE, DFE, 0, DFE, gu, D, 1, 0, scr, r, F.lane); continue; } r -= I_G;
        if (r < I_G) { transpose_item(F.in[37] + (size_t)e * D * DFE, DFE, 0, DFE, gu, D, 2, 0, scr, r, F.lane); continue; } r -= I_G;
        transpose_item(F.in[38] + (size_t)e * DFE * D, D, 0, D, dn, DFE, 0, 0, scr, r, F.lane);
    }
}

__device__ __forceinline__ void p0_mod_item(Frame& F, int item) {
    const int l = item / 48, cb = item % 48, tid = F.tid;
    LAS float* sc = (LAS float*)F.lds;
    LAS float* red = sc + 17 * 1024;
    for (int i = tid; i < 17 * 1024; i += NTHR) { const int r = i >> 10, k = i & 1023; const float v = r < 16 ? F.in[1][r * D + k] : F.in[3][k]; sc[i] = silu_f(v); }
    __syncthreads();
    const int col = cb * 128 + (tid & 127), kg = tid >> 7;
    const float* W = F.in[4] + (size_t)l * D * 6144 + col;
    float acc[17];
#pragma unroll
    for (int r = 0; r < 17; ++r) acc[r] = 0.f;
    for (int k = kg * 256; k < kg * 256 + 256; ++k) { const float w = W[(size_t)k * 6144];
#pragma unroll
        for (int r = 0; r < 17; ++r) acc[r] += sc[r * 1024 + k] * w; }
#pragma unroll
    for (int r = 0; r < 17; ++r) red[(kg * 17 + r) * 128 + (tid & 127)] = acc[r];
    __syncthreads();
    for (int i = tid; i < 17 * 128; i += NTHR) { const int r = i >> 7, c = i & 127;
        const float s = red[(0 * 17 + r) * 128 + c] + red[(1 * 17 + r) * 128 + c] + red[(2 * 17 + r) * 128 + c] + red[(3 * 17 + r) * 128 + c];
        WSP(float, WS_MOD)[((size_t)l * 17 + r) * 6144 + cb * 128 + c] = s + F.in[5][l * 6144 + cb * 128 + c]; }
    __syncthreads();
}
__device__ __forceinline__ void p0_fold_item(Frame& F, int item) {
    const int kb = item & 7, cs = (item >> 3) & 1, h = (item >> 4) & 3, l = item >> 6, tid = F.tid;
    LAS float* A = (LAS float*)F.lds;
    const float* wf = F.in[10] + ((size_t)l * 4 + h) * 64 * 64;
    for (int i = tid; i < 4096; i += NTHR) { const int d = i >> 6, e2 = i & 63; float s = 0.f;
        for (int e = 0; e < 64; ++e) { const int m = (e * d) & 63; const float tr = cs ? sinpif((float)m * (1.0f / 32.0f)) : cospif((float)m * (1.0f / 32.0f)); s += tr * wf[e * 64 + e2]; }
        A[i] = s * 0.125f; }
    __syncthreads();
    const int e2 = tid & 63;
    const float* win = F.in[8] + (size_t)l * D * DIN + h * 64;
    bf16* wt = WSP(bf16, WS_WIN) + (size_t)l * PTROWS * D + (size_t)(cs * 256 + h * 64 + e2) * D;
    for (int i = 0; i < 16; ++i) { const int kk = kb * 128 + (tid >> 6) + 8 * i; float s = 0.f;
        for (int d = 0; d < 64; ++d) s += win[(size_t)kk * DIN + d] * A[d * 64 + e2];
        wt[kk] = (bf16)f2bf(s); }
    __syncthreads();
}
__device__ __forceinline__ void gen_dft_rows(bf16* dst, int LL, int row0, int nrows, float scale, int tid) {
    const int cpr = 2 * LL / 8;
    for (int i = tid; i < nrows * cpr; i += NTHR) { const int k = row0 + i / cpr, j0 = (i % cpr) * 8; unsigned w[4];
#pragma unroll
        for (int q = 0; q < 4; ++q) { float v[2];
#pragma unroll
            for (int z = 0; z < 2; ++z) { const int j = j0 + 2 * q + z; const int jj = j < LL ? j : j - LL; const int m = (k * jj) & (LL - 1); const float x = (float)m * (2.0f / (float)LL);
                v[z] = (j < LL ? cospif(x) : -sinpif(x)) * scale; }
            w[q] = pk2(v[0], v[1]); }
        *(v4u*)(dst + (size_t)k * 2 * LL + j0) = (v4u){w[0], w[1], w[2], w[3]}; }
}
__device__ __forceinline__ void p0_filter_item(Frame& F, int item) {
    const int l = item / 272, pb = item % 272, tid = F.tid;
    const int LL = pb < 256 ? L : LC, p0 = pb < 256 ? pb * 16 : (pb - 256) * 16;
    LAS float* z = (LAS float*)F.lds;
    LAS float* h1 = z + 16 * 36;
    LAS float* h2 = h1 + 16 * 64;
    for (int i = tid; i < 16 * 33; i += NTHR) { const int pp = i / 33, j = i % 33; const int pos = p0 + pp;
        const double w = 6.283185307179586 * (double)pos / (double)LL; double v;
        if (j == 0) v = (double)pos / (double)(LL - 1);
        else { const int bj = (j - 1) & 15; const double band = 1e-4 + (double)bj * ((15.0 - 1e-4) / 15.0); v = j <= 16 ? cos(band * w) : -sin(band * w); }
        z[pp * 36 + j] = (float)v; }
    __syncthreads();
    for (int i = tid; i < 1024; i += NTHR) { const int pp = i >> 6, o = i & 63; float s = F.in[14][l * 64 + o];
        for (int j = 0; j < 33; ++j) s += z[pp * 36 + j] * F.in[13][((size_t)l * 33 + j) * 64 + o];
        h1[i] = sinf(F.in[15][l * 64 + o] * s); }
    __syncthreads();
    for (int i = tid; i < 1024; i += NTHR) { const int pp = i >> 6, o = i & 63; float s = F.in[17][l * 64 + o];
        for (int j = 0; j < 64; ++j) s += h1[pp * 64 + j] * F.in[16][((size_t)l * 64 + j) * 64 + o];
        h2[i] = sinf(F.in[18][l * 64 + o] * s); }
    __syncthreads();
    float* HT = WSP(float, WS_HT) + ((size_t)l * 4352 + (pb < 256 ? 0 : 4096)) * 1536;
    float* PS = WSP(float, WS_PS) + ((size_t)l * 272 + pb) * 1536;
    const float* fw3 = F.in[19] + (size_t)l * 64 * 1536;
    const float dmin = 3.0701134573253945f, dstep = (15.350567286626973f - 3.0701134573253945f) / 383.0f;
#pragma unroll 1
    for (int cc = 0; cc < 3; ++cc) { const int col = tid + 512 * cc; float acc[16];
#pragma unroll
        for (int pp = 0; pp < 16; ++pp) acc[pp] = 0.f;
        for (int j = 0; j < 64; ++j) { const float w = fw3[(size_t)j * 1536 + col];
#pragma unroll
            for (int pp = 0; pp < 16; ++pp) acc[pp] += h2[pp * 64 + j] * w; }
        const int c = col % 384, dir = col / 768; const float delta = dmin + (float)c * dstep; float ps = 0.f;
#pragma unroll
        for (int pp = 0; pp < 16; ++pp) { const int pos = p0 + pp; const float t = (float)pos / (float)(LL - 1); const float v = acc[pp] * __expf(-t * delta);
            HT[(size_t)pos * 1536 + col] = v; if (!(dir == 1 && pos == 0)) ps += fabsf(v); }
        PS[col] = ps; }
    __syncthreads();
}
__device__ __forceinline__ void p0_s5_item(Frame& F, int item) {
    const int l = item / 24, g = item % 24, tid = F.tid;
    LAS f32x2* apow = (LAS f32x2*)F.lds;
    LAS f32x2* bbar = apow + 2 * 17 * 64;
    LAS f32x2* Cc = bbar + 2 * 64 * 16;
    LAS float* Kd = (LAS float*)(Cc + 2 * 16 * 64);
    if (tid < 128) { const int dir = tid >> 6, p = tid & 63; const size_t ix = (((size_t)l * 2 + dir) * 24 + g) * 64 + p;
        const double are = F.in[21][ix], aim = F.in[22][ix], dt = exp((double)F.in[23][((size_t)l * 2 + dir) * 24 + g]);
        for (int tau = 0; tau <= 16; ++tau) { const double mg = exp(are * dt * tau), an = aim * dt * tau; apow[(dir * 17 + tau) * 64 + p] = (f32x2){(float)(mg * cos(an)), (float)(mg * sin(an))}; }
        const double mg = exp(are * dt), an = aim * dt; const double nr = mg * cos(an) - 1.0, ni = mg * sin(an); const double den = are * are + aim * aim;
        const double qr = (nr * are + ni * aim) / den, qi = (ni * are - nr * aim) / den;
        for (int h = 0; h < 16; ++h) { const double br = F.in[24][ix * 16 + h], bi = F.in[25][ix * 16 + h]; bbar[(dir * 64 + p) * 16 + h] = (f32x2){(float)(qr * br - qi * bi), (float)(qr * bi + qi * br)}; }
        const double m16 = exp(are * dt * 16.0), a16 = aim * dt * 16.0;
        WSP(float, WS_A16)[ix * 2 + 0] = (float)(m16 * cos(a16)); WSP(float, WS_A16)[ix * 2 + 1] = (float)(m16 * sin(a16)); }
    for (int i = tid; i < 2 * 16 * 64; i += NTHR) { const int dir = i >> 10, h = (i >> 6) & 15, p = i & 63; const size_t ix = ((((size_t)l * 2 + dir) * 24 + g) * 16 + h) * 64 + p;
        Cc[i] = (f32x2){F.in[26][ix], F.in[27][ix]}; }
    __syncthreads();
    for (int i = tid; i < 2 * 16 * 256; i += NTHR) { const int dir = i >> 12, tau = (i >> 8) & 15, h = (i >> 4) & 15, h2 = i & 15; float s = 0.f;
        for (int p = 0; p < 64; ++p) { const f32x2 a = apow[(dir * 17 + tau) * 64 + p], b = bbar[(dir * 64 + p) * 16 + h2], c = Cc[(dir * 16 + h) * 64 + p];
            const float tr = a.x * b.x - a.y * b.y, ti = a.x * b.y + a.y * b.x; s += c.x * tr - c.y * ti; }
        Kd[i] = s; }
    __syncthreads();
    bf16* EST = (bf16*)(F.ws + WS_S5M + (size_t)item * S5M_STRIDE); bf16* MOUT = EST + 256 * 256;
    for (int i = tid; i < 256 * 256; i += NTHR) { const int n = i >> 8, k = i & 255; const int dir = n >> 7, p = (n >> 1) & 63, ri = n & 1, hh = k >> 4, j = k & 15;
        const int tau = dir == 0 ? 15 - j : j; const f32x2 a = apow[(dir * 17 + tau) * 64 + p], b = bbar[(dir * 64 + p) * 16 + hh];
        const float v = ri == 0 ? a.x * b.x - a.y * b.y : a.x * b.y + a.y * b.x; EST[i] = (bf16)f2bf(v); }
    const float* dsk = F.in[28] + (size_t)l * 384 + g * 16;
    for (int i = tid; i < 256 * 512; i += NTHR) { const int n = i >> 9, k = i & 511; const int j = n >> 4, h = n & 15; float v;
        if (k < 256) { const int hh = k >> 4, ii = k & 15; v = 0.f;
            if (ii <= j) v += Kd[((0 * 16 + (j - ii)) * 16 + h) * 16 + hh];
            if (ii >= j) v += Kd[((1 * 16 + (ii - j)) * 16 + h) * 16 + hh];
            if (ii == j && h == hh) v += dsk[h]; }
        else { const int comp = k - 256, dir = comp >> 7, p = (comp >> 1) & 63, ri = comp & 1; const int tau = dir == 0 ? j + 1 : 16 - j;
            const f32x2 a = apow[(dir * 17 + tau) * 64 + p], c = Cc[(dir * 16 + h) * 64 + p];
            v = ri == 0 ? (c.x * a.x - c.y * a.y) : -(c.x * a.y + c.y * a.x); }
        MOUT[i] = (bf16)f2bf(v); }
    __syncthreads();
}
__device__ __forceinline__ void p0_prologue(Frame& F_) { Frame F = relocal(F_);
    p0_transposes(F);
    __syncthreads();
    for (int i = F.vcu * NTHR + F.tid; i < 2 * 128 * 384 / 8; i += F.G * NTHR) { const int l = i / (128 * 384 / 8), r = i % (128 * 384 / 8);
        *(v4u*)(WSP(bf16, WS_GLU) + (size_t)l * 512 * 384 + 384 * 384 + (size_t)r * 8) = (v4u){0u, 0u, 0u, 0u}; }
    constexpr int I_MOD = 96, I_FOLD = 128, I_DFT = 512, I_DFTC = 4, I_FIL = 544, I_S5 = 48, NIT = I_MOD + I_FOLD + I_DFT + I_DFTC + I_FIL + I_S5;
    for (int it = F.vcu; it < NIT; it += F.G) {
        int r = it;
        if (r < I_FIL) { p0_filter_item(F, r); continue; } r -= I_FIL;
        if (r < I_MOD) { p0_mod_item(F, r); continue; } r -= I_MOD;
        if (r < I_FOLD) { p0_fold_item(F, r); continue; } r -= I_FOLD;
        if (r < I_S5) { p0_s5_item(F, r); continue; } r -= I_S5;
        if (r < I_DFT) { gen_dft_rows(WSP(bf16, WS_DFT), L, r * 8, 8, 1.0f / 64.0f, F.tid); continue; } r -= I_DFT;
        gen_dft_rows(WSP(bf16, WS_DFTC), LC, r * 64, 64, 1.0f / 16.0f, F.tid);
    }
}
__device__ __forceinline__ void p1_item(Frame& F_, int item) { Frame F = relocal(F_);
    const int l = item / 1632; int r = item % 1632; const int set = r < 1536 ? 0 : 1; if (set) r -= 1536;
    const int npb = set ? 4 : 64, LL = set ? LC : L, pb = r % npb, ocb = r / npb, o = ocb / 12, cb = ocb % 12, tid = F.tid;
    LAS float* red = (LAS float*)F.lds;
    LAS float* inv = red + 512;
    LAS float* T = inv + 32;
    const float* PS = WSP(float, WS_PS) + ((size_t)l * 272 + (set ? 256 : 0)) * 1536;
    { const int ch = tid & 31, part = tid >> 5; float s = 0.f; const int nblk = LL / 16;
      for (int b = part; b < nblk; b += 16) s += PS[(size_t)b * 1536 + o * 384 + cb * 32 + ch] + PS[(size_t)b * 1536 + 768 + o * 384 + cb * 32 + ch];
      red[part * 32 + ch] = s; }
    __syncthreads();
    if (tid < 32) { float s = 0.f; for (int p = 0; p < 16; ++p) s += red[p * 32 + tid]; inv[tid] = 1.0f / s; }
    const float* HT = WSP(float, WS_HT) + ((size_t)l * 4352 + (set ? 4096 : 0)) * 1536;
    { const int ch = tid & 31, dir = (tid >> 5) & 1;
      for (int i = 0; i < 8; ++i) { const int pp = (tid >> 6) + 8 * i; T[(dir * 64 + pp) * 33 + ch] = HT[(size_t)(pb * 64 + pp) * 1536 + dir * 768 + o * 384 + cb * 32 + ch]; } }
    __syncthreads();
    float* KT = set ? WSP(float, WS_KTC) + ((size_t)(l * 2 + o) * 384) * 512 : WSP(float, WS_KT) + ((size_t)(l * 2 + o) * 384) * 8192;
    { const int pp = tid & 63;
      for (int i = 0; i < 4; ++i) { const int ch = (tid >> 6) + 8 * i; const int pos = pb * 64 + pp; float* kt = KT + (size_t)(cb * 32 + ch) * 2 * LL;
          kt[LL + pos] = T[(0 * 64 + pp) * 33 + ch] * inv[ch];
          if (pos > 0) kt[LL - pos] = T[(1 * 64 + pp) * 33 + ch] * inv[ch]; else kt[0] = 0.f; } }
    __syncthreads();
}

__device__ __forceinline__ void norm_rows(Frame& F_, const float* xlat, const float* xctx, int nrows, const float* gain, const float* mod, int sh_off, int sc_off, bf16* out) { Frame F = relocal(F_);
    const int gw = F.vcu * NWAVES + F.wave, NGW = F.G * NWAVES, lane = F.lane;
    for (int r = gw; r < nrows; r += NGW) {
        const float* xr = r < NL ? xlat + (size_t)r * D : xctx + (size_t)(r - NL) * D;
        const float* md = mod + (size_t)bidx_of(r) * 6144;
        f32x4 v[4]; float ss = 0.f;
#pragma unroll
        for (int j = 0; j < 4; ++j) { v[j] = ((const f32x4*)xr)[64 * j + lane]; ss += (v[j].x * v[j].x + v[j].y * v[j].y) + (v[j].z * v[j].z + v[j].w * v[j].w); }
        const float rstd = 1.0f / sqrtf(wave_sum(ss, lane) * (1.0f / D) + 1e-6f);
#pragma unroll
        for (int j = 0; j < 4; ++j) { const int col = (64 * j + lane) * 4; const f32x4 g4 = *(const f32x4*)(gain + col), sc = *(const f32x4*)(md + sc_off + col), sh = *(const f32x4*)(md + sh_off + col);
            const f32x4 h = v[j] * rstd * g4 * (sc + 1.0f) + sh;
            *(v2u*)(out + (size_t)r * D + col) = (v2u){pk2(h.x, h.y), pk2(h.z, h.w)}; }
    }
}
__device__ __forceinline__ void norm2_router(Frame& F_, const float* x, const float* gain, const float* mod, bf16* out) { Frame F = relocal(F_);
    LAS int* hist = (LAS int*)F.lds;
    const float* rw = F.in[34]; const float* rb = F.in[35];
    for (int tile = F.vcu; tile < NL / 256; tile += F.G) {
        if (F.tid < 16) hist[F.tid] = 0;
        __syncthreads();
        for (int i = 0; i < 32; ++i) { const int r = tile * 256 + F.wave * 32 + i, lane = F.lane;
            const float* xr = x + (size_t)r * D; const float* md = mod + (size_t)(r >> 12) * 6144;
            f32x4 v[4]; float ss = 0.f;
#pragma unroll
            for (int j = 0; j < 4; ++j) { v[j] = ((const f32x4*)xr)[64 * j + lane]; ss += (v[j].x * v[j].x + v[j].y * v[j].y) + (v[j].z * v[j].z + v[j].w * v[j].w); }
            const float rstd = 1.0f / sqrtf(wave_sum(ss, lane) * (1.0f / D) + 1e-6f);
            float lg[8];
#pragma unroll
            for (int e = 0; e < 8; ++e) lg[e] = 0.f;
#pragma unroll
            for (int j = 0; j < 4; ++j) { const int col = (64 * j + lane) * 4; const f32x4 g4 = *(const f32x4*)(gain + col), sc = *(const f32x4*)(md + 4096 + col), sh = *(const f32x4*)(md + 3072 + col);
                const f32x4 h = v[j] * rstd * g4 * (sc + 1.0f) + sh;
                *(v2u*)(out + (size_t)r * D + col) = (v2u){pk2(h.x, h.y), pk2(h.z, h.w)};
#pragma unroll
                for (int q = 0; q < 4; ++q) { const f32x4 w0 = *(const f32x4*)(rw + (size_t)(col + q) * 8), w1 = *(const f32x4*)(rw + (size_t)(col + q) * 8 + 4); const float hv = h[q];
                    lg[0] += hv * w0.x; lg[1] += hv * w0.y; lg[2] += hv * w0.z; lg[3] += hv * w0.w; lg[4] += hv * w1.x; lg[5] += hv * w1.y; lg[6] += hv * w1.z; lg[7] += hv * w1.w; } }
#pragma unroll
            for (int e = 0; e < 8; ++e) lg[e] = wave_sum(lg[e], lane) + rb[e];
            if (lane == 0) {
                int e1 = 0; float v1 = lg[0];
#pragma unroll
                for (int e = 1; e < 8; ++e) if (lg[e] > v1) { v1 = lg[e]; e1 = e; }
                int e2 = -1; float v2 = -3.4e38f;
#pragma unroll
                for (int e = 0; e < 8; ++e) if (e != e1 && lg[e] > v2) { v2 = lg[e]; e2 = e; }
                const float ex = __expf(v2 - v1), w1 = 1.0f / (1.0f + ex), w2 = ex / (1.0f + ex);
                *(v4u*)(F.ws + WS_TOPK + (size_t)r * 16) = (v4u){(unsigned)(e1 | (e2 << 8)), __builtin_bit_cast(unsigned, w1), __builtin_bit_cast(unsigned, w2), 0u};
                __hip_atomic_fetch_add(hist + e1, 1, __ATOMIC_RELAXED, __HIP_MEMORY_SCOPE_WORKGROUP); __hip_atomic_fetch_add(hist + 8 + e2, 1, __ATOMIC_RELAXED, __HIP_MEMORY_SCOPE_WORKGROUP);
            } }
        __syncthreads();
        if (F.tid < 16) ((int*)(F.ws + WS_META + META_CNT))[tile * 16 + F.tid] = hist[F.tid];
        __syncthreads();
    }
}
__device__ __forceinline__ void moe_slots(Frame& F_) { Frame F = relocal(F_);
    LAS int* tot = (LAS int*)F.lds;
    LAS int* es = tot + 32;
    const int* CNT = (const int*)(F.ws + WS_META + META_CNT); int* IDX = (int*)(F.ws + WS_META + META_IDX); int* TE = (int*)(F.ws + WS_META + META_TE); int* NT = (int*)(F.ws + WS_META + META_NT);
    for (int it = F.vcu; it < 512; it += F.G) { const int k = it >> 8, tile = it & 255, tid = F.tid;
        if (tid < 8) { int t = 0, b = 0; for (int i = 0; i < 256; ++i) { const int c = CNT[i * 16 + k * 8 + tid]; if (i < tile) b += c; t += c; } tot[tid] = t; tot[8 + tid] = b; }
        __syncthreads();
        if (tid == 0) { int s = 0; for (int e = 0; e < 8; ++e) { tot[16 + e] = s; s += (tot[e] + 255) & ~255; } tot[24] = s; }
        if (tid < 256) { const unsigned pk = *(const unsigned*)(F.ws + WS_TOPK + (size_t)(tile * 256 + tid) * 16); es[tid] = k == 0 ? (int)(pk & 255u) : (int)((pk >> 8) & 255u); }
        __syncthreads();
        if (tid < 256) { const int e = es[tid]; int rank = 0; for (int j = 0; j < tid; ++j) rank += (es[j] == e) ? 1 : 0;
            IDX[k * MAXSLOT + tot[16 + e] + tot[8 + e] + rank] = tile * 256 + tid; }
        if (tile == 0) {
            for (int e = 0; e < 8; ++e) { const int n = tot[e], np = (n + 255) & ~255, sb = tot[16 + e];
                for (int i = n + tid; i < np; i += NTHR) IDX[k * MAXSLOT + sb + i] = -1;
                for (int i = tid; i < np / 256; i += NTHR) TE[k * 272 + sb / 256 + i] = e; }
            if (tid == 0) NT[k] = tot[24] / 256; }
        __syncthreads();
    }
}
__device__ __forceinline__ void final_norm(Frame& F_) { Frame F = relocal(F_);
    const int gw = F.vcu * NWAVES + F.wave, NGW = F.G * NWAVES, lane = F.lane; const float* gain = F.in[39];
    for (int r = gw; r < NL; r += NGW) { float* xr = F.out + (size_t)r * D; f32x4 v[4]; float ss = 0.f;
#pragma unroll
        for (int j = 0; j < 4; ++j) { v[j] = ((const f32x4*)xr)[64 * j + lane]; ss += (v[j].x * v[j].x + v[j].y * v[j].y) + (v[j].z * v[j].z + v[j].w * v[j].w); }
        const float rstd = 1.0f / sqrtf(wave_sum(ss, lane) * (1.0f / D) + 1e-6f);
#pragma unroll
        for (int j = 0; j < 4; ++j) { const int col = (64 * j + lane) * 4; ((f32x4*)xr)[64 * j + lane] = v[j] * rstd * *(const f32x4*)(gain + col); } }
}

__device__ __forceinline__ float sconv(const bf16* prow, int colbase, int t, int LL, bool grid, float w0, float w1, float w2, float bias) {
    const bool hasl = grid ? ((t & 63) != 0) : (t > 0), hasr = grid ? ((t & 63) != 63) : (t < LL - 1);
    const float c = bf2f(prow[colbase + t]), a = hasl ? bf2f(prow[colbase + t - 1]) : 0.f, b = hasr ? bf2f(prow[colbase + t + 1]) : 0.f;
    return a * w0 + c * w1 + b * w2 + bias;
}
template <int LL, int NT, int NBT>
__device__ __forceinline__ void hyena_unit(Frame& F, int l, int o, int c, int b0, bool latent) {
    constexpr int TPB = LL / NT, BG = NTHR / TPB, NBU = BG * NBT;
    LAS float* kk = (LAS float*)F.lds;
    LAS float* us = kk + 2 * LL;
    const int tid = F.tid;
    const bf16* PT = WSP(bf16, WS_PT);
    const float* cw = F.in[11] + (size_t)l * 3 * 1152; const float* cb = F.in[12] + (size_t)l * 1152;
    const int in_row = R_HY + c;
    const int mul_row = R_HY + 384 * (o + 1) + c, mul_ch = 384 * (o + 1) + c;
    const int out_row = o == 0 ? R_HY + c : R_HY + 384 + c;
    const float* KT = latent ? WSP(float, WS_KT) + ((size_t)(l * 2 + o) * 384 + c) * 8192 : WSP(float, WS_KTC) + ((size_t)(l * 2 + o) * 384 + c) * 512;
    for (int i = tid; i < 2 * LL; i += NTHR) kk[i] = KT[i];
    { const float w0 = cw[c], w1 = cw[1152 + c], w2 = cw[2304 + c], bs = cb[c];
      for (int i = tid; i < NBU * LL; i += NTHR) { const int bb = i / LL, t = i % LL; const int colbase = latent ? (b0 + bb) * L : NL + (b0 + bb) * LC;
          us[i] = o == 0 ? sconv(PT + (size_t)in_row * MT, colbase, t, LL, latent, w0, w1, w2, bs) : bf2f(PT[(size_t)in_row * MT + colbase + t]); } }
    __syncthreads();
    float acc[NBT][NT];
#pragma unroll
    for (int bj = 0; bj < NBT; ++bj)
#pragma unroll
        for (int tj = 0; tj < NT; ++tj) acc[bj][tj] = 0.f;
    const int tb = tid % TPB, bg = tid / TPB;
#pragma unroll 4
    for (int s = 0; s < LL; ++s) { float kv[NT], uv[NBT];
#pragma unroll
        for (int tj = 0; tj < NT; ++tj) kv[tj] = kk[LL + tb + TPB * tj - s];
#pragma unroll
        for (int bj = 0; bj < NBT; ++bj) uv[bj] = us[(bg + BG * bj) * LL + s];
#pragma unroll
        for (int bj = 0; bj < NBT; ++bj)
#pragma unroll
            for (int tj = 0; tj < NT; ++tj) acc[bj][tj] += kv[tj] * uv[bj]; }
    const float hb = F.in[20][((size_t)l * 2 + o) * 384 + c];
    const float m0 = cw[mul_ch], m1 = cw[1152 + mul_ch], m2 = cw[2304 + mul_ch], mb = cb[mul_ch];
    bf16* PTw = WSP(bf16, WS_PT);
#pragma unroll
    for (int bj = 0; bj < NBT; ++bj)
#pragma unroll
        for (int tj = 0; tj < NT; ++tj) { const int bb = bg + BG * bj, t = tb + TPB * tj; const int colbase = latent ? (b0 + bb) * L : NL + (b0 + bb) * LC;
            const float uval = us[bb * LL + t]; const float xm = sconv(PT + (size_t)mul_row * MT, colbase, t, LL, latent, m0, m1, m2, mb);
            PTw[(size_t)out_row * MT + colbase + t] = (bf16)f2bf(xm * (acc[bj][tj] + hb * uval)); asm volatile("" ::: "memory"); }
    __syncthreads();
}
__device__ __forceinline__ void hyena_stage(Frame& F_, int l, int o) { Frame F = relocal(F_);
    const int nlat = 384 * 4, nctx = l == 0 ? 384 : 0;
    for (int u = F.vcu; u < nlat + nctx; u += F.G) {
        if (u < nlat) hyena_unit<L, 8, 4>(F, l, o, u >> 2, (u & 3) * 4, true);
        else hyena_unit<LC, 1, 8>(F, l, o, u - nlat, 0, false);
    }
}
__device__ __forceinline__ void hyena_transpose(Frame& F_, int nrows) { Frame F = relocal(F_);
    LAS bf16* T = (LAS bf16*)F.lds; constexpr int PITCH = 258;
    const bf16* PT = WSP(bf16, WS_PT); bf16* Y = WSP(bf16, WS_HMOD); const int tid = F.tid;
    const int nrt = nrows / 256;
    for (int it = F.vcu; it < 6 * nrt; it += F.G) { const int cb = it % 6, rt = it / 6;
        { const int c = tid >> 3, seg = tid & 7; const bf16* src = PT + (size_t)(R_HY + 384 + cb * 64 + c) * MT + rt * 256 + seg * 32;
#pragma unroll
          for (int q = 0; q < 4; ++q) { const v4u v = *(const v4u*)(src + q * 8); LAS unsigned* d = (LAS unsigned*)(T + c * PITCH + seg * 32 + q * 8); d[0] = v.x; d[1] = v.y; d[2] = v.z; d[3] = v.w; } }
        __syncthreads();
        { const int r = tid >> 1, half = tid & 1; unsigned w[16];
#pragma unroll
          for (int q = 0; q < 16; ++q) { const unsigned lo = T[(half * 32 + 2 * q) * PITCH + r], hi = T[(half * 32 + 2 * q + 1) * PITCH + r]; w[q] = lo | (hi << 16); }
          bf16* dst = Y + (size_t)(rt * 256 + r) * D + 256 + cb * 64 + half * 32;
#pragma unroll
          for (int q = 0; q < 4; ++q) *(v4u*)(dst + q * 8) = (v4u){w[4 * q], w[4 * q + 1], w[4 * q + 2], w[4 * q + 3]}; }
        __syncthreads();
    }
}

__device__ __forceinline__ void s5_carry(Frame& F_, int l) { Frame F = relocal(F_);
    const float* E = (const float*)((unsigned char*)F.out + DO_E); bf16* HS = (bf16*)((unsigned char*)F.out + DO_HS);
    const int id = F.vcu * NTHR + F.tid;
    if (id >= NB * 24 * 128) return;
    const int p = id & 63, dir = (id >> 6) & 1, g = (id >> 7) % 24, b = id / (128 * 24);
    const size_t ix = (((size_t)l * 2 + dir) * 24 + g) * 64 + p; const float ar = WSP(float, WS_A16)[ix * 2], ai = WSP(float, WS_A16)[ix * 2 + 1];
    const int comp = dir * 128 + 2 * p, q = comp >> 4, i0 = comp & 15;
    float sr = 0.f, si = 0.f;
    for (int step = 0; step < 272; ++step) {
        int cidx;
        if (dir == 0) cidx = step < 16 ? NL / 16 + b * 16 + step : b * 256 + (step - 16);
        else cidx = step < 16 ? NL / 16 + b * 16 + (15 - step) : b * 256 + (255 - (step - 16));
        *(unsigned*)(HS + (size_t)(g * 16 + q) * MT + (size_t)cidx * 16 + i0) = pk2(sr, si);
        const f32x2 e = *(const f32x2*)(E + ((size_t)g * NCHUNK + cidx) * 256 + comp);
        const float nr = ar * sr - ai * si + e.x, ni = ar * si + ai * sr + e.y; sr = nr; si = ni;
    }
}

struct A_WinT { const bf16* w; __device__ __forceinline__ const bf16* operator()(int, int r, int k) const { return w + (size_t)r * D + k; } };
struct E_PT { bf16* pt; __device__ __forceinline__ void operator()(int, int r, int c, f32x4 v0, f32x4 v1) const {
    *(v2u*)(pt + (size_t)r * MT + c) = (v2u){pk2(v0.x, v0.y), pk2(v0.z, v0.w)}; *(v2u*)(pt + (size_t)r * MT + c + 16) = (v2u){pk2(v1.x, v1.y), pk2(v1.z, v1.w)}; } };
struct A_Dft { const bf16* d; int ld; __device__ __forceinline__ const bf16* operator()(int, int r, int k) const { return d + (size_t)r * ld + k; } };
struct B_FnetLat { const bf16* pt; __device__ __forceinline__ const bf16* operator()(int bt, int n, int k) const { return pt + (size_t)((k >> 12) * 256 + n) * MT + bt * L + (k & 4095); } };
struct B_FnetCtx { const bf16* pt; __device__ __forceinline__ const bf16* operator()(int bt, int n, int k) const { return pt + (size_t)((k >> 8) * 256 + n) * MT + NL + bt * LC + (k & 255); } };
struct E_Fnet { bf16* y; int rowbase, rows_per; __device__ __forceinline__ void operator()(int bt, int r, int c, f32x4 v0, f32x4 v1) const { bf16* p = y + (size_t)(rowbase + bt * rows_per + r) * D + c;
    *(v2u*)p = (v2u){pk2(v0.x, v0.y), pk2(v0.z, v0.w)}; *(v2u*)(p + 16) = (v2u){pk2(v1.x, v1.y), pk2(v1.z, v1.w)}; } };
struct A_S5 { const bf16* pt; const bf16* hs; __device__ __forceinline__ const bf16* operator()(int g, int r, int k) const {
    return k < 256 ? pt + (size_t)(R_S5 + g * 16 + (k >> 4)) * MT + (size_t)r * 16 + (k & 15) : hs + (size_t)(g * 16 + ((k - 256) >> 4)) * MT + (size_t)r * 16 + (k & 15); } };
struct B_S5 { const bf16* m; int off, ld; __device__ __forceinline__ const bf16* operator()(int g, int n, int k) const { return (const bf16*)((const unsigned char*)m + (size_t)g * S5M_STRIDE) + off + (size_t)n * ld + k; } };
struct E_S5E { float* e; __device__ __forceinline__ void operator()(int g, int r, int c, f32x4 v0, f32x4 v1) const { float* p = e + ((size_t)g * NCHUNK + r) * 256 + c; *(f32x4*)p = v0; *(f32x4*)(p + 16) = v1; } };
struct E_S5O { bf16* ys; __device__ __forceinline__ void operator()(int g, int r, int c, f32x4 v0, f32x4 v1) const {
    { const int j = c >> 4, h = c & 15; bf16* p = ys + ((size_t)r * 16 + j) * 384 + g * 16 + h; *(v2u*)p = (v2u){pk2(gelu_tanh_f(v0.x), gelu_tanh_f(v0.y)), pk2(gelu_tanh_f(v0.z), gelu_tanh_f(v0.w))}; }
    { const int c1 = c + 16, j = c1 >> 4, h = c1 & 15; bf16* p = ys + ((size_t)r * 16 + j) * 384 + g * 16 + h; *(v2u*)p = (v2u){pk2(gelu_tanh_f(v1.x), gelu_tanh_f(v1.y)), pk2(gelu_tanh_f(v1.z), gelu_tanh_f(v1.w))}; } } };
struct E_Glu { const bf16* ys; bf16* y; const float* gb; __device__ __forceinline__ void one(int r, int c, f32x4 v) const { if (c >= 384) return;
    const v2u yv = *(const v2u*)(ys + (size_t)r * 384 + c); const f32x4 b = *(const f32x4*)(gb + c);
    const float y0 = bf2f(yv.x & 0xffffu), y1 = bf2f(yv.x >> 16), y2 = bf2f(yv.y & 0xffffu), y3 = bf2f(yv.y >> 16);
    *(v2u*)(y + (size_t)r * D + 640 + c) = (v2u){pk2(y0 * sigmoid_f(v.x + b.x), y1 * sigmoid_f(v.y + b.y)), pk2(y2 * sigmoid_f(v.z + b.z), y3 * sigmoid_f(v.w + b.w))}; }
    __device__ __forceinline__ void operator()(int, int r, int c, f32x4 v0, f32x4 v1) const { one(r, c, v0); one(r, c + 16, v1); } };
struct E_Res { const float* xlat; const float* xctx; float* xo; const float* mod; int goff; __device__ __forceinline__ void one(int r, int c, f32x4 v) const {
    const float* xi = r < NL ? xlat + (size_t)r * D + c : xctx + (size_t)(r - NL) * D + c; const f32x4 g = *(const f32x4*)(mod + (size_t)bidx_of(r) * 6144 + goff + c);
    *(f32x4*)(xo + (size_t)r * D + c) = *(const f32x4*)xi + g * v; }
    __device__ __forceinline__ void operator()(int, int r, int c, f32x4 v0, f32x4 v1) const { one(r, c, v0); one(r, c + 16, v1); } };
struct E_Swi { bf16* act; int ld; __device__ __forceinline__ void operator()(int, int r, int c, f32x4 v0, f32x4 v1) const {
    const int f = 16 * (c >> 5) + (c & 15); *(v2u*)(act + (size_t)r * ld + f) = (v2u){pk2(silu_f(v0.x) * v1.x, silu_f(v0.y) * v1.y), pk2(silu_f(v0.z) * v1.z, silu_f(v0.w) * v1.w)}; } };
struct A_MoeUp { const bf16* h; const int* idx; __device__ __forceinline__ const bf16* operator()(int, int r, int k) const { int t = idx[r]; t = t < 0 ? 0 : t; return h + (size_t)t * D + k; } };
struct E_MoeDown { float* x; const int* idx; const unsigned char* topk; const float* mod; int k; __device__ __forceinline__ void one(int r, int c, f32x4 v) const {
    const int t = idx[r]; if (t < 0) return; const float w = *(const float*)(topk + (size_t)t * 16 + 4 + 4 * k); const f32x4 g = *(const f32x4*)(mod + (size_t)(t >> 12) * 6144 + 5120 + c);
    float* p = x + (size_t)t * D + c; *(f32x4*)p = *(const f32x4*)p + g * (v * w); }
    __device__ __forceinline__ void operator()(int, int r, int c, f32x4 v0, f32x4 v1) const { one(r, c, v0); one(r, c + 16, v1); } };

template <class AF, class EP>
__device__ __forceinline__ void gemm_moe(int mtiles, int ntiles, int K, const AF& af, const unsigned char* wbase, size_t woff, int ldb, const int* te, const EP& ep, int vcu, int G) {
    int tid = threadIdx.x; asm volatile("" : "+v"(tid)); asm volatile("" : "+s"(vcu)); const int wid = tid >> 6, lane = tid & 63, wr = wid >> 2, wc = wid & 3, fr = lane & 15, fq = lane >> 4;
    const int nunits = mtiles * ntiles;
    for (int u = vcu; u < nunits; u += G) {
        const int pm = u / ntiles, pn = u - pm * ntiles;
        const int row0 = pm * 128 + wr * 64, col0 = pn * 128 + wc * 32;
        const bf16* B = (const bf16*)(wbase + (size_t)te[pm >> 1] * MOE_E_STRIDE + woff);
        f32x4 acc[4][2];
#pragma unroll
        for (int m = 0; m < 4; ++m) { acc[m][0] = (f32x4){0.f, 0.f, 0.f, 0.f}; acc[m][1] = (f32x4){0.f, 0.f, 0.f, 0.f}; }
#pragma unroll 2
        for (int k = 0; k < K; k += 32) {
            bf16x8 a[4], b[2];
#pragma unroll
            for (int m = 0; m < 4; ++m) a[m] = *(const bf16x8*)af(0, row0 + m * 16 + fr, k + fq * 8);
#pragma unroll
            for (int n = 0; n < 2; ++n) b[n] = *(const bf16x8*)(B + (size_t)(col0 + n * 16 + fr) * ldb + k + fq * 8);
#pragma unroll
            for (int m = 0; m < 4; ++m)
#pragma unroll
                for (int n = 0; n < 2; ++n) acc[m][n] = __builtin_amdgcn_mfma_f32_16x16x32_bf16(b[n], a[m], acc[m][n], 0, 0, 0);
        }
#pragma unroll
        for (int m = 0; m < 4; ++m) ep(0, row0 + m * 16 + fr, col0 + 4 * fq, acc[m][0], acc[m][1]);
    }
}

__device__ __forceinline__ Frame mkframe(const Args& args, unsigned char* ldsp) {
    Frame F; F.lds = (LAS unsigned char*)ldsp;
    int t = threadIdx.x; asm volatile("" : "+v"(t)); F.tid = t; F.lane = t & 63; F.wave = __builtin_amdgcn_readfirstlane(t >> 6);
    int g = gridDim.x, bx = blockIdx.x; asm volatile("" : "+s"(g), "+s"(bx)); F.G = g; F.vcu = (g % 8 == 0) ? (bx % 8) * (g / 8) + bx / 8 : bx;
    unsigned char* w = args.ws; float* o = args.out; asm volatile("" : "+s"(w), "+s"(o)); F.ws = w; F.out = o; F.in = args.in;
    return F;
}
__global__ void __launch_bounds__(NTHR, 2) mega(Args args) {
    extern __shared__ __attribute__((aligned(16))) unsigned char lds[];
    volatile LAS unsigned* MISC = (volatile LAS unsigned*)((LAS unsigned char*)lds + LDS_MISC);
    if (threadIdx.x < 16) MISC[threadIdx.x] = 0u;
    __syncthreads();
    XcdBarrier bar; bar.bar = (unsigned*)(args.ws + WS_CTL) + 4096; bar.x = 0; bar.st = nullptr;
    const int lo = args.ph_lo, hi = args.ph_hi;
    if (hi - lo > 1) bar = xcd_barrier_post((unsigned*)(args.ws + WS_CTL) + 4096, MISC + 8);
#define IN(k) (lo <= (k) && (k) < hi)
#define SEAM(k) do { if (IN(k) && IN((k) + 1)) xcd_barrier(bar); } while (0)
#define PHF Frame F = mkframe(args, lds); const int bxi = (int)blockIdx.x; (void)bxi
#define P_MOD (WSP(float, WS_MOD) + (size_t)l * 17 * 6144)
#define P_HM WSP(bf16, WS_HMOD)
#define P_PT WSP(bf16, WS_PT)
#define P_BUFA WSP(float, WS_BUFA)
#define P_E ((float*)((unsigned char*)F.out + DO_E))
#define P_HS ((bf16*)((unsigned char*)F.out + DO_HS))
#define P_YS ((bf16*)((unsigned char*)F.out + DO_YS))

    if (IN(PH_P0)) { PHF; p0_prologue(F); } SEAM(PH_P0);
    if (IN(PH_P1)) { PHF; for (int it = F.vcu; it < 2 * 1632; it += F.G) p1_item(F, it); } SEAM(PH_P1);

#pragma unroll 1
    for (int l = 0; l < 2; ++l) {
        const int pb = PH_L + l * PH_PER;
        if (IN(pb + S_NORM1)) { PHF; const float* xlat = l == 0 ? F.in[0] : P_BUFA; const float* xctx = l == 0 ? F.in[2] : P_BUFA + (size_t)NL * D;
            norm_rows(F, xlat, xctx, MT, F.in[6] + l * D, P_MOD, 0, 1024, P_HM); }
        SEAM(pb + S_NORM1);
        if (IN(pb + S_G1)) { PHF; E_PT ep{P_PT};
            g8::OpRow<true> oa{(const char*)(WSP(bf16, WS_WIN) + (size_t)l * PTROWS * D), D * 2, 0}; g8::OpRow<false> ob{(const char*)P_HM, D * 2, 0}; g8::Order S; S.init(1, PTROWS / 256, MT / 256, F.G, bxi);
            g8::gemm8(F.lds, D / 64, oa, ob, S, ep); }
        SEAM(pb + S_G1);
        if (IN(pb + S_FNET)) { PHF;
            { g8::OpRow<true> oa{(const char*)WSP(bf16, WS_DFT), 2 * L * 2, 0}; g8::OpFnetB ob{(const char*)P_PT, L * 2, 6}; g8::Order S; S.init(NB, L / 256, 1, F.G, bxi);
              E_Fnet ep{P_HM, 0, L}; g8::gemm8(F.lds, 2 * L / 64, oa, ob, S, ep); }
            if (l == 0) { g8::OpRow<true> oa{(const char*)WSP(bf16, WS_DFTC), 2 * LC * 2, 0}; g8::OpFnetB ob{(const char*)(P_PT + NL), LC * 2, 2}; g8::Order S; S.init(NB, 1, 1, F.G, bxi);
              E_Fnet ep{P_HM, NL, LC}; g8::gemm8(F.lds, 2 * LC / 64, oa, ob, S, ep); } }
        SEAM(pb + S_FNET);
        if (IN(pb + S_HY1)) { PHF; hyena_stage(F, l, 0); }
        SEAM(pb + S_HY1);
        if (IN(pb + S_S5E)) { PHF; E_S5E ep{P_E};
            g8::OpS5A oa{(const char*)(P_PT + (size_t)R_S5 * MT), (const char*)P_HS - (const char*)(P_PT + (size_t)R_S5 * MT)}; g8::OpRow<false> ob{(const char*)(F.ws + WS_S5M + (size_t)l * 24 * S5M_STRIDE), 256 * 2, (long)S5M_STRIDE};
            g8::Order S; S.init(24, NCHUNK / 256, 1, F.G, bxi); g8::gemm8(F.lds, 4, oa, ob, S, ep); }
        SEAM(pb + S_S5E);
        if (IN(pb + S_CARRY)) { PHF; s5_carry(F, l); }
        SEAM(pb + S_CARRY);
        if (IN(pb + S_HY2)) { PHF; hyena_stage(F, l, 1); }
        SEAM(pb + S_HY2);
        if (IN(pb + S_S5O)) { PHF; E_S5O ep{P_YS};
            g8::OpS5A oa{(const char*)(P_PT + (size_t)R_S5 * MT), (const char*)P_HS - (const char*)(P_PT + (size_t)R_S5 * MT)}; g8::OpRow<false> ob{(const char*)(F.ws + WS_S5M + (size_t)l * 24 * S5M_STRIDE) + 256 * 256 * 2, 512 * 2, (long)S5M_STRIDE};
            g8::Order S; S.init(24, NCHUNK / 256, 1, F.G, bxi); g8::gemm8(F.lds, 8, oa, ob, S, ep); }
        SEAM(pb + S_S5O);
        if (IN(pb + S_GLU)) { PHF; E_Glu ep{P_YS, P_HM, F.in[30] + l * 384};
            g8::OpRow<true> oa{(const char*)P_YS, 384 * 2, 0}; g8::OpRow<false> ob{(const char*)(WSP(bf16, WS_GLU) + (size_t)l * 512 * 384), 384 * 2, 0}; g8::Order S; S.init(1, MT / 256, 2, F.G, bxi);
            g8::gemm8(F.lds, 6, oa, ob, S, ep); }
        SEAM(pb + S_GLU);
        if (IN(pb + S_HYT)) { PHF; hyena_transpose(F, l == 0 ? MT : NL); }
        SEAM(pb + S_HYT);
        if (IN(pb + S_WOUT)) { PHF; const float* xlat = l == 0 ? F.in[0] : P_BUFA; const float* xctx = l == 0 ? F.in[2] : P_BUFA + (size_t)NL * D;
            E_Res ep{xlat, xctx, l == 0 ? P_BUFA : F.out, P_MOD, 2048};
            g8::OpRow<true> oa{(const char*)P_HM, D * 2, 0}; g8::OpRow<false> ob{(const char*)(WSP(bf16, WS_WOUT) + (size_t)l * D * D), D * 2, 0}; g8::Order S; S.init(1, (l == 0 ? MT : NL) / 256, D / 256, F.G, bxi);
            g8::gemm8(F.lds, D / 64, oa, ob, S, ep); }
        SEAM(pb + S_WOUT);
        if (l == 0) {
            if (IN(pb + S_NORM2)) { PHF; norm_rows(F, P_BUFA, P_BUFA + (size_t)NL * D, MT, F.in[7], P_MOD, 3072, 4096, P_HM); }
            SEAM(pb + S_NORM2);
            if (IN(pb + S_F0)) { PHF; E_Swi ep{WSP(bf16, WS_ACT), DFF};
                g8::OpRow<true> oa{(const char*)P_HM, D * 2, 0}; g8::OpRow<false> ob{(const char*)WSP(bf16, WS_FGU), D * 2, 0}; g8::Order S; S.init(1, MT / 256, 2 * DFF / 256, F.G, bxi);
                g8::gemm8(F.lds, D / 64, oa, ob, S, ep); }
            SEAM(pb + S_F0);
            if (IN(pb + S_F1)) { PHF; E_Res ep{P_BUFA, P_BUFA + (size_t)NL * D, P_BUFA, P_MOD, 5120};
                g8::OpRow<true> oa{(const char*)WSP(bf16, WS_ACT), DFF * 2, 0}; g8::OpRow<false> ob{(const char*)WSP(bf16, WS_FD), DFF * 2, 0}; g8::Order S; S.init(1, MT / 256, D / 256, F.G, bxi);
                g8::gemm8(F.lds, DFF / 64, oa, ob, S, ep); }
            SEAM(pb + S_F1);
        } else {
            if (IN(pb + S_NORM2)) { PHF; norm2_router(F, F.out, F.in[7] + D, P_MOD, P_HM); moe_transposes(F); }
            SEAM(pb + S_NORM2);
            if (IN(pb + S_F0)) { PHF; moe_slots(F); }
            SEAM(pb + S_F0);
#pragma unroll 1
            for (int k = 0; k < 2; ++k) {
                if (IN(pb + S_F1 + 2 * k)) { PHF; const int* IDX = (const int*)(F.ws + WS_META + META_IDX) + k * MAXSLOT; const int* TE = (const int*)(F.ws + WS_META + META_TE) + k * 272; const int nt = ((const int*)(F.ws + WS_META + META_NT))[k];
                    E_Swi ep{WSP(bf16, WS_ACT2), DFE};
                    g8::OpMoeA oa{(const char*)P_HM, IDX}; g8::OpMoeB ob{(const char*)(F.ws + WS_MOEW), TE, D * 2}; g8::Order S; S.init(1, nt, 2 * DFE / 256, F.G, bxi);
                    g8::gemm8(F.lds, D / 64, oa, ob, S, ep); }
                SEAM(pb + S_F1 + 2 * k);
                if (IN(pb + S_F2 + 2 * k)) { PHF; const int* IDX = (const int*)(F.ws + WS_META + META_IDX) + k * MAXSLOT; const int* TE = (const int*)(F.ws + WS_META + META_TE) + k * 272; const int nt = ((const int*)(F.ws + WS_META + META_NT))[k];
                    E_MoeDown ep{F.out, IDX, F.ws + WS_TOPK, P_MOD, k};
                    g8::OpRow<true> oa{(const char*)WSP(bf16, WS_ACT2), DFE * 2, 0}; g8::OpMoeB ob{(const char*)(F.ws + WS_MOEW + MOE_GU_BYTES), TE, DFE * 2}; g8::Order S; S.init(1, nt, D / 256, F.G, bxi);
                    g8::gemm8(F.lds, DFE / 64, oa, ob, S, ep); }
                SEAM(pb + S_F2 + 2 * k);
            }
            if (IN(pb + S_F5)) { PHF; final_norm(F); }
        }
    }
#undef IN
#undef SEAM
}

extern "C" void kernel_launch(void* const* d_in, const int* in_sizes, int n_in, void* d_out, int out_size, void* d_ws, size_t ws_size, hipStream_t stream) {
    static int grid = 0;
    if (grid == 0) {
        if (n_in != 40 || out_size != NL * D || ws_size < WS_END) { fprintf(stderr, "kernel_launch: unexpected shapes n_in %d out %d ws %zu (need %zu)\n", n_in, out_size, ws_size, (size_t)WS_END); grid = -1; return; }
        int dev = 0, cus = 0, per_cu = 0;
        if (hipGetDevice(&dev) != hipSuccess || hipDeviceGetAttribute(&cus, hipDeviceAttributeMultiprocessorCount, dev) != hipSuccess) { grid = -1; return; }
        if (hipFuncSetAttribute((const void*)mega, hipFuncAttributeMaxDynamicSharedMemorySize, LDS_BYTES) != hipSuccess) { fprintf(stderr, "kernel_launch: hipFuncSetAttribute failed\n"); grid = -1; return; }
        if (hipOccupancyMaxActiveBlocksPerMultiprocessor(&per_cu, (const void*)mega, NTHR, LDS_BYTES) != hipSuccess || per_cu < 1) fprintf(stderr, "kernel_launch: occupancy query says %d\n", per_cu);
        (void)hipGetLastError();
        grid = cus;
    }
    if (grid < 0) return;
    (void)hipMemsetAsync((char*)d_ws + WS_CTL, 0, CTL_ZERO_BYTES, stream);
    Args a{};
    for (int i = 0; i < 40; ++i) a.in[i] = (const float*)d_in[i];
    a.out = (float*)d_out; a.ws = (unsigned char*)d_ws;
#if MK_ONE_LAUNCH
    a.ph_lo = 0; a.ph_hi = N_PHASES;
    hipLaunchKernelGGL(mega, dim3(grid), dim3(NTHR), LDS_BYTES, stream, a);
#else
    for (int ph = 0; ph < N_PHASES; ++ph) {
        const int s = ph - PH_L;
        if (ph >= PH_L && s < PH_PER && s > S_F1) continue;
        if (ph >= PH_L + PH_PER && (ph - PH_L - PH_PER) > S_F5) continue;
        a.ph_lo = ph; a.ph_hi = ph + 1;
        hipLaunchKernelGGL(mega, dim3(grid), dim3(NTHR), LDS_BYTES, stream, a);
    }
#endif
}
```

```cpp
#include <hip/hip_runtime.h>
#include <cstdio>
#include <cstdint>

#ifndef G8_ALL
#define G8_ALL 1
#endif
#define G8_G1 G8_ALL
#define G8_FNET G8_ALL
#define G8_S5 G8_ALL
#define G8_GLU G8_ALL
#define G8_WOUT G8_ALL
#define G8_FFN G8_ALL
#define G8_MOE G8_ALL
#ifndef MK_ONE_LAUNCH
#define MK_ONE_LAUNCH 1
#endif

#define LAS __attribute__((address_space(3)))
typedef unsigned short bf16;
typedef short bf16x8 __attribute__((ext_vector_type(8)));
typedef float f32x4 __attribute__((ext_vector_type(4)));
typedef float f32x2 __attribute__((ext_vector_type(2)));
typedef unsigned v4u __attribute__((ext_vector_type(4)));
typedef unsigned v2u __attribute__((ext_vector_type(2)));

constexpr int D = 1024, NB = 16, L = 4096, LC = 256, NL = NB * L, NCX = NB * LC, MT = NL + NCX;
constexpr int DIN = 1792, DFF = 2816, NE = 8, DFE = 3584;
constexpr int PTROWS = 2048, R_HY = 512, R_S5 = 1664;
constexpr int NCHUNK = MT / 16;
constexpr int NTHR = 512, NWAVES = 8;
constexpr int MAXSLOT = NL + NE * 256;

constexpr size_t MiB = 1u << 20;
constexpr size_t WS_CTL = 0, CTL_ZERO_BYTES = 1 * MiB;
constexpr size_t WS_MOD = 1 * MiB;
constexpr size_t WS_WIN = 2 * MiB;
constexpr size_t WS_WOUT = 10 * MiB;
constexpr size_t WS_GLU = 14 * MiB;
constexpr size_t WS_FGU = 15 * MiB;
constexpr size_t WS_FD = 26 * MiB;
constexpr size_t WS_DFT = 32 * MiB;
constexpr size_t WS_DFTC = 96 * MiB;
constexpr size_t WS_S5M = 97 * MiB;
constexpr size_t S5M_STRIDE = 256 * 256 * 2 + 256 * 512 * 2;
constexpr size_t WS_A16 = 115 * MiB;
constexpr size_t WS_KT = 116 * MiB;
constexpr size_t WS_KTC = 164 * MiB;
constexpr size_t WS_PS = 167 * MiB;
constexpr size_t WS_TOPK = 171 * MiB;
constexpr size_t WS_META = 172 * MiB;
constexpr size_t META_CNT = 0, META_IDX = 64 * 1024, META_TE = META_IDX + 2 * MAXSLOT * 4, META_NT = META_TE + 2 * 272 * 4;
constexpr size_t WS_HMOD = 173 * MiB;
constexpr size_t WS_BUFA = 309 * MiB;
constexpr size_t WS_R = 581 * MiB;
constexpr size_t WS_END = 1024 * MiB;
constexpr size_t WS_PT = WS_R;
constexpr size_t WS_HT = WS_R;
constexpr size_t WS_Z1 = WS_R + 272 * MiB;
static_assert(WS_Z1 + (size_t)384 * MT * 2 <= WS_END, "z1");
constexpr size_t WS_ACT = WS_R;
constexpr size_t WS_MOEW = WS_BUFA;
constexpr size_t MOE_GU_BYTES = (size_t)2 * DFE * D * 2, MOE_D_BYTES = (size_t)D * DFE * 2, MOE_E_STRIDE = MOE_GU_BYTES + MOE_D_BYTES;
constexpr size_t WS_ACT2 = WS_BUFA + 168 * MiB;
static_assert(NE * MOE_E_STRIDE <= 168 * MiB, "moe weights");
static_assert(WS_ACT2 + (size_t)MAXSLOT * DFE * 2 <= WS_END, "act2");
static_assert(WS_PT + (size_t)PTROWS * MT * 2 <= WS_END, "pt");
static_assert(WS_ACT + (size_t)MT * DFF * 2 <= WS_END, "act");
static_assert(WS_HMOD + (size_t)MT * D * 2 <= WS_BUFA && WS_BUFA + (size_t)MT * D * 4 <= WS_R, "bufs");
constexpr size_t DO_E = 0, DO_HS = 102 * MiB, DO_YS = 153 * MiB;
static_assert(DO_YS + (size_t)MT * 384 * 2 <= (size_t)NL * D * 4, "d_out scratch");

constexpr int LDS_BYTES = 147456;
constexpr int LDS_MISC = 131072 + 8192;

__device__ __forceinline__ unsigned f2bf(float f) { unsigned u = __builtin_bit_cast(unsigned, f); return (u + 0x7fffu + ((u >> 16) & 1u)) >> 16; }
__device__ __forceinline__ unsigned pk2(float lo, float hi) { return f2bf(lo) | (f2bf(hi) << 16); }
__device__ __forceinline__ float bf2f(unsigned short b) { return __builtin_bit_cast(float, ((unsigned)b) << 16); }
__device__ __forceinline__ float wave_sum(float v, int lane) {
#pragma unroll
    for (int o = 1; o < 64; o <<= 1) v += __builtin_bit_cast(float, __builtin_amdgcn_ds_bpermute((lane ^ o) << 2, __builtin_bit_cast(int, v)));
    return v;
}
__device__ __forceinline__ float silu_f(float x) { return x / (1.0f + __expf(-x)); }
__device__ __forceinline__ float sigmoid_f(float x) { return 1.0f / (1.0f + __expf(-x)); }
__device__ __forceinline__ float gelu_tanh_f(float x) { const float u = 0.7978845608028654f * (x + 0.044715f * x * x * x); return 0.5f * x * (1.0f + tanhf(u)); }
__device__ __forceinline__ int bidx_of(int r) { return r < NL ? (r >> 12) : 16; }

__device__ __forceinline__ int lane_id() { return (int)__builtin_amdgcn_mbcnt_hi(~0u, __builtin_amdgcn_mbcnt_lo(~0u, 0u)); }
__device__ __forceinline__ int tid_of(int wv) { int t = (wv << 6) | lane_id(); asm volatile("" : "+v"(t)); return t; }
#define XB_TMO      128
#define XB_XCNT(j)  (256  + 64 * (j))
#define XB_XSUB(j)  (1280 + 64 * (j))
#define XB_XGEN(j)  (2304 + 64 * (j))
#define XB_TOP      3328
#define XB_TOPGEN   3392
#define XCD_BAR_WORDS 3456
#define XB_SPIN_CAP (1u << 22)
__device__ __forceinline__ unsigned xb_ld(unsigned* p)              { return __hip_atomic_load(p, __ATOMIC_RELAXED, __HIP_MEMORY_SCOPE_AGENT); }
__device__ __forceinline__ unsigned xb_add(unsigned* p, unsigned v) { return __hip_atomic_fetch_add(p, v, __ATOMIC_RELAXED, __HIP_MEMORY_SCOPE_AGENT); }
__device__ __forceinline__ unsigned xb_xcc_id() { return (unsigned)__builtin_amdgcn_s_getreg((3 << 11) | 20) & 0xFu; }
#define XB_SPIN(cond, bar) do { unsigned _sp = 0; while (cond) { __builtin_amdgcn_s_sleep(1); \
    if ((++_sp & 255u) == 0u) { if (xb_ld(&(bar)[XB_TMO])) break; if (_sp > XB_SPIN_CAP) { atomicAdd(&(bar)[XB_TMO], 1u); break; } } } } while (0)
struct XcdBarrier { unsigned* bar; unsigned x; volatile LAS unsigned* st; int wv; };
__device__ __forceinline__ XcdBarrier xcd_barrier_post(unsigned* bar, volatile LAS unsigned* st, int wv) {
    XcdBarrier b; b.bar = bar; b.x = xb_xcc_id(); b.st = st; b.wv = wv;
    if (wv == 0 && lane_id() == 0) (void)xb_add(&bar[XB_XCNT(b.x)], 1u);
    return b;
}
__device__ __forceinline__ void xcd_barrier_complete(unsigned* bar, unsigned x, unsigned& nloc, unsigned& nx) {
    const unsigned G = gridDim.x * gridDim.y * gridDim.z;
    unsigned sum, cnt, mine, sp = 0u;
    for (;;) {
        sum = 0u; cnt = 0u; mine = 0u;
#pragma unroll
        for (unsigned j = 0; j < 16; ++j) { const unsigned c = xb_ld(&bar[XB_XCNT(j)]); sum += c; cnt += (c > 0u) ? 1u : 0u; mine = (j == x) ? c : mine; }
        if (sum == G) break;
        __builtin_amdgcn_s_sleep(1);
        if ((++sp & 255u) == 0u) { if (xb_ld(&bar[XB_TMO])) break; if (sp > XB_SPIN_CAP) { atomicAdd(&bar[XB_TMO], 1u); break; } }
    }
    nloc = mine > 0u ? mine : 1u; nx = cnt > 0u ? cnt : 1u;
}
__device__ __noinline__ void xcd_barrier(const XcdBarrier b) {
    asm volatile("s_waitcnt vmcnt(0)" ::: "memory");
    __syncthreads();
    if (b.wv == 0 && lane_id() == 0) {
        unsigned* bar = b.bar;
        __builtin_amdgcn_s_waitcnt(0);
        unsigned nloc = b.st[0], nx = b.st[1];
        if (nloc == 0u) { xcd_barrier_complete(bar, b.x, nloc, nx); b.st[0] = nloc; b.st[1] = nx; }
        const unsigned old = xb_add(&bar[XB_XSUB(b.x)], 1u);
        const unsigned gen = old / nloc;
        if (old + 1u == (gen + 1u) * nloc) {
            __builtin_amdgcn_fence(__ATOMIC_RELEASE, "agent");
            asm volatile("s_waitcnt vmcnt(0)" ::: "memory");
            const unsigned og = xb_add(&bar[XB_TOP], 1u);
            const unsigned tg = og / nx;
            if (og + 1u == (tg + 1u) * nx) xb_add(&bar[XB_TOPGEN], 1u);
            else XB_SPIN(xb_ld(&bar[XB_TOPGEN]) == tg, bar);
            __builtin_amdgcn_fence(__ATOMIC_ACQUIRE, "agent");
            xb_add(&bar[XB_XGEN(b.x)], 1u);
            asm volatile("s_waitcnt vmcnt(0)" ::: "memory");
        } else {
            XB_SPIN(xb_ld(&bar[XB_XGEN(b.x)]) == gen, bar);
            __builtin_amdgcn_fence(__ATOMIC_ACQUIRE, "agent");
            asm volatile("s_waitcnt vmcnt(0)" ::: "memory");
        }
    }
    __syncthreads();
}

template <class AF, class BF, class EP>
__device__ __forceinline__ void gemm_simple(int nbatch, int mtiles, int ntiles, int K, const AF& af, const BF& bf, const EP& ep, int vcu, int G) {
    int tid = threadIdx.x; asm volatile("" : "+v"(tid)); asm volatile("" : "+s"(vcu)); const int wid = tid >> 6, lane = tid & 63, wr = wid >> 2, wc = wid & 3, fr = lane & 15, fq = lane >> 4;
    const int per = mtiles * ntiles, nunits = nbatch * per;
    for (int u = vcu; u < nunits; u += G) {
        const int bt = u / per, rem = u - bt * per, pm = rem / ntiles, pn = rem - pm * ntiles;
        const int row0 = pm * 128 + wr * 64, col0 = pn * 128 + wc * 32;
        f32x4 acc[4][2];
#pragma unroll
        for (int m = 0; m < 4; ++m) { acc[m][0] = (f32x4){0.f, 0.f, 0.f, 0.f}; acc[m][1] = (f32x4){0.f, 0.f, 0.f, 0.f}; }
#pragma unroll 2
        for (int k = 0; k < K; k += 32) {
            bf16x8 a[4], b[2];
#pragma unroll
            for (int m = 0; m < 4; ++m) a[m] = *(const bf16x8*)af(bt, row0 + m * 16 + fr, k + fq * 8);
#pragma unroll
            for (int n = 0; n < 2; ++n) b[n] = *(const bf16x8*)bf(bt, col0 + n * 16 + fr, k + fq * 8);
#pragma unroll
            for (int m = 0; m < 4; ++m)
#pragma unroll
                for (int n = 0; n < 2; ++n) acc[m][n] = __builtin_amdgcn_mfma_f32_16x16x32_bf16(b[n], a[m], acc[m][n], 0, 0, 0);
        }
#pragma unroll
        for (int m = 0; m < 4; ++m) ep(bt, row0 + m * 16 + fr, col0 + 4 * fq, acc[m][0], acc[m][1]);
    }
}
struct RowMajor { const bf16* p; long ld; __device__ __forceinline__ const bf16* operator()(int, int r, int k) const { return p + (long)r * ld + k; } };

namespace g8 {
constexpr int BM = 256, BK = 64, HALF = 128, HTB = HALF * BK * 2, NXCD = 8, WGM = 8;
__device__ __forceinline__ int lds_byte(int r, int c) { const int st = (r >> 4) * 2 + (c >> 5), rr = r & 15, cc = c & 31, ob = rr * 64 + cc * 2; return st * 1024 + (ob ^ (((ob >> 9) & 1) << 5)); }
__device__ __forceinline__ void stage_rc(int b, int& R, int& C) { const int st = b / 1024, sb = b % 1024, swz = sb ^ (((sb >> 9) & 1) << 5); R = (st >> 1) * 16 + swz / 64; C = (st & 1) * 32 + (swz % 64) / 2; }
struct Unit { int bt, pm, pn; };
struct Order {
    int nM, nN, per, nwg, G, c;
    __device__ __forceinline__ void init(int nb, int nM_, int nN_, int G_, int c_) { nM = nM_; nN = nN_; per = nM_ * nN_; nwg = nb * per; G = G_; c = c_; }
    __device__ __forceinline__ bool next(int i, Unit& u) const {
        const long Lx = (long)i * G + c; if (Lx >= nwg) return false;
        int wgid = (int)Lx; { const int q = nwg / NXCD, r = nwg % NXCD, xcd = wgid % NXCD, off = wgid / NXCD; wgid = (xcd < r ? xcd * (q + 1) : r * (q + 1) + (xcd - r) * q) + off; }
        u.bt = wgid / per; const int rem = wgid - u.bt * per;
        const int nig = WGM * nN, gid = rem / nig, fm = gid * WGM, gsz = (nM - fm) < WGM ? (nM - fm) : WGM;
        u.pm = fm + ((rem % nig) % gsz); u.pn = (rem % nig) / gsz; return true;
    }
};
template <bool ISA> struct OpRow {
    static constexpr bool GATHER = false;
    const char* p; long ld2; long bstride;
    __device__ __forceinline__ unsigned off(int R, int C) const { return (unsigned)(R * (int)ld2 + C * 2); }
    __device__ __forceinline__ const char* base(const Unit& u) const { return p + (long)u.bt * bstride + (long)(ISA ? u.pm : u.pn) * 256 * ld2; }
    __device__ __forceinline__ long koff(int t) const { return (long)t * 128; }
    __device__ __forceinline__ long hstep() const { return 128 * ld2; }
};
struct OpS5A {
    static constexpr bool GATHER = false;
    const char* ptb; long delta;
    __device__ __forceinline__ unsigned off(int R, int C) const { return (unsigned)((C >> 4) * (MT * 2) + R * 32 + (C & 15) * 2); }
    __device__ __forceinline__ const char* base(const Unit& u) const { return ptb + ((long)u.bt * 16 * MT + (long)u.pm * 4096) * 2; }
    __device__ __forceinline__ long koff(int t) const { return t < 4 ? (long)t * 4 * MT * 2 : delta + (long)(t - 4) * 4 * MT * 2; }
    __device__ __forceinline__ long hstep() const { return 4096; }
};
struct OpFnetB {
    static constexpr bool GATHER = false;
    const char* p; int seq2; int sh;
    __device__ __forceinline__ unsigned off(int R, int C) const { return (unsigned)(R * (MT * 2) + C * 2); }
    __device__ __forceinline__ const char* base(const Unit& u) const { return p + (long)u.bt * seq2 + (long)u.pn * 256 * MT * 2; }
    __device__ __forceinline__ long koff(int t) const { return (long)(t >> sh) * 256 * MT * 2 + (long)(t & ((1 << sh) - 1)) * 128; }
    __device__ __forceinline__ long hstep() const { return (long)128 * MT * 2; }
};
struct OpMoeA {
    static constexpr bool GATHER = true;
    const char* h; const int* idx;
    __device__ __forceinline__ unsigned off(int, int) const { return 0u; }
    __device__ __forceinline__ unsigned goff(const Unit& u, int R, int C) const { int t = idx[u.pm * 256 + R]; t = t < 0 ? 0 : t; return (unsigned)t * 2048u + (unsigned)C * 2u; }
    __device__ __forceinline__ const char* base(const Unit&) const { return h; }
    __device__ __forceinline__ long koff(int t) const { return (long)t * 128; }
    __device__ __forceinline__ long hstep() const { return 0; }
};
struct OpMoeB {
    static constexpr bool GATHER = false;
    const char* w; const int* te; long ld2;
    __device__ __forceinline__ unsigned off(int R, int C) const { return (unsigned)(R * (int)ld2 + C * 2); }
    __device__ __forceinline__ const char* base(const Unit& u) const { return w + (long)__builtin_amdgcn_readfirstlane(te[u.pm]) * (long)MOE_E_STRIDE + (long)u.pn * 256 * ld2; }
    __device__ __forceinline__ long koff(int t) const { return (long)t * 128; }
    __device__ __forceinline__ long hstep() const { return 128 * ld2; }
};

template <class OA, class OB, class Epi>
__device__ __forceinline__ void gemm8(LAS unsigned char* lds, const int wv, const int nt, const OA& oa, const OB& ob, const Order& S, const Epi& E) {
    const int tid = tid_of(wv);
    const int wid = __builtin_amdgcn_readfirstlane(tid >> 6), lane = tid & 63, wr = wid >> 2, wc = wid & 3, fr = lane & 15, fq = lane >> 4;
    unsigned voffA[2][2], voffB[2];
#pragma unroll
    for (int i = 0; i < 2; ++i) { int R_, C_; stage_rc(tid * 16 + i * 8192, R_, C_); voffB[i] = ob.off(R_, C_); voffA[0][i] = oa.off(R_, C_); voffA[1][i] = 0u; }
    const long hA = oa.hstep(), hB = ob.hstep();
    const unsigned ldsw = (unsigned)wid * 1024u;
    const int aoff = lds_byte(wr * 64 + fr, fq * 8), boff = lds_byte(wc * 32 + fr, fq * 8);
#define G8_SA(b, h) (((b) * 2 + (h)) * HTB)
#define G8_SB(b, h) ((4 + (b) * 2 + (h)) * HTB)
#define G8_STAGE_B(bufoff, gbase) do { _Pragma("unroll") for (int _i = 0; _i < 2; ++_i) \
        __builtin_amdgcn_global_load_lds((const unsigned*)((const char*)(gbase) + voffB[_i]), (LAS unsigned*)(lds + (bufoff) + ldsw + _i * 8192), 16, 0, 0); } while (0)
#define G8_STAGE_A(bufoff, gbase, h) do { _Pragma("unroll") for (int _i = 0; _i < 2; ++_i) \
        __builtin_amdgcn_global_load_lds((const unsigned*)((const char*)(gbase) + (OA::GATHER ? 0 : (h) * hA) + voffA[OA::GATHER ? (h) : 0][_i]), (LAS unsigned*)(lds + (bufoff) + ldsw + _i * 8192), 16, 0, 0); } while (0)
#define G8_LDA(dst, b, h) do { _Pragma("unroll") for (int m = 0; m < 4; ++m) _Pragma("unroll") for (int k = 0; k < 2; ++k) dst[m][k] = *(const LAS bf16x8*)(lds + G8_SA(b, h) + aoff + m * 2048 + k * 1024); } while (0)
#define G8_LDB(dst, b, h) do { _Pragma("unroll") for (int n = 0; n < 2; ++n) _Pragma("unroll") for (int k = 0; k < 2; ++k) dst[n][k] = *(const LAS bf16x8*)(lds + G8_SB(b, h) + boff + n * 2048 + k * 1024); } while (0)
#define G8_MMA(ai, bj, At, Bt) do { __builtin_amdgcn_s_setprio(1); _Pragma("unroll") for (int m = 0; m < 4; ++m) _Pragma("unroll") for (int n = 0; n < 2; ++n) _Pragma("unroll") for (int k = 0; k < 2; ++k) \
        acc[ai][bj][m][n] = __builtin_amdgcn_mfma_f32_16x16x32_bf16(Bt[n][k], At[m][k], acc[ai][bj][m][n], 0, 0, 0); __builtin_amdgcn_s_setprio(0); } while (0)
#define G8_WAIT_V(n) asm volatile("s_waitcnt vmcnt(" #n ")" ::: "memory")
#define G8_WAIT_L(n) asm volatile("s_waitcnt lgkmcnt(" #n ")" ::: "memory")
#define G8_BAR __builtin_amdgcn_s_barrier()
#define G8_SCHED __builtin_amdgcn_sched_barrier(0)
#define G8_GOFF(u) do { if constexpr (OA::GATHER) { const int _tz = tid_of(wv); _Pragma("unroll") for (int _i = 0; _i < 2; ++_i) { int _R, _C; stage_rc(_tz * 16 + _i * 8192, _R, _C); \
        _Pragma("unroll") for (int _h = 0; _h < 2; ++_h) voffA[_h][_i] = oa.goff(u, _R + 128 * _h, _C); } } } while (0)
    Unit cur, nxt; int ui = 0;
    if (!S.next(0, cur)) return;
    f32x4 acc[2][2][4][2];
#pragma unroll
    for (int a = 0; a < 2; ++a)
#pragma unroll
        for (int b = 0; b < 2; ++b)
#pragma unroll
            for (int m = 0; m < 4; ++m)
#pragma unroll
                for (int n = 0; n < 2; ++n) acc[a][b][m][n] = (f32x4){0.f, 0.f, 0.f, 0.f};
    bf16x8 At[4][2], B0[2][2], B1[2][2];
    const char* cA = oa.base(cur); const char* cB = ob.base(cur);
    G8_GOFF(cur);
    {   const long ka0 = oa.koff(0), ka1 = oa.koff(1), kb0 = ob.koff(0), kb1 = ob.koff(1);
        G8_STAGE_B(G8_SB(0, 0), cB + kb0); G8_STAGE_B(G8_SB(0, 1), cB + kb0 + hB); G8_STAGE_A(G8_SA(0, 0), cA + ka0, 0); G8_STAGE_A(G8_SA(0, 1), cA + ka0, 1);
        if (wr == 1) G8_BAR;
        G8_WAIT_V(2); G8_BAR;
        G8_STAGE_B(G8_SB(1, 0), cB + kb1); G8_STAGE_A(G8_SA(1, 0), cA + ka1, 0); G8_STAGE_B(G8_SB(1, 1), cB + kb1 + hB);
        G8_WAIT_V(6); G8_BAR; }
    for (;;) {
        const bool has_next = S.next(ui + 1, nxt);
        const char* nA = has_next ? oa.base(nxt) : cA; const char* nB = has_next ? ob.base(nxt) : cB;
        for (int t = 0; t < nt; t += 2) {
            const bool last = (t == nt - 2);
            const char* a1 = cA + oa.koff(t + 1);
            const char* a2 = last ? nA + oa.koff(0) : cA + oa.koff(t + 2); const char* b2 = last ? nB + ob.koff(0) : cB + ob.koff(t + 2);
            const char* a3 = last ? nA + oa.koff(1) : cA + oa.koff(t + 3); const char* b3 = last ? nB + ob.koff(1) : cB + ob.koff(t + 3);
            G8_LDB(B0, 0, 0); G8_LDB(B1, 0, 1); G8_SCHED; G8_LDA(At, 0, 0); G8_STAGE_A(G8_SA(1, 1), a1, 1);
            if (last && has_next) G8_GOFF(nxt);
            G8_WAIT_V(8); G8_WAIT_L(0); G8_BAR; G8_MMA(0, 0, At, B0); G8_MMA(0, 1, At, B1); G8_BAR; G8_SCHED;
            G8_LDA(At, 0, 1); G8_STAGE_B(G8_SB(0, 0), b2); G8_STAGE_B(G8_SB(0, 1), b2 + hB); G8_STAGE_A(G8_SA(0, 0), a2, 0);
            G8_WAIT_V(8); G8_WAIT_L(0); G8_BAR; G8_MMA(1, 0, At, B0); G8_MMA(1, 1, At, B1); G8_BAR; G8_SCHED;
            G8_LDB(B0, 1, 0); G8_LDB(B1, 1, 1); G8_SCHED; G8_LDA(At, 1, 0); G8_STAGE_A(G8_SA(0, 1), a2, 1);
            G8_WAIT_V(8); G8_WAIT_L(0); G8_BAR; G8_MMA(0, 0, At, B0); G8_MMA(0, 1, At, B1); G8_BAR; G8_SCHED;
            G8_LDA(At, 1, 1); G8_STAGE_B(G8_SB(1, 0), b3); G8_STAGE_B(G8_SB(1, 1), b3 + hB); G8_STAGE_A(G8_SA(1, 0), a3, 0);
            G8_WAIT_V(8); G8_WAIT_L(0); G8_BAR; G8_MMA(1, 0, At, B0); G8_MMA(1, 1, At, B1); G8_BAR; G8_SCHED;
        }
        if (wr == 0) G8_BAR;
        {   const int tz = tid_of(wv); const int wz = tz >> 6, lz = tz & 63;
            const int row0 = cur.pm * BM + (wz >> 2) * 64 + (lz & 15), col0 = cur.pn * BM + (wz & 3) * 32 + 4 * (lz >> 4);
#pragma unroll
            for (int ai = 0; ai < 2; ++ai)
#pragma unroll
                for (int m = 0; m < 4; ++m)
#pragma unroll
                    for (int bj = 0; bj < 2; ++bj) E(cur.bt, row0 + ai * HALF + m * 16, col0 + bj * HALF, acc[ai][bj][m][0], acc[ai][bj][m][1]); }
        if (!has_next) break;
#pragma unroll
        for (int a = 0; a < 2; ++a)
#pragma unroll
            for (int b = 0; b < 2; ++b)
#pragma unroll
                for (int m = 0; m < 4; ++m)
#pragma unroll
                    for (int n = 0; n < 2; ++n) acc[a][b][m][n] = (f32x4){0.f, 0.f, 0.f, 0.f};
        cur = nxt; cA = nA; cB = nB; ++ui;
        if (wr == 1) G8_BAR;
    }
    G8_WAIT_V(0);
    G8_BAR;
#undef G8_SA
#undef G8_SB
#undef G8_STAGE_A
#undef G8_STAGE_B
#undef G8_LDA
#undef G8_LDB
#undef G8_MMA
#undef G8_WAIT_V
#undef G8_WAIT_L
#undef G8_BAR
#undef G8_SCHED
#undef G8_GOFF
}
}

struct Args { const float* in[40]; float* out; unsigned char* ws; int ph_lo, ph_hi; };
struct Frame {
    LAS unsigned char* lds; int tid, lane, wave, vcu, G;
    const float* const* in; float* out; unsigned char* ws;
};
#define WSP(T, off) ((T*)(F.ws + (off)))
__device__ __forceinline__ Frame relocal(const Frame& F0) { Frame F = F0; const int t = tid_of(F0.wave); F.tid = t; F.lane = t & 63; F.wave = F0.wave; int v = F0.vcu; asm volatile("" : "+s"(v)); F.vcu = v; return F; }

constexpr int PH_P0 = 0, PH_P1 = 1, PH_L = 2, PH_PER = 20, N_PHASES = PH_L + 2 * PH_PER;
enum { S_NORM1 = 0, S_G1, S_FNET, S_HY1, S_S5E, S_CARRY, S_HY2, S_S5O, S_GLU, S_HYT, S_WOUT, S_NORM2, S_F0, S_F1, S_F2, S_F3, S_F4, S_F5 };

__device__ __forceinline__ int rowmap(int mode, int row_off, int n) { return mode == 0 ? row_off + n : (32 * (n >> 4) + (n & 15) + (mode == 2 ? 16 : 0)); }
__device__ __forceinline__ void transpose_item(const float* W, int ldw, int col0, int N, bf16* WT, int ldk, int mode, int row_off, LAS float* scr, int item, int lane) {
    const int nblk = N / 32, kb = item / nblk, nb = item % nblk, k0 = 64 * kb, n0 = 32 * nb;
#pragma unroll 8
    for (int i = 0; i < 32; ++i) { const int kk = 2 * i + (lane >> 5); scr[kk * 33 + (lane & 31)] = W[(size_t)(k0 + kk) * ldw + col0 + n0 + (lane & 31)]; }
    asm volatile("s_waitcnt lgkmcnt(0)" ::: "memory");
    const int c = lane & 7;
#pragma unroll
    for (int j = 0; j < 4; ++j) { const int n = (lane >> 3) + 8 * j; const LAS float* s = scr + (8 * c) * 33 + n;
        v4u o; o.x = pk2(s[0 * 33], s[1 * 33]); o.y = pk2(s[2 * 33], s[3 * 33]); o.z = pk2(s[4 * 33], s[5 * 33]); o.w = pk2(s[6 * 33], s[7 * 33]);
        *(v4u*)(WT + (size_t)rowmap(mode, row_off, n0 + n) * ldk + k0 + 8 * c) = o; }
    asm volatile("s_waitcnt lgkmcnt(0)" ::: "memory");
}

__device__ __forceinline__ void p0_transposes(Frame& F) {
    LAS float* scr = (LAS float*)(F.lds + F.wave * 16384);
    const int gw = F.vcu * NWAVES + F.wave, NGW = F.G * NWAVES;
    constexpr int I_IN = 16 * 48, I_OUT = 16 * 32, I_GLU = 6 * 12, I_FG = 16 * 88, I_FD = 44 * 32;
    constexpr int NIT = 2 * (I_IN + I_OUT + I_GLU) + 2 * I_FG + I_FD;
    for (int it = gw; it < NIT; it += NGW) {
        int r = it;
        if (r < 2 * I_IN) { const int l = r / I_IN; transpose_item(F.in[8] + (size_t)l * D * DIN, DIN, 256, 1536, WSP(bf16, WS_WIN) + (size_t)l * PTROWS * D, D, 0, 512, scr, r % I_IN, F.lane); continue; } r -= 2 * I_IN;
        if (r < 2 * I_OUT) { const int l = r / I_OUT; transpose_item(F.in[9] + (size_t)l * D * D, D, 0, D, WSP(bf16, WS_WOUT) + (size_t)l * D * D, D, 0, 0, scr, r % I_OUT, F.lane); continue; } r -= 2 * I_OUT;
        if (r < 2 * I_GLU) { const int l = r / I_GLU; transpose_item(F.in[29] + (size_t)l * 384 * 384, 384, 0, 384, WSP(bf16, WS_GLU) + (size_t)l * 512 * 384, 384, 0, 0, scr, r % I_GLU, F.lane); continue; } r -= 2 * I_GLU;
        if (r < I_FG) { transpose_item(F.in[31], DFF, 0, DFF, WSP(bf16, WS_FGU), D, 1, 0, scr, r, F.lane); continue; } r -= I_FG;
        if (r < I_FG) { transpose_item(F.in[32], DFF, 0, DFF, WSP(bf16, WS_FGU), D, 2, 0, scr, r, F.lane); continue; } r -= I_FG;
        transpose_item(F.in[33], D, 0, D, WSP(bf16, WS_FD), DFF, 0, 0, scr, r, F.lane);
    }
}
__device__ __forceinline__ void moe_transposes(Frame& F_) { Frame F = relocal(F_);
    LAS float* scr = (LAS float*)(F.lds + F.wave * 16384);
    const int gw = F.vcu * NWAVES + F.wave, NGW = F.G * NWAVES;
    constexpr int I_G = 16 * 112, I_D = 56 * 32, PER_E = 2 * I_G + I_D;
    for (int it = gw; it < NE * PER_E; it += NGW) {
        const int e = it / PER_E; int r = it % PER_E;
        bf16* gu = (bf16*)(F.ws + WS_MOEW + (size_t)e * MOE_E_STRIDE); bf16* dn = (bf16*)(F.ws + WS_MOEW + (size_t)e * MOE_E_STRIDE + MOE_GU_BYTES);
        if (r < I_G) { transpose_item(F.in[36] + (size_t)e * D * DFE, DFE, 0, DFE, gu, D, 1, 0, scr, r, F.lane); continue; } r -= I_G;
        if (r < I_G) { transpose_item(F.in[37] + (size_t)e * D * DFE, DFE, 0, DFE, gu, D, 2, 0, scr, r, F.lane); continue; } r -= I_G;
        transpose_item(F.in[38] + (size_t)e * DFE * D, D, 0, D, dn, DFE, 0, 0, scr, r, F.lane);
    }
}

__device__ __forceinline__ void p0_mod_item(Frame& F, int item) {
    const int l = item / 48, cb = item % 48, tid = F.tid;
    LAS float* sc = (LAS float*)F.lds;
    LAS float* red = sc + 17 * 1024;
    for (int i = tid; i < 17 * 1024; i += NTHR) { const int r = i >> 10, k = i & 1023; const float v = r < 16 ? F.in[1][r * D + k] : F.in[3][k]; sc[i] = silu_f(v); }
    __syncthreads();
    const int col = cb * 128 + (tid & 127), kg = tid >> 7;
    const float* W = F.in[4] + (size_t)l * D * 6144 + col;
    float acc[17];
#pragma unroll
    for (int r = 0; r < 17; ++r) acc[r] = 0.f;
    for (int k = kg * 256; k < kg * 256 + 256; ++k) { const float w = W[(size_t)k * 6144];
#pragma unroll
        for (int r = 0; r < 17; ++r) acc[r] += sc[r * 1024 + k] * w; }
#pragma unroll
    for (int r = 0; r < 17; ++r) red[(kg * 17 + r) * 128 + (tid & 127)] = acc[r];
    __syncthreads();
    for (int i = tid; i < 17 * 128; i += NTHR) { const int r = i >> 7, c = i & 127;
        const float s = red[(0 * 17 + r) * 128 + c] + red[(1 * 17 + r) * 128 + c] + red[(2 * 17 + r) * 128 + c] + red[(3 * 17 + r) * 128 + c];
        WSP(float, WS_MOD)[((size_t)l * 17 + r) * 6144 + cb * 128 + c] = s + F.in[5][l * 6144 + cb * 128 + c]; }
    __syncthreads();
}
__device__ __forceinline__ void p0_fold_item(Frame& F, int item) {
    const int kb = item & 7, cs = (item >> 3) & 1, h = (item >> 4) & 3, l = item >> 6, tid = F.tid;
    LAS float* A = (LAS float*)F.lds;
    const float* wf = F.in[10] + ((size_t)l * 4 + h) * 64 * 64;
    for (int i = tid; i < 4096; i += NTHR) { const int d = i >> 6, e2 = i & 63; float s = 0.f;
        for (int e = 0; e < 64; ++e) { const int m = (e * d) & 63; const float tr = cs ? sinpif((float)m * (1.0f / 32.0f)) : cospif((float)m * (1.0f / 32.0f)); s += tr * wf[e * 64 + e2]; }
        A[i] = s * 0.125f; }
    __syncthreads();
    const int e2 = tid & 63;
    const float* win = F.in[8] + (size_t)l * D * DIN + h * 64;
    bf16* wt = WSP(bf16, WS_WIN) + (size_t)l * PTROWS * D + (size_t)(cs * 256 + h * 64 + e2) * D;
    for (int i = 0; i < 16; ++i) { const int kk = kb * 128 + (tid >> 6) + 8 * i; float s = 0.f;
        for (int d = 0; d < 64; ++d) s += win[(size_t)kk * DIN + d] * A[d * 64 + e2];
        wt[kk] = (bf16)f2bf(s); }
    __syncthreads();
}
__device__ __forceinline__ void gen_dft_rows(bf16* dst, int LL, int row0, int nrows, float scale, int tid) {
    const int cpr = 2 * LL / 8;
    for (int i = tid; i < nrows * cpr; i += NTHR) { const int k = row0 + i / cpr, j0 = (i % cpr) * 8; unsigned w[4];
#pragma unroll
        for (int q = 0; q < 4; ++q) { float v[2];
#pragma unroll
            for (int z = 0; z < 2; ++z) { const int j = j0 + 2 * q + z; const int jj = j < LL ? j : j - LL; const int m = (k * jj) & (LL - 1); const float x = (float)m * (2.0f / (float)LL);
                v[z] = (j < LL ? cospif(x) : -sinpif(x)) * scale; }
            w[q] = pk2(v[0], v[1]); }
        *(v4u*)(dst + (size_t)k * 2 * LL + j0) = (v4u){w[0], w[1], w[2], w[3]}; }
}
__device__ __forceinline__ void p0_filter_item(Frame& F, int item) {
    const int l = item / 272, pb = item % 272, tid = F.tid;
    const int LL = pb < 256 ? L : LC, p0 = pb < 256 ? pb * 16 : (pb - 256) * 16;
    LAS float* z = (LAS float*)F.lds;
    LAS float* h1 = z + 16 * 36;
    LAS float* h2 = h1 + 16 * 64;
    for (int i = tid; i < 16 * 33; i += NTHR) { const int pp = i / 33, j = i % 33; const int pos = p0 + pp;
        const double w = 6.283185307179586 * (double)pos / (double)LL; double v;
        if (j == 0) v = (double)pos / (double)(LL - 1);
        else { const int bj = (j - 1) & 15; const double band = 1e-4 + (double)bj * ((15.0 - 1e-4) / 15.0); v = j <= 16 ? cos(band * w) : -sin(band * w); }
        z[pp * 36 + j] = (float)v; }
    __syncthreads();
    for (int i = tid; i < 1024; i += NTHR) { const int pp = i >> 6, o = i & 63; float s = F.in[14][l * 64 + o];
        for (int j = 0; j < 33; ++j) s += z[pp * 36 + j] * F.in[13][((size_t)l * 33 + j) * 64 + o];
        h1[i] = sinf(F.in[15][l * 64 + o] * s); }
    __syncthreads();
    for (int i = tid; i < 1024; i += NTHR) { const int pp = i >> 6, o = i & 63; float s = F.in[17][l * 64 + o];
        for (int j = 0; j < 64; ++j) s += h1[pp * 64 + j] * F.in[16][((size_t)l * 64 + j) * 64 + o];
        h2[i] = sinf(F.in[18][l * 64 + o] * s); }
    __syncthreads();
    float* HT = WSP(float, WS_HT) + ((size_t)l * 4352 + (pb < 256 ? 0 : 4096)) * 1536;
    float* PS = WSP(float, WS_PS) + ((size_t)l * 272 + pb) * 1536;
    const float* fw3 = F.in[19] + (size_t)l * 64 * 1536;
    const float dmin = 3.0701134573253945f, dstep = (15.350567286626973f - 3.0701134573253945f) / 383.0f;
#pragma unroll 1
    for (int cc = 0; cc < 3; ++cc) { const int col = tid + 512 * cc; float acc[16];
#pragma unroll
        for (int pp = 0; pp < 16; ++pp) acc[pp] = 0.f;
        for (int j = 0; j < 64; ++j) { const float w = fw3[(size_t)j * 1536 + col];
#pragma unroll
            for (int pp = 0; pp < 16; ++pp) acc[pp] += h2[pp * 64 + j] * w; }
        const int c = col % 384, dir = col / 768; const float delta = dmin + (float)c * dstep; float ps = 0.f;
#pragma unroll
        for (int pp = 0; pp < 16; ++pp) { const int pos = p0 + pp; const float t = (float)pos / (float)(LL - 1); const float v = acc[pp] * __expf(-t * delta);
            HT[(size_t)pos * 1536 + col] = v; if (!(dir == 1 && pos == 0)) ps += fabsf(v); }
        PS[col] = ps; }
    __syncthreads();
}
__device__ __forceinline__ void p0_s5_item(Frame& F, int item) {
    const int l = item / 24, g = item % 24, tid = F.tid;
    LAS f32x2* apow = (LAS f32x2*)F.lds;
    LAS f32x2* bbar = apow + 2 * 17 * 64;
    LAS f32x2* Cc = bbar + 2 * 64 * 16;
    LAS float* Kd = (LAS float*)(Cc + 2 * 16 * 64);
    if (tid < 128) { const int dir = tid >> 6, p = tid & 63; const size_t ix = (((size_t)l * 2 + dir) * 24 + g) * 64 + p;
        const double are = F.in[21][ix], aim = F.in[22][ix], dt = exp((double)F.in[23][((size_t)l * 2 + dir) * 24 + g]);
        for (int tau = 0; tau <= 16; ++tau) { const double mg = exp(are * dt * tau), an = aim * dt * tau; apow[(dir * 17 + tau) * 64 + p] = (f32x2){(float)(mg * cos(an)), (float)(mg * sin(an))}; }
        const double mg = exp(are * dt), an = aim * dt; const double nr = mg * cos(an) - 1.0, ni = mg * sin(an); const double den = are * are + aim * aim;
        const double qr = (nr * are + ni * aim) / den, qi = (ni * are - nr * aim) / den;
        for (int h = 0; h < 16; ++h) { const double br = F.in[24][ix * 16 + h], bi = F.in[25][ix * 16 + h]; bbar[(dir * 64 + p) * 16 + h] = (f32x2){(float)(qr * br - qi * bi), (float)(qr * bi + qi * br)}; }
        const double m16 = exp(are * dt * 16.0), a16 = aim * dt * 16.0;
        WSP(float, WS_A16)[ix * 2 + 0] = (float)(m16 * cos(a16)); WSP(float, WS_A16)[ix * 2 + 1] = (float)(m16 * sin(a16)); }
    for (int i = tid; i < 2 * 16 * 64; i += NTHR) { const int dir = i >> 10, h = (i >> 6) & 15, p = i & 63; const size_t ix = ((((size_t)l * 2 + dir) * 24 + g) * 16 + h) * 64 + p;
        Cc[i] = (f32x2){F.in[26][ix], F.in[27][ix]}; }
    __syncthreads();
    for (int i = tid; i < 2 * 16 * 256; i += NTHR) { const int dir = i >> 12, tau = (i >> 8) & 15, h = (i >> 4) & 15, h2 = i & 15; float s = 0.f;
        for (int p = 0; p < 64; ++p) { const f32x2 a = apow[(dir * 17 + tau) * 64 + p], b = bbar[(dir * 64 + p) * 16 + h2], c = Cc[(dir * 16 + h) * 64 + p];
            const float tr = a.x * b.x - a.y * b.y, ti = a.x * b.y + a.y * b.x; s += c.x * tr - c.y * ti; }
        Kd[i] = s; }
    __syncthreads();
    bf16* EST = (bf16*)(F.ws + WS_S5M + (size_t)item * S5M_STRIDE); bf16* MOUT = EST + 256 * 256;
    for (int i = tid; i < 256 * 256; i += NTHR) { const int n = i >> 8, k = i & 255; const int dir = n >> 7, p = (n >> 1) & 63, ri = n & 1, hh = k >> 4, j = k & 15;
        const int tau = dir == 0 ? 15 - j : j; const f32x2 a = apow[(dir * 17 + tau) * 64 + p], b = bbar[(dir * 64 + p) * 16 + hh];
        const float v = ri == 0 ? a.x * b.x - a.y * b.y : a.x * b.y + a.y * b.x; EST[i] = (bf16)f2bf(v); }
    const float* dsk = F.in[28] + (size_t)l * 384 + g * 16;
    for (int i = tid; i < 256 * 512; i += NTHR) { const int n = i >> 9, k = i & 511; const int j = n >> 4, h = n & 15; float v;
        if (k < 256) { const int hh = k >> 4, ii = k & 15; v = 0.f;
            if (ii <= j) v += Kd[((0 * 16 + (j - ii)) * 16 + h) * 16 + hh];
            if (ii >= j) v += Kd[((1 * 16 + (ii - j)) * 16 + h) * 16 + hh];
            if (ii == j && h == hh) v += dsk[h]; }
        else { const int comp = k - 256, dir = comp >> 7, p = (comp >> 1) & 63, ri = comp & 1; const int tau = dir == 0 ? j + 1 : 16 - j;
            const f32x2 a = apow[(dir * 17 + tau) * 64 + p], c = Cc[(dir * 16 + h) * 64 + p];
            v = ri == 0 ? (c.x * a.x - c.y * a.y) : -(c.x * a.y + c.y * a.x); }
        MOUT[i] = (bf16)f2bf(v); }
    __syncthreads();
}
__device__ __forceinline__ void p0_prologue(Frame& F_) { Frame F = relocal(F_);
    p0_transposes(F);
    __syncthreads();
    for (int i = F.vcu * NTHR + F.tid; i < 2 * 128 * 384 / 8; i += F.G * NTHR) { const int l = i / (128 * 384 / 8), r = i % (128 * 384 / 8);
        *(v4u*)(WSP(bf16, WS_GLU) + (size_t)l * 512 * 384 + 384 * 384 + (size_t)r * 8) = (v4u){0u, 0u, 0u, 0u}; }
    constexpr int I_MOD = 96, I_FOLD = 128, I_DFT = 512, I_DFTC = 4, I_FIL = 544, I_S5 = 48, NIT = I_MOD + I_FOLD + I_DFT + I_DFTC + I_FIL + I_S5;
    for (int it = F.vcu; it < NIT; it += F.G) {
        int r = it;
        if (r < I_FIL) { p0_filter_item(F, r); continue; } r -= I_FIL;
        if (r < I_MOD) { p0_mod_item(F, r); continue; } r -= I_MOD;
        if (r < I_FOLD) { p0_fold_item(F, r); continue; } r -= I_FOLD;
        if (r < I_S5) { p0_s5_item(F, r); continue; } r -= I_S5;
        if (r < I_DFT) { gen_dft_rows(WSP(bf16, WS_DFT), L, r * 8, 8, 1.0f / 64.0f, F.tid); continue; } r -= I_DFT;
        gen_dft_rows(WSP(bf16, WS_DFTC), LC, r * 64, 64, 1.0f / 16.0f, F.tid);
    }
}
__device__ __forceinline__ void p1_item(Frame& F_, int item) { Frame F = relocal(F_);
    const int l = item / 1632; int r = item % 1632; const int set = r < 1536 ? 0 : 1; if (set) r -= 1536;
    const int npb = set ? 4 : 64, LL = set ? LC : L, pb = r % npb, ocb = r / npb, o = ocb / 12, cb = ocb % 12, tid = F.tid;
    LAS float* red = (LAS float*)F.lds;
    LAS float* inv = red + 512;
    LAS float* T = inv + 32;
    const float* PS = WSP(float, WS_PS) + ((size_t)l * 272 + (set ? 256 : 0)) * 1536;
    { const int ch = tid & 31, part = tid >> 5; float s = 0.f; const int nblk = LL / 16;
      for (int b = part; b < nblk; b += 16) s += PS[(size_t)b * 1536 + o * 384 + cb * 32 + ch] + PS[(size_t)b * 1536 + 768 + o * 384 + cb * 32 + ch];
      red[part * 32 + ch] = s; }
    __syncthreads();
    if (tid < 32) { float s = 0.f; for (int p = 0; p < 16; ++p) s += red[p * 32 + tid]; inv[tid] = 1.0f / s; }
    const float* HT = WSP(float, WS_HT) + ((size_t)l * 4352 + (set ? 4096 : 0)) * 1536;
    { const int ch = tid & 31, dir = (tid >> 5) & 1;
      for (int i = 0; i < 8; ++i) { const int pp = (tid >> 6) + 8 * i; T[(dir * 64 + pp) * 33 + ch] = HT[(size_t)(pb * 64 + pp) * 1536 + dir * 768 + o * 384 + cb * 32 + ch]; } }
    __syncthreads();
    float* KT = set ? WSP(float, WS_KTC) + ((size_t)(l * 2 + o) * 384) * 512 : WSP(float, WS_KT) + ((size_t)(l * 2 + o) * 384) * 8192;
    { const int pp = tid & 63;
      for (int i = 0; i < 4; ++i) { const int ch = (tid >> 6) + 8 * i; const int pos = pb * 64 + pp; float* kt = KT + (size_t)(cb * 32 + ch) * 2 * LL;
          kt[LL + pos] = T[(0 * 64 + pp) * 33 + ch] * inv[ch];
          if (pos > 0) kt[LL - pos] = T[(1 * 64 + pp) * 33 + ch] * inv[ch]; else kt[0] = 0.f; } }
    __syncthreads();
}

__device__ __forceinline__ void norm_rows(Frame& F_, const float* xlat, const float* xctx, int nrows, const float* gain, const float* mod, int sh_off, int sc_off, bf16* out) { Frame F = relocal(F_);
    const int gw = F.vcu * NWAVES + F.wave, NGW = F.G * NWAVES, lane = F.lane;
    for (int r = gw; r < nrows; r += NGW) {
        const float* xr = r < NL ? xlat + (size_t)r * D : xctx + (size_t)(r - NL) * D;
        const float* md = mod + (size_t)bidx_of(r) * 6144;
        f32x4 v[4]; float ss = 0.f;
#pragma unroll
        for (int j = 0; j < 4; ++j) { v[j] = ((const f32x4*)xr)[64 * j + lane]; ss += (v[j].x * v[j].x + v[j].y * v[j].y) + (v[j].z * v[j].z + v[j].w * v[j].w); }
        const float rstd = 1.0f / sqrtf(wave_sum(ss, lane) * (1.0f / D) + 1e-6f);
#pragma unroll
        for (int j = 0; j < 4; ++j) { const int col = (64 * j + lane) * 4; const f32x4 g4 = *(const f32x4*)(gain + col), sc = *(const f32x4*)(md + sc_off + col), sh = *(const f32x4*)(md + sh_off + col);
            const f32x4 h = v[j] * rstd * g4 * (sc + 1.0f) + sh;
            *(v2u*)(out + (size_t)r * D + col) = (v2u){pk2(h.x, h.y), pk2(h.z, h.w)}; }
    }
}
__device__ __forceinline__ void norm2_router(Frame& F_, const float* x, const float* gain, const float* mod, bf16* out) { Frame F = relocal(F_);
    LAS int* hist = (LAS int*)F.lds;
    const float* rw = F.in[34]; const float* rb = F.in[35];
    for (int tile = F.vcu; tile < NL / 256; tile += F.G) {
        if (F.tid < 16) hist[F.tid] = 0;
        __syncthreads();
        for (int i = 0; i < 32; ++i) { const int r = tile * 256 + F.wave * 32 + i, lane = F.lane;
            const float* xr = x + (size_t)r * D; const float* md = mod + (size_t)(r >> 12) * 6144;
            f32x4 v[4]; float ss = 0.f;
#pragma unroll
            for (int j = 0; j < 4; ++j) { v[j] = ((const f32x4*)xr)[64 * j + lane]; ss += (v[j].x * v[j].x + v[j].y * v[j].y) + (v[j].z * v[j].z + v[j].w * v[j].w); }
            const float rstd = 1.0f / sqrtf(wave_sum(ss, lane) * (1.0f / D) + 1e-6f);
            float lg[8];
#pragma unroll
            for (int e = 0; e < 8; ++e) lg[e] = 0.f;
#pragma unroll
            for (int j = 0; j < 4; ++j) { const int col = (64 * j + lane) * 4; const f32x4 g4 = *(const f32x4*)(gain + col), sc = *(const f32x4*)(md + 4096 + col), sh = *(const f32x4*)(md + 3072 + col);
                const f32x4 h = v[j] * rstd * g4 * (sc + 1.0f) + sh;
                *(v2u*)(out + (size_t)r * D + col) = (v2u){pk2(h.x, h.y), pk2(h.z, h.w)};
#pragma unroll
                for (int q = 0; q < 4; ++q) { const f32x4 w0 = *(const f32x4*)(rw + (size_t)(col + q) * 8), w1 = *(const f32x4*)(rw + (size_t)(col + q) * 8 + 4); const float hv = h[q];
                    lg[0] += hv * w0.x; lg[1] += hv * w0.y; lg[2] += hv * w0.z; lg[3] += hv * w0.w; lg[4] += hv * w1.x; lg[5] += hv * w1.y; lg[6] += hv * w1.z; lg[7] += hv * w1.w; } }
#pragma unroll
            for (int e = 0; e < 8; ++e) lg[e] = wave_sum(lg[e], lane) + rb[e];
            if (lane == 0) {
                int e1 = 0; float v1 = lg[0];
#pragma unroll
                for (int e = 1; e < 8; ++e) if (lg[e] > v1) { v1 = lg[e]; e1 = e; }
                int e2 = -1; float v2 = -3.4e38f;
#pragma unroll
                for (int e = 0; e < 8; ++e) if (e != e1 && lg[e] > v2) { v2 = lg[e]; e2 = e; }
                const float ex = __expf(v2 - v1), w1 = 1.0f / (1.0f + ex), w2 = ex / (1.0f + ex);
                *(v4u*)(F.ws + WS_TOPK + (size_t)r * 16) = (v4u){(unsigned)(e1 | (e2 << 8)), __builtin_bit_cast(unsigned, w1), __builtin_bit_cast(unsigned, w2), 0u};
                __hip_atomic_fetch_add(hist + e1, 1, __ATOMIC_RELAXED, __HIP_MEMORY_SCOPE_WORKGROUP); __hip_atomic_fetch_add(hist + 8 + e2, 1, __ATOMIC_RELAXED, __HIP_MEMORY_SCOPE_WORKGROUP);
            } }
        __syncthreads();
        if (F.tid < 16) ((int*)(F.ws + WS_META + META_CNT))[tile * 16 + F.tid] = hist[F.tid];
        __syncthreads();
    }
}
__device__ __forceinline__ void moe_slots(Frame& F_) { Frame F = relocal(F_);
    LAS int* tot = (LAS int*)F.lds;
    LAS int* es = tot + 32;
    const int* CNT = (const int*)(F.ws + WS_META + META_CNT); int* IDX = (int*)(F.ws + WS_META + META_IDX); int* TE = (int*)(F.ws + WS_META + META_TE); int* NT = (int*)(F.ws + WS_META + META_NT);
    for (int it = F.vcu; it < 512; it += F.G) { const int k = it >> 8, tile = it & 255, tid = F.tid;
        if (tid < 8) { int t = 0, b = 0; for (int i = 0; i < 256; ++i) { const int c = CNT[i * 16 + k * 8 + tid]; if (i < tile) b += c; t += c; } tot[tid] = t; tot[8 + tid] = b; }
        __syncthreads();
        if (tid == 0) { int s = 0; for (int e = 0; e < 8; ++e) { tot[16 + e] = s; s += (tot[e] + 255) & ~255; } tot[24] = s; }
        if (tid < 256) { const unsigned pk = *(const unsigned*)(F.ws + WS_TOPK + (size_t)(tile * 256 + tid) * 16); es[tid] = k == 0 ? (int)(pk & 255u) : (int)((pk >> 8) & 255u); }
        __syncthreads();
        if (tid < 256) { const int e = es[tid]; int rank = 0; for (int j = 0; j < tid; ++j) rank += (es[j] == e) ? 1 : 0;
            IDX[k * MAXSLOT + tot[16 + e] + tot[8 + e] + rank] = tile * 256 + tid; }
        if (tile == 0) {
            for (int e = 0; e < 8; ++e) { const int n = tot[e], np = (n + 255) & ~255, sb = tot[16 + e];
                for (int i = n + tid; i < np; i += NTHR) IDX[k * MAXSLOT + sb + i] = -1;
                for (int i = tid; i < np / 256; i += NTHR) TE[k * 272 + sb / 256 + i] = e; }
            if (tid == 0) NT[k] = tot[24] / 256; }
        __syncthreads();
    }
}
__device__ __forceinline__ void final_norm(Frame& F_) { Frame F = relocal(F_);
    const int gw = F.vcu * NWAVES + F.wave, NGW = F.G * NWAVES, lane = F.lane; const float* gain = F.in[39];
    for (int r = gw; r < NL; r += NGW) { float* xr = F.out + (size_t)r * D; f32x4 v[4]; float ss = 0.f;
#pragma unroll
        for (int j = 0; j < 4; ++j) { v[j] = ((const f32x4*)xr)[64 * j + lane]; ss += (v[j].x * v[j].x + v[j].y * v[j].y) + (v[j].z * v[j].z + v[j].w * v[j].w); }
        const float rstd = 1.0f / sqrtf(wave_sum(ss, lane) * (1.0f / D) + 1e-6f);
#pragma unroll
        for (int j = 0; j < 4; ++j) { const int col = (64 * j + lane) * 4; ((f32x4*)xr)[64 * j + lane] = v[j] * rstd * *(const f32x4*)(gain + col); } }
}

__device__ __forceinline__ float sconv(const bf16* prow, int colbase, int t, int LL, bool grid, float w0, float w1, float w2, float bias) {
    const bool hasl = grid ? ((t & 63) != 0) : (t > 0), hasr = grid ? ((t & 63) != 63) : (t < LL - 1);
    const float c = bf2f(prow[colbase + t]), a = hasl ? bf2f(prow[colbase + t - 1]) : 0.f, b = hasr ? bf2f(prow[colbase + t + 1]) : 0.f;
    return a * w0 + c * w1 + b * w2 + bias;
}
template <int LL, int NT, int NBT>
__device__ __forceinline__ void hyena_unit(Frame& F, int l, int o, int c, int b0, bool latent) {
    constexpr int TPB = LL / NT, BG = NTHR / TPB, NBU = BG * NBT;
    LAS float* kk = (LAS float*)F.lds;
    LAS float* us = kk + 2 * LL;
    const int tid = F.tid;
    const bf16* PT = WSP(bf16, WS_PT);
    const float* cw = F.in[11] + (size_t)l * 3 * 1152; const float* cb = F.in[12] + (size_t)l * 1152;
    const int in_row = R_HY + c;
    const int mul_row = R_HY + 384 * (o + 1) + c, mul_ch = 384 * (o + 1) + c;
    const int out_row = o == 0 ? R_HY + c : R_HY + 384 + c;
    const float* KT = latent ? WSP(float, WS_KT) + ((size_t)(l * 2 + o) * 384 + c) * 8192 : WSP(float, WS_KTC) + ((size_t)(l * 2 + o) * 384 + c) * 512;
    for (int i = tid; i < 2 * LL; i += NTHR) kk[i] = KT[i];
    { const float w0 = cw[c], w1 = cw[1152 + c], w2 = cw[2304 + c], bs = cb[c];
      for (int i = tid; i < NBU * LL; i += NTHR) { const int bb = i / LL, t = i % LL; const int colbase = latent ? (b0 + bb) * L : NL + (b0 + bb) * LC;
          us[i] = o == 0 ? sconv(PT + (size_t)in_row * MT, colbase, t, LL, latent, w0, w1, w2, bs) : bf2f(PT[(size_t)in_row * MT + colbase + t]); } }
    __syncthreads();
    float acc[NBT][NT];
#pragma unroll
    for (int bj = 0; bj < NBT; ++bj)
#pragma unroll
        for (int tj = 0; tj < NT; ++tj) acc[bj][tj] = 0.f;
    const int tb = tid % TPB, bg = tid / TPB;
#pragma unroll 4
    for (int s = 0; s < LL; ++s) { float kv[NT], uv[NBT];
#pragma unroll
        for (int tj = 0; tj < NT; ++tj) kv[tj] = kk[LL + tb + TPB * tj - s];
#pragma unroll
        for (int bj = 0; bj < NBT; ++bj) uv[bj] = us[(bg + BG * bj) * LL + s];
#pragma unroll
        for (int bj = 0; bj < NBT; ++bj)
#pragma unroll
            for (int tj = 0; tj < NT; ++tj) acc[bj][tj] += kv[tj] * uv[bj]; }
    const float hb = F.in[20][((size_t)l * 2 + o) * 384 + c];
    const float m0 = cw[mul_ch], m1 = cw[1152 + mul_ch], m2 = cw[2304 + mul_ch], mb = cb[mul_ch];
    bf16* PTw = WSP(bf16, WS_PT);
#pragma unroll
    for (int bj = 0; bj < NBT; ++bj)
#pragma unroll
        for (int tj = 0; tj < NT; ++tj) { const int bb = bg + BG * bj, t = tb + TPB * tj; const int colbase = latent ? (b0 + bb) * L : NL + (b0 + bb) * LC;
            const float uval = us[bb * LL + t]; const float xm = sconv(PT + (size_t)mul_row * MT, colbase, t, LL, latent, m0, m1, m2, mb);
            PTw[(size_t)out_row * MT + colbase + t] = (bf16)f2bf(xm * (acc[bj][tj] + hb * uval)); asm volatile("" ::: "memory"); }
    __syncthreads();
}
template <int LL, int NTW, bool GRID>
__device__ __forceinline__ void hyena_job(Frame& F, int l, int o, int c, int tbase) {
    constexpr int TR = NWAVES * NTW * 16, NENT = LL - 8 + TR, NSG = LL / 128;
    const int tid = F.tid, lane = F.lane, fr = lane & 15, fq = lane >> 4;
    const int mmin = -tbase - TR + 1;
    LAS unsigned char* VT = F.lds;
    {   const float* KT = GRID ? WSP(float, WS_KT) + ((size_t)(l * 2 + o) * 384 + c) * 8192 : WSP(float, WS_KTC) + ((size_t)(l * 2 + o) * 384 + c) * 512;
        for (int e = tid; e < NENT; e += NTHR) { const int m = mmin + e; float v[8];
#pragma unroll
            for (int j = 0; j < 8; ++j) { const int tau = -(m + j); v[j] = (tau > -LL && tau < LL) ? KT[tau + LL] : 0.f; }
            *(LAS v4u*)(VT + e * 16) = (v4u){pk2(v[0], v[1]), pk2(v[2], v[3]), pk2(v[4], v[5]), pk2(v[6], v[7])}; } }
    __syncthreads();
    const float* cw = F.in[11] + (size_t)l * 3 * 1152; const float* cb = F.in[12] + (size_t)l * 1152;
    const bf16* inrow = o == 0 ? WSP(bf16, WS_PT) + (size_t)(R_HY + c) * MT : WSP(bf16, WS_Z1) + (size_t)c * MT;
    const bf16* mulrow = WSP(bf16, WS_PT) + (size_t)(R_HY + 384 * (o + 1) + c) * MT;
    bf16* outrow = o == 0 ? WSP(bf16, WS_Z1) + (size_t)c * MT : WSP(bf16, WS_PT) + (size_t)(R_HY + 384 + c) * MT;
    const float iw0 = cw[c], iw1 = cw[1152 + c], iw2 = cw[2304 + c], ib = cb[c];
    const int colb = GRID ? fr * L : NL + fr * LC;
    const int T0 = tbase + F.wave * NTW * 16;
    f32x4 acc[NTW];
#pragma unroll
    for (int i = 0; i < NTW; ++i) acc[i] = (f32x4){0.f, 0.f, 0.f, 0.f};
    const int lb = (8 * fq - fr - T0 - mmin - 16 * (NTW - 1)) * 16;
    v4u raw[4]; unsigned rl[4], rr[4];
#define HY_LOADRAW(sg) do { _Pragma("unroll") for (int jj = 0; jj < 4; ++jj) { const int sidx = (sg) * 128 + jj * 32 + 8 * fq; const bf16* p = inrow + colb + sidx; raw[jj] = *(const v4u*)p; \
        if (o == 0) { const bool hl = GRID ? ((sidx & 63) != 0) : (sidx > 0), hr = GRID ? (((sidx + 7) & 63) != 63) : (sidx + 8 < LL); rl[jj] = hl ? (unsigned)p[-1] : 0u; rr[jj] = hr ? (unsigned)p[8] : 0u; } } } while (0)
    HY_LOADRAW(0);
#pragma unroll 1
    for (int sg = 0; sg < NSG; ++sg) {
        bf16x8 Bf[4];
#pragma unroll
        for (int jj = 0; jj < 4; ++jj) {
            if (o == 0) { float p[10]; p[0] = bf2f((unsigned short)rl[jj]); p[9] = bf2f((unsigned short)rr[jj]);
                p[1] = bf2f(raw[jj].x & 0xffffu); p[2] = bf2f(raw[jj].x >> 16); p[3] = bf2f(raw[jj].y & 0xffffu); p[4] = bf2f(raw[jj].y >> 16);
                p[5] = bf2f(raw[jj].z & 0xffffu); p[6] = bf2f(raw[jj].z >> 16); p[7] = bf2f(raw[jj].w & 0xffffu); p[8] = bf2f(raw[jj].w >> 16);
                float q[8];
#pragma unroll
                for (int j = 0; j < 8; ++j) q[j] = p[j] * iw0 + p[j + 1] * iw1 + p[j + 2] * iw2 + ib;
                const v4u w = (v4u){pk2(q[0], q[1]), pk2(q[2], q[3]), pk2(q[4], q[5]), pk2(q[6], q[7])}; Bf[jj] = __builtin_bit_cast(bf16x8, w); }
            else Bf[jj] = __builtin_bit_cast(bf16x8, raw[jj]); }
        if (sg + 1 < NSG) HY_LOADRAW(sg + 1);
        const LAS unsigned char* vt = VT + lb + sg * 2048;
#pragma unroll
        for (int dd = 0; dd < NTW + 6; ++dd) { const int e = dd - 6; const bf16x8 A = *(const LAS bf16x8*)(vt + 256 * (NTW - 1 - e));
#pragma unroll
            for (int jj = 0; jj < 4; ++jj) { const int i = e + 2 * jj; if (i >= 0 && i < NTW) acc[i] = __builtin_amdgcn_mfma_f32_16x16x32_bf16(A, Bf[jj], acc[i], 0, 0, 0); } }
    }
#undef HY_LOADRAW
    const float hb = F.in[20][((size_t)l * 2 + o) * 384 + c];
    const int mch = 384 * (o + 1) + c; const float m0 = cw[mch], m1 = cw[1152 + mch], m2 = cw[2304 + mch], mb = cb[mch];
#pragma unroll
    for (int i = 0; i < NTW; ++i) { const int t = T0 + 16 * i + 4 * fq;
        const bool hl = GRID ? ((t & 63) != 0) : (t > 0), hr = GRID ? (((t + 3) & 63) != 63) : (t + 4 < LL);
        float x[6], u[4];
        { const bf16* p = mulrow + colb + t; const v2u r2 = *(const v2u*)p; x[0] = hl ? bf2f(p[-1]) : 0.f; x[5] = hr ? bf2f(p[4]) : 0.f;
          x[1] = bf2f(r2.x & 0xffffu); x[2] = bf2f(r2.x >> 16); x[3] = bf2f(r2.y & 0xffffu); x[4] = bf2f(r2.y >> 16); }
        { const bf16* p = inrow + colb + t; const v2u r2 = *(const v2u*)p; float y[6];
          y[1] = bf2f(r2.x & 0xffffu); y[2] = bf2f(r2.x >> 16); y[3] = bf2f(r2.y & 0xffffu); y[4] = bf2f(r2.y >> 16);
          if (o == 0) { y[0] = hl ? bf2f(p[-1]) : 0.f; y[5] = hr ? bf2f(p[4]) : 0.f;
#pragma unroll
              for (int r = 0; r < 4; ++r) u[r] = y[r] * iw0 + y[r + 1] * iw1 + y[r + 2] * iw2 + ib; }
          else { u[0] = y[1]; u[1] = y[2]; u[2] = y[3]; u[3] = y[4]; } }
        float ov[4];
#pragma unroll
        for (int r = 0; r < 4; ++r) { const float xm = x[r] * m0 + x[r + 1] * m1 + x[r + 2] * m2 + mb; ov[r] = xm * (acc[i][r] + hb * u[r]); }
        *(v2u*)(outrow + colb + t) = (v2u){pk2(ov[0], ov[1]), pk2(ov[2], ov[3])};
        asm volatile("" ::: "memory"); }
    __syncthreads();
}
__device__ __forceinline__ void hyena_stage(Frame& F_, int l, int o) { Frame F = relocal(F_);
    const int nlat = 384 * 2, nctx = l == 0 ? 384 : 0;
    for (int u = F.vcu; u < nlat + nctx; u += F.G) {
        if (u < nlat) hyena_job<L, 16, true>(F, l, o, u >> 1, (u & 1) * 2048);
        else hyena_job<LC, 2, false>(F, l, o, u - nlat, 0);
    }
}
__device__ __forceinline__ void hyena_transpose(Frame& F_, int nrows) { Frame F = relocal(F_);
    LAS bf16* T = (LAS bf16*)F.lds; constexpr int PITCH = 258;
    const bf16* PT = WSP(bf16, WS_PT); bf16* Y = WSP(bf16, WS_HMOD); const int tid = F.tid;
    const int nrt = nrows / 256;
    for (int it = F.vcu; it < 6 * nrt; it += F.G) { const int cb = it % 6, rt = it / 6;
        { const int c = tid >> 3, seg = tid & 7; const bf16* src = PT + (size_t)(R_HY + 384 + cb * 64 + c) * MT + rt * 256 + seg * 32;
#pragma unroll
          for (int q = 0; q < 4; ++q) { const v4u v = *(const v4u*)(src + q * 8); LAS unsigned* d = (LAS unsigned*)(T + c * PITCH + seg * 32 + q * 8); d[0] = v.x; d[1] = v.y; d[2] = v.z; d[3] = v.w; } }
        __syncthreads();
        { const int r = tid >> 1, half = tid & 1; unsigned w[16];
#pragma unroll
          for (int q = 0; q < 16; ++q) { const unsigned lo = T[(half * 32 + 2 * q) * PITCH + r], hi = T[(half * 32 + 2 * q + 1) * PITCH + r]; w[q] = lo | (hi << 16); }
          bf16* dst = Y + (size_t)(rt * 256 + r) * D + 256 + cb * 64 + half * 32;
#pragma unroll
          for (int q = 0; q < 4; ++q) *(v4u*)(dst + q * 8) = (v4u){w[4 * q], w[4 * q + 1], w[4 * q + 2], w[4 * q + 3]}; }
        __syncthreads();
    }
}

__device__ __forceinline__ void s5_carry(Frame& F_, int l) { Frame F = relocal(F_);
    const float* E = (const float*)((unsigned char*)F.out + DO_E); bf16* HS = (bf16*)((unsigned char*)F.out + DO_HS);
    const int id = F.vcu * NTHR + F.tid;
    if (id >= NB * 24 * 128) return;
    const int p = id & 63, dir = (id >> 6) & 1, g = (id >> 7) % 24, b = id / (128 * 24);
    const size_t ix = (((size_t)l * 2 + dir) * 24 + g) * 64 + p; const float ar = WSP(float, WS_A16)[ix * 2], ai = WSP(float, WS_A16)[ix * 2 + 1];
    const int comp = dir * 128 + 2 * p, q = comp >> 4, i0 = comp & 15;
    float sr = 0.f, si = 0.f;
    for (int step = 0; step < 272; ++step) {
        int cidx;
        if (dir == 0) cidx = step < 16 ? NL / 16 + b * 16 + step : b * 256 + (step - 16);
        else cidx = step < 16 ? NL / 16 + b * 16 + (15 - step) : b * 256 + (255 - (step - 16));
        *(unsigned*)(HS + (size_t)(g * 16 + q) * MT + (size_t)cidx * 16 + i0) = pk2(sr, si);
        const f32x2 e = *(const f32x2*)(E + ((size_t)g * NCHUNK + cidx) * 256 + comp);
        const float nr = ar * sr - ai * si + e.x, ni = ar * si + ai * sr + e.y; sr = nr; si = ni;
    }
}

struct A_WinT { const bf16* w; __device__ __forceinline__ const bf16* operator()(int, int r, int k) const { return w + (size_t)r * D + k; } };
struct E_PT { bf16* pt; __device__ __forceinline__ void operator()(int, int r, int c, f32x4 v0, f32x4 v1) const {
    *(v2u*)(pt + (size_t)r * MT + c) = (v2u){pk2(v0.x, v0.y), pk2(v0.z, v0.w)}; *(v2u*)(pt + (size_t)r * MT + c + 16) = (v2u){pk2(v1.x, v1.y), pk2(v1.z, v1.w)}; } };
struct A_Dft { const bf16* d; int ld; __device__ __forceinline__ const bf16* operator()(int, int r, int k) const { return d + (size_t)r * ld + k; } };
struct B_FnetLat { const bf16* pt; __device__ __forceinline__ const bf16* operator()(int bt, int n, int k) const { return pt + (size_t)((k >> 12) * 256 + n) * MT + bt * L + (k & 4095); } };
struct B_FnetCtx { const bf16* pt; __device__ __forceinline__ const bf16* operator()(int bt, int n, int k) const { return pt + (size_t)((k >> 8) * 256 + n) * MT + NL + bt * LC + (k & 255); } };
struct E_Fnet { bf16* y; int rowbase, rows_per; __device__ __forceinline__ void operator()(int bt, int r, int c, f32x4 v0, f32x4 v1) const { bf16* p = y + (size_t)(rowbase + bt * rows_per + r) * D + c;
    *(v2u*)p = (v2u){pk2(v0.x, v0.y), pk2(v0.z, v0.w)}; *(v2u*)(p + 16) = (v2u){pk2(v1.x, v1.y), pk2(v1.z, v1.w)}; } };
struct A_S5 { const bf16* pt; const bf16* hs; __device__ __forceinline__ const bf16* operator()(int g, int r, int k) const {
    return k < 256 ? pt + (size_t)(R_S5 + g * 16 + (k >> 4)) * MT + (size_t)r * 16 + (k & 15) : hs + (size_t)(g * 16 + ((k - 256) >> 4)) * MT + (size_t)r * 16 + (k & 15); } };
struct B_S5 { const bf16* m; int off, ld; __device__ __forceinline__ const bf16* operator()(int g, int n, int k) const { return (const bf16*)((const unsigned char*)m + (size_t)g * S5M_STRIDE) + off + (size_t)n * ld + k; } };
struct E_S5E { float* e; __device__ __forceinline__ void operator()(int g, int r, int c, f32x4 v0, f32x4 v1) const { float* p = e + ((size_t)g * NCHUNK + r) * 256 + c; *(f32x4*)p = v0; *(f32x4*)(p + 16) = v1; } };
struct E_S5O { bf16* ys; __device__ __forceinline__ void operator()(int g, int r, int c, f32x4 v0, f32x4 v1) const {
    { const int j = c >> 4, h = c & 15; bf16* p = ys + ((size_t)r * 16 + j) * 384 + g * 16 + h; *(v2u*)p = (v2u){pk2(gelu_tanh_f(v0.x), gelu_tanh_f(v0.y)), pk2(gelu_tanh_f(v0.z), gelu_tanh_f(v0.w))}; }
    { const int c1 = c + 16, j = c1 >> 4, h = c1 & 15; bf16* p = ys + ((size_t)r * 16 + j) * 384 + g * 16 + h; *(v2u*)p = (v2u){pk2(gelu_tanh_f(v1.x), gelu_tanh_f(v1.y)), pk2(gelu_tanh_f(v1.z), gelu_tanh_f(v1.w))}; } } };
struct E_Glu { const bf16* ys; bf16* y; const float* gb; __device__ __forceinline__ void one(int r, int c, f32x4 v) const { if (c >= 384) return;
    const v2u yv = *(const v2u*)(ys + (size_t)r * 384 + c); const f32x4 b = *(const f32x4*)(gb + c);
    const float y0 = bf2f(yv.x & 0xffffu), y1 = bf2f(yv.x >> 16), y2 = bf2f(yv.y & 0xffffu), y3 = bf2f(yv.y >> 16);
    *(v2u*)(y + (size_t)r * D + 640 + c) = (v2u){pk2(y0 * sigmoid_f(v.x + b.x), y1 * sigmoid_f(v.y + b.y)), pk2(y2 * sigmoid_f(v.z + b.z), y3 * sigmoid_f(v.w + b.w))}; }
    __device__ __forceinline__ void operator()(int, int r, int c, f32x4 v0, f32x4 v1) const { one(r, c, v0); one(r, c + 16, v1); } };
struct E_Res { const float* xlat; const float* xctx; float* xo; const float* mod; int goff; __device__ __forceinline__ void one(int r, int c, f32x4 v) const {
    const float* xi = r < NL ? xlat + (size_t)r * D + c : xctx + (size_t)(r - NL) * D + c; const f32x4 g = *(const f32x4*)(mod + (size_t)bidx_of(r) * 6144 + goff + c);
    *(f32x4*)(xo + (size_t)r * D + c) = *(const f32x4*)xi + g * v; }
    __device__ __forceinline__ void operator()(int, int r, int c, f32x4 v0, f32x4 v1) const { one(r, c, v0); one(r, c + 16, v1); } };
struct E_Swi { bf16* act; int ld; __device__ __forceinline__ void operator()(int, int r, int c, f32x4 v0, f32x4 v1) const {
    const int f = 16 * (c >> 5) + (c & 15); *(v2u*)(act + (size_t)r * ld + f) = (v2u){pk2(silu_f(v0.x) * v1.x, silu_f(v0.y) * v1.y), pk2(silu_f(v0.z) * v1.z, silu_f(v0.w) * v1.w)}; } };
struct A_MoeUp { const bf16* h; const int* idx; __device__ __forceinline__ const bf16* operator()(int, int r, int k) const { int t = idx[r]; t = t < 0 ? 0 : t; return h + (size_t)t * D + k; } };
struct E_MoeDown { float* x; const int* idx; const unsigned char* topk; const float* mod; int k; __device__ __forceinline__ void one(int r, int c, f32x4 v) const {
    const int t = idx[r]; if (t < 0) return; const float w = *(const float*)(topk + (size_t)t * 16 + 4 + 4 * k); const f32x4 g = *(const f32x4*)(mod + (size_t)(t >> 12) * 6144 + 5120 + c);
    float* p = x + (size_t)t * D + c; *(f32x4*)p = *(const f32x4*)p + g * (v * w); }
    __device__ __forceinline__ void operator()(int, int r, int c, f32x4 v0, f32x4 v1) const { one(r, c, v0); one(r, c + 16, v1); } };

template <class AF, class EP>
__device__ __forceinline__ void gemm_moe(int mtiles, int ntiles, int K, const AF& af, const unsigned char* wbase, size_t woff, int ldb, const int* te, const EP& ep, int vcu, int G) {
    int tid = threadIdx.x; asm volatile("" : "+v"(tid)); asm volatile("" : "+s"(vcu)); const int wid = tid >> 6, lane = tid & 63, wr = wid >> 2, wc = wid & 3, fr = lane & 15, fq = lane >> 4;
    const int nunits = mtiles * ntiles;
    for (int u = vcu; u < nunits; u += G) {
        const int pm = u / ntiles, pn = u - pm * ntiles;
        const int row0 = pm * 128 + wr * 64, col0 = pn * 128 + wc * 32;
        const bf16* B = (const bf16*)(wbase + (size_t)te[pm >> 1] * MOE_E_STRIDE + woff);
        f32x4 acc[4][2];
#pragma unroll
        for (int m = 0; m < 4; ++m) { acc[m][0] = (f32x4){0.f, 0.f, 0.f, 0.f}; acc[m][1] = (f32x4){0.f, 0.f, 0.f, 0.f}; }
#pragma unroll 2
        for (int k = 0; k < K; k += 32) {
            bf16x8 a[4], b[2];
#pragma unroll
            for (int m = 0; m < 4; ++m) a[m] = *(const bf16x8*)af(0, row0 + m * 16 + fr, k + fq * 8);
#pragma unroll
            for (int n = 0; n < 2; ++n) b[n] = *(const bf16x8*)(B + (size_t)(col0 + n * 16 + fr) * ldb + k + fq * 8);
#pragma unroll
            for (int m = 0; m < 4; ++m)
#pragma unroll
                for (int n = 0; n < 2; ++n) acc[m][n] = __builtin_amdgcn_mfma_f32_16x16x32_bf16(b[n], a[m], acc[m][n], 0, 0, 0);
        }
#pragma unroll
        for (int m = 0; m < 4; ++m) ep(0, row0 + m * 16 + fr, col0 + 4 * fq, acc[m][0], acc[m][1]);
    }
}

__device__ __forceinline__ Frame mkframe(const Args& args, unsigned char* ldsp, int wv) {
    Frame F; F.lds = (LAS unsigned char*)ldsp;
    const int t = tid_of(wv); F.tid = t; F.lane = t & 63; F.wave = wv;
    int g = gridDim.x, bx = blockIdx.x; asm volatile("" : "+s"(g), "+s"(bx)); F.G = g; F.vcu = (g % 8 == 0) ? (bx % 8) * (g / 8) + bx / 8 : bx;
    unsigned char* w = args.ws; float* o = args.out; asm volatile("" : "+s"(w), "+s"(o)); F.ws = w; F.out = o; F.in = args.in;
    return F;
}
__global__ void __launch_bounds__(NTHR, 2) mega(Args args) {
    extern __shared__ __attribute__((aligned(16))) unsigned char lds[];
    volatile LAS unsigned* MISC = (volatile LAS unsigned*)((LAS unsigned char*)lds + LDS_MISC);
    const int wv = __builtin_amdgcn_readfirstlane((int)threadIdx.x >> 6);
    if (threadIdx.x < 16) MISC[threadIdx.x] = 0u;
    __syncthreads();
    XcdBarrier bar; bar.bar = (unsigned*)(args.ws + WS_CTL) + 4096; bar.x = 0; bar.st = nullptr; bar.wv = wv;
    const int lo = args.ph_lo, hi = args.ph_hi;
    if (hi - lo > 1) bar = xcd_barrier_post((unsigned*)(args.ws + WS_CTL) + 4096, MISC + 8, wv);
#define IN(k) (lo <= (k) && (k) < hi)
#define SEAM(k) do { if (IN(k) && IN((k) + 1)) xcd_barrier(bar); } while (0)
#define PHF Frame F = mkframe(args, lds, wv); const int bxi = (int)blockIdx.x; (void)bxi
#define P_MOD (WSP(float, WS_MOD) + (size_t)l * 17 * 6144)
#define P_HM WSP(bf16, WS_HMOD)
#define P_PT WSP(bf16, WS_PT)
#define P_BUFA WSP(float, WS_BUFA)
#define P_E ((float*)((unsigned char*)F.out + DO_E))
#define P_HS ((bf16*)((unsigned char*)F.out + DO_HS))
#define P_YS ((bf16*)((unsigned char*)F.out + DO_YS))

    if (IN(PH_P0)) { PHF; p0_prologue(F); } SEAM(PH_P0);
    if (IN(PH_P1)) { PHF; for (int it = F.vcu; it < 2 * 1632; it += F.G) p1_item(F, it); } SEAM(PH_P1);

#pragma unroll 1
    for (int l = 0; l < 2; ++l) {
        const int pb = PH_L + l * PH_PER;
        if (IN(pb + S_NORM1)) { PHF; const float* xlat = l == 0 ? F.in[0] : P_BUFA; const float* xctx = l == 0 ? F.in[2] : P_BUFA + (size_t)NL * D;
            norm_rows(F, xlat, xctx, MT, F.in[6] + l * D, P_MOD, 0, 1024, P_HM); }
        SEAM(pb + S_NORM1);
        if (IN(pb + S_G1)) { PHF; E_PT ep{P_PT};
            g8::OpRow<true> oa{(const char*)(WSP(bf16, WS_WIN) + (size_t)l * PTROWS * D), D * 2, 0}; g8::OpRow<false> ob{(const char*)P_HM, D * 2, 0}; g8::Order S; S.init(1, PTROWS / 256, MT / 256, F.G, bxi);
            g8::gemm8(F.lds, F.wave, D / 64, oa, ob, S, ep); }
        SEAM(pb + S_G1);
        if (IN(pb + S_FNET)) { PHF;
            { g8::OpRow<true> oa{(const char*)WSP(bf16, WS_DFT), 2 * L * 2, 0}; g8::OpFnetB ob{(const char*)P_PT, L * 2, 6}; g8::Order S; S.init(NB, L / 256, 1, F.G, bxi);
              E_Fnet ep{P_HM, 0, L}; g8::gemm8(F.lds, F.wave, 2 * L / 64, oa, ob, S, ep); }
            if (l == 0) { g8::OpRow<true> oa{(const char*)WSP(bf16, WS_DFTC), 2 * LC * 2, 0}; g8::OpFnetB ob{(const char*)(P_PT + NL), LC * 2, 2}; g8::Order S; S.init(NB, 1, 1, F.G, bxi);
              E_Fnet ep{P_HM, NL, LC}; g8::gemm8(F.lds, F.wave, 2 * LC / 64, oa, ob, S, ep); } }
        SEAM(pb + S_FNET);
        if (IN(pb + S_HY1)) { PHF; hyena_stage(F, l, 0); }
        SEAM(pb + S_HY1);
        if (IN(pb + S_S5E)) { PHF; E_S5E ep{P_E};
            g8::OpS5A oa{(const char*)(P_PT + (size_t)R_S5 * MT), (const char*)P_HS - (const char*)(P_PT + (size_t)R_S5 * MT)}; g8::OpRow<false> ob{(const char*)(F.ws + WS_S5M + (size_t)l * 24 * S5M_STRIDE), 256 * 2, (long)S5M_STRIDE};
            g8::Order S; S.init(24, NCHUNK / 256, 1, F.G, bxi); g8::gemm8(F.lds, F.wave, 4, oa, ob, S, ep); }
        SEAM(pb + S_S5E);
        if (IN(pb + S_CARRY)) { PHF; s5_carry(F, l); }
        SEAM(pb + S_CARRY);
        if (IN(pb + S_HY2)) { PHF; hyena_stage(F, l, 1); }
        SEAM(pb + S_HY2);
        if (IN(pb + S_S5O)) { PHF; E_S5O ep{P_YS};
            g8::OpS5A oa{(const char*)(P_PT + (size_t)R_S5 * MT), (const char*)P_HS - (const char*)(P_PT + (size_t)R_S5 * MT)}; g8::OpRow<false> ob{(const char*)(F.ws + WS_S5M + (size_t)l * 24 * S5M_STRIDE) + 256 * 256 * 2, 512 * 2, (long)S5M_STRIDE};
            g8::Order S; S.init(24, NCHUNK / 256, 1, F.G, bxi); g8::gemm8(F.lds, F.wave, 8, oa, ob, S, ep); }
        SEAM(pb + S_S5O);
        if (IN(pb + S_GLU)) { PHF; E_Glu ep{P_YS, P_HM, F.in[30] + l * 384};
            g8::OpRow<true> oa{(const char*)P_YS, 384 * 2, 0}; g8::OpRow<false> ob{(const char*)(WSP(bf16, WS_GLU) + (size_t)l * 512 * 384), 384 * 2, 0}; g8::Order S; S.init(1, MT / 256, 2, F.G, bxi);
            g8::gemm8(F.lds, F.wave, 6, oa, ob, S, ep); }
        SEAM(pb + S_GLU);
        if (IN(pb + S_HYT)) { PHF; hyena_transpose(F, l == 0 ? MT : NL); }
        SEAM(pb + S_HYT);
        if (IN(pb + S_WOUT)) { PHF; const float* xlat = l == 0 ? F.in[0] : P_BUFA; const float* xctx = l == 0 ? F.in[2] : P_BUFA + (size_t)NL * D;
            E_Res ep{xlat, xctx, l == 0 ? P_BUFA : F.out, P_MOD, 2048};
            g8::OpRow<true> oa{(const char*)P_HM, D * 2, 0}; g8::OpRow<false> ob{(const char*)(WSP(bf16, WS_WOUT) + (size_t)l * D * D), D * 2, 0}; g8::Order S; S.init(1, (l == 0 ? MT : NL) / 256, D / 256, F.G, bxi);
            g8::gemm8(F.lds, F.wave, D / 64, oa, ob, S, ep); }
        SEAM(pb + S_WOUT);
        if (l == 0) {
            if (IN(pb + S_NORM2)) { PHF; norm_rows(F, P_BUFA, P_BUFA + (size_t)NL * D, MT, F.in[7], P_MOD, 3072, 4096, P_HM); }
            SEAM(pb + S_NORM2);
            if (IN(pb + S_F0)) { PHF; E_Swi ep{WSP(bf16, WS_ACT), DFF};
                g8::OpRow<true> oa{(const char*)P_HM, D * 2, 0}; g8::OpRow<false> ob{(const char*)WSP(bf16, WS_FGU), D * 2, 0}; g8::Order S; S.init(1, MT / 256, 2 * DFF / 256, F.G, bxi);
                g8::gemm8(F.lds, F.wave, D / 64, oa, ob, S, ep); }
            SEAM(pb + S_F0);
            if (IN(pb + S_F1)) { PHF; E_Res ep{P_BUFA, P_BUFA + (size_t)NL * D, P_BUFA, P_MOD, 5120};
                g8::OpRow<true> oa{(const char*)WSP(bf16, WS_ACT), DFF * 2, 0}; g8::OpRow<false> ob{(const char*)WSP(bf16, WS_FD), DFF * 2, 0}; g8::Order S; S.init(1, MT / 256, D / 256, F.G, bxi);
                g8::gemm8(F.lds, F.wave, DFF / 64, oa, ob, S, ep); }
            SEAM(pb + S_F1);
        } else {
            if (IN(pb + S_NORM2)) { PHF; norm2_router(F, F.out, F.in[7] + D, P_MOD, P_HM); moe_transposes(F); }
            SEAM(pb + S_NORM2);
            if (IN(pb + S_F0)) { PHF; moe_slots(F); }
            SEAM(pb + S_F0);
#pragma unroll 1
            for (int k = 0; k < 2; ++k) {
                if (IN(pb + S_F1 + 2 * k)) { PHF; const int* IDX = (const int*)(F.ws + WS_META + META_IDX) + k * MAXSLOT; const int* TE = (const int*)(F.ws + WS_META + META_TE) + k * 272; const int nt = __builtin_amdgcn_readfirstlane(((const int*)(F.ws + WS_META + META_NT))[k]);
                    E_Swi ep{WSP(bf16, WS_ACT2), DFE};
                    g8::OpMoeA oa{(const char*)P_HM, IDX}; g8::OpMoeB ob{(const char*)(F.ws + WS_MOEW), TE, D * 2}; g8::Order S; S.init(1, nt, 2 * DFE / 256, F.G, bxi);
                    g8::gemm8(F.lds, F.wave, D / 64, oa, ob, S, ep); }
                SEAM(pb + S_F1 + 2 * k);
                if (IN(pb + S_F2 + 2 * k)) { PHF; const int* IDX = (const int*)(F.ws + WS_META + META_IDX) + k * MAXSLOT; const int* TE = (const int*)(F.ws + WS_META + META_TE) + k * 272; const int nt = __builtin_amdgcn_readfirstlane(((const int*)(F.ws + WS_META + META_NT))[k]);
                    E_MoeDown ep{F.out, IDX, F.ws + WS_TOPK, P_MOD, k};
                    g8::OpRow<true> oa{(const char*)WSP(bf16, WS_ACT2), DFE * 2, 0}; g8::OpMoeB ob{(const char*)(F.ws + WS_MOEW + MOE_GU_BYTES), TE, DFE * 2}; g8::Order S; S.init(1, nt, D / 256, F.G, bxi);
                    g8::gemm8(F.lds, F.wave, DFE / 64, oa, ob, S, ep); }
                SEAM(pb + S_F2 + 2 * k);
            }
            if (IN(pb + S_F5)) { PHF; final_norm(F); }
        }
    }
#undef IN
#undef SEAM
}

extern "C" void kernel_launch(void* const* d_in, const int* in_sizes, int n_in, void* d_out, int out_size, void* d_ws, size_t ws_size, hipStream_t stream) {
    static int grid = 0;
    if (grid == 0) {
        if (n_in != 40 || out_size != NL * D || ws_size < WS_END) { fprintf(stderr, "kernel_launch: unexpected shapes n_in %d out %d ws %zu (need %zu)\n", n_in, out_size, ws_size, (size_t)WS_END); grid = -1; return; }
        int dev = 0, cus = 0, per_cu = 0;
        if (hipGetDevice(&dev) != hipSuccess || hipDeviceGetAttribute(&cus, hipDeviceAttributeMultiprocessorCount, dev) != hipSuccess) { grid = -1; return; }
        if (hipFuncSetAttribute((const void*)mega, hipFuncAttributeMaxDynamicSharedMemorySize, LDS_BYTES) != hipSuccess) { fprintf(stderr, "kernel_launch: hipFuncSetAttribute failed\n"); grid = -1; return; }
        if (hipOccupancyMaxActiveBlocksPerMultiprocessor(&per_cu, (const void*)mega, NTHR, LDS_BYTES) != hipSuccess || per_cu < 1) fprintf(stderr, "kernel_launch: occupancy query says %d\n", per_cu);
        (void)hipGetLastError();
        grid = cus;
    }
    if (grid < 0) return;
    (void)hipMemsetAsync((char*)d_ws + WS_CTL, 0, CTL_ZERO_BYTES, stream);
    Args a{};
    for (int i = 0; i < 40; ++i) a.in[i] = (const float*)d_in[i];
    a.out = (float*)d_out; a.ws = (unsigned char*)d_ws;
#if MK_ONE_LAUNCH
    a.ph_lo = 0; a.ph_hi = N_PHASES;
    hipLaunchKernelGGL(mega, dim3(grid), dim3(NTHR), LDS_BYTES, stream, a);
#else
    for (int ph = 0; ph < N_PHASES; ++ph) {
        const int s = ph - PH_L;
        if (ph >= PH_L && s < PH_PER && s > S_F1) continue;
        if (ph >= PH_L + PH_PER && (ph - PH_L - PH_PER) > S_F5) continue;
        a.ph_lo = ph; a.ph_hi = ph + 1;
        hipLaunchKernelGGL(mega, dim3(grid), dim3(NTHR), LDS_BYTES, stream, a);
    }
#endif
}
```

```cpp
#include <hip/hip_runtime.h>
#include <cstdio>
#include <cstdint>

#ifndef G8_ALL
#define G8_ALL 1
#endif
#define G8_G1 G8_ALL
#define G8_FNET G8_ALL
#define G8_S5 G8_ALL
#define G8_GLU G8_ALL
#define G8_WOUT G8_ALL
#define G8_FFN G8_ALL
#define G8_MOE G8_ALL
#ifndef UP_ALIGN
#define UP_ALIGN false
#endif
#ifndef STAG_ON
#define STAG_ON 0
#endif
#define STAG(x) (STAG_ON ? (x) : 0)
#ifndef MK_ONE_LAUNCH
#define MK_ONE_LAUNCH 1
#endif

#define LAS __attribute__((address_space(3)))
typedef unsigned short bf16;
typedef short bf16x8 __attribute__((ext_vector_type(8)));
typedef float f32x4 __attribute__((ext_vector_type(4)));
typedef float f32x2 __attribute__((ext_vector_type(2)));
typedef unsigned v4u __attribute__((ext_vector_type(4)));
typedef unsigned v2u __attribute__((ext_vector_type(2)));

constexpr int D = 1024, NB = 16, L = 4096, LC = 256, NL = NB * L, NCX = NB * LC, MT = NL + NCX;
constexpr int DIN = 1792, DFF = 2816, NE = 8, DFE = 3584;
constexpr int PTROWS = 2048, R_HY = 512, R_S5 = 1664;
constexpr int NCHUNK = MT / 16;
constexpr int NTHR = 512, NWAVES = 8;
constexpr int MAXSLOT = NL + NE * 256;

constexpr size_t MiB = 1u << 20;
constexpr size_t WS_CTL = 0, CTL_ZERO_BYTES = 1 * MiB;
constexpr size_t WS_MOD = 1 * MiB;
constexpr size_t WS_WIN = 2 * MiB;
constexpr size_t WS_WOUT = 10 * MiB;
constexpr size_t WS_GLU = 14 * MiB;
constexpr size_t WS_FGU = 15 * MiB;
constexpr size_t WS_FD = 26 * MiB;
constexpr size_t WS_FAW = 32 * MiB;
constexpr size_t WS_FBW = 33 * MiB;
constexpr size_t WS_DFTC = 96 * MiB;
constexpr size_t WS_S5M = 97 * MiB;
constexpr size_t S5M_STRIDE = 256 * 256 * 2 + 256 * 512 * 2;
constexpr size_t WS_A16 = 115 * MiB;
constexpr size_t WS_KT = 116 * MiB;
constexpr size_t WS_KTC = 164 * MiB;
constexpr size_t WS_PS = 167 * MiB;
constexpr size_t WS_TOPK = 171 * MiB;
constexpr size_t WS_META = 172 * MiB;
constexpr size_t META_CNT = 0, META_IDX = 64 * 1024, META_TE = META_IDX + 2 * MAXSLOT * 4, META_NT = META_TE + 2 * 272 * 4, META_SL1 = 768 * 1024;
static_assert(META_NT + 8 <= META_SL1 && META_SL1 + (size_t)NL * 4 <= MiB, "meta");
constexpr size_t WS_HMOD = 173 * MiB;
constexpr size_t WS_BUFA = 309 * MiB;
constexpr size_t WS_R = 581 * MiB;
constexpr size_t WS_END = 1024 * MiB;
constexpr size_t WS_PT = WS_R;
constexpr size_t WS_HT = WS_R;
constexpr size_t WS_Z1 = WS_R + 272 * MiB;
constexpr size_t WS_ABUF = WS_R + 374 * MiB;
static_assert(WS_ABUF + (size_t)16 * 256 * 64 * 128 * 2 <= WS_END, "abuf");
constexpr size_t WS_VP = WS_R + 323 * MiB;
static_assert(WS_VP + (size_t)384 * MT * 2 <= WS_END, "vp");
constexpr size_t WS_ACT = WS_R;
constexpr size_t WS_MOEW = WS_BUFA;
constexpr size_t MOE_GU_BYTES = (size_t)2 * DFE * D * 2, MOE_D_BYTES = (size_t)D * DFE * 2, MOE_E_STRIDE = MOE_GU_BYTES + MOE_D_BYTES;
constexpr size_t WS_ACT2 = WS_BUFA + 168 * MiB;
static_assert(NE * MOE_E_STRIDE <= 168 * MiB, "moe weights");
static_assert(WS_ACT2 + (size_t)MAXSLOT * DFE * 2 <= WS_END, "act2");
static_assert(WS_PT + (size_t)PTROWS * MT * 2 <= WS_END, "pt");
static_assert(WS_ACT + (size_t)MT * DFF * 2 <= WS_END, "act");
static_assert(WS_HMOD + (size_t)MT * D * 2 <= WS_BUFA && WS_BUFA + (size_t)MT * D * 4 <= WS_R, "bufs");
constexpr size_t DO_E = 0, DO_HS = 102 * MiB, DO_YS = 153 * MiB;
static_assert(DO_YS + (size_t)MT * 384 * 2 <= (size_t)NL * D * 4, "d_out scratch");

constexpr int LDS_BYTES = 147456;
constexpr int LDS_MISC = 131072 + 8192;

__device__ __forceinline__ unsigned f2bf(float f) { unsigned u = __builtin_bit_cast(unsigned, f); return (u + 0x7fffu + ((u >> 16) & 1u)) >> 16; }
__device__ __forceinline__ unsigned pk2(float lo, float hi) { unsigned r; asm("v_cvt_pk_bf16_f32 %0, %1, %2" : "=v"(r) : "v"(lo), "v"(hi)); return r; }
__device__ __forceinline__ float bf2f(unsigned short b) { return __builtin_bit_cast(float, ((unsigned)b) << 16); }
__device__ __forceinline__ float wave_sum(float v, int lane) {
#pragma unroll
    for (int o = 1; o < 64; o <<= 1) v += __builtin_bit_cast(float, __builtin_amdgcn_ds_bpermute((lane ^ o) << 2, __builtin_bit_cast(int, v)));
    return v;
}
__device__ __forceinline__ float silu_f(float x) { return x * __builtin_amdgcn_rcpf(1.0f + __expf(-x)); }
__device__ __forceinline__ float sigmoid_f(float x) { return __builtin_amdgcn_rcpf(1.0f + __expf(-x)); }
__device__ __forceinline__ float gelu_tanh_f(float x) { const float u = 0.7978845608028654f * (x + 0.044715f * x * x * x); return x * __builtin_amdgcn_rcpf(1.0f + __expf(-2.0f * u)); }
__device__ __forceinline__ int bidx_of(int r) { return r < NL ? (r >> 12) : 16; }

__device__ __forceinline__ int lane_id() { return (int)__builtin_amdgcn_mbcnt_hi(~0u, __builtin_amdgcn_mbcnt_lo(~0u, 0u)); }
__device__ __forceinline__ int tid_of(int wv) { int t = (wv << 6) | lane_id(); asm volatile("" : "+v"(t)); return t; }
#define XB_TMO      128
#define XB_XCNT(j)  (256  + 64 * (j))
#define XB_XSUB(j)  (1280 + 64 * (j))
#define XB_XGEN(j)  (2304 + 64 * (j))
#define XB_TOP      3328
#define XB_TOPGEN   3392
#define XCD_BAR_WORDS 3456
#define XB_SPIN_CAP (1u << 22)
__device__ __forceinline__ unsigned xb_ld(unsigned* p)              { return __hip_atomic_load(p, __ATOMIC_RELAXED, __HIP_MEMORY_SCOPE_AGENT); }
__device__ __forceinline__ unsigned xb_add(unsigned* p, unsigned v) { return __hip_atomic_fetch_add(p, v, __ATOMIC_RELAXED, __HIP_MEMORY_SCOPE_AGENT); }
__device__ __forceinline__ unsigned xb_xcc_id() { return (unsigned)__builtin_amdgcn_s_getreg((3 << 11) | 20) & 0xFu; }
#define XB_SPIN(cond, bar) do { unsigned _sp = 0; while (cond) { __builtin_amdgcn_s_sleep(1); \
    if ((++_sp & 255u) == 0u) { if (xb_ld(&(bar)[XB_TMO])) break; if (_sp > XB_SPIN_CAP) { atomicAdd(&(bar)[XB_TMO], 1u); break; } } } } while (0)
struct XcdBarrier { unsigned* bar; unsigned x; volatile LAS unsigned* st; int wv; };
__device__ __forceinline__ XcdBarrier xcd_barrier_post(unsigned* bar, volatile LAS unsigned* st, int wv) {
    XcdBarrier b; b.bar = bar; b.x = xb_xcc_id(); b.st = st; b.wv = wv;
    if (wv == 0 && lane_id() == 0) (void)xb_add(&bar[XB_XCNT(b.x)], 1u);
    return b;
}
__device__ __forceinline__ void xcd_barrier_complete(unsigned* bar, unsigned x, unsigned& nloc, unsigned& nx) {
    const unsigned G = gridDim.x * gridDim.y * gridDim.z;
    unsigned sum, cnt, mine, sp = 0u;
    for (;;) {
        sum = 0u; cnt = 0u; mine = 0u;
#pragma unroll
        for (unsigned j = 0; j < 16; ++j) { const unsigned c = xb_ld(&bar[XB_XCNT(j)]); sum += c; cnt += (c > 0u) ? 1u : 0u; mine = (j == x) ? c : mine; }
        if (sum == G) break;
        __builtin_amdgcn_s_sleep(1);
        if ((++sp & 255u) == 0u) { if (xb_ld(&bar[XB_TMO])) break; if (sp > XB_SPIN_CAP) { atomicAdd(&bar[XB_TMO], 1u); break; } }
    }
    nloc = mine > 0u ? mine : 1u; nx = cnt > 0u ? cnt : 1u;
}
__device__ __noinline__ void xcd_barrier(const XcdBarrier b) {
    asm volatile("s_waitcnt vmcnt(0)" ::: "memory");
    __syncthreads();
    if (b.wv == 0 && lane_id() == 0) {
        unsigned* bar = b.bar;
        __builtin_amdgcn_s_waitcnt(0);
        unsigned nloc = b.st[0], nx = b.st[1];
        if (nloc == 0u) { xcd_barrier_complete(bar, b.x, nloc, nx); b.st[0] = nloc; b.st[1] = nx; }
        const unsigned old = xb_add(&bar[XB_XSUB(b.x)], 1u);
        const unsigned gen = old / nloc;
        if (old + 1u == (gen + 1u) * nloc) {
            __builtin_amdgcn_fence(__ATOMIC_RELEASE, "agent");
            asm volatile("s_waitcnt vmcnt(0)" ::: "memory");
            const unsigned og = xb_add(&bar[XB_TOP], 1u);
            const unsigned tg = og / nx;
            if (og + 1u == (tg + 1u) * nx) xb_add(&bar[XB_TOPGEN], 1u);
            else XB_SPIN(xb_ld(&bar[XB_TOPGEN]) == tg, bar);
            __builtin_amdgcn_fence(__ATOMIC_ACQUIRE, "agent");
            xb_add(&bar[XB_XGEN(b.x)], 1u);
            asm volatile("s_waitcnt vmcnt(0)" ::: "memory");
        } else {
            XB_SPIN(xb_ld(&bar[XB_XGEN(b.x)]) == gen, bar);
            __builtin_amdgcn_fence(__ATOMIC_ACQUIRE, "agent");
            asm volatile("s_waitcnt vmcnt(0)" ::: "memory");
        }
    }
    __syncthreads();
}

__device__ __forceinline__ size_t tiled_idx(int r, int k, int KT) { return ((size_t)(r >> 8) * KT + (k >> 6)) * 16384 + (size_t)(r & 255) * 64 + (k & 63); }
template <class AF, class BF, class EP>
__device__ __forceinline__ void gemm_simple(int nbatch, int mtiles, int ntiles, int K, const AF& af, const BF& bf, const EP& ep, int vcu, int G) {
    int tid = threadIdx.x; asm volatile("" : "+v"(tid)); asm volatile("" : "+s"(vcu)); const int wid = tid >> 6, lane = tid & 63, wr = wid >> 2, wc = wid & 3, fr = lane & 15, fq = lane >> 4;
    const int per = mtiles * ntiles, nunits = nbatch * per;
    for (int u = vcu; u < nunits; u += G) {
        const int bt = u / per, rem = u - bt * per, pm = rem / ntiles, pn = rem - pm * ntiles;
        const int row0 = pm * 128 + wr * 64, col0 = pn * 128 + wc * 32;
        f32x4 acc[4][2];
#pragma unroll
        for (int m = 0; m < 4; ++m) { acc[m][0] = (f32x4){0.f, 0.f, 0.f, 0.f}; acc[m][1] = (f32x4){0.f, 0.f, 0.f, 0.f}; }
#pragma unroll 2
        for (int k = 0; k < K; k += 32) {
            bf16x8 a[4], b[2];
#pragma unroll
            for (int m = 0; m < 4; ++m) a[m] = *(const bf16x8*)af(bt, row0 + m * 16 + fr, k + fq * 8);
#pragma unroll
            for (int n = 0; n < 2; ++n) b[n] = *(const bf16x8*)bf(bt, col0 + n * 16 + fr, k + fq * 8);
#pragma unroll
            for (int m = 0; m < 4; ++m)
#pragma unroll
                for (int n = 0; n < 2; ++n) acc[m][n] = __builtin_amdgcn_mfma_f32_16x16x32_bf16(b[n], a[m], acc[m][n], 0, 0, 0);
        }
#pragma unroll
        for (int m = 0; m < 4; ++m) ep(bt, row0 + m * 16 + fr, col0 + 4 * fq, acc[m][0], acc[m][1]);
    }
}
struct RowMajor { const bf16* p; long ld; __device__ __forceinline__ const bf16* operator()(int, int r, int k) const { return p + (long)r * ld + k; } };

namespace g8 {
constexpr int BM = 256, BK = 64, HALF = 128, HTB = HALF * BK * 2, NXCD = 8, WGM = 8;
__device__ __forceinline__ int lds_byte(int r, int c) { const int st = (r >> 4) * 2 + (c >> 5), rr = r & 15, cc = c & 31, ob = rr * 64 + cc * 2; return st * 1024 + (ob ^ (((ob >> 9) & 1) << 5)); }
__device__ __forceinline__ void stage_rc(int b, int& R, int& C) { const int st = b / 1024, sb = b % 1024, swz = sb ^ (((sb >> 9) & 1) << 5); R = (st >> 1) * 16 + swz / 64; C = (st & 1) * 32 + (swz % 64) / 2; }
struct Unit { int bt, pm, pn; };
struct Order {
    int nM, nN, per, nwg, G, c, pm_off;
    __device__ __forceinline__ void init(int nb, int nM_, int nN_, int G_, int c_, int rot = 0) { nM = nM_; nN = nN_; per = nM_ * nN_; nwg = nb * per; G = G_; c = c_ - rot; if (c < 0) c += G_; pm_off = 0; }
    __device__ __forceinline__ bool next(int i, Unit& u) const {
        const long Lx = (long)i * G + c; if (Lx >= nwg) return false;
        int wgid = (int)Lx; { const int q = nwg / NXCD, r = nwg % NXCD, xcd = wgid % NXCD, off = wgid / NXCD; wgid = (xcd < r ? xcd * (q + 1) : r * (q + 1) + (xcd - r) * q) + off; }
        u.bt = wgid / per; const int rem = wgid - u.bt * per;
        const int nig = WGM * nN, gid = rem / nig, fm = gid * WGM, gsz = (nM - fm) < WGM ? (nM - fm) : WGM;
        u.pm = pm_off + fm + ((rem % nig) % gsz); u.pn = (rem % nig) / gsz; return true;
    }
};
template <bool ISA> struct OpRow {
    static constexpr bool GATHER = false;
    const char* p; long ld2; long bstride;
    __device__ __forceinline__ unsigned off(int R, int C) const { return (unsigned)(R * (int)ld2 + C * 2); }
    __device__ __forceinline__ const char* base(const Unit& u) const { return p + (long)u.bt * bstride + (long)(ISA ? u.pm : u.pn) * 256 * ld2; }
    __device__ __forceinline__ long koff(int t) const { return (long)t * 128; }
    __device__ __forceinline__ long hstep() const { return 128 * ld2; }
};
template <bool ISA> struct OpTiled {
    static constexpr bool GATHER = false;
    const char* p; int KT;
    __device__ __forceinline__ unsigned off(int R, int C) const { return (unsigned)(R * 128 + C * 2); }
    __device__ __forceinline__ const char* base(const Unit& u) const { return p + (long)(ISA ? u.pm : u.pn) * KT * 32768; }
    __device__ __forceinline__ long koff(int t) const { return (long)t * 32768; }
    __device__ __forceinline__ long hstep() const { return 16384; }
};
struct OpMoeBT {
    static constexpr bool GATHER = false;
    const char* w; const LAS int* te; int KT;
    __device__ __forceinline__ unsigned off(int R, int C) const { return (unsigned)(R * 128 + C * 2); }
    __device__ __forceinline__ const char* base(const Unit& u) const { return w + (long)__builtin_amdgcn_readfirstlane(te[u.pm]) * (long)MOE_E_STRIDE + (long)u.pn * KT * 32768; }
    __device__ __forceinline__ long koff(int t) const { return (long)t * 32768; }
    __device__ __forceinline__ long hstep() const { return 16384; }
};
struct OpS5A {
    static constexpr bool GATHER = false;
    const char* ptb; long delta;
    __device__ __forceinline__ unsigned off(int R, int C) const { return (unsigned)((C >> 4) * (MT * 2) + R * 32 + (C & 15) * 2); }
    __device__ __forceinline__ const char* base(const Unit& u) const { return ptb + ((long)u.bt * 16 * MT + (long)u.pm * 4096) * 2; }
    __device__ __forceinline__ long koff(int t) const { return t < 4 ? (long)t * 4 * MT * 2 : delta + (long)(t - 4) * 4 * MT * 2; }
    __device__ __forceinline__ long hstep() const { return 4096; }
};
struct OpFnetB {
    static constexpr bool GATHER = false;
    const char* p; int seq2; int sh;
    __device__ __forceinline__ unsigned off(int R, int C) const { return (unsigned)(R * (MT * 2) + C * 2); }
    __device__ __forceinline__ const char* base(const Unit& u) const { return p + (long)u.bt * seq2 + (long)u.pn * 256 * MT * 2; }
    __device__ __forceinline__ long koff(int t) const { return (long)(t >> sh) * 256 * MT * 2 + (long)(t & ((1 << sh) - 1)) * 128; }
    __device__ __forceinline__ long hstep() const { return (long)128 * MT * 2; }
};
struct OpPermB {
    static constexpr bool GATHER = false;
    const char* p;
    __device__ __forceinline__ unsigned off(int R, int C) const { return (unsigned)((64 * (R & 63) + (R >> 6)) * 2048 + C * 2); }
    __device__ __forceinline__ const char* base(const Unit& u) const { return p + ((long)(u.pn >> 4) * 4096 + (long)(u.pn & 15) * 4) * 2048; }
    __device__ __forceinline__ long koff(int t) const { return (long)t * 128; }
    __device__ __forceinline__ long hstep() const { return 2 * 2048; }
};
struct OpFA {
    static constexpr bool GATHER = false;
    const char* p;
    __device__ __forceinline__ unsigned off(int R, int C) const { return (unsigned)((R >> 6) * (MT * 2) + (R & 63) * 128 + C * 2); }
    __device__ __forceinline__ const char* base(const Unit& u) const { return p + (long)(u.pn & 63) * 4 * MT * 2 + (long)(u.pn >> 6) * 4096 * 2; }
    __device__ __forceinline__ long koff(int t) const { return (long)t * 256 * MT * 2; }
    __device__ __forceinline__ long hstep() const { return (long)2 * MT * 2; }
};
struct OpFB {
    static constexpr bool GATHER = false;
    const char* p;
    __device__ __forceinline__ unsigned off(int R, int C) const { return (unsigned)(R * 16384 + C * 2); }
    __device__ __forceinline__ const char* base(const Unit& u) const { return p + (long)u.bt * 256 * 16384 + (long)u.pm * 1024; }
    __device__ __forceinline__ long koff(int t) const { return (long)t * 128; }
    __device__ __forceinline__ long hstep() const { return (long)128 * 16384; }
};
struct OpMoeA {
    static constexpr bool GATHER = true;
    const char* h; const int* idx;
    __device__ __forceinline__ unsigned off(int, int) const { return 0u; }
    __device__ __forceinline__ unsigned goff(const Unit& u, int R, int C) const { int t = idx[u.pm * 256 + R]; t = t < 0 ? 0 : t; return (unsigned)t * 2048u + (unsigned)C * 2u; }
    __device__ __forceinline__ const char* base(const Unit&) const { return h; }
    __device__ __forceinline__ long koff(int t) const { return (long)t * 128; }
    __device__ __forceinline__ long hstep() const { return 0; }
};
struct OpMoeB {
    static constexpr bool GATHER = false;
    const char* w; const LAS int* te; long ld2;
    __device__ __forceinline__ unsigned off(int R, int C) const { return (unsigned)(R * (int)ld2 + C * 2); }
    __device__ __forceinline__ const char* base(const Unit& u) const { return w + (long)__builtin_amdgcn_readfirstlane(te[u.pm]) * (long)MOE_E_STRIDE + (long)u.pn * 256 * ld2; }
    __device__ __forceinline__ long koff(int t) const { return (long)t * 128; }
    __device__ __forceinline__ long hstep() const { return 128 * ld2; }
};

template <class T, class = void> struct IsRmw { static constexpr bool value = false; };
template <class T> struct IsRmw<T, decltype((void)sizeof(typename T::Pre))> { static constexpr bool value = true; };
template <bool ALIGN = true, class OA, class OB, class Epi>
__device__ __forceinline__ void gemm8(LAS unsigned char* lds, const int wv, const int nt, const OA& oa, const OB& ob, const Order& S, const Epi& E, const int stag = 0) {
    if (stag > 0) {
        const unsigned long long t0 = __builtin_amdgcn_s_memrealtime(), want = (unsigned long long)(((S.c >> 3) & 3) * stag);
        while (__builtin_amdgcn_s_memrealtime() - t0 < want) __builtin_amdgcn_s_sleep(4); }
    const int tid = tid_of(wv);
    const int wid = __builtin_amdgcn_readfirstlane(tid >> 6), lane = tid & 63, wr = wid >> 2, wc = wid & 3, fr = lane & 15, fq = lane >> 4;
    unsigned voffA[2][2], voffB[2];
#pragma unroll
    for (int i = 0; i < 2; ++i) { int R_, C_; stage_rc(tid * 16 + i * 8192, R_, C_); voffB[i] = ob.off(R_, C_); voffA[0][i] = oa.off(R_, C_); voffA[1][i] = 0u; }
    const long hA = oa.hstep(), hB = ob.hstep();
    const unsigned ldsw = (unsigned)wid * 1024u;
    const int aoff = lds_byte(wr * 64 + fr, fq * 8), boff = lds_byte(wc * 32 + fr, fq * 8);
#define G8_SA(b, h) (((b) * 2 + (h)) * HTB)
#define G8_SB(b, h) ((4 + (b) * 2 + (h)) * HTB)
#define G8_STAGE_B(bufoff, gbase) do { _Pragma("unroll") for (int _i = 0; _i < 2; ++_i) \
        __builtin_amdgcn_global_load_lds((const unsigned*)((const char*)(gbase) + voffB[_i]), (LAS unsigned*)(lds + (bufoff) + ldsw + _i * 8192), 16, 0, 0); } while (0)
#define G8_STAGE_A(bufoff, gbase, h) do { _Pragma("unroll") for (int _i = 0; _i < 2; ++_i) \
        __builtin_amdgcn_global_load_lds((const unsigned*)((const char*)(gbase) + (OA::GATHER ? 0 : (h) * hA) + voffA[OA::GATHER ? (h) : 0][_i]), (LAS unsigned*)(lds + (bufoff) + ldsw + _i * 8192), 16, 0, 0); } while (0)
#define G8_LDA(dst, b, h) do { _Pragma("unroll") for (int m = 0; m < 4; ++m) _Pragma("unroll") for (int k = 0; k < 2; ++k) dst[m][k] = *(const LAS bf16x8*)(lds + G8_SA(b, h) + aoff + m * 2048 + k * 1024); } while (0)
#define G8_LDB(dst, b, h) do { _Pragma("unroll") for (int n = 0; n < 2; ++n) _Pragma("unroll") for (int k = 0; k < 2; ++k) dst[n][k] = *(const LAS bf16x8*)(lds + G8_SB(b, h) + boff + n * 2048 + k * 1024); } while (0)
#define G8_MMA(ai, bj, At, Bt) do { __builtin_amdgcn_s_setprio(1); _Pragma("unroll") for (int m = 0; m < 4; ++m) _Pragma("unroll") for (int n = 0; n < 2; ++n) _Pragma("unroll") for (int k = 0; k < 2; ++k) \
        acc[ai][bj][m][n] = __builtin_amdgcn_mfma_f32_16x16x32_bf16(Bt[n][k], At[m][k], acc[ai][bj][m][n], 0, 0, 0); __builtin_amdgcn_s_setprio(0); } while (0)
#define G8_WAIT_V(n) asm volatile("s_waitcnt vmcnt(" #n ")" ::: "memory")
#define G8_WAIT_L(n) asm volatile("s_waitcnt lgkmcnt(" #n ")" ::: "memory")
#define G8_BAR __builtin_amdgcn_s_barrier()
#define G8_SCHED __builtin_amdgcn_sched_barrier(0)
#define G8_GOFF(u) do { if constexpr (OA::GATHER) { const int _tz = tid_of(wv); _Pragma("unroll") for (int _i = 0; _i < 2; ++_i) { int _R, _C; stage_rc(_tz * 16 + _i * 8192, _R, _C); \
        _Pragma("unroll") for (int _h = 0; _h < 2; ++_h) voffA[_h][_i] = oa.goff(u, _R + 128 * _h, _C); } } } while (0)
    Unit cur, nxt; int ui = 0;
    if (!S.next(0, cur)) return;
    f32x4 acc[2][2][4][2];
#pragma unroll
    for (int a = 0; a < 2; ++a)
#pragma unroll
        for (int b = 0; b < 2; ++b)
#pragma unroll
            for (int m = 0; m < 4; ++m)
#pragma unroll
                for (int n = 0; n < 2; ++n) acc[a][b][m][n] = (f32x4){0.f, 0.f, 0.f, 0.f};
    bf16x8 At[4][2], B0[2][2], B1[2][2];
    const char* cA = oa.base(cur); const char* cB = ob.base(cur);
    asm volatile("" : "+s"(cA), "+s"(cB));
    G8_GOFF(cur);
    {   const long ka0 = oa.koff(0), ka1 = oa.koff(1), kb0 = ob.koff(0), kb1 = ob.koff(1);
        G8_STAGE_B(G8_SB(0, 0), cB + kb0); G8_STAGE_B(G8_SB(0, 1), cB + kb0 + hB); G8_STAGE_A(G8_SA(0, 0), cA + ka0, 0); G8_STAGE_A(G8_SA(0, 1), cA + ka0, 1);
        if (wr == 1) G8_BAR;
        G8_WAIT_V(2); G8_BAR;
        G8_STAGE_B(G8_SB(1, 0), cB + kb1); G8_STAGE_A(G8_SA(1, 0), cA + ka1, 0); G8_STAGE_B(G8_SB(1, 1), cB + kb1 + hB);
        G8_WAIT_V(6); G8_BAR; }
    for (;;) {
        const bool has_next = S.next(ui + 1, nxt);
        const char* nA = has_next ? oa.base(nxt) : cA; const char* nB = has_next ? ob.base(nxt) : cB;
        asm volatile("" : "+s"(nA), "+s"(nB));
        for (int t = 0; t < nt; t += 2) {
            const bool last = (t == nt - 2);
            const char* a1 = cA + oa.koff(t + 1);
            const char* a2 = last ? nA + oa.koff(0) : cA + oa.koff(t + 2); const char* b2 = last ? nB + ob.koff(0) : cB + ob.koff(t + 2);
            const char* a3 = last ? nA + oa.koff(1) : cA + oa.koff(t + 3); const char* b3 = last ? nB + ob.koff(1) : cB + ob.koff(t + 3);
            G8_LDB(B0, 0, 0); G8_LDB(B1, 0, 1); G8_SCHED; G8_LDA(At, 0, 0); G8_STAGE_A(G8_SA(1, 1), a1, 1);
            if (last && has_next && nxt.pm != cur.pm) G8_GOFF(nxt);
            G8_WAIT_V(8); G8_WAIT_L(0); G8_BAR; G8_MMA(0, 0, At, B0); G8_MMA(0, 1, At, B1); G8_BAR; G8_SCHED;
            G8_LDA(At, 0, 1); G8_STAGE_B(G8_SB(0, 0), b2); G8_STAGE_B(G8_SB(0, 1), b2 + hB); G8_STAGE_A(G8_SA(0, 0), a2, 0);
            G8_WAIT_V(8); G8_WAIT_L(0); G8_BAR; G8_MMA(1, 0, At, B0); G8_MMA(1, 1, At, B1); G8_BAR; G8_SCHED;
            G8_LDB(B0, 1, 0); G8_LDB(B1, 1, 1); G8_SCHED; G8_LDA(At, 1, 0); G8_STAGE_A(G8_SA(0, 1), a2, 1);
            G8_WAIT_V(8); G8_WAIT_L(0); G8_BAR; G8_MMA(0, 0, At, B0); G8_MMA(0, 1, At, B1); G8_BAR; G8_SCHED;
            G8_LDA(At, 1, 1); G8_STAGE_B(G8_SB(1, 0), b3); G8_STAGE_B(G8_SB(1, 1), b3 + hB); G8_STAGE_A(G8_SA(1, 0), a3, 0);
            G8_WAIT_V(8); G8_WAIT_L(0); G8_BAR; G8_MMA(1, 0, At, B0); G8_MMA(1, 1, At, B1); G8_BAR; G8_SCHED;
        }
        if (ALIGN) { if (wr == 0) G8_BAR; }
        {   const int tz = tid_of(wv); const int wz = tz >> 6, lz = tz & 63;
            const int row0 = cur.pm * BM + (wz >> 2) * 64 + (lz & 15), col0 = cur.pn * BM + (wz & 3) * 32 + 4 * (lz >> 4);
            if constexpr (IsRmw<Epi>::value) {
#pragma unroll
                for (int ai = 0; ai < 2; ++ai)
#pragma unroll
                    for (int mh = 0; mh < 4; mh += 2) { typename Epi::Pre pr[2][2];
#pragma unroll
                        for (int m2 = 0; m2 < 2; ++m2)
#pragma unroll
                            for (int bj = 0; bj < 2; ++bj) pr[m2][bj] = E.pre(cur.bt, row0 + ai * HALF + (mh + m2) * 16, col0 + bj * HALF);
#pragma unroll
                        for (int m2 = 0; m2 < 2; ++m2)
#pragma unroll
                            for (int bj = 0; bj < 2; ++bj) E.post(pr[m2][bj], cur.bt, row0 + ai * HALF + (mh + m2) * 16, col0 + bj * HALF, acc[ai][bj][mh + m2][0], acc[ai][bj][mh + m2][1]); }
            } else {
#pragma unroll
            for (int ai = 0; ai < 2; ++ai)
#pragma unroll
                for (int m = 0; m < 4; ++m)
#pragma unroll
                    for (int bj = 0; bj < 2; ++bj) E(cur.bt, row0 + ai * HALF + m * 16, col0 + bj * HALF, acc[ai][bj][m][0], acc[ai][bj][m][1]); } }
        if (!has_next) break;
#pragma unroll
        for (int a = 0; a < 2; ++a)
#pragma unroll
            for (int b = 0; b < 2; ++b)
#pragma unroll
                for (int m = 0; m < 4; ++m)
#pragma unroll
                    for (int n = 0; n < 2; ++n) acc[a][b][m][n] = (f32x4){0.f, 0.f, 0.f, 0.f};
        cur = nxt; cA = nA; cB = nB; ++ui;
        if (ALIGN) { if (wr == 1) G8_BAR; }
    }
    G8_WAIT_V(0);
    if (!ALIGN) { if (wr == 0) G8_BAR; }
    G8_BAR;
#undef G8_SA
#undef G8_SB
#undef G8_STAGE_A
#undef G8_STAGE_B
#undef G8_LDA
#undef G8_LDB
#undef G8_MMA
#undef G8_WAIT_V
#undef G8_WAIT_L
#undef G8_BAR
#undef G8_SCHED
#undef G8_GOFF
}
}

#ifndef PROBE_SEL
#define PROBE_SEL -1
#endif
#ifndef PROBE_BLK
#define PROBE_BLK 0
#endif
#ifndef PROBE_TID
#define PROBE_TID 0
#endif
#if PROBE_SEL >= 0
__device__ __forceinline__ void prb_b(LAS unsigned char* lds, int tid) { if (tid == PROBE_TID) { asm volatile("s_waitcnt vmcnt(0) lgkmcnt(0)" ::: "memory"); *(volatile LAS unsigned long long*)(lds + LDS_MISC + 64) = __builtin_amdgcn_s_memrealtime(); } }
__device__ __forceinline__ void prb_e(LAS unsigned char* lds, int tid) { if (tid == PROBE_TID) { asm volatile("s_waitcnt vmcnt(0) lgkmcnt(0)" ::: "memory"); volatile LAS unsigned long long* p = (volatile LAS unsigned long long*)(lds + LDS_MISC + 64); p[1] = p[1] + (__builtin_amdgcn_s_memrealtime() - p[0]); } }
#define PB(id) do { if ((id) == PROBE_SEL) prb_b(F.lds, F.tid); } while (0)
#define PE(id) do { if ((id) == PROBE_SEL) prb_e(F.lds, F.tid); } while (0)
#else
#define PB(id) do { } while (0)
#define PE(id) do { } while (0)
#endif
struct Args { const float* in[40]; float* out; unsigned char* ws; int ph_lo, ph_hi; };
struct Frame {
    LAS unsigned char* lds; int tid, lane, wave, vcu, G;
    const float* const* in; float* out; unsigned char* ws;
};
#define WSP(T, off) ((T*)(F.ws + (off)))
__device__ __forceinline__ Frame relocal(const Frame& F0) { Frame F = F0; const int t = tid_of(F0.wave); F.tid = t; F.lane = t & 63; F.wave = F0.wave; int v = F0.vcu; asm volatile("" : "+s"(v)); F.vcu = v; return F; }

constexpr int PH_P0 = 0, PH_P1 = 1, PH_L = 2, PH_PER = 20, N_PHASES = PH_L + 2 * PH_PER;
enum { S_NORM1 = 0, S_G1, S_FNET, S_HY1, S_S5E, S_CARRY, S_HY2, S_S5O, S_GLU, S_HYT, S_WOUT, S_NORM2, S_F0, S_F1, S_F2, S_F3, S_F4, S_F5, S_F6 };

__device__ __forceinline__ int wq_next(Frame& F, int qid) {
    LAS int* slot = (LAS int*)(F.lds + LDS_MISC + 96);
    if (F.tid == 0) *slot = (int)__hip_atomic_fetch_add((unsigned*)(F.ws + WS_CTL) + 8192 + 64 * qid, 1u, __ATOMIC_RELAXED, __HIP_MEMORY_SCOPE_AGENT);
    __syncthreads();
    const int v = *slot;
    __syncthreads();
    return v;
}
__device__ __forceinline__ int rowmap(int mode, int row_off, int n) { return (mode == 0 || mode == 3) ? row_off + n : (32 * (n >> 4) + (n & 15) + (mode == 2 ? 16 : 0)); }
__device__ __forceinline__ void transpose_item(const float* W, int ldw, int col0, int N, bf16* WT, int ldk, int mode, int row_off, LAS float* scr, int item, int lane) {
    const int nblk = N / 32, kb = item / nblk, nb = item % nblk, k0 = 64 * kb, n0 = 32 * nb;
    const int r8 = lane >> 3, c4 = lane & 7;
    f32x4 v[8];
#pragma unroll
    for (int i = 0; i < 8; ++i) v[i] = *(const f32x4*)(W + (size_t)(k0 + 8 * i + r8) * ldw + col0 + n0 + 4 * c4);
#pragma unroll
    for (int i = 0; i < 8; ++i) { LAS float* d = scr + (8 * i + r8) * 33 + 4 * c4; d[0] = v[i].x; d[1] = v[i].y; d[2] = v[i].z; d[3] = v[i].w; }
    asm volatile("s_waitcnt lgkmcnt(0)" ::: "memory");
    const int c = lane & 7;
#pragma unroll
    for (int j = 0; j < 4; ++j) { const int n = (lane >> 3) + 8 * j; const LAS float* s = scr + (8 * c) * 33 + n;
        v4u o; o.x = pk2(s[0 * 33], s[1 * 33]); o.y = pk2(s[2 * 33], s[3 * 33]); o.z = pk2(s[4 * 33], s[5 * 33]); o.w = pk2(s[6 * 33], s[7 * 33]);
        if (mode == 3) *(v4u*)(WT + tiled_idx(row_off + n0 + n, k0 + 8 * c, ldk / 64)) = o; else *(v4u*)(WT + (size_t)rowmap(mode, row_off, n0 + n) * ldk + k0 + 8 * c) = o; }
    asm volatile("s_waitcnt lgkmcnt(0)" ::: "memory");
}

__device__ __forceinline__ void p0_transposes(Frame& F) {
    LAS float* scr = (LAS float*)(F.lds + F.wave * 16384);
    const int gw = F.vcu * NWAVES + F.wave, NGW = F.G * NWAVES;
    constexpr int I_IN = 16 * 48, I_OUT = 16 * 32, I_GLU = 6 * 12, I_FG = 16 * 88, I_FD = 44 * 32;
    constexpr int NIT = 2 * (I_IN + I_OUT + I_GLU) + 2 * I_FG + I_FD;
    for (int it = gw; it < NIT; it += NGW) {
        int r = it;
        if (r < 2 * I_IN) { const int l = r / I_IN; transpose_item(F.in[8] + (size_t)l * D * DIN, DIN, 256, 1536, WSP(bf16, WS_WIN) + (size_t)l * PTROWS * D, D, 0, 512, scr, r % I_IN, F.lane); continue; } r -= 2 * I_IN;
        if (r < 2 * I_OUT) { const int l = r / I_OUT; transpose_item(F.in[9] + (size_t)l * D * D, D, 0, D, WSP(bf16, WS_WOUT) + (size_t)l * D * D, D, 0, 0, scr, r % I_OUT, F.lane); continue; } r -= 2 * I_OUT;
        if (r < 2 * I_GLU) { const int l = r / I_GLU; transpose_item(F.in[29] + (size_t)l * 384 * 384, 384, 0, 384, WSP(bf16, WS_GLU) + (size_t)l * 512 * 384, 384, 0, 0, scr, r % I_GLU, F.lane); continue; } r -= 2 * I_GLU;
        if (r < I_FG) { transpose_item(F.in[31], DFF, 0, DFF, WSP(bf16, WS_FGU), D, 1, 0, scr, r, F.lane); continue; } r -= I_FG;
        if (r < I_FG) { transpose_item(F.in[32], DFF, 0, DFF, WSP(bf16, WS_FGU), D, 2, 0, scr, r, F.lane); continue; } r -= I_FG;
        transpose_item(F.in[33], D, 0, D, WSP(bf16, WS_FD), DFF, 3, 0, scr, r, F.lane);
    }
}
struct TItem { const float* src; int ldw; bf16* dst; int ldk, mode, k0, n0; };
__device__ __forceinline__ void titem_load(const TItem& t, int lane, f32x4 (&v)[8]) { const int r8 = lane >> 3, c4 = lane & 7;
#pragma unroll
    for (int i = 0; i < 8; ++i) v[i] = *(const f32x4*)(t.src + (size_t)(t.k0 + 8 * i + r8) * t.ldw + t.n0 + 4 * c4); }
__device__ __forceinline__ void titem_finish(const TItem& t, int lane, const f32x4 (&v)[8], LAS float* scr) { const int r8 = lane >> 3, c4 = lane & 7;
#pragma unroll
    for (int i = 0; i < 8; ++i) { LAS float* d = scr + (8 * i + r8) * 33 + 4 * c4; d[0] = v[i].x; d[1] = v[i].y; d[2] = v[i].z; d[3] = v[i].w; }
    asm volatile("s_waitcnt lgkmcnt(0)" ::: "memory");
    const int c = lane & 7;
#pragma unroll
    for (int j = 0; j < 4; ++j) { const int n = (lane >> 3) + 8 * j; const LAS float* s = scr + (8 * c) * 33 + n;
        v4u o; o.x = pk2(s[0 * 33], s[1 * 33]); o.y = pk2(s[2 * 33], s[3 * 33]); o.z = pk2(s[4 * 33], s[5 * 33]); o.w = pk2(s[6 * 33], s[7 * 33]);
        if (t.mode == 3) *(v4u*)(t.dst + tiled_idx(t.n0 + n, t.k0 + 8 * c, t.ldk / 64)) = o; else *(v4u*)(t.dst + (size_t)rowmap(t.mode, 0, t.n0 + n) * t.ldk + t.k0 + 8 * c) = o; }
    asm volatile("s_waitcnt lgkmcnt(0)" ::: "memory"); }
__device__ __forceinline__ TItem moe_titem(Frame& F, int it) {
    constexpr int I_G = 16 * 112, I_D = 56 * 32, PER_E = 2 * I_G + I_D;
    const int e = it / PER_E; int r = it % PER_E; TItem t;
    bf16* gu = (bf16*)(F.ws + WS_MOEW + (size_t)e * MOE_E_STRIDE); bf16* dn = (bf16*)(F.ws + WS_MOEW + (size_t)e * MOE_E_STRIDE + MOE_GU_BYTES);
    if (r < 2 * I_G) { const int up = r >= I_G; if (up) r -= I_G; t.src = F.in[36 + up] + (size_t)e * D * DFE; t.ldw = DFE; t.dst = gu; t.ldk = D; t.mode = 1 + up; t.k0 = 64 * (r / 112); t.n0 = 32 * (r % 112); }
    else { r -= 2 * I_G; t.src = F.in[38] + (size_t)e * DFE * D; t.ldw = D; t.dst = dn; t.ldk = DFE; t.mode = 3; t.k0 = 64 * (r / 32); t.n0 = 32 * (r % 32); }
    return t; }
__device__ __forceinline__ void moe_transposes(Frame& F_) { Frame F = relocal(F_);
    LAS float* scr = (LAS float*)(F.lds + F.wave * 16384);
    const int gw = F.vcu * NWAVES + F.wave, NGW = F.G * NWAVES; constexpr int NIT = NE * (2 * 16 * 112 + 56 * 32);
    int it = gw; if (it >= NIT) return;
    TItem cur = moe_titem(F, it); f32x4 va[8], vb[8]; titem_load(cur, F.lane, va);
    for (;;) {
        const int itn = it + NGW; const bool hn = itn < NIT; TItem nx = cur; if (hn) { nx = moe_titem(F, itn); titem_load(nx, F.lane, vb); }
        titem_finish(cur, F.lane, va, scr);
        if (!hn) break;
        const int itn2 = itn + NGW; const bool hn2 = itn2 < NIT; TItem nx2 = nx; if (hn2) { nx2 = moe_titem(F, itn2); titem_load(nx2, F.lane, va); }
        titem_finish(nx, F.lane, vb, scr);
        if (!hn2) break;
        cur = nx2; it = itn2;
    }
}

__device__ __forceinline__ void p0_mod_item(Frame& F, int item) {
    const int l = item / 48, cb = item % 48, tid = tid_of(F.wave), lane = tid & 63;
    LAS float* sc = (LAS float*)F.lds;
    LAS float* red = sc + 17 * 1024;
    for (int i = tid; i < 17 * 1024; i += NTHR) { const int r = i >> 10, k = i & 1023; const float v = r < 16 ? F.in[1][r * D + k] : F.in[3][k]; sc[i] = silu_f(v); }
    __syncthreads();
    const int cq = lane & 31, kg = (lane >> 5) + 2 * F.wave;
    const float* W = F.in[4] + (size_t)l * D * 6144 + cb * 128 + 4 * cq;
    f32x4 acc[17];
#pragma unroll
    for (int r = 0; r < 17; ++r) acc[r] = (f32x4){0.f, 0.f, 0.f, 0.f};
#pragma unroll 1
    for (int k0 = kg * 64; k0 < kg * 64 + 64; k0 += 8) { f32x4 w[8];
#pragma unroll
        for (int j = 0; j < 8; ++j) w[j] = *(const f32x4*)(W + (size_t)(k0 + j) * 6144);
#pragma unroll
        for (int j = 0; j < 8; ++j)
#pragma unroll
            for (int r = 0; r < 17; ++r) acc[r] += w[j] * sc[r * 1024 + k0 + j]; }
    if (lane < 32) {
#pragma unroll
        for (int r = 0; r < 17; ++r) *(LAS f32x4*)(red + (F.wave * 17 + r) * 128 + 4 * cq) = acc[r]; }
    __syncthreads();
    if (lane >= 32) {
#pragma unroll
        for (int r = 0; r < 17; ++r) { LAS f32x4* p = (LAS f32x4*)(red + (F.wave * 17 + r) * 128 + 4 * cq); *p = *p + acc[r]; } }
    __syncthreads();
    for (int i = tid; i < 17 * 128; i += NTHR) { const int r = i >> 7, c = i & 127; float s = 0.f;
#pragma unroll
        for (int w8 = 0; w8 < 8; ++w8) s += red[(w8 * 17 + r) * 128 + c];
        WSP(float, WS_MOD)[((size_t)l * 17 + r) * 6144 + cb * 128 + c] = s + F.in[5][l * 6144 + cb * 128 + c]; }
    __syncthreads();
}
__device__ __forceinline__ void p0_fold_item(Frame& F, int item) {
    const int kb = item & 7, cs = (item >> 3) & 1, h = (item >> 4) & 3, l = item >> 6, tid = tid_of(F.wave);
    LAS float* A = (LAS float*)F.lds;
    LAS float* WF = A + 4096;
    LAS float* WI = WF + 4096;
    LAS float* T = WI + 128 * 65;
    if (tid < 64) T[tid] = cs ? sinpif((float)tid * (1.0f / 32.0f)) : cospif((float)tid * (1.0f / 32.0f));
    const float* wf = F.in[10] + ((size_t)l * 4 + h) * 64 * 64;
    for (int i = tid; i < 4096; i += NTHR) WF[i] = wf[i];
    const float* win = F.in[8] + (size_t)l * D * DIN + (size_t)kb * 128 * DIN + h * 64;
    for (int i = tid; i < 128 * 64; i += NTHR) { const int kk = i >> 6, d = i & 63; WI[kk * 65 + d] = win[(size_t)kk * DIN + d]; }
    __syncthreads();
    for (int i = tid; i < 4096; i += NTHR) { const int d = i >> 6, e2 = i & 63; float s = 0.f;
        for (int e = 0; e < 64; ++e) s += T[(e * d) & 63] * WF[e * 64 + e2];
        A[i] = s * 0.125f; }
    __syncthreads();
    const int e2 = tid & 63;
    bf16* wt = WSP(bf16, WS_WIN) + (size_t)l * PTROWS * D + (size_t)(cs * 256 + h * 64 + e2) * D + kb * 128;
    for (int i = 0; i < 16; ++i) { const int kk = (tid >> 6) + 8 * i; float s = 0.f;
#pragma unroll 8
        for (int d = 0; d < 64; ++d) s += WI[kk * 65 + d] * A[d * 64 + e2];
        wt[kk] = (bf16)f2bf(s); }
    __syncthreads();
}
__device__ __forceinline__ void gen_dft_rows(bf16* dst, int LL, int row0, int nrows, float scale, int tid) {
    const int cpr = 2 * LL / 8;
    for (int i = tid; i < nrows * cpr; i += NTHR) { const int k = row0 + i / cpr, j0 = (i % cpr) * 8; unsigned w[4];
#pragma unroll
        for (int q = 0; q < 4; ++q) { float v[2];
#pragma unroll
            for (int z = 0; z < 2; ++z) { const int j = j0 + 2 * q + z; const int jj = j < LL ? j : j - LL; const int m = (k * jj) & (LL - 1); const float x = (float)m * (2.0f / (float)LL);
                v[z] = (j < LL ? cospif(x) : -sinpif(x)) * scale; }
            w[q] = pk2(v[0], v[1]); }
        *(v4u*)(dst + (size_t)k * 2 * LL + j0) = (v4u){w[0], w[1], w[2], w[3]}; }
}
__device__ __forceinline__ void gen_fft_mats(Frame& F, int item) {
    const int tid = tid_of(F.wave);
    if (item == 64) { bf16* W = WSP(bf16, WS_FAW);
        for (int i = tid; i < 256 * 128; i += NTHR) { const int m = i >> 7, k = i & 127; float v = 0.f;
            if (m < 128) { const int pp = m >> 6, t1 = m & 63, pa = k >> 6, s1 = k & 63; const float x = (float)((t1 * s1) & 63) * (1.0f / 32.0f); const float c = cospif(x) * 0.125f, sn = sinpif(x) * 0.125f;
                v = pp == 0 ? (pa == 0 ? c : -sn) : (pa == 0 ? -sn : -c); }
            W[i] = (bf16)f2bf(v); }
        return; }
    const int grp = item >> 2, q = item & 3; bf16* W = WSP(bf16, WS_FBW) + (size_t)grp * 256 * 512;
    for (int i = q * 32768 + tid; i < (q + 1) * 32768; i += NTHR) { const int r = i >> 9, k = i & 511; const int t1p = r >> 6, t2 = r & 63, t1q = k >> 7, pa = (k >> 6) & 1, s2 = k & 63; float v = 0.f;
        if (t1p == t1q) { const int t = 4 * grp + t1p + 64 * t2; const float x = (float)((s2 * t) & 4095) * (1.0f / 2048.0f); v = (pa == 0 ? cospif(x) : sinpif(x)) * 0.125f; }
        W[i] = (bf16)f2bf(v); }
}
__device__ __forceinline__ void p0_filter_item(Frame& F, int item) {
    const int l = item / 272, pb = item % 272, tid = tid_of(F.wave);
    const int LL = pb < 256 ? L : LC, p0 = pb < 256 ? pb * 16 : (pb - 256) * 16;
    LAS float* z = (LAS float*)F.lds;
    LAS float* h1 = z + 16 * 36;
    LAS float* h2 = h1 + 16 * 64;
    LAS float* W1 = h2 + 16 * 64;
    LAS float* W2 = W1 + 33 * 64;
    for (int i = tid; i < 33 * 64; i += NTHR) W1[i] = F.in[13][(size_t)l * 33 * 64 + i];
    for (int i = tid; i < 64 * 64; i += NTHR) W2[i] = F.in[16][(size_t)l * 64 * 64 + i];
    for (int i = tid; i < 16 * 33; i += NTHR) { const int pp = i / 33, j = i % 33; const int pos = p0 + pp; float v;
        if (j == 0) v = (float)pos / (float)(LL - 1);
        else { const int bj = (j - 1) & 15; const float band = 1e-4f + (float)bj * ((15.0f - 1e-4f) / 15.0f); const float u = 2.0f * band * (float)pos / (float)LL;
            v = j <= 16 ? cospif(u) : -sinpif(u); }
        z[pp * 36 + j] = v; }
    __syncthreads();
    for (int i = tid; i < 1024; i += NTHR) { const int pp = i >> 6, o = i & 63; float s = F.in[14][l * 64 + o];
        for (int j = 0; j < 33; ++j) s += z[pp * 36 + j] * W1[j * 64 + o];
        h1[i] = sinf(F.in[15][l * 64 + o] * s); }
    __syncthreads();
    for (int i = tid; i < 1024; i += NTHR) { const int pp = i >> 6, o = i & 63; float s = F.in[17][l * 64 + o];
        for (int j = 0; j < 64; ++j) s += h1[pp * 64 + j] * W2[j * 64 + o];
        h2[i] = sinf(F.in[18][l * 64 + o] * s); }
    __syncthreads();
    float* HT = WSP(float, WS_HT) + ((size_t)l * 4352 + (pb < 256 ? 0 : 4096)) * 1536;
    float* PS = WSP(float, WS_PS) + ((size_t)l * 272 + pb) * 1536;
    const float* fw3 = F.in[19] + (size_t)l * 64 * 1536;
    const float dmin = 3.0701134573253945f, dstep = (15.350567286626973f - 3.0701134573253945f) / 383.0f;
#pragma unroll 1
    for (int cc = 0; cc < 3; ++cc) { const int col = tid + 512 * cc; float acc[16];
#pragma unroll
        for (int pp = 0; pp < 16; ++pp) acc[pp] = 0.f;
#pragma unroll 1
        for (int j0 = 0; j0 < 64; j0 += 32) { float w[32];
#pragma unroll
            for (int j = 0; j < 32; ++j) w[j] = fw3[(size_t)(j0 + j) * 1536 + col];
#pragma unroll
            for (int pp = 0; pp < 16; ++pp) { float a = acc[pp];
#pragma unroll
                for (int j = 0; j < 32; j += 4) { const f32x4 hv = *(const LAS f32x4*)(h2 + pp * 64 + j0 + j); a += (hv.x * w[j] + hv.y * w[j + 1]) + (hv.z * w[j + 2] + hv.w * w[j + 3]); }
                acc[pp] = a; __builtin_amdgcn_sched_barrier(0); } }
        const int c = col % 384, dir = col / 768; const float delta = dmin + (float)c * dstep; float ps = 0.f;
#pragma unroll
        for (int pp = 0; pp < 16; ++pp) { const int pos = p0 + pp; const float t = (float)pos / (float)(LL - 1); const float v = acc[pp] * __expf(-t * delta);
            HT[(size_t)pos * 1536 + col] = v; if (!(dir == 1 && pos == 0)) ps += fabsf(v); }
        PS[col] = ps; }
    __syncthreads();
}
__device__ __forceinline__ void p0_s5_item(Frame& F, int item2) {
    const int item = item2 >> 1, part = item2 & 1, l = item / 24, g = item % 24, tid = tid_of(F.wave);
    LAS f32x2* apow = (LAS f32x2*)F.lds;
    LAS f32x2* bbar = apow + 2 * 17 * 64;
    LAS f32x2* Cc = bbar + 2 * 64 * 16;
    LAS float* Kd = (LAS float*)(Cc + 2 * 16 * 64);
    if (tid < 128) { const int dir = tid >> 6, p = tid & 63; const size_t ix = (((size_t)l * 2 + dir) * 24 + g) * 64 + p;
        const float are = F.in[21][ix], aim = F.in[22][ix], dt = __expf(F.in[23][((size_t)l * 2 + dir) * 24 + g]);
        const float x = are * dt, yp = aim * dt * 0.3183098861837907f;
        for (int tau = 0; tau <= 16; ++tau) { const float mg = __expf(x * (float)tau), an = yp * (float)tau; apow[(dir * 17 + tau) * 64 + p] = (f32x2){mg * cospif(an), mg * sinpif(an)}; }
        const float sh = sinpif(0.5f * yp), nr = expm1f(x) * cospif(yp) - 2.0f * sh * sh, ni = __expf(x) * sinpif(yp); const float den = are * are + aim * aim;
        const float qr = (nr * are + ni * aim) / den, qi = (ni * are - nr * aim) / den;
        for (int h = 0; h < 16; ++h) { const float br = F.in[24][ix * 16 + h], bi = F.in[25][ix * 16 + h]; bbar[(dir * 64 + p) * 16 + h] = (f32x2){qr * br - qi * bi, qr * bi + qi * br}; }
        const float m16 = __expf(x * 16.0f), a16 = yp * 16.0f;
        WSP(float, WS_A16)[ix * 2 + 0] = m16 * cospif(a16); WSP(float, WS_A16)[ix * 2 + 1] = m16 * sinpif(a16); }
    for (int i = tid; i < 2 * 16 * 64; i += NTHR) { const int dir = i >> 10, h = (i >> 6) & 15, p = i & 63; const size_t ix = ((((size_t)l * 2 + dir) * 24 + g) * 16 + h) * 64 + p;
        Cc[i] = (f32x2){F.in[26][ix], F.in[27][ix]}; }
    __syncthreads();
    for (int i = tid; i < 2 * 16 * 256; i += NTHR) { const int dir = i >> 12, tau = (i >> 8) & 15, h = (i >> 4) & 15, h2 = i & 15; float s = 0.f;
        for (int p = 0; p < 64; ++p) { const f32x2 a = apow[(dir * 17 + tau) * 64 + p], b = bbar[(dir * 64 + p) * 16 + h2], c = Cc[(dir * 16 + h) * 64 + p];
            const float tr = a.x * b.x - a.y * b.y, ti = a.x * b.y + a.y * b.x; s += c.x * tr - c.y * ti; }
        Kd[i] = s; }
    __syncthreads();
    bf16* EST = (bf16*)(F.ws + WS_S5M + (size_t)item * S5M_STRIDE); bf16* MOUT = EST + 256 * 256;
    const float* dsk = F.in[28] + (size_t)l * 384 + g * 16;
    const int e_lo = part == 0 ? 0 : 32768 + 16384, e_hi = part == 0 ? 32768 + 16384 : 32768 + 65536;
    for (int pi = e_lo + tid; pi < e_hi; pi += NTHR) {
        float v2[2];
        if (pi < 32768) { const int n = pi >> 7, k0 = (pi & 127) * 2; const int dir = n >> 7, p = (n >> 1) & 63, ri = n & 1;
#pragma unroll
            for (int z = 0; z < 2; ++z) { const int k = k0 + z, hh = k >> 4, j = k & 15; const int tau = dir == 0 ? 15 - j : j; const f32x2 a = apow[(dir * 17 + tau) * 64 + p], bq = bbar[(dir * 64 + p) * 16 + hh];
                v2[z] = ri == 0 ? a.x * bq.x - a.y * bq.y : a.x * bq.y + a.y * bq.x; }
            *(unsigned*)(EST + (size_t)n * 256 + k0) = pk2(v2[0], v2[1]); }
        else { const int q = pi - 32768, n = q >> 8, k0 = (q & 255) * 2; const int j = n >> 4, h = n & 15;
#pragma unroll
            for (int z = 0; z < 2; ++z) { const int k = k0 + z; float v;
                if (k < 256) { const int hh = k >> 4, ii = k & 15; v = 0.f;
                    if (ii <= j) v += Kd[((0 * 16 + (j - ii)) * 16 + h) * 16 + hh];
                    if (ii >= j) v += Kd[((1 * 16 + (ii - j)) * 16 + h) * 16 + hh];
                    if (ii == j && h == hh) v += dsk[h]; }
                else { const int comp = k - 256, dir = comp >> 7, p = (comp >> 1) & 63, ri = comp & 1; const int tau = dir == 0 ? j + 1 : 16 - j;
                    const f32x2 a = apow[(dir * 17 + tau) * 64 + p], c = Cc[(dir * 16 + h) * 64 + p];
                    v = ri == 0 ? (c.x * a.x - c.y * a.y) : -(c.x * a.y + c.y * a.x); }
                v2[z] = v; }
            *(unsigned*)(MOUT + (size_t)n * 512 + k0) = pk2(v2[0], v2[1]); } }
    __syncthreads();
}
__device__ __forceinline__ void p0_prologue(Frame& F_) { Frame F = relocal(F_);
    PB(10); p0_transposes(F);
    __syncthreads(); PE(10);
    for (int i = F.vcu * NTHR + F.tid; i < 2 * 128 * 384 / 8; i += F.G * NTHR) { const int l = i / (128 * 384 / 8), r = i % (128 * 384 / 8);
        *(v4u*)(WSP(bf16, WS_GLU) + (size_t)l * 512 * 384 + 384 * 384 + (size_t)r * 8) = (v4u){0u, 0u, 0u, 0u}; }
    constexpr int I_S5 = 96, I_MOD = 96, I_FOLD = 128, I_FIL = 544, I_DFT = 65, I_DFTC = 4, NIT = I_S5 + I_MOD + I_FOLD + I_FIL + I_DFT + I_DFTC;
    for (int it = wq_next(F, 0); it < NIT; it = wq_next(F, 0)) {
        int r = it;
        if (r < I_S5) { PB(14); p0_s5_item(F, r); PE(14); continue; } r -= I_S5;
        if (r < I_MOD) { PB(12); p0_mod_item(F, r); PE(12); continue; } r -= I_MOD;
        if (r < I_FOLD) { PB(13); p0_fold_item(F, r); PE(13); continue; } r -= I_FOLD;
        if (r < I_FIL) { PB(11); p0_filter_item(F, r); PE(11); continue; } r -= I_FIL;
        if (r < I_DFT) { PB(15); gen_fft_mats(F, r); PE(15); continue; } r -= I_DFT;
        gen_dft_rows(WSP(bf16, WS_DFTC), LC, r * 64, 64, 1.0f / 16.0f, F.tid);
    }
}
__device__ __forceinline__ void p1_item(Frame& F_, int item) { Frame F = relocal(F_);
    const int qt = item & 3, ocb = (item >> 2) % 24, ls = (item >> 2) / 24, set = ls & 1, l = ls >> 1, o = ocb / 12, cb = ocb % 12, tid = F.tid;
    const int LL = set ? LC : L, nbt = set ? 1 : 4;
    if (set && qt) return;
    LAS float* red = (LAS float*)F.lds;
    LAS float* inv = red + 512;
    LAS float* T = inv + 32;
    const float* PS = WSP(float, WS_PS) + ((size_t)l * 272 + (set ? 256 : 0)) * 1536;
    { const int ch = tid & 31, part = tid >> 5; float s = 0.f; const int nblk = LL / 16;
      for (int b = part; b < nblk; b += 16) s += PS[(size_t)b * 1536 + o * 384 + cb * 32 + ch] + PS[(size_t)b * 1536 + 768 + o * 384 + cb * 32 + ch];
      red[part * 32 + ch] = s; }
    __syncthreads();
    if (tid < 32) { float s = 0.f; for (int p = 0; p < 16; ++p) s += red[p * 32 + tid]; inv[tid] = 1.0f / s; }
    const float* HT = WSP(float, WS_HT) + ((size_t)l * 4352 + (set ? 4096 : 0)) * 1536;
    float* KT = set ? WSP(float, WS_KTC) + ((size_t)(l * 2 + o) * 384) * 512 : WSP(float, WS_KT) + ((size_t)(l * 2 + o) * 384) * 8192;
#pragma unroll 1
    for (int bi = 0; bi < nbt; ++bi) { const int pos0 = (qt * nbt + bi) * 256;
        { const int ch = tid & 31, dir = (tid >> 5) & 1;
#pragma unroll 8
          for (int i = 0; i < 32; ++i) { const int pp = (tid >> 6) + 8 * i; T[(dir * 256 + pp) * 33 + ch] = HT[(size_t)(pos0 + pp) * 1536 + dir * 768 + o * 384 + cb * 32 + ch]; } }
        __syncthreads();
        { const int pp = tid & 255, c0 = tid >> 8;
#pragma unroll 4
          for (int i = 0; i < 16; ++i) { const int ch = c0 + 2 * i; const int pos = pos0 + pp; float* kt = KT + (size_t)(cb * 32 + ch) * 2 * LL;
              kt[LL + pos] = T[(0 * 256 + pp) * 33 + ch] * inv[ch];
              if (pos > 0) kt[LL - pos] = T[(1 * 256 + pp) * 33 + ch] * inv[ch]; else kt[0] = 0.f; } }
        __syncthreads(); }
}

__device__ __forceinline__ void norm_rows(Frame& F_, const float* xlat, const float* xctx, int nrows, const float* gain, const float* mod, int sh_off, int sc_off, bf16* out) { Frame F = relocal(F_);
    const int gw = F.vcu * NWAVES + F.wave, NGW = F.G * NWAVES, lane = F.lane;
    for (int r0 = gw; r0 < nrows; r0 += 2 * NGW) {
        f32x4 v[2][4]; float ss[2];
#pragma unroll
        for (int q = 0; q < 2; ++q) { const int r = r0 + q * NGW; ss[q] = 0.f;
            if (r < nrows) { const float* xr = r < NL ? xlat + (size_t)r * D : xctx + (size_t)(r - NL) * D;
#pragma unroll
                for (int j = 0; j < 4; ++j) v[q][j] = ((const f32x4*)xr)[64 * j + lane]; } }
#pragma unroll
        for (int q = 0; q < 2; ++q) { const int r = r0 + q * NGW;
            if (r < nrows) {
#pragma unroll
                for (int j = 0; j < 4; ++j) ss[q] += (v[q][j].x * v[q][j].x + v[q][j].y * v[q][j].y) + (v[q][j].z * v[q][j].z + v[q][j].w * v[q][j].w);
                const float rstd = 1.0f / sqrtf(wave_sum(ss[q], lane) * (1.0f / D) + 1e-6f);
                const float* md = mod + (size_t)bidx_of(r) * 6144;
#pragma unroll
                for (int j = 0; j < 4; ++j) { const int col = (64 * j + lane) * 4; const f32x4 g4 = *(const f32x4*)(gain + col), sc = *(const f32x4*)(md + sc_off + col), sh = *(const f32x4*)(md + sh_off + col);
                    const f32x4 h = v[q][j] * rstd * g4 * (sc + 1.0f) + sh;
                    *(v2u*)(out + (size_t)r * D + col) = (v2u){pk2(h.x, h.y), pk2(h.z, h.w)}; } } }
    }
}
__device__ __forceinline__ void norm_rows_b16(Frame& F_, const bf16* x, int nrows, const float* gain, const float* mod, int sh_off, int sc_off, bf16* out) { Frame F = relocal(F_);
    const int gw = F.vcu * NWAVES + F.wave, NGW = F.G * NWAVES, lane = F.lane;
    for (int r0 = gw; r0 < nrows; r0 += 2 * NGW) {
        v4u raw[2][2];
#pragma unroll
        for (int q = 0; q < 2; ++q) { const int r = r0 + q * NGW; if (r < nrows) {
#pragma unroll
            for (int j = 0; j < 2; ++j) raw[q][j] = *(const v4u*)(x + (size_t)r * D + 512 * j + 8 * lane); } }
#pragma unroll
        for (int q = 0; q < 2; ++q) { const int r = r0 + q * NGW;
            if (r < nrows) { float v[2][8]; float ss = 0.f;
#pragma unroll
                for (int j = 0; j < 2; ++j) { const v4u u = raw[q][j]; v[j][0] = bf2f(u.x & 0xffffu); v[j][1] = bf2f(u.x >> 16); v[j][2] = bf2f(u.y & 0xffffu); v[j][3] = bf2f(u.y >> 16); v[j][4] = bf2f(u.z & 0xffffu); v[j][5] = bf2f(u.z >> 16); v[j][6] = bf2f(u.w & 0xffffu); v[j][7] = bf2f(u.w >> 16);
#pragma unroll
                    for (int i = 0; i < 8; ++i) ss += v[j][i] * v[j][i]; }
                const float rstd = 1.0f / sqrtf(wave_sum(ss, lane) * (1.0f / D) + 1e-6f);
                const float* md = mod + (size_t)bidx_of(r) * 6144;
#pragma unroll
                for (int j = 0; j < 2; ++j) { const int col = 512 * j + 8 * lane; float h[8];
#pragma unroll
                    for (int i4 = 0; i4 < 2; ++i4) { const f32x4 g4 = *(const f32x4*)(gain + col + 4 * i4), sc = *(const f32x4*)(md + sc_off + col + 4 * i4), sh = *(const f32x4*)(md + sh_off + col + 4 * i4);
                        h[4 * i4 + 0] = v[j][4 * i4 + 0] * rstd * g4.x * (sc.x + 1.0f) + sh.x; h[4 * i4 + 1] = v[j][4 * i4 + 1] * rstd * g4.y * (sc.y + 1.0f) + sh.y;
                        h[4 * i4 + 2] = v[j][4 * i4 + 2] * rstd * g4.z * (sc.z + 1.0f) + sh.z; h[4 * i4 + 3] = v[j][4 * i4 + 3] * rstd * g4.w * (sc.w + 1.0f) + sh.w; }
                    *(v4u*)(out + (size_t)r * D + col) = (v4u){pk2(h[0], h[1]), pk2(h[2], h[3]), pk2(h[4], h[5]), pk2(h[6], h[7])}; } } }
    }
}
__device__ __forceinline__ void norm2_router(Frame& F_, const float* x, const float* gain, const float* mod, bf16* out) { Frame F = relocal(F_);
    LAS int* hist = (LAS int*)F.lds;
    const float* rw = F.in[34]; const float* rb = F.in[35];
    for (int tile = F.vcu; tile < NL / 256; tile += F.G) {
        if (F.tid < 16) hist[F.tid] = 0;
        __syncthreads();
        f32x4 vn[4];
        { const float* xr0 = x + (size_t)(tile * 256 + F.wave * 32) * D;
#pragma unroll
          for (int j = 0; j < 4; ++j) vn[j] = ((const f32x4*)xr0)[64 * j + F.lane]; }
#pragma unroll 1
        for (int i = 0; i < 32; ++i) { const int r = tile * 256 + F.wave * 32 + i, lane = F.lane;
            const float* md = mod + (size_t)(r >> 12) * 6144;
            f32x4 v[4]; float ss = 0.f;
#pragma unroll
            for (int j = 0; j < 4; ++j) v[j] = vn[j];
            if (i + 1 < 32) { const float* xn = x + (size_t)(r + 1) * D;
#pragma unroll
                for (int j = 0; j < 4; ++j) vn[j] = ((const f32x4*)xn)[64 * j + lane]; }
#pragma unroll
            for (int j = 0; j < 4; ++j) ss += (v[j].x * v[j].x + v[j].y * v[j].y) + (v[j].z * v[j].z + v[j].w * v[j].w);
            const float rstd = 1.0f / sqrtf(wave_sum(ss, lane) * (1.0f / D) + 1e-6f);
            float lg[8];
#pragma unroll
            for (int e = 0; e < 8; ++e) lg[e] = 0.f;
#pragma unroll
            for (int j = 0; j < 4; ++j) { const int col = (64 * j + lane) * 4; const f32x4 g4 = *(const f32x4*)(gain + col), sc = *(const f32x4*)(md + 4096 + col), sh = *(const f32x4*)(md + 3072 + col);
                const f32x4 h = v[j] * rstd * g4 * (sc + 1.0f) + sh;
                *(v2u*)(out + (size_t)r * D + col) = (v2u){pk2(h.x, h.y), pk2(h.z, h.w)};
#pragma unroll
                for (int q = 0; q < 4; ++q) { const f32x4 w0 = *(const f32x4*)(rw + (size_t)(col + q) * 8), w1 = *(const f32x4*)(rw + (size_t)(col + q) * 8 + 4); const float hv = h[q];
                    lg[0] += hv * w0.x; lg[1] += hv * w0.y; lg[2] += hv * w0.z; lg[3] += hv * w0.w; lg[4] += hv * w1.x; lg[5] += hv * w1.y; lg[6] += hv * w1.z; lg[7] += hv * w1.w; } }
#pragma unroll
            for (int e = 0; e < 8; ++e) lg[e] = wave_sum(lg[e], lane) + rb[e];
            if (lane == 0) {
                int e1 = 0; float v1 = lg[0];
#pragma unroll
                for (int e = 1; e < 8; ++e) if (lg[e] > v1) { v1 = lg[e]; e1 = e; }
                int e2 = -1; float v2 = -3.4e38f;
#pragma unroll
                for (int e = 0; e < 8; ++e) if (e != e1 && lg[e] > v2) { v2 = lg[e]; e2 = e; }
                const float ex = __expf(v2 - v1), w1 = 1.0f / (1.0f + ex), w2 = ex / (1.0f + ex);
                *(v4u*)(F.ws + WS_TOPK + (size_t)r * 16) = (v4u){(unsigned)(e1 | (e2 << 8)), __builtin_bit_cast(unsigned, w1), __builtin_bit_cast(unsigned, w2), 0u};
                __hip_atomic_fetch_add(hist + e1, 1, __ATOMIC_RELAXED, __HIP_MEMORY_SCOPE_WORKGROUP); __hip_atomic_fetch_add(hist + 8 + e2, 1, __ATOMIC_RELAXED, __HIP_MEMORY_SCOPE_WORKGROUP);
            } }
        __syncthreads();
        if (F.tid < 16) ((int*)(F.ws + WS_META + META_CNT))[tile * 16 + F.tid] = hist[F.tid];
        __syncthreads();
    }
}
__device__ __forceinline__ void moe_slots(Frame& F_) { Frame F = relocal(F_);
    LAS int* tot = (LAS int*)F.lds;
    LAS int* es = tot + 32;
    const int* CNT = (const int*)(F.ws + WS_META + META_CNT); int* IDX = (int*)(F.ws + WS_META + META_IDX); int* TE = (int*)(F.ws + WS_META + META_TE); int* NT = (int*)(F.ws + WS_META + META_NT);
    for (int it = F.vcu; it < 512; it += F.G) { const int k = it >> 8, tile = it & 255, tid = F.tid;
        if (tid < 8) { int t = 0, b = 0; for (int i = 0; i < 256; ++i) { const int c = CNT[i * 16 + k * 8 + tid]; if (i < tile) b += c; t += c; } tot[tid] = t; tot[8 + tid] = b; }
        __syncthreads();
        if (tid == 0) { int s = 0; for (int e = 0; e < 8; ++e) { tot[16 + e] = s; s += (tot[e] + 255) & ~255; } tot[24] = s; }
        if (tid < 256) { const unsigned pk = *(const unsigned*)(F.ws + WS_TOPK + (size_t)(tile * 256 + tid) * 16); es[tid] = k == 0 ? (int)(pk & 255u) : (int)((pk >> 8) & 255u); }
        __syncthreads();
        if (tid < 256) { const int e = es[tid]; int rank = 0; for (int j = 0; j < tid; ++j) rank += (es[j] == e) ? 1 : 0;
            const int slot = tot[16 + e] + tot[8 + e] + rank; IDX[k * MAXSLOT + slot] = tile * 256 + tid; if (k == 1) ((int*)(F.ws + WS_META + META_SL1))[tile * 256 + tid] = slot; }
        if (tile == 0) {
            for (int e = 0; e < 8; ++e) { const int n = tot[e], np = (n + 255) & ~255, sb = tot[16 + e];
                for (int i = n + tid; i < np; i += NTHR) IDX[k * MAXSLOT + sb + i] = -1;
                for (int i = tid; i < np / 256; i += NTHR) TE[k * 272 + sb / 256 + i] = e; }
            if (tid == 0) NT[k] = tot[24] / 256; }
        __syncthreads();
    }
}
__device__ __forceinline__ void final_norm_part(Frame& F_, int part, int ntw) { Frame F = relocal(F_);
    const int bx = (int)blockIdx.x; if (part == 0 && bx < ntw) return;
    const int gw = part == 0 ? (bx - ntw) * NWAVES + F.wave : F.vcu * NWAVES + F.wave, NGW = (part == 0 ? F.G - ntw : F.G) * NWAVES, lane = F.lane; const float* gain = F.in[39];
    const int* SL1 = (const int*)(F.ws + WS_META + META_SL1);
    for (int r0 = gw; r0 < NL; r0 += 2 * NGW) { f32x4 v[2][4]; bool ok[2];
#pragma unroll
        for (int q = 0; q < 2; ++q) { const int r = r0 + q * NGW; ok[q] = r < NL && ((SL1[r < NL ? r : 0] >= NL) == (part == 1)); if (ok[q]) { const float* xr = F.out + (size_t)r * D;
#pragma unroll
            for (int j = 0; j < 4; ++j) v[q][j] = ((const f32x4*)xr)[64 * j + lane]; } }
#pragma unroll
        for (int q = 0; q < 2; ++q) { const int r = r0 + q * NGW; if (ok[q]) { float* xr = F.out + (size_t)r * D; float ss = 0.f;
#pragma unroll
            for (int j = 0; j < 4; ++j) ss += (v[q][j].x * v[q][j].x + v[q][j].y * v[q][j].y) + (v[q][j].z * v[q][j].z + v[q][j].w * v[q][j].w);
            const float rstd = 1.0f / sqrtf(wave_sum(ss, lane) * (1.0f / D) + 1e-6f);
#pragma unroll
            for (int j = 0; j < 4; ++j) { const int col = (64 * j + lane) * 4; ((f32x4*)xr)[64 * j + lane] = v[q][j] * rstd * *(const f32x4*)(gain + col); } } } }
}

__device__ __forceinline__ float sconv(const bf16* prow, int colbase, int t, int LL, bool grid, float w0, float w1, float w2, float bias) {
    const bool hasl = grid ? ((t & 63) != 0) : (t > 0), hasr = grid ? ((t & 63) != 63) : (t < LL - 1);
    const float c = bf2f(prow[colbase + t]), a = hasl ? bf2f(prow[colbase + t - 1]) : 0.f, b = hasr ? bf2f(prow[colbase + t + 1]) : 0.f;
    return a * w0 + c * w1 + b * w2 + bias;
}
template <int LL, int NT, int NBT>
__device__ __forceinline__ void hyena_unit(Frame& F, int l, int o, int c, int b0, bool latent) {
    constexpr int TPB = LL / NT, BG = NTHR / TPB, NBU = BG * NBT;
    LAS float* kk = (LAS float*)F.lds;
    LAS float* us = kk + 2 * LL;
    const int tid = F.tid;
    const bf16* PT = WSP(bf16, WS_PT);
    const float* cw = F.in[11] + (size_t)l * 3 * 1152; const float* cb = F.in[12] + (size_t)l * 1152;
    const int in_row = R_HY + c;
    const int mul_row = R_HY + 384 * (o + 1) + c, mul_ch = 384 * (o + 1) + c;
    const int out_row = o == 0 ? R_HY + c : R_HY + 384 + c;
    const float* KT = latent ? WSP(float, WS_KT) + ((size_t)(l * 2 + o) * 384 + c) * 8192 : WSP(float, WS_KTC) + ((size_t)(l * 2 + o) * 384 + c) * 512;
    for (int i = tid; i < 2 * LL; i += NTHR) kk[i] = KT[i];
    { const float w0 = cw[c], w1 = cw[1152 + c], w2 = cw[2304 + c], bs = cb[c];
      for (int i = tid; i < NBU * LL; i += NTHR) { const int bb = i / LL, t = i % LL; const int colbase = latent ? (b0 + bb) * L : NL + (b0 + bb) * LC;
          us[i] = o == 0 ? sconv(PT + (size_t)in_row * MT, colbase, t, LL, latent, w0, w1, w2, bs) : bf2f(PT[(size_t)in_row * MT + colbase + t]); } }
    __syncthreads();
    float acc[NBT][NT];
#pragma unroll
    for (int bj = 0; bj < NBT; ++bj)
#pragma unroll
        for (int tj = 0; tj < NT; ++tj) acc[bj][tj] = 0.f;
    const int tb = tid % TPB, bg = tid / TPB;
#pragma unroll 4
    for (int s = 0; s < LL; ++s) { float kv[NT], uv[NBT];
#pragma unroll
        for (int tj = 0; tj < NT; ++tj) kv[tj] = kk[LL + tb + TPB * tj - s];
#pragma unroll
        for (int bj = 0; bj < NBT; ++bj) uv[bj] = us[(bg + BG * bj) * LL + s];
#pragma unroll
        for (int bj = 0; bj < NBT; ++bj)
#pragma unroll
            for (int tj = 0; tj < NT; ++tj) acc[bj][tj] += kv[tj] * uv[bj]; }
    const float hb = F.in[20][((size_t)l * 2 + o) * 384 + c];
    const float m0 = cw[mul_ch], m1 = cw[1152 + mul_ch], m2 = cw[2304 + mul_ch], mb = cb[mul_ch];
    bf16* PTw = WSP(bf16, WS_PT);
#pragma unroll
    for (int bj = 0; bj < NBT; ++bj)
#pragma unroll
        for (int tj = 0; tj < NT; ++tj) { const int bb = bg + BG * bj, t = tb + TPB * tj; const int colbase = latent ? (b0 + bb) * L : NL + (b0 + bb) * LC;
            const float uval = us[bb * LL + t]; const float xm = sconv(PT + (size_t)mul_row * MT, colbase, t, LL, latent, m0, m1, m2, mb);
            PTw[(size_t)out_row * MT + colbase + t] = (bf16)f2bf(xm * (acc[bj][tj] + hb * uval)); asm volatile("" ::: "memory"); }
    __syncthreads();
}
template <int LL, int NTW, bool GRID>
__device__ __forceinline__ void hyena_job(Frame& F, int l, int o, int c, int tbase) {
    constexpr int TR = NWAVES * NTW * 16, NENT = LL - 8 + TR, NSG = LL / 128;
    const int tid = F.tid, lane = F.lane, fr = lane & 15, fq = lane >> 4;
    const int mmin = -tbase - TR + 1;
    LAS unsigned char* VT = F.lds;
    PB(2);
    {   const float* KT = GRID ? WSP(float, WS_KT) + ((size_t)(l * 2 + o) * 384 + c) * 8192 : WSP(float, WS_KTC) + ((size_t)(l * 2 + o) * 384 + c) * 512;
        for (int e = tid; e < NENT; e += NTHR) { const int m = mmin + e; float v[8];
#pragma unroll
            for (int j = 0; j < 8; ++j) { const int tau = -(m + j); v[j] = (tau > -LL && tau < LL) ? KT[tau + LL] : 0.f; }
            *(LAS v4u*)(VT + (e ^ (((e >> 4) & 1) << 3)) * 16) = (v4u){pk2(v[0], v[1]), pk2(v[2], v[3]), pk2(v[4], v[5]), pk2(v[6], v[7])}; } }
    __syncthreads();
    PE(2); PB(3);
    const float* cw = F.in[11] + (size_t)l * 3 * 1152; const float* cb = F.in[12] + (size_t)l * 1152;
    const bf16* inrow = (o == 0 ? WSP(bf16, WS_VP) : WSP(bf16, WS_Z1)) + (size_t)c * MT;
    const bf16* mulrow = WSP(bf16, WS_PT) + (size_t)(R_HY + 384 * (o + 1) + c) * MT;
    bf16* outrow = o == 0 ? WSP(bf16, WS_Z1) + (size_t)c * MT : WSP(bf16, WS_PT) + (size_t)(R_HY + 384 + c) * MT;
    const int colb = GRID ? fr * L : NL + fr * LC;
    const int T0 = tbase + F.wave * NTW * 16;
    f32x4 acc[NTW];
#pragma unroll
    for (int i = 0; i < NTW; ++i) acc[i] = (f32x4){0.f, 0.f, 0.f, 0.f};
    const int E0 = 8 * fq - fr - T0 - mmin - 16 * (NTW - 1);
    const int lbA = ((E0 & ~15) | ((E0 & 15) ^ (((E0 >> 4) & 1) << 3))) * 16, lbB = lbA ^ 128;
    const bf16* bp = inrow + colb + 8 * fq;
    v4u ra[4], rb[4];
#pragma unroll
    for (int jj = 0; jj < 4; ++jj) { ra[jj] = *(const v4u*)(bp + jj * 32); rb[jj] = *(const v4u*)(bp + 128 + jj * 32); }
#define HY_GROUP(sg, R) do { bf16x8 Bf[4]; _Pragma("unroll") for (int jj = 0; jj < 4; ++jj) Bf[jj] = __builtin_bit_cast(bf16x8, R[jj]); \
        if ((sg) + 2 < NSG) { _Pragma("unroll") for (int jj = 0; jj < 4; ++jj) R[jj] = *(const v4u*)(bp + ((sg) + 2) * 128 + jj * 32); } \
        const LAS unsigned char* vtA = VT + lbA + (sg) * 2048; const LAS unsigned char* vtB = VT + lbB + (sg) * 2048; \
        bf16x8 Ar[NBUF]; \
        _Pragma("unroll") for (int q = 0; q < NBUF; ++q) Ar[q] = *(const LAS bf16x8*)((((NTW + 5 - q) & 1) ? vtB : vtA) + 256 * (NTW + 5 - q)); \
        _Pragma("unroll") for (int dd = 0; dd < ND; ++dd) { const int e = dd - 6; const bf16x8 A = Ar[dd % NBUF]; \
            _Pragma("unroll") for (int jj = 0; jj < 4; ++jj) { const int i = e + 2 * jj; if (i >= 0 && i < NTW) acc[i] = __builtin_amdgcn_mfma_f32_16x16x32_bf16(A, Bf[jj], acc[i], 0, 0, 0); } \
            if (dd + NBUF < ND) Ar[dd % NBUF] = *(const LAS bf16x8*)((((NTW + 5 - dd - NBUF) & 1) ? vtB : vtA) + 256 * (NTW + 5 - dd - NBUF)); \
            __builtin_amdgcn_sched_barrier(0); } } while (0)
    constexpr int ND = NTW + 6, NBUF = ND < 4 ? ND : 4;
#pragma unroll 1
    for (int sg = 0; sg < NSG; sg += 2) { HY_GROUP(sg, ra); HY_GROUP(sg + 1, rb); }
#undef HY_GROUP
    PE(3); PB(4);
    const float hb = F.in[20][((size_t)l * 2 + o) * 384 + c];
    const int mch = 384 * (o + 1) + c; const float m0 = cw[mch], m1 = cw[1152 + mch], m2 = cw[2304 + mch], mb = cb[mch];
    constexpr int EB = NTW;
#pragma unroll
    for (int i0 = 0; i0 < NTW; i0 += EB) {
        v2u xr[EB], ur[EB]; unsigned xl[EB], xh[EB];
#pragma unroll
        for (int q = 0; q < EB; ++q) { const int t = T0 + 16 * (i0 + q) + 4 * fq;
            const bool hl = GRID ? ((t & 63) != 0) : (t > 0), hr = GRID ? (((t + 3) & 63) != 63) : (t + 4 < LL);
            const bf16* p = mulrow + colb + t; xr[q] = *(const v2u*)p; xl[q] = hl ? (unsigned)p[-1] : 0u; xh[q] = hr ? (unsigned)p[4] : 0u;
            ur[q] = *(const v2u*)(inrow + colb + t); }
#pragma unroll
        for (int q = 0; q < EB; ++q) { const int i = i0 + q; const int t = T0 + 16 * i + 4 * fq;
            float x[6], u[4];
            x[0] = bf2f((unsigned short)xl[q]); x[5] = bf2f((unsigned short)xh[q]); x[1] = bf2f(xr[q].x & 0xffffu); x[2] = bf2f(xr[q].x >> 16); x[3] = bf2f(xr[q].y & 0xffffu); x[4] = bf2f(xr[q].y >> 16);
            u[0] = bf2f(ur[q].x & 0xffffu); u[1] = bf2f(ur[q].x >> 16); u[2] = bf2f(ur[q].y & 0xffffu); u[3] = bf2f(ur[q].y >> 16);
            float ov[4];
#pragma unroll
            for (int r = 0; r < 4; ++r) { const float xm = x[r] * m0 + x[r + 1] * m1 + x[r + 2] * m2 + mb; ov[r] = xm * (acc[i][r] + hb * u[r]); }
            *(v2u*)(outrow + colb + t) = (v2u){pk2(ov[0], ov[1]), pk2(ov[2], ov[3])}; }
    }
    __syncthreads();
    PE(4);
}
__device__ __forceinline__ void shortconv_v(Frame& F_, int l) { Frame F = relocal(F_);
    const float* cw = F.in[11] + (size_t)l * 3 * 1152; const float* cb = F.in[12] + (size_t)l * 1152;
    const int ncol8 = (l == 0 ? MT : NL) / 8; const long total = (long)384 * ncol8;
    const long stride = (long)F.G * NTHR;
    for (long it0 = (long)F.vcu * NTHR + F.tid; it0 < total; it0 += 2 * stride) {
        v4u raw[2]; unsigned lft[2], rgt[2]; int cc[2], colv[2]; bool ok[2];
#pragma unroll
        for (int q = 0; q < 2; ++q) { const long it = it0 + q * stride; ok[q] = it < total; cc[q] = 0; colv[q] = 0; raw[q] = (v4u){0u, 0u, 0u, 0u}; lft[q] = 0u; rgt[q] = 0u;
            if (ok[q]) { const int c = (int)(it / ncol8), col = (int)(it % ncol8) * 8; cc[q] = c; colv[q] = col;
                const bf16* p = WSP(bf16, WS_PT) + (size_t)(R_HY + c) * MT + col;
                bool hl, hr; if (col < NL) { hl = (col & 63) != 0; hr = ((col + 7) & 63) != 63; } else { const int t = (col - NL) & (LC - 1); hl = t != 0; hr = t + 8 < LC; }
                raw[q] = *(const v4u*)p; lft[q] = hl ? (unsigned)p[-1] : 0u; rgt[q] = hr ? (unsigned)p[8] : 0u; } }
#pragma unroll
        for (int q = 0; q < 2; ++q) if (ok[q]) { const int c = cc[q]; float qv[10]; qv[0] = bf2f((unsigned short)lft[q]); qv[9] = bf2f((unsigned short)rgt[q]);
            qv[1] = bf2f(raw[q].x & 0xffffu); qv[2] = bf2f(raw[q].x >> 16); qv[3] = bf2f(raw[q].y & 0xffffu); qv[4] = bf2f(raw[q].y >> 16); qv[5] = bf2f(raw[q].z & 0xffffu); qv[6] = bf2f(raw[q].z >> 16); qv[7] = bf2f(raw[q].w & 0xffffu); qv[8] = bf2f(raw[q].w >> 16);
            const float w0 = cw[c], w1 = cw[1152 + c], w2 = cw[2304 + c], bs = cb[c]; float r[8];
#pragma unroll
            for (int j = 0; j < 8; ++j) r[j] = qv[j] * w0 + qv[j + 1] * w1 + qv[j + 2] * w2 + bs;
            *(v4u*)(WSP(bf16, WS_VP) + (size_t)c * MT + colv[q]) = (v4u){pk2(r[0], r[1]), pk2(r[2], r[3]), pk2(r[4], r[5]), pk2(r[6], r[7])}; } }
}
__device__ __forceinline__ void hyena_stage(Frame& F_, int l, int o) { Frame F = relocal(F_);
    const int nlat = 384 * 2, nctx = l == 0 ? 384 : 0;
    for (int u = F.vcu; u < nlat + nctx; u += F.G) {
        if (u < nlat) hyena_job<L, 16, true>(F, l, o, u >> 1, (u & 1) * 2048);
        else hyena_job<LC, 2, false>(F, l, o, u - nlat, 0);
    }
}
__device__ __forceinline__ void hyena_transpose(Frame& F_, int nrows) { Frame F = relocal(F_);
    LAS bf16* T = (LAS bf16*)F.lds; constexpr int PITCH = 258;
    const bf16* PT = WSP(bf16, WS_PT); bf16* Y = WSP(bf16, WS_HMOD); const int tid = F.tid;
    const int nrt = nrows / 256;
    for (int it = F.vcu; it < 6 * nrt; it += F.G) { const int cb = it % 6, rt = it / 6;
        { const int c = tid >> 3, seg = tid & 7; const bf16* src = PT + (size_t)(R_HY + 384 + cb * 64 + c) * MT + rt * 256 + seg * 32;
#pragma unroll
          for (int q = 0; q < 4; ++q) { const v4u v = *(const v4u*)(src + q * 8); LAS unsigned* d = (LAS unsigned*)(T + c * PITCH + seg * 32 + q * 8); d[0] = v.x; d[1] = v.y; d[2] = v.z; d[3] = v.w; } }
        __syncthreads();
        { const int r = tid >> 1, half = tid & 1; unsigned w[16];
#pragma unroll
          for (int q = 0; q < 16; ++q) { const unsigned lo = T[(half * 32 + 2 * q) * PITCH + r], hi = T[(half * 32 + 2 * q + 1) * PITCH + r]; w[q] = lo | (hi << 16); }
          bf16* dst = Y + (size_t)(rt * 256 + r) * D + 256 + cb * 64 + half * 32;
#pragma unroll
          for (int q = 0; q < 4; ++q) *(v4u*)(dst + q * 8) = (v4u){w[4 * q], w[4 * q + 1], w[4 * q + 2], w[4 * q + 3]}; }
        __syncthreads();
    }
}

__device__ __forceinline__ void s5_carry_item(Frame& F, int l, int item) {
    const float* E = (const float*)((unsigned char*)F.out + DO_E); bf16* HS = (bf16*)((unsigned char*)F.out + DO_HS);
    const int id = item * NTHR + F.tid;
    const int p = id & 63, dir = (id >> 6) & 1, g = (id >> 7) % 24, b = id / (128 * 24);
    const size_t ix = (((size_t)l * 2 + dir) * 24 + g) * 64 + p; const float ar = WSP(float, WS_A16)[ix * 2], ai = WSP(float, WS_A16)[ix * 2 + 1];
    const int comp = dir * 128 + 2 * p, q = comp >> 4, i0 = comp & 15;
    float sr = 0.f, si = 0.f;
#pragma unroll 1
    for (int s0 = 0; s0 < 272; s0 += 8) { f32x2 e[8]; int ci[8];
#pragma unroll
        for (int j = 0; j < 8; ++j) { const int step = s0 + j; int cidx;
            if (dir == 0) cidx = step < 16 ? NL / 16 + b * 16 + step : b * 256 + (step - 16);
            else cidx = step < 16 ? NL / 16 + b * 16 + (15 - step) : b * 256 + (255 - (step - 16));
            ci[j] = cidx; e[j] = *(const f32x2*)(E + ((size_t)g * NCHUNK + cidx) * 256 + comp); }
#pragma unroll
        for (int j = 0; j < 8; ++j) { *(unsigned*)(HS + (size_t)(g * 16 + q) * MT + (size_t)ci[j] * 16 + i0) = pk2(sr, si);
            const float nr = ar * sr - ai * si + e[j].x, ni = ar * si + ai * sr + e[j].y; sr = nr; si = ni; } }
}
__device__ __forceinline__ void hyena_stage2_carry(Frame& F_, int l) { Frame F = relocal(F_);
    const int ncar = 96, nlat = 384 * 2, nctx = l == 0 ? 384 : 0, qid = 1 + l;
    for (int u = wq_next(F, qid); u < ncar + nlat + nctx; u = wq_next(F, qid)) {
        if (u < ncar) s5_carry_item(F, l, u);
        else if (u < ncar + nlat) hyena_job<L, 16, true>(F, l, 1, (u - ncar) >> 1, ((u - ncar) & 1) * 2048);
        else hyena_job<LC, 2, false>(F, l, 1, u - ncar - nlat, 0);
    }
}

struct A_WinT { const bf16* w; __device__ __forceinline__ const bf16* operator()(int, int r, int k) const { return w + (size_t)r * D + k; } };
struct E_PT { bf16* pt; __device__ __forceinline__ void operator()(int, int r, int c, f32x4 v0, f32x4 v1) const {
    *(v2u*)(pt + (size_t)r * MT + c) = (v2u){pk2(v0.x, v0.y), pk2(v0.z, v0.w)}; *(v2u*)(pt + (size_t)r * MT + c + 16) = (v2u){pk2(v1.x, v1.y), pk2(v1.z, v1.w)}; } };
struct A_Dft { const bf16* d; int ld; __device__ __forceinline__ const bf16* operator()(int, int r, int k) const { return d + (size_t)r * ld + k; } };
struct B_FnetLat { const bf16* pt; __device__ __forceinline__ const bf16* operator()(int bt, int n, int k) const { return pt + (size_t)((k >> 12) * 256 + n) * MT + bt * L + (k & 4095); } };
struct B_FnetCtx { const bf16* pt; __device__ __forceinline__ const bf16* operator()(int bt, int n, int k) const { return pt + (size_t)((k >> 8) * 256 + n) * MT + NL + bt * LC + (k & 255); } };
struct E_FA { bf16* ab; __device__ __forceinline__ void one(int m, int c, f32x4 v) const { const int b = c >> 14, n = (c >> 6) & 255, s2 = c & 63, pp = m >> 6, t1 = m & 63;
    *(v2u*)(ab + ((((size_t)b * 256 + n) * 64 + t1) * 2 + pp) * 64 + s2) = (v2u){pk2(v.x, v.y), pk2(v.z, v.w)}; }
    __device__ __forceinline__ void operator()(int, int m, int c, f32x4 v0, f32x4 v1) const { if (m >= 128) return; one(m, c, v0); one(m, c + 16, v1); } };
struct E_FB { bf16* y; __device__ __forceinline__ void operator()(int bt, int r, int c, f32x4 v0, f32x4 v1) const { const int t = 4 * (r >> 8) + ((r >> 6) & 3) + 64 * (r & 63);
    bf16* p = y + ((size_t)bt * L + t) * D + c; *(v2u*)p = (v2u){pk2(v0.x, v0.y), pk2(v0.z, v0.w)}; *(v2u*)(p + 16) = (v2u){pk2(v1.x, v1.y), pk2(v1.z, v1.w)}; } };
struct E_Fnet { bf16* y; int rowbase, rows_per; __device__ __forceinline__ void operator()(int bt, int r, int c, f32x4 v0, f32x4 v1) const { bf16* p = y + (size_t)(rowbase + bt * rows_per + r) * D + c;
    *(v2u*)p = (v2u){pk2(v0.x, v0.y), pk2(v0.z, v0.w)}; *(v2u*)(p + 16) = (v2u){pk2(v1.x, v1.y), pk2(v1.z, v1.w)}; } };
struct A_S5 { const bf16* pt; const bf16* hs; __device__ __forceinline__ const bf16* operator()(int g, int r, int k) const {
    return k < 256 ? pt + (size_t)(R_S5 + g * 16 + (k >> 4)) * MT + (size_t)r * 16 + (k & 15) : hs + (size_t)(g * 16 + ((k - 256) >> 4)) * MT + (size_t)r * 16 + (k & 15); } };
struct B_S5 { const bf16* m; int off, ld; __device__ __forceinline__ const bf16* operator()(int g, int n, int k) const { return (const bf16*)((const unsigned char*)m + (size_t)g * S5M_STRIDE) + off + (size_t)n * ld + k; } };
struct E_S5E { float* e; __device__ __forceinline__ void operator()(int g, int r, int c, f32x4 v0, f32x4 v1) const { float* p = e + ((size_t)g * NCHUNK + r) * 256 + c; *(f32x4*)p = v0; *(f32x4*)(p + 16) = v1; } };
struct E_S5O { bf16* ys; __device__ __forceinline__ void operator()(int g, int r, int c, f32x4 v0, f32x4 v1) const {
    { const int j = c >> 4, h = c & 15; bf16* p = ys + ((size_t)r * 16 + j) * 384 + g * 16 + h; *(v2u*)p = (v2u){pk2(gelu_tanh_f(v0.x), gelu_tanh_f(v0.y)), pk2(gelu_tanh_f(v0.z), gelu_tanh_f(v0.w))}; }
    { const int c1 = c + 16, j = c1 >> 4, h = c1 & 15; bf16* p = ys + ((size_t)r * 16 + j) * 384 + g * 16 + h; *(v2u*)p = (v2u){pk2(gelu_tanh_f(v1.x), gelu_tanh_f(v1.y)), pk2(gelu_tanh_f(v1.z), gelu_tanh_f(v1.w))}; } } };
struct E_Glu { const bf16* ys; bf16* y; const float* gb;
    struct Pre { v2u y0, y1; f32x4 b0, b1; };
    __device__ __forceinline__ Pre pre(int, int r, int c) const { Pre p; p.y0 = (v2u){0u, 0u}; p.y1 = p.y0; p.b0 = (f32x4){0.f, 0.f, 0.f, 0.f}; p.b1 = p.b0;
        if (c < 384) { p.y0 = *(const v2u*)(ys + (size_t)r * 384 + c); p.b0 = *(const f32x4*)(gb + c); } if (c + 16 < 384) { p.y1 = *(const v2u*)(ys + (size_t)r * 384 + c + 16); p.b1 = *(const f32x4*)(gb + c + 16); } return p; }
    __device__ __forceinline__ void one(int r, int c, v2u yv, f32x4 b, f32x4 v) const { if (c >= 384) return;
        const float y0 = bf2f(yv.x & 0xffffu), y1 = bf2f(yv.x >> 16), y2 = bf2f(yv.y & 0xffffu), y3 = bf2f(yv.y >> 16);
        *(v2u*)(y + (size_t)r * D + 640 + c) = (v2u){pk2(y0 * sigmoid_f(v.x + b.x), y1 * sigmoid_f(v.y + b.y)), pk2(y2 * sigmoid_f(v.z + b.z), y3 * sigmoid_f(v.w + b.w))}; }
    __device__ __forceinline__ void post(const Pre& p, int, int r, int c, f32x4 v0, f32x4 v1) const { one(r, c, p.y0, p.b0, v0); one(r, c + 16, p.y1, p.b1, v1); } };
template <bool XI16, bool XO16> struct E_Res {
    static constexpr bool RMW = true; const void* xlat; const void* xctx; void* xo; const float* mod; int goff;
    struct Pre { f32x4 x0, x1, g0, g1; };
    __device__ __forceinline__ static f32x4 ld4(const void* base, size_t idx) { if (XI16) { const v2u u = *(const v2u*)((const bf16*)base + idx); return (f32x4){bf2f(u.x & 0xffffu), bf2f(u.x >> 16), bf2f(u.y & 0xffffu), bf2f(u.y >> 16)}; } else return *(const f32x4*)((const float*)base + idx); }
    __device__ __forceinline__ Pre pre(int, int r, int c) const { Pre p; const float* g = mod + (size_t)bidx_of(r) * 6144 + goff + c;
        const void* xb = r < NL ? xlat : xctx; const size_t idx = (size_t)(r < NL ? r : r - NL) * D + c;
        p.x0 = ld4(xb, idx); p.x1 = ld4(xb, idx + 16); p.g0 = *(const f32x4*)g; p.g1 = *(const f32x4*)(g + 16); return p; }
    __device__ __forceinline__ void post(const Pre& p, int, int r, int c, f32x4 v0, f32x4 v1) const { const f32x4 o0 = p.x0 + p.g0 * v0, o1 = p.x1 + p.g1 * v1; const size_t idx = (size_t)r * D + c;
        if (XO16) { *(v2u*)((bf16*)xo + idx) = (v2u){pk2(o0.x, o0.y), pk2(o0.z, o0.w)}; *(v2u*)((bf16*)xo + idx + 16) = (v2u){pk2(o1.x, o1.y), pk2(o1.z, o1.w)}; }
        else { *(f32x4*)((float*)xo + idx) = o0; *(f32x4*)((float*)xo + idx + 16) = o1; } } };
struct E_Swi { bf16* act; int ld; __device__ __forceinline__ void operator()(int, int r, int c, f32x4 v0, f32x4 v1) const {
    const int f = 16 * (c >> 5) + (c & 15); *(v2u*)(act + tiled_idx(r, f, ld / 64)) = (v2u){pk2(silu_f(v0.x) * v1.x, silu_f(v0.y) * v1.y), pk2(silu_f(v0.z) * v1.z, silu_f(v0.w) * v1.w)}; } };
struct A_MoeUp { const bf16* h; const int* idx; __device__ __forceinline__ const bf16* operator()(int, int r, int k) const { int t = idx[r]; t = t < 0 ? 0 : t; return h + (size_t)t * D + k; } };
struct E_MoeDown { static constexpr bool RMW = true; float* x; const int* idx; const unsigned char* topk; const float* mod; int k;
    struct Pre { f32x4 x0, x1, g0, g1; int t; float w; };
    __device__ __forceinline__ Pre pre(int, int r, int c) const { Pre p; p.t = idx[r]; const int tt = p.t < 0 ? 0 : p.t; p.w = *(const float*)(topk + (size_t)tt * 16 + 4 + 4 * k);
        const float* g = mod + (size_t)(tt >> 12) * 6144 + 5120 + c; const float* xi = x + (size_t)tt * D + c;
        p.x0 = *(const f32x4*)xi; p.x1 = *(const f32x4*)(xi + 16); p.g0 = *(const f32x4*)g; p.g1 = *(const f32x4*)(g + 16); return p; }
    __device__ __forceinline__ void post(const Pre& p, int, int r, int c, f32x4 v0, f32x4 v1) const { if (p.t < 0) return; float* o = x + (size_t)p.t * D + c;
        *(f32x4*)o = p.x0 + p.g0 * (v0 * p.w); *(f32x4*)(o + 16) = p.x1 + p.g1 * (v1 * p.w); } };

template <class AF, class EP>
__device__ __forceinline__ void gemm_moe(int mtiles, int ntiles, int K, const AF& af, const unsigned char* wbase, size_t woff, int ldb, const int* te, const EP& ep, int vcu, int G) {
    int tid = threadIdx.x; asm volatile("" : "+v"(tid)); asm volatile("" : "+s"(vcu)); const int wid = tid >> 6, lane = tid & 63, wr = wid >> 2, wc = wid & 3, fr = lane & 15, fq = lane >> 4;
    const int nunits = mtiles * ntiles;
    for (int u = vcu; u < nunits; u += G) {
        const int pm = u / ntiles, pn = u - pm * ntiles;
        const int row0 = pm * 128 + wr * 64, col0 = pn * 128 + wc * 32;
        const bf16* B = (const bf16*)(wbase + (size_t)te[pm >> 1] * MOE_E_STRIDE + woff);
        f32x4 acc[4][2];
#pragma unroll
        for (int m = 0; m < 4; ++m) { acc[m][0] = (f32x4){0.f, 0.f, 0.f, 0.f}; acc[m][1] = (f32x4){0.f, 0.f, 0.f, 0.f}; }
#pragma unroll 2
        for (int k = 0; k < K; k += 32) {
            bf16x8 a[4], b[2];
#pragma unroll
            for (int m = 0; m < 4; ++m) a[m] = *(const bf16x8*)af(0, row0 + m * 16 + fr, k + fq * 8);
#pragma unroll
            for (int n = 0; n < 2; ++n) b[n] = *(const bf16x8*)(B + (size_t)(col0 + n * 16 + fr) * ldb + k + fq * 8);
#pragma unroll
            for (int m = 0; m < 4; ++m)
#pragma unroll
                for (int n = 0; n < 2; ++n) acc[m][n] = __builtin_amdgcn_mfma_f32_16x16x32_bf16(b[n], a[m], acc[m][n], 0, 0, 0);
        }
#pragma unroll
        for (int m = 0; m < 4; ++m) ep(0, row0 + m * 16 + fr, col0 + 4 * fq, acc[m][0], acc[m][1]);
    }
}

__device__ __forceinline__ Frame mkframe(const Args& args, unsigned char* ldsp, int wv) {
    Frame F; F.lds = (LAS unsigned char*)ldsp;
    const int t = tid_of(wv); F.tid = t; F.lane = t & 63; F.wave = wv;
    int g = gridDim.x, bx = blockIdx.x; asm volatile("" : "+s"(g), "+s"(bx)); F.G = g; F.vcu = (g % 8 == 0) ? (bx % 8) * (g / 8) + bx / 8 : bx;
    unsigned char* w = args.ws; float* o = args.out; asm volatile("" : "+s"(w), "+s"(o)); F.ws = w; F.out = o; F.in = args.in;
    return F;
}
__global__ void __launch_bounds__(NTHR, 2) mega(Args args) {
    extern __shared__ __attribute__((aligned(16))) unsigned char lds[];
    volatile LAS unsigned* MISC = (volatile LAS unsigned*)((LAS unsigned char*)lds + LDS_MISC);
    const int wv = __builtin_amdgcn_readfirstlane((int)threadIdx.x >> 6);
    if (threadIdx.x < 32) MISC[threadIdx.x] = 0u;
    __syncthreads();
    XcdBarrier bar; bar.bar = (unsigned*)(args.ws + WS_CTL) + 4096; bar.x = 0; bar.st = nullptr; bar.wv = wv;
    const int lo = args.ph_lo, hi = args.ph_hi;
    if (hi - lo > 1) bar = xcd_barrier_post((unsigned*)(args.ws + WS_CTL) + 4096, MISC + 8, wv);
#define IN(k) (lo <= (k) && (k) < hi)
#define SEAM(k) do { if (IN(k) && IN((k) + 1)) xcd_barrier(bar); } while (0)
#if PROBE_SEL >= 100
#define PBG(k) do { if (PROBE_SEL == 100 + (k)) prb_b((LAS unsigned char*)lds, tid_of(wv)); } while (0)
#define PEG(k) do { if (PROBE_SEL == 100 + (k)) prb_e((LAS unsigned char*)lds, tid_of(wv)); } while (0)
#else
#define PBG(k) do { } while (0)
#define PEG(k) do { } while (0)
#endif
#define PHF Frame F = mkframe(args, lds, wv); const int bxi = (int)blockIdx.x; (void)bxi
#define P_MOD (WSP(float, WS_MOD) + (size_t)l * 17 * 6144)
#define P_HM WSP(bf16, WS_HMOD)
#define P_PT WSP(bf16, WS_PT)
#define P_XB WSP(bf16, WS_BUFA)
#define P_E ((float*)((unsigned char*)F.out + DO_E))
#define P_HS ((bf16*)((unsigned char*)F.out + DO_HS))
#define P_YS ((bf16*)((unsigned char*)F.out + DO_YS))

    PBG(PH_P0); if (IN(PH_P0)) { PHF; p0_prologue(F); } SEAM(PH_P0); PEG(PH_P0);
    PBG(PH_P1); if (IN(PH_P1)) { PHF; for (int it = F.vcu; it < 2 * 2 * 24 * 4; it += F.G) p1_item(F, it); } SEAM(PH_P1); PEG(PH_P1);

#pragma unroll 1
    for (int l = 0; l < 2; ++l) {
        const int pb = PH_L + l * PH_PER;
        PBG(pb + S_NORM1); if (IN(pb + S_NORM1)) { PHF;
            if (l == 0) norm_rows(F, F.in[0], F.in[2], MT, F.in[6], P_MOD, 0, 1024, P_HM); else norm_rows_b16(F, P_XB, MT, F.in[6] + D, P_MOD, 0, 1024, P_HM); }
        SEAM(pb + S_NORM1); PEG(pb + S_NORM1);
        PBG(pb + S_G1); if (IN(pb + S_G1)) { PHF; const char* wt = (const char*)(WSP(bf16, WS_WIN) + (size_t)l * PTROWS * D);
            {
                g8::OpRow<true> oa{wt, D * 2, 0}; g8::OpPermB ob{(const char*)P_HM}; g8::Order S; S.init(1, 2, NL / 256, F.G, bxi); E_PT ep{P_PT};
                g8::gemm8(F.lds, F.wave, D / 64, oa, ob, S, ep); }
            int rot = 0;
            if (l == 0) {
                g8::OpRow<true> oa{wt, D * 2, 0}; g8::OpRow<false> ob{(const char*)(P_HM + (size_t)NL * D), D * 2, 0}; g8::Order S; S.init(1, 2, NCX / 256, F.G, bxi); E_PT ep{P_PT + NL};
                g8::gemm8(F.lds, F.wave, D / 64, oa, ob, S, ep); rot = 32; }
            {
                g8::OpRow<true> oa{wt + (size_t)512 * D * 2, D * 2, 0}; g8::OpRow<false> ob{(const char*)P_HM, D * 2, 0}; g8::Order S; S.init(1, 6, MT / 256, F.G, bxi, rot); E_PT ep{P_PT + (size_t)512 * MT};
                g8::gemm8(F.lds, F.wave, D / 64, oa, ob, S, ep); } }
        SEAM(pb + S_G1); PEG(pb + S_G1);
        PBG(pb + S_FNET); if (IN(pb + S_FNET)) { PHF; shortconv_v(F, l);
            {
                g8::OpRow<true> oa{(const char*)WSP(bf16, WS_FAW), 128 * 2, 0}; g8::OpFA ob{(const char*)P_PT}; g8::Order S; S.init(1, 1, 1024, F.G, bxi); E_FA ep{WSP(bf16, WS_ABUF)};
                g8::gemm8(F.lds, F.wave, 2, oa, ob, S, ep); }
            if (l == 0) { g8::OpRow<true> oa{(const char*)WSP(bf16, WS_DFTC), 2 * LC * 2, 0}; g8::OpFnetB ob{(const char*)(P_PT + NL), LC * 2, 2}; g8::Order S; S.init(NB, 1, 1, F.G, bxi);
              E_Fnet ep{P_HM, NL, LC}; g8::gemm8(F.lds, F.wave, 2 * LC / 64, oa, ob, S, ep); }
            {
                E_S5E ep{P_E}; g8::OpS5A oa{(const char*)(P_PT + (size_t)R_S5 * MT), (const char*)P_HS - (const char*)(P_PT + (size_t)R_S5 * MT)}; g8::OpRow<false> ob{(const char*)(F.ws + WS_S5M + (size_t)l * 24 * S5M_STRIDE), 256 * 2, (long)S5M_STRIDE};
                g8::Order S; S.init(24, NCHUNK / 256, 1, F.G, bxi, l == 0 ? 16 : 0); g8::gemm8(F.lds, F.wave, 4, oa, ob, S, ep); } }
        SEAM(pb + S_FNET); PEG(pb + S_FNET);
        { PHF; PB(1); } PBG(pb + S_HY1); if (IN(pb + S_HY1)) { PHF;
            {
                g8::OpRow<true> oa{(const char*)WSP(bf16, WS_FBW), 512 * 2, 0}; g8::OpFB ob{(const char*)WSP(bf16, WS_ABUF)}; g8::Order S; S.init(NB, 16, 1, F.G, bxi); E_FB ep{P_HM};
                g8::gemm8(F.lds, F.wave, 8, oa, ob, S, ep); }
            hyena_stage(F, l, 0); }
        SEAM(pb + S_HY1); PEG(pb + S_HY1); { PHF; PE(1); }
        { PHF; PB(1); } PBG(pb + S_HY2); if (IN(pb + S_HY2)) { PHF; hyena_stage2_carry(F, l); }
        SEAM(pb + S_HY2); PEG(pb + S_HY2); { PHF; PE(1); }
        PBG(pb + S_S5O); if (IN(pb + S_S5O)) { PHF; E_S5O ep{P_YS};
            g8::OpS5A oa{(const char*)(P_PT + (size_t)R_S5 * MT), (const char*)P_HS - (const char*)(P_PT + (size_t)R_S5 * MT)}; g8::OpRow<false> ob{(const char*)(F.ws + WS_S5M + (size_t)l * 24 * S5M_STRIDE) + 256 * 256 * 2, 512 * 2, (long)S5M_STRIDE};
            g8::Order S; S.init(24, NCHUNK / 256, 1, F.G, bxi); g8::gemm8(F.lds, F.wave, 8, oa, ob, S, ep); }
        SEAM(pb + S_S5O); PEG(pb + S_S5O);
        PBG(pb + S_GLU); if (IN(pb + S_GLU)) { PHF; E_Glu ep{P_YS, P_HM, F.in[30] + l * 384};
            g8::OpRow<true> oa{(const char*)P_YS, 384 * 2, 0}; g8::OpRow<false> ob{(const char*)(WSP(bf16, WS_GLU) + (size_t)l * 512 * 384), 384 * 2, 0}; g8::Order S; S.init(1, MT / 256, 2, F.G, bxi);
            g8::gemm8(F.lds, F.wave, 6, oa, ob, S, ep);
            hyena_transpose(F, l == 0 ? MT : NL); }
        SEAM(pb + S_GLU); PEG(pb + S_GLU);
        PBG(pb + S_WOUT); if (IN(pb + S_WOUT)) { PHF;
            g8::OpRow<true> oa{(const char*)P_HM, D * 2, 0}; g8::OpRow<false> ob{(const char*)(WSP(bf16, WS_WOUT) + (size_t)l * D * D), D * 2, 0}; g8::Order S; S.init(1, (l == 0 ? MT : NL) / 256, D / 256, F.G, bxi);
            if (l == 0) { E_Res<false, true> ep{F.in[0], F.in[2], P_XB, P_MOD, 2048}; g8::gemm8(F.lds, F.wave, D / 64, oa, ob, S, ep, STAG(1000)); }
            else { E_Res<true, false> ep{P_XB, P_XB + (size_t)NL * D, F.out, P_MOD, 2048}; g8::gemm8(F.lds, F.wave, D / 64, oa, ob, S, ep, STAG(1000)); } }
        SEAM(pb + S_WOUT); PEG(pb + S_WOUT);
        if (l == 0) {
            PBG(pb + S_NORM2); if (IN(pb + S_NORM2)) { PHF; norm_rows_b16(F, P_XB, MT, F.in[7], P_MOD, 3072, 4096, P_HM); }
            SEAM(pb + S_NORM2); PEG(pb + S_NORM2);
            PBG(pb + S_F0); if (IN(pb + S_F0)) { PHF; E_Swi ep{WSP(bf16, WS_ACT), DFF};
                g8::OpRow<true> oa{(const char*)P_HM, D * 2, 0}; g8::OpRow<false> ob{(const char*)WSP(bf16, WS_FGU), D * 2, 0}; g8::Order S; S.init(1, MT / 256, 2 * DFF / 256, F.G, bxi);
                g8::gemm8<UP_ALIGN>(F.lds, F.wave, D / 64, oa, ob, S, ep, STAG(750)); }
            SEAM(pb + S_F0); PEG(pb + S_F0);
            PBG(pb + S_F1); if (IN(pb + S_F1)) { PHF; E_Res<true, true> ep{P_XB, P_XB + (size_t)NL * D, P_XB, P_MOD, 5120};
                g8::OpTiled<true> oa{(const char*)WSP(bf16, WS_ACT), DFF / 64}; g8::OpTiled<false> ob{(const char*)WSP(bf16, WS_FD), DFF / 64}; g8::Order S; S.init(1, MT / 256, D / 256, F.G, bxi);
                g8::gemm8(F.lds, F.wave, DFF / 64, oa, ob, S, ep, STAG(2200)); }
            SEAM(pb + S_F1); PEG(pb + S_F1);
        } else {
            PBG(pb + S_NORM2); if (IN(pb + S_NORM2)) { PHF; norm2_router(F, F.out, F.in[7] + D, P_MOD, P_HM); moe_transposes(F); }
            SEAM(pb + S_NORM2); PEG(pb + S_NORM2);
            PBG(pb + S_F0); if (IN(pb + S_F0)) { PHF; moe_slots(F); }
            SEAM(pb + S_F0); PEG(pb + S_F0);
#pragma unroll 1
            for (int k = 0; k < 2; ++k) {
#pragma unroll 1
                for (int seg = 0; seg < 3; ++seg) {
                    PBG(pb + S_F1 + 2 * k); if (IN(pb + S_F1 + 2 * k)) { PHF; const int* IDX = (const int*)(F.ws + WS_META + META_IDX) + k * MAXSLOT; const int* TE = (const int*)(F.ws + WS_META + META_TE) + k * 272; const int nt = __builtin_amdgcn_readfirstlane(((const int*)(F.ws + WS_META + META_NT))[k]);
                        const int nseg = seg < 2 ? 128 : nt - 256;
                        if (nseg > 0) { E_Swi ep{WSP(bf16, WS_ACT2), DFE};
                            LAS int* tel = (LAS int*)(F.lds + LDS_MISC + 1024); if (F.tid < 272) tel[F.tid] = TE[F.tid]; __syncthreads();
                            g8::OpMoeA oa{(const char*)P_HM, IDX}; g8::OpMoeB ob{(const char*)(F.ws + WS_MOEW), tel, D * 2}; g8::Order S; S.init(1, nseg, 2 * DFE / 256, F.G, bxi); S.pm_off = 128 * seg;
                            g8::gemm8<UP_ALIGN>(F.lds, F.wave, D / 64, oa, ob, S, ep, STAG(750)); } }
                    SEAM(pb + S_F1 + 2 * k); PEG(pb + S_F1 + 2 * k);
                    if (k == 1 && seg == 2) break;
                    PBG(pb + S_F2 + 2 * k); if (IN(pb + S_F2 + 2 * k)) { PHF; const int* IDX = (const int*)(F.ws + WS_META + META_IDX) + k * MAXSLOT; const int* TE = (const int*)(F.ws + WS_META + META_TE) + k * 272; const int nt = __builtin_amdgcn_readfirstlane(((const int*)(F.ws + WS_META + META_NT))[k]);
                        const int nseg = seg < 2 ? 128 : nt - 256;
                        if (nseg > 0) { E_MoeDown ep{F.out, IDX, F.ws + WS_TOPK, P_MOD, k};
                            LAS int* tel = (LAS int*)(F.lds + LDS_MISC + 1024); if (F.tid < 272) tel[F.tid] = TE[F.tid]; __syncthreads();
                            g8::OpTiled<true> oa{(const char*)WSP(bf16, WS_ACT2), DFE / 64}; g8::OpMoeBT ob{(const char*)(F.ws + WS_MOEW + MOE_GU_BYTES), tel, DFE / 64}; g8::Order S; S.init(1, nseg, D / 256, F.G, bxi); S.pm_off = 128 * seg;
                            g8::gemm8(F.lds, F.wave, DFE / 64, oa, ob, S, ep, STAG(2700)); } }
                    SEAM(pb + S_F2 + 2 * k); PEG(pb + S_F2 + 2 * k);
                }
            }
            PBG(pb + S_F5); if (IN(pb + S_F5)) { PHF; const int k = 1; const int* IDX = (const int*)(F.ws + WS_META + META_IDX) + k * MAXSLOT; const int* TE = (const int*)(F.ws + WS_META + META_TE) + k * 272; const int nt = __builtin_amdgcn_readfirstlane(((const int*)(F.ws + WS_META + META_NT))[k]);
                const int ntl = nt - 256, ntw = ntl * (D / 256);
                if (ntl > 0) { E_MoeDown ep{F.out, IDX, F.ws + WS_TOPK, P_MOD, k};
                    LAS int* tel = (LAS int*)(F.lds + LDS_MISC + 1024); if (F.tid < 272) tel[F.tid] = TE[F.tid]; __syncthreads();
                    g8::OpTiled<true> oa{(const char*)WSP(bf16, WS_ACT2), DFE / 64}; g8::OpMoeBT ob{(const char*)(F.ws + WS_MOEW + MOE_GU_BYTES), tel, DFE / 64}; g8::Order S; S.init(1, ntl, D / 256, F.G, bxi); S.pm_off = 256;
                    g8::gemm8(F.lds, F.wave, DFE / 64, oa, ob, S, ep); }
                final_norm_part(F, 0, ntw); }
            SEAM(pb + S_F5); PEG(pb + S_F5);
            PBG(pb + S_F6); if (IN(pb + S_F6)) { PHF; final_norm_part(F, 1, 0); } PEG(pb + S_F6);
        }
    }
#if PROBE_SEL >= 0
    if (blockIdx.x == PROBE_BLK && tid_of(wv) == 0) { const unsigned long long want = *(volatile LAS unsigned long long*)((LAS unsigned char*)lds + LDS_MISC + 72), t0 = __builtin_amdgcn_s_memrealtime();
        while (__builtin_amdgcn_s_memrealtime() - t0 < want) __builtin_amdgcn_s_sleep(8); }
#endif
#undef IN
#undef SEAM
}

extern "C" void kernel_launch(void* const* d_in, const int* in_sizes, int n_in, void* d_out, int out_size, void* d_ws, size_t ws_size, hipStream_t stream) {
    static int grid = 0;
    if (grid == 0) {
        if (n_in != 40 || out_size != NL * D || ws_size < WS_END) { fprintf(stderr, "kernel_launch: unexpected shapes n_in %d out %d ws %zu (need %zu)\n", n_in, out_size, ws_size, (size_t)WS_END); grid = -1; return; }
        int dev = 0, cus = 0, per_cu = 0;
        if (hipGetDevice(&dev) != hipSuccess || hipDeviceGetAttribute(&cus, hipDeviceAttributeMultiprocessorCount, dev) != hipSuccess) { grid = -1; return; }
        if (hipFuncSetAttribute((const void*)mega, hipFuncAttributeMaxDynamicSharedMemorySize, LDS_BYTES) != hipSuccess) { fprintf(stderr, "kernel_launch: hipFuncSetAttribute failed\n"); grid = -1; return; }
        if (hipOccupancyMaxActiveBlocksPerMultiprocessor(&per_cu, (const void*)mega, NTHR, LDS_BYTES) != hipSuccess || per_cu < 1) fprintf(stderr, "kernel_launch: occupancy query says %d\n", per_cu);
        (void)hipGetLastError();
        grid = cus;
    }
    if (grid < 0) return;
    (void)hipMemsetAsync((char*)d_ws + WS_CTL, 0, CTL_ZERO_BYTES, stream);
    Args a{};
    for (int i = 0; i < 40; ++i) a.in[i] = (const float*)d_in[i];
    a.out = (float*)d_out; a.ws = (unsigned char*)d_ws;
#if MK_ONE_LAUNCH
    a.ph_lo = 0; a.ph_hi = N_PHASES;
    hipLaunchKernelGGL(mega, dim3(grid), dim3(NTHR), LDS_BYTES, stream, a);
#else
    for (int ph = 0; ph < N_PHASES; ++ph) {
        const int s = ph - PH_L;
        if (ph >= PH_L && s < PH_PER && s > S_F1) continue;
        if (ph >= PH_L + PH_PER && (ph - PH_L - PH_PER) > S_F5) continue;
        a.ph_lo = ph; a.ph_hi = ph + 1;
        hipLaunchKernelGGL(mega, dim3(grid), dim3(NTHR), LDS_BYTES, stream, a);
    }
#endif
}
```

```cpp
#include <hip/hip_runtime.h>
#include <cstdio>
#include <cstdint>

#ifndef G8_ALL
#define G8_ALL 1
#endif
#define G8_G1 G8_ALL
#define G8_FNET G8_ALL
#define G8_S5 G8_ALL
#define G8_GLU G8_ALL
#define G8_WOUT G8_ALL
#define G8_FFN G8_ALL
#define G8_MOE G8_ALL
#ifndef UP_ALIGN
#define UP_ALIGN false
#endif
#ifndef STAG_ON
#define STAG_ON 0
#endif
#define STAG(x) (STAG_ON ? (x) : 0)
#ifndef MK_ONE_LAUNCH
#define MK_ONE_LAUNCH 1
#endif

#define LAS __attribute__((address_space(3)))
typedef unsigned short bf16;
typedef short bf16x8 __attribute__((ext_vector_type(8)));
typedef float f32x4 __attribute__((ext_vector_type(4)));
typedef float f32x2 __attribute__((ext_vector_type(2)));
typedef unsigned v4u __attribute__((ext_vector_type(4)));
typedef unsigned v2u __attribute__((ext_vector_type(2)));

constexpr int D = 1024, NB = 16, L = 4096, LC = 256, NL = NB * L, NCX = NB * LC, MT = NL + NCX;
constexpr int DIN = 1792, DFF = 2816, NE = 8, DFE = 3584;
constexpr int PTROWS = 2048, R_HY = 512, R_S5 = 1664;
constexpr int NCHUNK = MT / 16;
constexpr int NTHR = 512, NWAVES = 8;
constexpr int MAXSLOT = NL + NE * 256;

constexpr size_t MiB = 1u << 20;
constexpr size_t WS_CTL = 0, CTL_ZERO_BYTES = 1 * MiB;
constexpr size_t WS_MOD = 1 * MiB;
constexpr size_t WS_WIN = 2 * MiB;
constexpr size_t WS_WOUT = 10 * MiB;
constexpr size_t WS_GLU = 14 * MiB;
constexpr size_t WS_FGU = 15 * MiB;
constexpr size_t WS_FD = 26 * MiB;
constexpr size_t WS_FAW = 32 * MiB;
constexpr size_t WS_O1 = 38 * MiB;
constexpr size_t WS_FBW = 33 * MiB;
constexpr size_t WS_DFTC = 96 * MiB;
constexpr size_t WS_S5M = 97 * MiB;
constexpr size_t S5M_STRIDE = 256 * 256 * 2 + 256 * 512 * 2;
constexpr size_t WS_A16 = 115 * MiB;
constexpr size_t WS_KT = 116 * MiB;
constexpr size_t WS_KTC = 164 * MiB;
constexpr size_t WS_PS = 167 * MiB;
constexpr size_t WS_TOPK = 171 * MiB;
constexpr size_t WS_META = 172 * MiB;
constexpr size_t META_CNT = 0, META_IDX = 64 * 1024, META_TE = META_IDX + 2 * MAXSLOT * 4, META_NT = META_TE + 2 * 272 * 4, META_SL1 = 768 * 1024;
static_assert(META_NT + 8 <= META_SL1 && META_SL1 + (size_t)NL * 4 <= MiB, "meta");
constexpr size_t WS_HMOD = 173 * MiB;
constexpr size_t WS_BUFA = 309 * MiB;
constexpr size_t WS_R = 581 * MiB;
constexpr size_t WS_END = 1024 * MiB;
constexpr size_t WS_PT = WS_R;
constexpr size_t WS_HT = WS_R;
constexpr size_t WS_Z1 = WS_R + 272 * MiB;
constexpr size_t WS_ABUF = WS_R + 374 * MiB;
static_assert(WS_ABUF + (size_t)16 * 256 * 64 * 128 * 2 <= WS_END, "abuf");
constexpr size_t WS_VP = WS_R + 323 * MiB;
static_assert(WS_VP + (size_t)384 * MT * 2 <= WS_END, "vp");
constexpr size_t WS_ACT = WS_R;
constexpr size_t WS_MOEW = WS_BUFA;
constexpr size_t MOE_GU_BYTES = (size_t)2 * DFE * D * 2, MOE_D_BYTES = (size_t)D * DFE * 2, MOE_E_STRIDE = MOE_GU_BYTES + MOE_D_BYTES;
constexpr size_t WS_ACT2 = WS_BUFA + 168 * MiB;
static_assert(NE * MOE_E_STRIDE <= 168 * MiB, "moe weights");
static_assert(WS_ACT2 + (size_t)MAXSLOT * DFE * 2 <= WS_END, "act2");
static_assert(WS_PT + (size_t)PTROWS * MT * 2 <= WS_END, "pt");
static_assert(WS_ACT + (size_t)MT * DFF * 2 <= WS_END, "act");
static_assert(WS_HMOD + (size_t)MT * D * 2 <= WS_BUFA && WS_BUFA + (size_t)MT * D * 4 <= WS_R, "bufs");
constexpr size_t DO_E = 0, DO_HS = 102 * MiB, DO_YS = 153 * MiB;
static_assert(DO_YS + (size_t)MT * 384 * 2 <= (size_t)NL * D * 4, "d_out scratch");

constexpr int LDS_BYTES = 147456;
constexpr int LDS_MISC = 131072 + 8192;

__device__ __forceinline__ unsigned f2bf(float f) { unsigned u = __builtin_bit_cast(unsigned, f); return (u + 0x7fffu + ((u >> 16) & 1u)) >> 16; }
__device__ __forceinline__ unsigned pk2(float lo, float hi) { unsigned r; asm("v_cvt_pk_bf16_f32 %0, %1, %2" : "=v"(r) : "v"(lo), "v"(hi)); return r; }
__device__ __forceinline__ float bf2f(unsigned short b) { return __builtin_bit_cast(float, ((unsigned)b) << 16); }
__device__ __forceinline__ float wave_sum(float v, int lane) {
#pragma unroll
    for (int o = 1; o < 64; o <<= 1) v += __builtin_bit_cast(float, __builtin_amdgcn_ds_bpermute((lane ^ o) << 2, __builtin_bit_cast(int, v)));
    return v;
}
__device__ __forceinline__ float silu_f(float x) { return x * __builtin_amdgcn_rcpf(1.0f + __expf(-x)); }
__device__ __forceinline__ float sigmoid_f(float x) { return __builtin_amdgcn_rcpf(1.0f + __expf(-x)); }
__device__ __forceinline__ float gelu_tanh_f(float x) { const float u = 0.7978845608028654f * (x + 0.044715f * x * x * x); return x * __builtin_amdgcn_rcpf(1.0f + __expf(-2.0f * u)); }
__device__ __forceinline__ int bidx_of(int r) { return r < NL ? (r >> 12) : 16; }

__device__ __forceinline__ int lane_id() { return (int)__builtin_amdgcn_mbcnt_hi(~0u, __builtin_amdgcn_mbcnt_lo(~0u, 0u)); }
__device__ __forceinline__ int tid_of(int wv) { int t = (wv << 6) | lane_id(); asm volatile("" : "+v"(t)); return t; }
#define XB_TMO      128
#define XB_XCNT(j)  (256  + 64 * (j))
#define XB_XSUB(j)  (1280 + 64 * (j))
#define XB_XGEN(j)  (2304 + 64 * (j))
#define XB_TOP      3328
#define XB_TOPGEN   3392
#define XCD_BAR_WORDS 3456
#define XB_SPIN_CAP (1u << 22)
__device__ __forceinline__ unsigned xb_ld(unsigned* p)              { return __hip_atomic_load(p, __ATOMIC_RELAXED, __HIP_MEMORY_SCOPE_AGENT); }
__device__ __forceinline__ unsigned xb_add(unsigned* p, unsigned v) { return __hip_atomic_fetch_add(p, v, __ATOMIC_RELAXED, __HIP_MEMORY_SCOPE_AGENT); }
__device__ __forceinline__ unsigned xb_xcc_id() { return (unsigned)__builtin_amdgcn_s_getreg((3 << 11) | 20) & 0xFu; }
#define XB_SPIN(cond, bar) do { unsigned _sp = 0; while (cond) { __builtin_amdgcn_s_sleep(1); \
    if ((++_sp & 255u) == 0u) { if (xb_ld(&(bar)[XB_TMO])) break; if (_sp > XB_SPIN_CAP) { atomicAdd(&(bar)[XB_TMO], 1u); break; } } } } while (0)
struct XcdBarrier { unsigned* bar; unsigned x; volatile LAS unsigned* st; int wv; };
__device__ __forceinline__ XcdBarrier xcd_barrier_post(unsigned* bar, volatile LAS unsigned* st, int wv) {
    XcdBarrier b; b.bar = bar; b.x = xb_xcc_id(); b.st = st; b.wv = wv;
    if (wv == 0 && lane_id() == 0) (void)xb_add(&bar[XB_XCNT(b.x)], 1u);
    return b;
}
__device__ __forceinline__ void xcd_barrier_complete(unsigned* bar, unsigned x, unsigned& nloc, unsigned& nx) {
    const unsigned G = gridDim.x * gridDim.y * gridDim.z;
    unsigned sum, cnt, mine, sp = 0u;
    for (;;) {
        sum = 0u; cnt = 0u; mine = 0u;
#pragma unroll
        for (unsigned j = 0; j < 16; ++j) { const unsigned c = xb_ld(&bar[XB_XCNT(j)]); sum += c; cnt += (c > 0u) ? 1u : 0u; mine = (j == x) ? c : mine; }
        if (sum == G) break;
        __builtin_amdgcn_s_sleep(1);
        if ((++sp & 255u) == 0u) { if (xb_ld(&bar[XB_TMO])) break; if (sp > XB_SPIN_CAP) { atomicAdd(&bar[XB_TMO], 1u); break; } }
    }
    nloc = mine > 0u ? mine : 1u; nx = cnt > 0u ? cnt : 1u;
}
__device__ __noinline__ void xcd_barrier(const XcdBarrier b) {
    asm volatile("s_waitcnt vmcnt(0)" ::: "memory");
    __syncthreads();
    if (b.wv == 0 && lane_id() == 0) {
        unsigned* bar = b.bar;
        __builtin_amdgcn_s_waitcnt(0);
        unsigned nloc = b.st[0], nx = b.st[1];
        if (nloc == 0u) { xcd_barrier_complete(bar, b.x, nloc, nx); b.st[0] = nloc; b.st[1] = nx; }
        const unsigned old = xb_add(&bar[XB_XSUB(b.x)], 1u);
        const unsigned gen = old / nloc;
        if (old + 1u == (gen + 1u) * nloc) {
            __builtin_amdgcn_fence(__ATOMIC_RELEASE, "agent");
            asm volatile("s_waitcnt vmcnt(0)" ::: "memory");
            const unsigned og = xb_add(&bar[XB_TOP], 1u);
            const unsigned tg = og / nx;
            if (og + 1u == (tg + 1u) * nx) xb_add(&bar[XB_TOPGEN], 1u);
            else XB_SPIN(xb_ld(&bar[XB_TOPGEN]) == tg, bar);
            __builtin_amdgcn_fence(__ATOMIC_ACQUIRE, "agent");
            xb_add(&bar[XB_XGEN(b.x)], 1u);
            asm volatile("s_waitcnt vmcnt(0)" ::: "memory");
        } else {
            XB_SPIN(xb_ld(&bar[XB_XGEN(b.x)]) == gen, bar);
            __builtin_amdgcn_fence(__ATOMIC_ACQUIRE, "agent");
            asm volatile("s_waitcnt vmcnt(0)" ::: "memory");
        }
    }
    __syncthreads();
}

__device__ __forceinline__ size_t tiled_idx(int r, int k, int KT) { return ((size_t)(r >> 8) * KT + (k >> 6)) * 16384 + (size_t)(r & 255) * 64 + (k & 63); }
template <class AF, class BF, class EP>
__device__ __forceinline__ void gemm_simple(int nbatch, int mtiles, int ntiles, int K, const AF& af, const BF& bf, const EP& ep, int vcu, int G) {
    int tid = threadIdx.x; asm volatile("" : "+v"(tid)); asm volatile("" : "+s"(vcu)); const int wid = tid >> 6, lane = tid & 63, wr = wid >> 2, wc = wid & 3, fr = lane & 15, fq = lane >> 4;
    const int per = mtiles * ntiles, nunits = nbatch * per;
    for (int u = vcu; u < nunits; u += G) {
        const int bt = u / per, rem = u - bt * per, pm = rem / ntiles, pn = rem - pm * ntiles;
        const int row0 = pm * 128 + wr * 64, col0 = pn * 128 + wc * 32;
        f32x4 acc[4][2];
#pragma unroll
        for (int m = 0; m < 4; ++m) { acc[m][0] = (f32x4){0.f, 0.f, 0.f, 0.f}; acc[m][1] = (f32x4){0.f, 0.f, 0.f, 0.f}; }
#pragma unroll 2
        for (int k = 0; k < K; k += 32) {
            bf16x8 a[4], b[2];
#pragma unroll
            for (int m = 0; m < 4; ++m) a[m] = *(const bf16x8*)af(bt, row0 + m * 16 + fr, k + fq * 8);
#pragma unroll
            for (int n = 0; n < 2; ++n) b[n] = *(const bf16x8*)bf(bt, col0 + n * 16 + fr, k + fq * 8);
#pragma unroll
            for (int m = 0; m < 4; ++m)
#pragma unroll
                for (int n = 0; n < 2; ++n) acc[m][n] = __builtin_amdgcn_mfma_f32_16x16x32_bf16(b[n], a[m], acc[m][n], 0, 0, 0);
        }
#pragma unroll
        for (int m = 0; m < 4; ++m) ep(bt, row0 + m * 16 + fr, col0 + 4 * fq, acc[m][0], acc[m][1]);
    }
}
struct RowMajor { const bf16* p; long ld; __device__ __forceinline__ const bf16* operator()(int, int r, int k) const { return p + (long)r * ld + k; } };

namespace g8 {
constexpr int BM = 256, BK = 64, HALF = 128, HTB = HALF * BK * 2, NXCD = 8, WGM = 8;
__device__ __forceinline__ int lds_byte(int r, int c) { const int st = (r >> 4) * 2 + (c >> 5), rr = r & 15, cc = c & 31, ob = rr * 64 + cc * 2; return st * 1024 + (ob ^ (((ob >> 9) & 1) << 5)); }
__device__ __forceinline__ void stage_rc(int b, int& R, int& C) { const int st = b / 1024, sb = b % 1024, swz = sb ^ (((sb >> 9) & 1) << 5); R = (st >> 1) * 16 + swz / 64; C = (st & 1) * 32 + (swz % 64) / 2; }
struct Unit { int bt, pm, pn; };
struct Order {
    int nM, nN, per, nwg, G, c, pm_off;
    __device__ __forceinline__ void init(int nb, int nM_, int nN_, int G_, int c_, int rot = 0) { nM = nM_; nN = nN_; per = nM_ * nN_; nwg = nb * per; G = G_; c = c_ - rot; if (c < 0) c += G_; pm_off = 0; }
    __device__ __forceinline__ bool next(int i, Unit& u) const {
        const long Lx = (long)i * G + c; if (Lx >= nwg) return false;
        int wgid = (int)Lx; { const int q = nwg / NXCD, r = nwg % NXCD, xcd = wgid % NXCD, off = wgid / NXCD; wgid = (xcd < r ? xcd * (q + 1) : r * (q + 1) + (xcd - r) * q) + off; }
        u.bt = wgid / per; const int rem = wgid - u.bt * per;
        const int nig = WGM * nN, gid = rem / nig, fm = gid * WGM, gsz = (nM - fm) < WGM ? (nM - fm) : WGM;
        u.pm = pm_off + fm + ((rem % nig) % gsz); u.pn = (rem % nig) / gsz; return true;
    }
};
template <bool ISA> struct OpRow {
    static constexpr bool GATHER = false;
    const char* p; long ld2; long bstride;
    __device__ __forceinline__ unsigned off(int R, int C) const { return (unsigned)(R * (int)ld2 + C * 2); }
    __device__ __forceinline__ const char* base(const Unit& u) const { return p + (long)u.bt * bstride + (long)(ISA ? u.pm : u.pn) * 256 * ld2; }
    __device__ __forceinline__ long koff(int t) const { return (long)t * 128; }
    __device__ __forceinline__ long hstep() const { return 128 * ld2; }
};
template <bool ISA> struct OpTiled {
    static constexpr bool GATHER = false;
    const char* p; int KT;
    __device__ __forceinline__ unsigned off(int R, int C) const { return (unsigned)(R * 128 + C * 2); }
    __device__ __forceinline__ const char* base(const Unit& u) const { return p + (long)(ISA ? u.pm : u.pn) * KT * 32768; }
    __device__ __forceinline__ long koff(int t) const { return (long)t * 32768; }
    __device__ __forceinline__ long hstep() const { return 16384; }
};
struct OpMoeBT {
    static constexpr bool GATHER = false;
    const char* w; const LAS int* te; int KT;
    __device__ __forceinline__ unsigned off(int R, int C) const { return (unsigned)(R * 128 + C * 2); }
    __device__ __forceinline__ const char* base(const Unit& u) const { return w + (long)__builtin_amdgcn_readfirstlane(te[u.pm]) * (long)MOE_E_STRIDE + (long)u.pn * KT * 32768; }
    __device__ __forceinline__ long koff(int t) const { return (long)t * 32768; }
    __device__ __forceinline__ long hstep() const { return 16384; }
};
struct OpS5A {
    static constexpr bool GATHER = false;
    const char* ptb; long delta;
    __device__ __forceinline__ unsigned off(int R, int C) const { return (unsigned)((C >> 4) * (MT * 2) + R * 32 + (C & 15) * 2); }
    __device__ __forceinline__ const char* base(const Unit& u) const { return ptb + ((long)u.bt * 16 * MT + (long)u.pm * 4096) * 2; }
    __device__ __forceinline__ long koff(int t) const { return t < 4 ? (long)t * 4 * MT * 2 : delta + (long)(t - 4) * 4 * MT * 2; }
    __device__ __forceinline__ long hstep() const { return 4096; }
};
struct OpFnetB {
    static constexpr bool GATHER = false;
    const char* p; int seq2; int sh;
    __device__ __forceinline__ unsigned off(int R, int C) const { return (unsigned)(R * (MT * 2) + C * 2); }
    __device__ __forceinline__ const char* base(const Unit& u) const { return p + (long)u.bt * seq2 + (long)u.pn * 256 * MT * 2; }
    __device__ __forceinline__ long koff(int t) const { return (long)(t >> sh) * 256 * MT * 2 + (long)(t & ((1 << sh) - 1)) * 128; }
    __device__ __forceinline__ long hstep() const { return (long)128 * MT * 2; }
};
struct OpPermB {
    static constexpr bool GATHER = false;
    const char* p;
    __device__ __forceinline__ unsigned off(int R, int C) const { return (unsigned)((64 * (R & 63) + (R >> 6)) * 2048 + C * 2); }
    __device__ __forceinline__ const char* base(const Unit& u) const { return p + ((long)(u.pn >> 4) * 4096 + (long)(u.pn & 15) * 4) * 2048; }
    __device__ __forceinline__ long koff(int t) const { return (long)t * 128; }
    __device__ __forceinline__ long hstep() const { return 2 * 2048; }
};
struct OpFA {
    static constexpr bool GATHER = false;
    const char* p;
    __device__ __forceinline__ unsigned off(int R, int C) const { return (unsigned)((R >> 6) * (MT * 2) + (R & 63) * 128 + C * 2); }
    __device__ __forceinline__ const char* base(const Unit& u) const { return p + (long)(u.pn & 63) * 4 * MT * 2 + (long)(u.pn >> 6) * 4096 * 2; }
    __device__ __forceinline__ long koff(int t) const { return (long)t * 256 * MT * 2; }
    __device__ __forceinline__ long hstep() const { return (long)2 * MT * 2; }
};
struct OpFB {
    static constexpr bool GATHER = false;
    const char* p;
    __device__ __forceinline__ unsigned off(int R, int C) const { return (unsigned)(R * 16384 + C * 2); }
    __device__ __forceinline__ const char* base(const Unit& u) const { return p + (long)u.bt * 256 * 16384 + (long)u.pm * 1024; }
    __device__ __forceinline__ long koff(int t) const { return (long)t * 128; }
    __device__ __forceinline__ long hstep() const { return (long)128 * 16384; }
};
struct OpMoeA {
    static constexpr bool GATHER = true;
    const char* h; const int* idx;
    __device__ __forceinline__ unsigned off(int, int) const { return 0u; }
    __device__ __forceinline__ unsigned goff(const Unit& u, int R, int C) const { int t = idx[u.pm * 256 + R]; t = t < 0 ? 0 : t; return (unsigned)t * 2048u + (unsigned)C * 2u; }
    __device__ __forceinline__ const char* base(const Unit&) const { return h; }
    __device__ __forceinline__ long koff(int t) const { return (long)t * 128; }
    __device__ __forceinline__ long hstep() const { return 0; }
};
struct OpMoeB {
    static constexpr bool GATHER = false;
    const char* w; const LAS int* te; long ld2;
    __device__ __forceinline__ unsigned off(int R, int C) const { return (unsigned)(R * (int)ld2 + C * 2); }
    __device__ __forceinline__ const char* base(const Unit& u) const { return w + (long)__builtin_amdgcn_readfirstlane(te[u.pm]) * (long)MOE_E_STRIDE + (long)u.pn * 256 * ld2; }
    __device__ __forceinline__ long koff(int t) const { return (long)t * 128; }
    __device__ __forceinline__ long hstep() const { return 128 * ld2; }
};

template <class T, class = void> struct IsRmw { static constexpr bool value = false; };
template <class T> struct IsRmw<T, decltype((void)sizeof(typename T::Pre))> { static constexpr bool value = true; };
template <bool ALIGN = true, class OA, class OB, class Epi>
__device__ __forceinline__ void gemm8(LAS unsigned char* lds, const int wv, const int nt, const OA& oa, const OB& ob, const Order& S, const Epi& E, const int stag = 0) {
    if (stag > 0) {
        const unsigned long long t0 = __builtin_amdgcn_s_memrealtime(), want = (unsigned long long)(((S.c >> 3) & 3) * stag);
        while (__builtin_amdgcn_s_memrealtime() - t0 < want) __builtin_amdgcn_s_sleep(4); }
    const int tid = tid_of(wv);
    const int wid = __builtin_amdgcn_readfirstlane(tid >> 6), lane = tid & 63, wr = wid >> 2, wc = wid & 3, fr = lane & 15, fq = lane >> 4;
    unsigned voffA[2][2], voffB[2];
#pragma unroll
    for (int i = 0; i < 2; ++i) { int R_, C_; stage_rc(tid * 16 + i * 8192, R_, C_); voffB[i] = ob.off(R_, C_); voffA[0][i] = oa.off(R_, C_); voffA[1][i] = 0u; }
    const long hA = oa.hstep(), hB = ob.hstep();
    const unsigned ldsw = (unsigned)wid * 1024u;
    const int aoff = lds_byte(wr * 64 + fr, fq * 8), boff = lds_byte(wc * 32 + fr, fq * 8);
#define G8_SA(b, h) (((b) * 2 + (h)) * HTB)
#define G8_SB(b, h) ((4 + (b) * 2 + (h)) * HTB)
#define G8_STAGE_B(bufoff, gbase) do { _Pragma("unroll") for (int _i = 0; _i < 2; ++_i) \
        __builtin_amdgcn_global_load_lds((const unsigned*)((const char*)(gbase) + voffB[_i]), (LAS unsigned*)(lds + (bufoff) + ldsw + _i * 8192), 16, 0, 0); } while (0)
#define G8_STAGE_A(bufoff, gbase, h) do { _Pragma("unroll") for (int _i = 0; _i < 2; ++_i) \
        __builtin_amdgcn_global_load_lds((const unsigned*)((const char*)(gbase) + (OA::GATHER ? 0 : (h) * hA) + voffA[OA::GATHER ? (h) : 0][_i]), (LAS unsigned*)(lds + (bufoff) + ldsw + _i * 8192), 16, 0, 0); } while (0)
#define G8_LDA(dst, b, h) do { _Pragma("unroll") for (int m = 0; m < 4; ++m) _Pragma("unroll") for (int k = 0; k < 2; ++k) dst[m][k] = *(const LAS bf16x8*)(lds + G8_SA(b, h) + aoff + m * 2048 + k * 1024); } while (0)
#define G8_LDB(dst, b, h) do { _Pragma("unroll") for (int n = 0; n < 2; ++n) _Pragma("unroll") for (int k = 0; k < 2; ++k) dst[n][k] = *(const LAS bf16x8*)(lds + G8_SB(b, h) + boff + n * 2048 + k * 1024); } while (0)
#define G8_MMA(ai, bj, At, Bt) do { __builtin_amdgcn_s_setprio(1); _Pragma("unroll") for (int m = 0; m < 4; ++m) _Pragma("unroll") for (int n = 0; n < 2; ++n) _Pragma("unroll") for (int k = 0; k < 2; ++k) \
        acc[ai][bj][m][n] = __builtin_amdgcn_mfma_f32_16x16x32_bf16(Bt[n][k], At[m][k], acc[ai][bj][m][n], 0, 0, 0); __builtin_amdgcn_s_setprio(0); } while (0)
#define G8_WAIT_V(n) asm volatile("s_waitcnt vmcnt(" #n ")" ::: "memory")
#define G8_WAIT_L(n) asm volatile("s_waitcnt lgkmcnt(" #n ")" ::: "memory")
#define G8_BAR __builtin_amdgcn_s_barrier()
#define G8_SCHED __builtin_amdgcn_sched_barrier(0)
#define G8_GOFF(u) do { if constexpr (OA::GATHER) { const int _tz = tid_of(wv); _Pragma("unroll") for (int _i = 0; _i < 2; ++_i) { int _R, _C; stage_rc(_tz * 16 + _i * 8192, _R, _C); \
        _Pragma("unroll") for (int _h = 0; _h < 2; ++_h) voffA[_h][_i] = oa.goff(u, _R + 128 * _h, _C); } } } while (0)
    Unit cur, nxt; int ui = 0;
    if (!S.next(0, cur)) return;
    f32x4 acc[2][2][4][2];
#pragma unroll
    for (int a = 0; a < 2; ++a)
#pragma unroll
        for (int b = 0; b < 2; ++b)
#pragma unroll
            for (int m = 0; m < 4; ++m)
#pragma unroll
                for (int n = 0; n < 2; ++n) acc[a][b][m][n] = (f32x4){0.f, 0.f, 0.f, 0.f};
    bf16x8 At[4][2], B0[2][2], B1[2][2];
    const char* cA = oa.base(cur); const char* cB = ob.base(cur);
    asm volatile("" : "+s"(cA), "+s"(cB));
    G8_GOFF(cur);
    {   const long ka0 = oa.koff(0), ka1 = oa.koff(1), kb0 = ob.koff(0), kb1 = ob.koff(1);
        G8_STAGE_B(G8_SB(0, 0), cB + kb0); G8_STAGE_B(G8_SB(0, 1), cB + kb0 + hB); G8_STAGE_A(G8_SA(0, 0), cA + ka0, 0); G8_STAGE_A(G8_SA(0, 1), cA + ka0, 1);
        if (wr == 1) G8_BAR;
        G8_WAIT_V(2); G8_BAR;
        G8_STAGE_B(G8_SB(1, 0), cB + kb1); G8_STAGE_A(G8_SA(1, 0), cA + ka1, 0); G8_STAGE_B(G8_SB(1, 1), cB + kb1 + hB);
        G8_WAIT_V(6); G8_BAR; }
    for (;;) {
        const bool has_next = S.next(ui + 1, nxt);
        const char* nA = has_next ? oa.base(nxt) : cA; const char* nB = has_next ? ob.base(nxt) : cB;
        asm volatile("" : "+s"(nA), "+s"(nB));
        for (int t = 0; t < nt; t += 2) {
            const bool last = (t == nt - 2);
            const char* a1 = cA + oa.koff(t + 1);
            const char* a2 = last ? nA + oa.koff(0) : cA + oa.koff(t + 2); const char* b2 = last ? nB + ob.koff(0) : cB + ob.koff(t + 2);
            const char* a3 = last ? nA + oa.koff(1) : cA + oa.koff(t + 3); const char* b3 = last ? nB + ob.koff(1) : cB + ob.koff(t + 3);
            G8_LDB(B0, 0, 0); G8_LDB(B1, 0, 1); G8_SCHED; G8_LDA(At, 0, 0); G8_STAGE_A(G8_SA(1, 1), a1, 1);
            if (last && has_next && nxt.pm != cur.pm) G8_GOFF(nxt);
            G8_WAIT_V(8); G8_WAIT_L(0); G8_BAR; G8_MMA(0, 0, At, B0); G8_MMA(0, 1, At, B1); G8_BAR; G8_SCHED;
            G8_LDA(At, 0, 1); G8_STAGE_B(G8_SB(0, 0), b2); G8_STAGE_B(G8_SB(0, 1), b2 + hB); G8_STAGE_A(G8_SA(0, 0), a2, 0);
            G8_WAIT_V(8); G8_WAIT_L(0); G8_BAR; G8_MMA(1, 0, At, B0); G8_MMA(1, 1, At, B1); G8_BAR; G8_SCHED;
            G8_LDB(B0, 1, 0); G8_LDB(B1, 1, 1); G8_SCHED; G8_LDA(At, 1, 0); G8_STAGE_A(G8_SA(0, 1), a2, 1);
            G8_WAIT_V(8); G8_WAIT_L(0); G8_BAR; G8_MMA(0, 0, At, B0); G8_MMA(0, 1, At, B1); G8_BAR; G8_SCHED;
            G8_LDA(At, 1, 1); G8_STAGE_B(G8_SB(1, 0), b3); G8_STAGE_B(G8_SB(1, 1), b3 + hB); G8_STAGE_A(G8_SA(1, 0), a3, 0);
            G8_WAIT_V(8); G8_WAIT_L(0); G8_BAR; G8_MMA(1, 0, At, B0); G8_MMA(1, 1, At, B1); G8_BAR; G8_SCHED;
        }
        if (ALIGN) { if (wr == 0) G8_BAR; }
        {   const int tz = tid_of(wv); const int wz = tz >> 6, lz = tz & 63;
            const int row0 = cur.pm * BM + (wz >> 2) * 64 + (lz & 15), col0 = cur.pn * BM + (wz & 3) * 32 + 4 * (lz >> 4);
            if constexpr (IsRmw<Epi>::value) {
#pragma unroll
                for (int ai = 0; ai < 2; ++ai)
#pragma unroll
                    for (int mh = 0; mh < 4; mh += 2) { typename Epi::Pre pr[2][2];
#pragma unroll
                        for (int m2 = 0; m2 < 2; ++m2)
#pragma unroll
                            for (int bj = 0; bj < 2; ++bj) pr[m2][bj] = E.pre(cur.bt, row0 + ai * HALF + (mh + m2) * 16, col0 + bj * HALF);
#pragma unroll
                        for (int m2 = 0; m2 < 2; ++m2)
#pragma unroll
                            for (int bj = 0; bj < 2; ++bj) E.post(pr[m2][bj], cur.bt, row0 + ai * HALF + (mh + m2) * 16, col0 + bj * HALF, acc[ai][bj][mh + m2][0], acc[ai][bj][mh + m2][1]); }
            } else {
#pragma unroll
            for (int ai = 0; ai < 2; ++ai)
#pragma unroll
                for (int m = 0; m < 4; ++m)
#pragma unroll
                    for (int bj = 0; bj < 2; ++bj) E(cur.bt, row0 + ai * HALF + m * 16, col0 + bj * HALF, acc[ai][bj][m][0], acc[ai][bj][m][1]); } }
        if (!has_next) break;
#pragma unroll
        for (int a = 0; a < 2; ++a)
#pragma unroll
            for (int b = 0; b < 2; ++b)
#pragma unroll
                for (int m = 0; m < 4; ++m)
#pragma unroll
                    for (int n = 0; n < 2; ++n) acc[a][b][m][n] = (f32x4){0.f, 0.f, 0.f, 0.f};
        cur = nxt; cA = nA; cB = nB; ++ui;
        if (ALIGN) { if (wr == 1) G8_BAR; }
    }
    G8_WAIT_V(0);
    if (!ALIGN) { if (wr == 0) G8_BAR; }
    G8_BAR;
#undef G8_SA
#undef G8_SB
#undef G8_STAGE_A
#undef G8_STAGE_B
#undef G8_LDA
#undef G8_LDB
#undef G8_MMA
#undef G8_WAIT_V
#undef G8_WAIT_L
#undef G8_BAR
#undef G8_SCHED
#undef G8_GOFF
}
}

#ifndef PROBE_SEL
#define PROBE_SEL -1
#endif
#ifndef PROBE_BLK
#define PROBE_BLK 0
#endif
#ifndef PROBE_TID
#define PROBE_TID 0
#endif
#if PROBE_SEL >= 0
__device__ __forceinline__ void prb_b(LAS unsigned char* lds, int tid) { if (tid == PROBE_TID) { asm volatile("s_waitcnt vmcnt(0) lgkmcnt(0)" ::: "memory"); *(volatile LAS unsigned long long*)(lds + LDS_MISC + 64) = __builtin_amdgcn_s_memrealtime(); } }
__device__ __forceinline__ void prb_e(LAS unsigned char* lds, int tid) { if (tid == PROBE_TID) { asm volatile("s_waitcnt vmcnt(0) lgkmcnt(0)" ::: "memory"); volatile LAS unsigned long long* p = (volatile LAS unsigned long long*)(lds + LDS_MISC + 64); p[1] = p[1] + (__builtin_amdgcn_s_memrealtime() - p[0]); } }
#define PB(id) do { if ((id) == PROBE_SEL) prb_b(F.lds, F.tid); } while (0)
#define PE(id) do { if ((id) == PROBE_SEL) prb_e(F.lds, F.tid); } while (0)
#else
#define PB(id) do { } while (0)
#define PE(id) do { } while (0)
#endif
struct Args { const float* in[40]; float* out; unsigned char* ws; int ph_lo, ph_hi; };
struct Frame {
    LAS unsigned char* lds; int tid, lane, wave, vcu, G;
    const float* const* in; float* out; unsigned char* ws;
};
#define WSP(T, off) ((T*)(F.ws + (off)))
__device__ __forceinline__ Frame relocal(const Frame& F0) { Frame F = F0; const int t = tid_of(F0.wave); F.tid = t; F.lane = t & 63; F.wave = F0.wave; int v = F0.vcu; asm volatile("" : "+s"(v)); F.vcu = v; return F; }

constexpr int PH_P0 = 0, PH_P1 = 1, PH_L = 2, PH_PER = 20, N_PHASES = PH_L + 2 * PH_PER;
enum { S_NORM1 = 0, S_G1, S_FNET, S_HY1, S_S5E, S_CARRY, S_HY2, S_S5O, S_GLU, S_HYT, S_WOUT, S_NORM2, S_F0, S_F1, S_F2, S_F3, S_F4, S_F5, S_F6 };

__device__ __forceinline__ int wq_next(Frame& F, int qid) {
    LAS int* slot = (LAS int*)(F.lds + LDS_MISC + 96);
    if (F.tid == 0) *slot = (int)__hip_atomic_fetch_add((unsigned*)(F.ws + WS_CTL) + 8192 + 64 * qid, 1u, __ATOMIC_RELAXED, __HIP_MEMORY_SCOPE_AGENT);
    __syncthreads();
    const int v = *slot;
    __syncthreads();
    return v;
}
__device__ __forceinline__ int rowmap(int mode, int row_off, int n) { return (mode == 0 || mode == 3) ? row_off + n : (32 * (n >> 4) + (n & 15) + (mode == 2 ? 16 : 0)); }
__device__ __forceinline__ void transpose_item(const float* W, int ldw, int col0, int N, bf16* WT, int ldk, int mode, int row_off, LAS float* scr, int item, int lane) {
    const int nblk = N / 32, kb = item / nblk, nb = item % nblk, k0 = 64 * kb, n0 = 32 * nb;
    const int r8 = lane >> 3, c4 = lane & 7;
    f32x4 v[8];
#pragma unroll
    for (int i = 0; i < 8; ++i) v[i] = *(const f32x4*)(W + (size_t)(k0 + 8 * i + r8) * ldw + col0 + n0 + 4 * c4);
#pragma unroll
    for (int i = 0; i < 8; ++i) { LAS float* d = scr + (8 * i + r8) * 33 + 4 * c4; d[0] = v[i].x; d[1] = v[i].y; d[2] = v[i].z; d[3] = v[i].w; }
    asm volatile("s_waitcnt lgkmcnt(0)" ::: "memory");
    const int c = lane & 7;
#pragma unroll
    for (int j = 0; j < 4; ++j) { const int n = (lane >> 3) + 8 * j; const LAS float* s = scr + (8 * c) * 33 + n;
        v4u o; o.x = pk2(s[0 * 33], s[1 * 33]); o.y = pk2(s[2 * 33], s[3 * 33]); o.z = pk2(s[4 * 33], s[5 * 33]); o.w = pk2(s[6 * 33], s[7 * 33]);
        if (mode == 3) *(v4u*)(WT + tiled_idx(row_off + n0 + n, k0 + 8 * c, ldk / 64)) = o; else *(v4u*)(WT + (size_t)rowmap(mode, row_off, n0 + n) * ldk + k0 + 8 * c) = o; }
    asm volatile("s_waitcnt lgkmcnt(0)" ::: "memory");
}

__device__ __forceinline__ void p0_transposes(Frame& F) {
    LAS float* scr = (LAS float*)(F.lds + F.wave * 16384);
    const int gw = F.vcu * NWAVES + F.wave, NGW = F.G * NWAVES;
    constexpr int I_IN = 16 * 48, I_OUT = 16 * 32, I_GLU = 6 * 12, I_FG = 16 * 88, I_FD = 44 * 32;
    constexpr int NIT = 2 * (I_IN + I_OUT + I_GLU) + 2 * I_FG + I_FD;
    for (int it = gw; it < NIT; it += NGW) {
        int r = it;
        if (r < 2 * I_IN) { const int l = r / I_IN; transpose_item(F.in[8] + (size_t)l * D * DIN, DIN, 256, 1536, WSP(bf16, WS_WIN) + (size_t)l * PTROWS * D, D, 0, 512, scr, r % I_IN, F.lane); continue; } r -= 2 * I_IN;
        if (r < 2 * I_OUT) { const int l = r / I_OUT; transpose_item(F.in[9] + (size_t)l * D * D, D, 0, D, WSP(bf16, WS_WOUT) + (size_t)l * D * D, D, 0, 0, scr, r % I_OUT, F.lane); continue; } r -= 2 * I_OUT;
        if (r < 2 * I_GLU) { const int l = r / I_GLU; transpose_item(F.in[29] + (size_t)l * 384 * 384, 384, 0, 384, WSP(bf16, WS_GLU) + (size_t)l * 512 * 384, 384, 0, 0, scr, r % I_GLU, F.lane); continue; } r -= 2 * I_GLU;
        if (r < I_FG) { transpose_item(F.in[31], DFF, 0, DFF, WSP(bf16, WS_FGU), D, 1, 0, scr, r, F.lane); continue; } r -= I_FG;
        if (r < I_FG) { transpose_item(F.in[32], DFF, 0, DFF, WSP(bf16, WS_FGU), D, 2, 0, scr, r, F.lane); continue; } r -= I_FG;
        transpose_item(F.in[33], D, 0, D, WSP(bf16, WS_FD), DFF, 3, 0, scr, r, F.lane);
    }
}
struct TItem { const float* src; int ldw; bf16* dst; int ldk, mode, k0, n0; };
__device__ __forceinline__ void titem_load(const TItem& t, int lane, f32x4 (&v)[8]) { const int r8 = lane >> 3, c4 = lane & 7;
#pragma unroll
    for (int i = 0; i < 8; ++i) v[i] = *(const f32x4*)(t.src + (size_t)(t.k0 + 8 * i + r8) * t.ldw + t.n0 + 4 * c4); }
__device__ __forceinline__ void titem_finish(const TItem& t, int lane, const f32x4 (&v)[8], LAS float* scr) { const int r8 = lane >> 3, c4 = lane & 7;
#pragma unroll
    for (int i = 0; i < 8; ++i) { LAS float* d = scr + (8 * i + r8) * 33 + 4 * c4; d[0] = v[i].x; d[1] = v[i].y; d[2] = v[i].z; d[3] = v[i].w; }
    asm volatile("s_waitcnt lgkmcnt(0)" ::: "memory");
    const int c = lane & 7;
#pragma unroll
    for (int j = 0; j < 4; ++j) { const int n = (lane >> 3) + 8 * j; const LAS float* s = scr + (8 * c) * 33 + n;
        v4u o; o.x = pk2(s[0 * 33], s[1 * 33]); o.y = pk2(s[2 * 33], s[3 * 33]); o.z = pk2(s[4 * 33], s[5 * 33]); o.w = pk2(s[6 * 33], s[7 * 33]);
        if (t.mode == 3) *(v4u*)(t.dst + tiled_idx(t.n0 + n, t.k0 + 8 * c, t.ldk / 64)) = o; else *(v4u*)(t.dst + (size_t)rowmap(t.mode, 0, t.n0 + n) * t.ldk + t.k0 + 8 * c) = o; }
    asm volatile("s_waitcnt lgkmcnt(0)" ::: "memory"); }
__device__ __forceinline__ TItem moe_titem(Frame& F, int it) {
    constexpr int I_G = 16 * 112, I_D = 56 * 32, PER_E = 2 * I_G + I_D;
    const int e = it / PER_E; int r = it % PER_E; TItem t;
    bf16* gu = (bf16*)(F.ws + WS_MOEW + (size_t)e * MOE_E_STRIDE); bf16* dn = (bf16*)(F.ws + WS_MOEW + (size_t)e * MOE_E_STRIDE + MOE_GU_BYTES);
    if (r < 2 * I_G) { const int up = r >= I_G; if (up) r -= I_G; t.src = F.in[36 + up] + (size_t)e * D * DFE; t.ldw = DFE; t.dst = gu; t.ldk = D; t.mode = 1 + up; t.k0 = 64 * (r / 112); t.n0 = 32 * (r % 112); }
    else { r -= 2 * I_G; t.src = F.in[38] + (size_t)e * DFE * D; t.ldw = D; t.dst = dn; t.ldk = DFE; t.mode = 3; t.k0 = 64 * (r / 32); t.n0 = 32 * (r % 32); }
    return t; }
__device__ __forceinline__ void moe_transposes(Frame& F_) { Frame F = relocal(F_);
    LAS float* scr = (LAS float*)(F.lds + F.wave * 16384);
    const int gw = F.vcu * NWAVES + F.wave, NGW = F.G * NWAVES; constexpr int NIT = NE * (2 * 16 * 112 + 56 * 32);
    int it = gw; if (it >= NIT) return;
    TItem cur = moe_titem(F, it); f32x4 va[8], vb[8]; titem_load(cur, F.lane, va);
    for (;;) {
        const int itn = it + NGW; const bool hn = itn < NIT; TItem nx = cur; if (hn) { nx = moe_titem(F, itn); titem_load(nx, F.lane, vb); }
        titem_finish(cur, F.lane, va, scr);
        if (!hn) break;
        const int itn2 = itn + NGW; const bool hn2 = itn2 < NIT; TItem nx2 = nx; if (hn2) { nx2 = moe_titem(F, itn2); titem_load(nx2, F.lane, va); }
        titem_finish(nx, F.lane, vb, scr);
        if (!hn2) break;
        cur = nx2; it = itn2;
    }
}

__device__ __forceinline__ void p0_mod_item(Frame& F, int item) {
    const int l = item / 48, cb = item % 48, tid = tid_of(F.wave), lane = tid & 63;
    LAS float* sc = (LAS float*)F.lds;
    LAS float* red = sc + 17 * 1024;
    for (int i = tid; i < 17 * 1024; i += NTHR) { const int r = i >> 10, k = i & 1023; const float v = r < 16 ? F.in[1][r * D + k] : F.in[3][k]; sc[i] = silu_f(v); }
    __syncthreads();
    const int cq = lane & 31, kg = (lane >> 5) + 2 * F.wave;
    const float* W = F.in[4] + (size_t)l * D * 6144 + cb * 128 + 4 * cq;
    f32x4 acc[17];
#pragma unroll
    for (int r = 0; r < 17; ++r) acc[r] = (f32x4){0.f, 0.f, 0.f, 0.f};
#pragma unroll 1
    for (int k0 = kg * 64; k0 < kg * 64 + 64; k0 += 8) { f32x4 w[8];
#pragma unroll
        for (int j = 0; j < 8; ++j) w[j] = *(const f32x4*)(W + (size_t)(k0 + j) * 6144);
#pragma unroll
        for (int j = 0; j < 8; ++j)
#pragma unroll
            for (int r = 0; r < 17; ++r) acc[r] += w[j] * sc[r * 1024 + k0 + j]; }
    if (lane < 32) {
#pragma unroll
        for (int r = 0; r < 17; ++r) *(LAS f32x4*)(red + (F.wave * 17 + r) * 128 + 4 * cq) = acc[r]; }
    __syncthreads();
    if (lane >= 32) {
#pragma unroll
        for (int r = 0; r < 17; ++r) { LAS f32x4* p = (LAS f32x4*)(red + (F.wave * 17 + r) * 128 + 4 * cq); *p = *p + acc[r]; } }
    __syncthreads();
    for (int i = tid; i < 17 * 128; i += NTHR) { const int r = i >> 7, c = i & 127; float s = 0.f;
#pragma unroll
        for (int w8 = 0; w8 < 8; ++w8) s += red[(w8 * 17 + r) * 128 + c];
        WSP(float, WS_MOD)[((size_t)l * 17 + r) * 6144 + cb * 128 + c] = s + F.in[5][l * 6144 + cb * 128 + c]; }
    __syncthreads();
}
__device__ __forceinline__ void p0_fold_item(Frame& F, int item) {
    const int kb = item & 7, cs = (item >> 3) & 1, h = (item >> 4) & 3, l = item >> 6, tid = tid_of(F.wave);
    LAS float* A = (LAS float*)F.lds;
    LAS float* WF = A + 4096;
    LAS float* WI = WF + 4096;
    LAS float* T = WI + 128 * 65;
    if (tid < 64) T[tid] = cs ? sinpif((float)tid * (1.0f / 32.0f)) : cospif((float)tid * (1.0f / 32.0f));
    const float* wf = F.in[10] + ((size_t)l * 4 + h) * 64 * 64;
    for (int i = tid; i < 4096; i += NTHR) WF[i] = wf[i];
    const float* win = F.in[8] + (size_t)l * D * DIN + (size_t)kb * 128 * DIN + h * 64;
    for (int i = tid; i < 128 * 64; i += NTHR) { const int kk = i >> 6, d = i & 63; WI[kk * 65 + d] = win[(size_t)kk * DIN + d]; }
    __syncthreads();
    for (int i = tid; i < 4096; i += NTHR) { const int d = i >> 6, e2 = i & 63; float s = 0.f;
        for (int e = 0; e < 64; ++e) s += T[(e * d) & 63] * WF[e * 64 + e2];
        A[i] = s * 0.125f; }
    __syncthreads();
    const int e2 = tid & 63;
    bf16* wt = WSP(bf16, WS_WIN) + (size_t)l * PTROWS * D + (size_t)(cs * 256 + h * 64 + e2) * D + kb * 128;
    for (int i = 0; i < 16; ++i) { const int kk = (tid >> 6) + 8 * i; float s = 0.f;
#pragma unroll 8
        for (int d = 0; d < 64; ++d) s += WI[kk * 65 + d] * A[d * 64 + e2];
        wt[kk] = (bf16)f2bf(s); }
    __syncthreads();
}
__device__ __forceinline__ void gen_dft_rows(bf16* dst, int LL, int row0, int nrows, float scale, int tid) {
    const int cpr = 2 * LL / 8;
    for (int i = tid; i < nrows * cpr; i += NTHR) { const int k = row0 + i / cpr, j0 = (i % cpr) * 8; unsigned w[4];
#pragma unroll
        for (int q = 0; q < 4; ++q) { float v[2];
#pragma unroll
            for (int z = 0; z < 2; ++z) { const int j = j0 + 2 * q + z; const int jj = j < LL ? j : j - LL; const int m = (k * jj) & (LL - 1); const float x = (float)m * (2.0f / (float)LL);
                v[z] = (j < LL ? cospif(x) : -sinpif(x)) * scale; }
            w[q] = pk2(v[0], v[1]); }
        *(v4u*)(dst + (size_t)k * 2 * LL + j0) = (v4u){w[0], w[1], w[2], w[3]}; }
}
__device__ __forceinline__ void gen_fft_mats(Frame& F, int item) {
    const int tid = tid_of(F.wave);
    if (item == 64) { bf16* W = WSP(bf16, WS_FAW);
        for (int i = tid; i < 256 * 128; i += NTHR) { const int m = i >> 7, k = i & 127; float v = 0.f;
            if (m < 128) { const int pp = m >> 6, t1 = m & 63, pa = k >> 6, s1 = k & 63; const float x = (float)((t1 * s1) & 63) * (1.0f / 32.0f); const float c = cospif(x) * 0.125f, sn = sinpif(x) * 0.125f;
                v = pp == 0 ? (pa == 0 ? c : -sn) : (pa == 0 ? -sn : -c); }
            W[i] = (bf16)f2bf(v); }
        return; }
    const int grp = item >> 2, q = item & 3; bf16* W = WSP(bf16, WS_FBW) + (size_t)grp * 256 * 512;
    for (int i = q * 32768 + tid; i < (q + 1) * 32768; i += NTHR) { const int r = i >> 9, k = i & 511; const int t1p = r >> 6, t2 = r & 63, t1q = k >> 7, pa = (k >> 6) & 1, s2 = k & 63; float v = 0.f;
        if (t1p == t1q) { const int t = 4 * grp + t1p + 64 * t2; const float x = (float)((s2 * t) & 4095) * (1.0f / 2048.0f); v = (pa == 0 ? cospif(x) : sinpif(x)) * 0.125f; }
        W[i] = (bf16)f2bf(v); }
}
__device__ __forceinline__ void p0_filter_item(Frame& F, int item) {
    const int l = item / 272, pb = item % 272, tid = tid_of(F.wave);
    const int LL = pb < 256 ? L : LC, p0 = pb < 256 ? pb * 16 : (pb - 256) * 16;
    LAS float* z = (LAS float*)F.lds;
    LAS float* h1 = z + 16 * 36;
    LAS float* h2 = h1 + 16 * 64;
    LAS float* W1 = h2 + 16 * 64;
    LAS float* W2 = W1 + 33 * 64;
    for (int i = tid; i < 33 * 64; i += NTHR) W1[i] = F.in[13][(size_t)l * 33 * 64 + i];
    for (int i = tid; i < 64 * 64; i += NTHR) W2[i] = F.in[16][(size_t)l * 64 * 64 + i];
    for (int i = tid; i < 16 * 33; i += NTHR) { const int pp = i / 33, j = i % 33; const int pos = p0 + pp; float v;
        if (j == 0) v = (float)pos / (float)(LL - 1);
        else { const int bj = (j - 1) & 15; const float band = 1e-4f + (float)bj * ((15.0f - 1e-4f) / 15.0f); const float u = 2.0f * band * (float)pos / (float)LL;
            v = j <= 16 ? cospif(u) : -sinpif(u); }
        z[pp * 36 + j] = v; }
    __syncthreads();
    for (int i = tid; i < 1024; i += NTHR) { const int pp = i >> 6, o = i & 63; float s = F.in[14][l * 64 + o];
        for (int j = 0; j < 33; ++j) s += z[pp * 36 + j] * W1[j * 64 + o];
        h1[i] = sinf(F.in[15][l * 64 + o] * s); }
    __syncthreads();
    for (int i = tid; i < 1024; i += NTHR) { const int pp = i >> 6, o = i & 63; float s = F.in[17][l * 64 + o];
        for (int j = 0; j < 64; ++j) s += h1[pp * 64 + j] * W2[j * 64 + o];
        h2[i] = sinf(F.in[18][l * 64 + o] * s); }
    __syncthreads();
    float* HT = WSP(float, WS_HT) + ((size_t)l * 4352 + (pb < 256 ? 0 : 4096)) * 1536;
    float* PS = WSP(float, WS_PS) + ((size_t)l * 272 + pb) * 1536;
    const float* fw3 = F.in[19] + (size_t)l * 64 * 1536;
    const float dmin = 3.0701134573253945f, dstep = (15.350567286626973f - 3.0701134573253945f) / 383.0f;
#pragma unroll 1
    for (int cc = 0; cc < 3; ++cc) { const int col = tid + 512 * cc; float acc[16];
#pragma unroll
        for (int pp = 0; pp < 16; ++pp) acc[pp] = 0.f;
#pragma unroll 1
        for (int j0 = 0; j0 < 64; j0 += 32) { float w[32];
#pragma unroll
            for (int j = 0; j < 32; ++j) w[j] = fw3[(size_t)(j0 + j) * 1536 + col];
#pragma unroll
            for (int pp = 0; pp < 16; ++pp) { float a = acc[pp];
#pragma unroll
                for (int j = 0; j < 32; j += 4) { const f32x4 hv = *(const LAS f32x4*)(h2 + pp * 64 + j0 + j); a += (hv.x * w[j] + hv.y * w[j + 1]) + (hv.z * w[j + 2] + hv.w * w[j + 3]); }
                acc[pp] = a; __builtin_amdgcn_sched_barrier(0); } }
        const int c = col % 384, dir = col / 768; const float delta = dmin + (float)c * dstep; float ps = 0.f;
#pragma unroll
        for (int pp = 0; pp < 16; ++pp) { const int pos = p0 + pp; const float t = (float)pos / (float)(LL - 1); const float v = acc[pp] * __expf(-t * delta);
            HT[(size_t)pos * 1536 + col] = v; if (!(dir == 1 && pos == 0)) ps += fabsf(v); }
        PS[col] = ps; }
    __syncthreads();
}
__device__ __forceinline__ void p0_s5_item(Frame& F, int item2) {
    const int item = item2 >> 1, part = item2 & 1, l = item / 24, g = item % 24, tid = tid_of(F.wave);
    LAS f32x2* apow = (LAS f32x2*)F.lds;
    LAS f32x2* bbar = apow + 2 * 17 * 64;
    LAS f32x2* Cc = bbar + 2 * 64 * 16;
    LAS float* Kd = (LAS float*)(Cc + 2 * 16 * 64);
    if (tid < 128) { const int dir = tid >> 6, p = tid & 63; const size_t ix = (((size_t)l * 2 + dir) * 24 + g) * 64 + p;
        const float are = F.in[21][ix], aim = F.in[22][ix], dt = __expf(F.in[23][((size_t)l * 2 + dir) * 24 + g]);
        const float x = are * dt, yp = aim * dt * 0.3183098861837907f;
        for (int tau = 0; tau <= 16; ++tau) { const float mg = __expf(x * (float)tau), an = yp * (float)tau; apow[(dir * 17 + tau) * 64 + p] = (f32x2){mg * cospif(an), mg * sinpif(an)}; }
        const float sh = sinpif(0.5f * yp), nr = expm1f(x) * cospif(yp) - 2.0f * sh * sh, ni = __expf(x) * sinpif(yp); const float den = are * are + aim * aim;
        const float qr = (nr * are + ni * aim) / den, qi = (ni * are - nr * aim) / den;
        for (int h = 0; h < 16; ++h) { const float br = F.in[24][ix * 16 + h], bi = F.in[25][ix * 16 + h]; bbar[(dir * 64 + p) * 16 + h] = (f32x2){qr * br - qi * bi, qr * bi + qi * br}; }
        const float m16 = __expf(x * 16.0f), a16 = yp * 16.0f;
        WSP(float, WS_A16)[ix * 2 + 0] = m16 * cospif(a16); WSP(float, WS_A16)[ix * 2 + 1] = m16 * sinpif(a16); }
    for (int i = tid; i < 2 * 16 * 64; i += NTHR) { const int dir = i >> 10, h = (i >> 6) & 15, p = i & 63; const size_t ix = ((((size_t)l * 2 + dir) * 24 + g) * 16 + h) * 64 + p;
        Cc[i] = (f32x2){F.in[26][ix], F.in[27][ix]}; }
    __syncthreads();
    for (int i = tid; i < 2 * 16 * 256; i += NTHR) { const int dir = i >> 12, tau = (i >> 8) & 15, h = (i >> 4) & 15, h2 = i & 15; float s = 0.f;
        for (int p = 0; p < 64; ++p) { const f32x2 a = apow[(dir * 17 + tau) * 64 + p], b = bbar[(dir * 64 + p) * 16 + h2], c = Cc[(dir * 16 + h) * 64 + p];
            const float tr = a.x * b.x - a.y * b.y, ti = a.x * b.y + a.y * b.x; s += c.x * tr - c.y * ti; }
        Kd[i] = s; }
    __syncthreads();
    bf16* EST = (bf16*)(F.ws + WS_S5M + (size_t)item * S5M_STRIDE); bf16* MOUT = EST + 256 * 256;
    const float* dsk = F.in[28] + (size_t)l * 384 + g * 16;
    const int e_lo = part == 0 ? 0 : 32768 + 16384, e_hi = part == 0 ? 32768 + 16384 : 32768 + 65536;
    for (int pi = e_lo + tid; pi < e_hi; pi += NTHR) {
        float v2[2];
        if (pi < 32768) { const int n = pi >> 7, k0 = (pi & 127) * 2; const int dir = n >> 7, p = (n >> 1) & 63, ri = n & 1;
#pragma unroll
            for (int z = 0; z < 2; ++z) { const int k = k0 + z, hh = k >> 4, j = k & 15; const int tau = dir == 0 ? 15 - j : j; const f32x2 a = apow[(dir * 17 + tau) * 64 + p], bq = bbar[(dir * 64 + p) * 16 + hh];
                v2[z] = ri == 0 ? a.x * bq.x - a.y * bq.y : a.x * bq.y + a.y * bq.x; }
            *(unsigned*)(EST + (size_t)n * 256 + k0) = pk2(v2[0], v2[1]); }
        else { const int q = pi - 32768, n = q >> 8, k0 = (q & 255) * 2; const int j = n >> 4, h = n & 15;
#pragma unroll
            for (int z = 0; z < 2; ++z) { const int k = k0 + z; float v;
                if (k < 256) { const int hh = k >> 4, ii = k & 15; v = 0.f;
                    if (ii <= j) v += Kd[((0 * 16 + (j - ii)) * 16 + h) * 16 + hh];
                    if (ii >= j) v += Kd[((1 * 16 + (ii - j)) * 16 + h) * 16 + hh];
                    if (ii == j && h == hh) v += dsk[h]; }
                else { const int comp = k - 256, dir = comp >> 7, p = (comp >> 1) & 63, ri = comp & 1; const int tau = dir == 0 ? j + 1 : 16 - j;
                    const f32x2 a = apow[(dir * 17 + tau) * 64 + p], c = Cc[(dir * 16 + h) * 64 + p];
                    v = ri == 0 ? (c.x * a.x - c.y * a.y) : -(c.x * a.y + c.y * a.x); }
                v2[z] = v; }
            *(unsigned*)(MOUT + (size_t)n * 512 + k0) = pk2(v2[0], v2[1]); } }
    __syncthreads();
}
__device__ __forceinline__ void p0_prologue(Frame& F_) { Frame F = relocal(F_);
    PB(10); p0_transposes(F);
    __syncthreads(); PE(10);
    for (int i = F.vcu * NTHR + F.tid; i < 2 * 128 * 384 / 8; i += F.G * NTHR) { const int l = i / (128 * 384 / 8), r = i % (128 * 384 / 8);
        *(v4u*)(WSP(bf16, WS_GLU) + (size_t)l * 512 * 384 + 384 * 384 + (size_t)r * 8) = (v4u){0u, 0u, 0u, 0u}; }
    constexpr int I_S5 = 96, I_MOD = 96, I_FOLD = 128, I_FIL = 544, I_DFT = 65, I_DFTC = 4, NIT = I_S5 + I_MOD + I_FOLD + I_FIL + I_DFT + I_DFTC;
    for (int it = wq_next(F, 0); it < NIT; it = wq_next(F, 0)) {
        int r = it;
        if (r < I_S5) { PB(14); p0_s5_item(F, r); PE(14); continue; } r -= I_S5;
        if (r < I_MOD) { PB(12); p0_mod_item(F, r); PE(12); continue; } r -= I_MOD;
        if (r < I_FOLD) { PB(13); p0_fold_item(F, r); PE(13); continue; } r -= I_FOLD;
        if (r < I_FIL) { PB(11); p0_filter_item(F, r); PE(11); continue; } r -= I_FIL;
        if (r < I_DFT) { PB(15); gen_fft_mats(F, r); PE(15); continue; } r -= I_DFT;
        gen_dft_rows(WSP(bf16, WS_DFTC), LC, r * 64, 64, 1.0f / 16.0f, F.tid);
    }
}
__device__ __forceinline__ void p1_item(Frame& F_, int item) { Frame F = relocal(F_);
    const int qt = item & 3, ocb = (item >> 2) % 24, ls = (item >> 2) / 24, set = ls & 1, l = ls >> 1, o = ocb / 12, cb = ocb % 12, tid = F.tid;
    const int LL = set ? LC : L, nbt = set ? 1 : 4;
    if (set && qt) return;
    LAS float* red = (LAS float*)F.lds;
    LAS float* inv = red + 512;
    LAS float* T = inv + 32;
    const float* PS = WSP(float, WS_PS) + ((size_t)l * 272 + (set ? 256 : 0)) * 1536;
    { const int ch = tid & 31, part = tid >> 5; float s = 0.f; const int nblk = LL / 16;
      for (int b = part; b < nblk; b += 16) s += PS[(size_t)b * 1536 + o * 384 + cb * 32 + ch] + PS[(size_t)b * 1536 + 768 + o * 384 + cb * 32 + ch];
      red[part * 32 + ch] = s; }
    __syncthreads();
    if (tid < 32) { float s = 0.f; for (int p = 0; p < 16; ++p) s += red[p * 32 + tid]; inv[tid] = 1.0f / s; }
    const float* HT = WSP(float, WS_HT) + ((size_t)l * 4352 + (set ? 4096 : 0)) * 1536;
    float* KT = set ? WSP(float, WS_KTC) + ((size_t)(l * 2 + o) * 384) * 512 : WSP(float, WS_KT) + ((size_t)(l * 2 + o) * 384) * 8192;
#pragma unroll 1
    for (int bi = 0; bi < nbt; ++bi) { const int pos0 = (qt * nbt + bi) * 256;
        { const int ch = tid & 31, dir = (tid >> 5) & 1;
#pragma unroll 8
          for (int i = 0; i < 32; ++i) { const int pp = (tid >> 6) + 8 * i; T[(dir * 256 + pp) * 33 + ch] = HT[(size_t)(pos0 + pp) * 1536 + dir * 768 + o * 384 + cb * 32 + ch]; } }
        __syncthreads();
        { const int pp = tid & 255, c0 = tid >> 8;
#pragma unroll 4
          for (int i = 0; i < 16; ++i) { const int ch = c0 + 2 * i; const int pos = pos0 + pp; float* kt = KT + (size_t)(cb * 32 + ch) * 2 * LL;
              kt[LL + pos] = T[(0 * 256 + pp) * 33 + ch] * inv[ch];
              if (pos > 0) kt[LL - pos] = T[(1 * 256 + pp) * 33 + ch] * inv[ch]; else kt[0] = 0.f; } }
        __syncthreads(); }
}

__device__ __forceinline__ void norm_rows(Frame& F_, const float* xlat, const float* xctx, int nrows, const float* gain, const float* mod, int sh_off, int sc_off, bf16* out) { Frame F = relocal(F_);
    const int gw = F.vcu * NWAVES + F.wave, NGW = F.G * NWAVES, lane = F.lane;
    for (int r0 = gw; r0 < nrows; r0 += 2 * NGW) {
        f32x4 v[2][4]; float ss[2];
#pragma unroll
        for (int q = 0; q < 2; ++q) { const int r = r0 + q * NGW; ss[q] = 0.f;
            if (r < nrows) { const float* xr = r < NL ? xlat + (size_t)r * D : xctx + (size_t)(r - NL) * D;
#pragma unroll
                for (int j = 0; j < 4; ++j) v[q][j] = ((const f32x4*)xr)[64 * j + lane]; } }
#pragma unroll
        for (int q = 0; q < 2; ++q) { const int r = r0 + q * NGW;
            if (r < nrows) {
#pragma unroll
                for (int j = 0; j < 4; ++j) ss[q] += (v[q][j].x * v[q][j].x + v[q][j].y * v[q][j].y) + (v[q][j].z * v[q][j].z + v[q][j].w * v[q][j].w);
                const float rstd = 1.0f / sqrtf(wave_sum(ss[q], lane) * (1.0f / D) + 1e-6f);
                const float* md = mod + (size_t)bidx_of(r) * 6144;
#pragma unroll
                for (int j = 0; j < 4; ++j) { const int col = (64 * j + lane) * 4; const f32x4 g4 = *(const f32x4*)(gain + col), sc = *(const f32x4*)(md + sc_off + col), sh = *(const f32x4*)(md + sh_off + col);
                    const f32x4 h = v[q][j] * rstd * g4 * (sc + 1.0f) + sh;
                    *(v2u*)(out + (size_t)r * D + col) = (v2u){pk2(h.x, h.y), pk2(h.z, h.w)}; } } }
    }
}
__device__ __forceinline__ void norm_rows_b16(Frame& F_, const bf16* x, int nrows, const float* gain, const float* mod, int sh_off, int sc_off, bf16* out) { Frame F = relocal(F_);
    const int gw = F.vcu * NWAVES + F.wave, NGW = F.G * NWAVES, lane = F.lane;
    for (int r0 = gw; r0 < nrows; r0 += 2 * NGW) {
        v4u raw[2][2];
#pragma unroll
        for (int q = 0; q < 2; ++q) { const int r = r0 + q * NGW; if (r < nrows) {
#pragma unroll
            for (int j = 0; j < 2; ++j) raw[q][j] = *(const v4u*)(x + (size_t)r * D + 512 * j + 8 * lane); } }
#pragma unroll
        for (int q = 0; q < 2; ++q) { const int r = r0 + q * NGW;
            if (r < nrows) { float v[2][8]; float ss = 0.f;
#pragma unroll
                for (int j = 0; j < 2; ++j) { const v4u u = raw[q][j]; v[j][0] = bf2f(u.x & 0xffffu); v[j][1] = bf2f(u.x >> 16); v[j][2] = bf2f(u.y & 0xffffu); v[j][3] = bf2f(u.y >> 16); v[j][4] = bf2f(u.z & 0xffffu); v[j][5] = bf2f(u.z >> 16); v[j][6] = bf2f(u.w & 0xffffu); v[j][7] = bf2f(u.w >> 16);
#pragma unroll
                    for (int i = 0; i < 8; ++i) ss += v[j][i] * v[j][i]; }
                const float rstd = 1.0f / sqrtf(wave_sum(ss, lane) * (1.0f / D) + 1e-6f);
                const float* md = mod + (size_t)bidx_of(r) * 6144;
#pragma unroll
                for (int j = 0; j < 2; ++j) { const int col = 512 * j + 8 * lane; float h[8];
#pragma unroll
                    for (int i4 = 0; i4 < 2; ++i4) { const f32x4 g4 = *(const f32x4*)(gain + col + 4 * i4), sc = *(const f32x4*)(md + sc_off + col + 4 * i4), sh = *(const f32x4*)(md + sh_off + col + 4 * i4);
                        h[4 * i4 + 0] = v[j][4 * i4 + 0] * rstd * g4.x * (sc.x + 1.0f) + sh.x; h[4 * i4 + 1] = v[j][4 * i4 + 1] * rstd * g4.y * (sc.y + 1.0f) + sh.y;
                        h[4 * i4 + 2] = v[j][4 * i4 + 2] * rstd * g4.z * (sc.z + 1.0f) + sh.z; h[4 * i4 + 3] = v[j][4 * i4 + 3] * rstd * g4.w * (sc.w + 1.0f) + sh.w; }
                    *(v4u*)(out + (size_t)r * D + col) = (v4u){pk2(h[0], h[1]), pk2(h[2], h[3]), pk2(h[4], h[5]), pk2(h[6], h[7])}; } } }
    }
}
__device__ __forceinline__ void norm2_router(Frame& F_, const float* x, const float* gain, const float* mod, bf16* out) { Frame F = relocal(F_);
    LAS int* hist = (LAS int*)F.lds;
    const float* rw = F.in[34]; const float* rb = F.in[35];
    for (int tile = F.vcu; tile < NL / 256; tile += F.G) {
        if (F.tid < 16) hist[F.tid] = 0;
        __syncthreads();
        f32x4 vn[4];
        { const float* xr0 = x + (size_t)(tile * 256 + F.wave * 32) * D;
#pragma unroll
          for (int j = 0; j < 4; ++j) vn[j] = ((const f32x4*)xr0)[64 * j + F.lane]; }
#pragma unroll 1
        for (int i = 0; i < 32; ++i) { const int r = tile * 256 + F.wave * 32 + i, lane = F.lane;
            const float* md = mod + (size_t)(r >> 12) * 6144;
            f32x4 v[4]; float ss = 0.f;
#pragma unroll
            for (int j = 0; j < 4; ++j) v[j] = vn[j];
            if (i + 1 < 32) { const float* xn = x + (size_t)(r + 1) * D;
#pragma unroll
                for (int j = 0; j < 4; ++j) vn[j] = ((const f32x4*)xn)[64 * j + lane]; }
#pragma unroll
            for (int j = 0; j < 4; ++j) ss += (v[j].x * v[j].x + v[j].y * v[j].y) + (v[j].z * v[j].z + v[j].w * v[j].w);
            const float rstd = 1.0f / sqrtf(wave_sum(ss, lane) * (1.0f / D) + 1e-6f);
            float lg[8];
#pragma unroll
            for (int e = 0; e < 8; ++e) lg[e] = 0.f;
#pragma unroll
            for (int j = 0; j < 4; ++j) { const int col = (64 * j + lane) * 4; const f32x4 g4 = *(const f32x4*)(gain + col), sc = *(const f32x4*)(md + 4096 + col), sh = *(const f32x4*)(md + 3072 + col);
                const f32x4 h = v[j] * rstd * g4 * (sc + 1.0f) + sh;
                *(v2u*)(out + (size_t)r * D + col) = (v2u){pk2(h.x, h.y), pk2(h.z, h.w)};
#pragma unroll
                for (int q = 0; q < 4; ++q) { const f32x4 w0 = *(const f32x4*)(rw + (size_t)(col + q) * 8), w1 = *(const f32x4*)(rw + (size_t)(col + q) * 8 + 4); const float hv = h[q];
                    lg[0] += hv * w0.x; lg[1] += hv * w0.y; lg[2] += hv * w0.z; lg[3] += hv * w0.w; lg[4] += hv * w1.x; lg[5] += hv * w1.y; lg[6] += hv * w1.z; lg[7] += hv * w1.w; } }
#pragma unroll
            for (int e = 0; e < 8; ++e) lg[e] = wave_sum(lg[e], lane) + rb[e];
            if (lane == 0) {
                int e1 = 0; float v1 = lg[0];
#pragma unroll
                for (int e = 1; e < 8; ++e) if (lg[e] > v1) { v1 = lg[e]; e1 = e; }
                int e2 = -1; float v2 = -3.4e38f;
#pragma unroll
                for (int e = 0; e < 8; ++e) if (e != e1 && lg[e] > v2) { v2 = lg[e]; e2 = e; }
                const float ex = __expf(v2 - v1), w1 = 1.0f / (1.0f + ex), w2 = ex / (1.0f + ex);
                *(v4u*)(F.ws + WS_TOPK + (size_t)r * 16) = (v4u){(unsigned)(e1 | (e2 << 8)), __builtin_bit_cast(unsigned, w1), __builtin_bit_cast(unsigned, w2), 0u};
                __hip_atomic_fetch_add(hist + e1, 1, __ATOMIC_RELAXED, __HIP_MEMORY_SCOPE_WORKGROUP); __hip_atomic_fetch_add(hist + 8 + e2, 1, __ATOMIC_RELAXED, __HIP_MEMORY_SCOPE_WORKGROUP);
            } }
        __syncthreads();
        if (F.tid < 16) ((int*)(F.ws + WS_META + META_CNT))[tile * 16 + F.tid] = hist[F.tid];
        __syncthreads();
    }
}
__device__ __forceinline__ void moe_slots(Frame& F_) { Frame F = relocal(F_);
    LAS int* tot = (LAS int*)F.lds;
    LAS int* es = tot + 32;
    const int* CNT = (const int*)(F.ws + WS_META + META_CNT); int* IDX = (int*)(F.ws + WS_META + META_IDX); int* TE = (int*)(F.ws + WS_META + META_TE); int* NT = (int*)(F.ws + WS_META + META_NT);
    for (int it = F.vcu; it < 512; it += F.G) { const int k = it >> 8, tile = it & 255, tid = F.tid;
        if (tid < 8) { int t = 0, b = 0; for (int i = 0; i < 256; ++i) { const int c = CNT[i * 16 + k * 8 + tid]; if (i < tile) b += c; t += c; } tot[tid] = t; tot[8 + tid] = b; }
        __syncthreads();
        if (tid == 0) { int s = 0; for (int e = 0; e < 8; ++e) { tot[16 + e] = s; s += (tot[e] + 255) & ~255; } tot[24] = s; }
        if (tid < 256) { const unsigned pk = *(const unsigned*)(F.ws + WS_TOPK + (size_t)(tile * 256 + tid) * 16); es[tid] = k == 0 ? (int)(pk & 255u) : (int)((pk >> 8) & 255u); }
        __syncthreads();
        if (tid < 256) { const int e = es[tid]; int rank = 0; for (int j = 0; j < tid; ++j) rank += (es[j] == e) ? 1 : 0;
            const int slot = tot[16 + e] + tot[8 + e] + rank; IDX[k * MAXSLOT + slot] = tile * 256 + tid; if (k == 1) ((int*)(F.ws + WS_META + META_SL1))[tile * 256 + tid] = slot; }
        if (tile == 0) {
            for (int e = 0; e < 8; ++e) { const int n = tot[e], np = (n + 255) & ~255, sb = tot[16 + e];
                for (int i = n + tid; i < np; i += NTHR) IDX[k * MAXSLOT + sb + i] = -1;
                for (int i = tid; i < np / 256; i += NTHR) TE[k * 272 + sb / 256 + i] = e; }
            if (tid == 0) NT[k] = tot[24] / 256; }
        __syncthreads();
    }
}
__device__ __forceinline__ void final_norm_part(Frame& F_, int part, int ntw) { Frame F = relocal(F_);
    const int bx = (int)blockIdx.x; if (part == 0 && bx < ntw) return;
    const int gw = part == 0 ? (bx - ntw) * NWAVES + F.wave : F.vcu * NWAVES + F.wave, NGW = (part == 0 ? F.G - ntw : F.G) * NWAVES, lane = F.lane; const float* gain = F.in[39];
    const int* SL1 = (const int*)(F.ws + WS_META + META_SL1);
    for (int r0 = gw; r0 < NL; r0 += 2 * NGW) { f32x4 v[2][4]; bool ok[2];
#pragma unroll
        for (int q = 0; q < 2; ++q) { const int r = r0 + q * NGW; ok[q] = r < NL && ((SL1[r < NL ? r : 0] >= NL) == (part == 1)); if (ok[q]) { const float* xr = F.out + (size_t)r * D;
#pragma unroll
            for (int j = 0; j < 4; ++j) v[q][j] = ((const f32x4*)xr)[64 * j + lane]; } }
#pragma unroll
        for (int q = 0; q < 2; ++q) { const int r = r0 + q * NGW; if (ok[q]) { float* xr = F.out + (size_t)r * D; float ss = 0.f;
#pragma unroll
            for (int j = 0; j < 4; ++j) ss += (v[q][j].x * v[q][j].x + v[q][j].y * v[q][j].y) + (v[q][j].z * v[q][j].z + v[q][j].w * v[q][j].w);
            const float rstd = 1.0f / sqrtf(wave_sum(ss, lane) * (1.0f / D) + 1e-6f);
#pragma unroll
            for (int j = 0; j < 4; ++j) { const int col = (64 * j + lane) * 4; ((f32x4*)xr)[64 * j + lane] = v[q][j] * rstd * *(const f32x4*)(gain + col); } } } }
}

__device__ __forceinline__ float sconv(const bf16* prow, int colbase, int t, int LL, bool grid, float w0, float w1, float w2, float bias) {
    const bool hasl = grid ? ((t & 63) != 0) : (t > 0), hasr = grid ? ((t & 63) != 63) : (t < LL - 1);
    const float c = bf2f(prow[colbase + t]), a = hasl ? bf2f(prow[colbase + t - 1]) : 0.f, b = hasr ? bf2f(prow[colbase + t + 1]) : 0.f;
    return a * w0 + c * w1 + b * w2 + bias;
}
template <int LL, int NT, int NBT>
__device__ __forceinline__ void hyena_unit(Frame& F, int l, int o, int c, int b0, bool latent) {
    constexpr int TPB = LL / NT, BG = NTHR / TPB, NBU = BG * NBT;
    LAS float* kk = (LAS float*)F.lds;
    LAS float* us = kk + 2 * LL;
    const int tid = F.tid;
    const bf16* PT = WSP(bf16, WS_PT);
    const float* cw = F.in[11] + (size_t)l * 3 * 1152; const float* cb = F.in[12] + (size_t)l * 1152;
    const int in_row = R_HY + c;
    const int mul_row = R_HY + 384 * (o + 1) + c, mul_ch = 384 * (o + 1) + c;
    const int out_row = o == 0 ? R_HY + c : R_HY + 384 + c;
    const float* KT = latent ? WSP(float, WS_KT) + ((size_t)(l * 2 + o) * 384 + c) * 8192 : WSP(float, WS_KTC) + ((size_t)(l * 2 + o) * 384 + c) * 512;
    for (int i = tid; i < 2 * LL; i += NTHR) kk[i] = KT[i];
    { const float w0 = cw[c], w1 = cw[1152 + c], w2 = cw[2304 + c], bs = cb[c];
      for (int i = tid; i < NBU * LL; i += NTHR) { const int bb = i / LL, t = i % LL; const int colbase = latent ? (b0 + bb) * L : NL + (b0 + bb) * LC;
          us[i] = o == 0 ? sconv(PT + (size_t)in_row * MT, colbase, t, LL, latent, w0, w1, w2, bs) : bf2f(PT[(size_t)in_row * MT + colbase + t]); } }
    __syncthreads();
    float acc[NBT][NT];
#pragma unroll
    for (int bj = 0; bj < NBT; ++bj)
#pragma unroll
        for (int tj = 0; tj < NT; ++tj) acc[bj][tj] = 0.f;
    const int tb = tid % TPB, bg = tid / TPB;
#pragma unroll 4
    for (int s = 0; s < LL; ++s) { float kv[NT], uv[NBT];
#pragma unroll
        for (int tj = 0; tj < NT; ++tj) kv[tj] = kk[LL + tb + TPB * tj - s];
#pragma unroll
        for (int bj = 0; bj < NBT; ++bj) uv[bj] = us[(bg + BG * bj) * LL + s];
#pragma unroll
        for (int bj = 0; bj < NBT; ++bj)
#pragma unroll
            for (int tj = 0; tj < NT; ++tj) acc[bj][tj] += kv[tj] * uv[bj]; }
    const float hb = F.in[20][((size_t)l * 2 + o) * 384 + c];
    const float m0 = cw[mul_ch], m1 = cw[1152 + mul_ch], m2 = cw[2304 + mul_ch], mb = cb[mul_ch];
    bf16* PTw = WSP(bf16, WS_PT);
#pragma unroll
    for (int bj = 0; bj < NBT; ++bj)
#pragma unroll
        for (int tj = 0; tj < NT; ++tj) { const int bb = bg + BG * bj, t = tb + TPB * tj; const int colbase = latent ? (b0 + bb) * L : NL + (b0 + bb) * LC;
            const float uval = us[bb * LL + t]; const float xm = sconv(PT + (size_t)mul_row * MT, colbase, t, LL, latent, m0, m1, m2, mb);
            PTw[(size_t)out_row * MT + colbase + t] = (bf16)f2bf(xm * (acc[bj][tj] + hb * uval)); asm volatile("" ::: "memory"); }
    __syncthreads();
}
template <int LL, int NTW, bool GRID>
__device__ __forceinline__ void hyena_job(Frame& F, int l, int o, int c, int tbase) {
    constexpr int TR = NWAVES * NTW * 16, NENT = LL - 8 + TR, NSG = LL / 128;
    const int tid = F.tid, lane = F.lane, fr = lane & 15, fq = lane >> 4;
    const int mmin = -tbase - TR + 1;
    LAS unsigned char* VT = F.lds;
    PB(2);
    {   const float* KT = GRID ? WSP(float, WS_KT) + ((size_t)(l * 2 + o) * 384 + c) * 8192 : WSP(float, WS_KTC) + ((size_t)(l * 2 + o) * 384 + c) * 512;
        for (int e = tid; e < NENT; e += NTHR) { const int m = mmin + e; float v[8];
#pragma unroll
            for (int j = 0; j < 8; ++j) { const int tau = -(m + j); v[j] = (tau > -LL && tau < LL) ? KT[tau + LL] : 0.f; }
            *(LAS v4u*)(VT + (e ^ (((e >> 4) & 1) << 3)) * 16) = (v4u){pk2(v[0], v[1]), pk2(v[2], v[3]), pk2(v[4], v[5]), pk2(v[6], v[7])}; } }
    __syncthreads();
    PE(2); PB(3);
    const float* cw = F.in[11] + (size_t)l * 3 * 1152; const float* cb = F.in[12] + (size_t)l * 1152;
    const bf16* inrow = (o == 0 ? WSP(bf16, WS_VP) : WSP(bf16, WS_Z1)) + (size_t)c * MT;
    const bf16* mulrow = WSP(bf16, WS_PT) + (size_t)(R_HY + 384 * (o + 1) + c) * MT;
    bf16* outrow = o == 0 ? WSP(bf16, WS_Z1) + (size_t)c * MT : WSP(bf16, WS_PT) + (size_t)(R_HY + 384 + c) * MT;
    const int colb = GRID ? fr * L : NL + fr * LC;
    const int T0 = tbase + F.wave * NTW * 16;
    f32x4 acc[NTW];
#pragma unroll
    for (int i = 0; i < NTW; ++i) acc[i] = (f32x4){0.f, 0.f, 0.f, 0.f};
    const int E0 = 8 * fq - fr - T0 - mmin - 16 * (NTW - 1);
    const int lbA = ((E0 & ~15) | ((E0 & 15) ^ (((E0 >> 4) & 1) << 3))) * 16, lbB = lbA ^ 128;
    const bf16* bp = inrow + colb + 8 * fq;
    v4u ra[4], rb[4];
#pragma unroll
    for (int jj = 0; jj < 4; ++jj) { ra[jj] = *(const v4u*)(bp + jj * 32); rb[jj] = *(const v4u*)(bp + 128 + jj * 32); }
#define HY_GROUP(sg, R) do { bf16x8 Bf[4]; _Pragma("unroll") for (int jj = 0; jj < 4; ++jj) Bf[jj] = __builtin_bit_cast(bf16x8, R[jj]); \
        if ((sg) + 2 < NSG) { _Pragma("unroll") for (int jj = 0; jj < 4; ++jj) R[jj] = *(const v4u*)(bp + ((sg) + 2) * 128 + jj * 32); } \
        const LAS unsigned char* vtA = VT + lbA + (sg) * 2048; const LAS unsigned char* vtB = VT + lbB + (sg) * 2048; \
        bf16x8 Ar[NBUF]; \
        _Pragma("unroll") for (int q = 0; q < NBUF; ++q) Ar[q] = *(const LAS bf16x8*)((((NTW + 5 - q) & 1) ? vtB : vtA) + 256 * (NTW + 5 - q)); \
        _Pragma("unroll") for (int dd = 0; dd < ND; ++dd) { const int e = dd - 6; const bf16x8 A = Ar[dd % NBUF]; \
            _Pragma("unroll") for (int jj = 0; jj < 4; ++jj) { const int i = e + 2 * jj; if (i >= 0 && i < NTW) acc[i] = __builtin_amdgcn_mfma_f32_16x16x32_bf16(A, Bf[jj], acc[i], 0, 0, 0); } \
            if (dd + NBUF < ND) Ar[dd % NBUF] = *(const LAS bf16x8*)((((NTW + 5 - dd - NBUF) & 1) ? vtB : vtA) + 256 * (NTW + 5 - dd - NBUF)); \
            __builtin_amdgcn_sched_barrier(0); } } while (0)
    constexpr int ND = NTW + 6, NBUF = ND < 4 ? ND : 4;
#pragma unroll 1
    for (int sg = 0; sg < NSG; sg += 2) { HY_GROUP(sg, ra); HY_GROUP(sg + 1, rb); }
#undef HY_GROUP
    PE(3); PB(4);
    const float hb = F.in[20][((size_t)l * 2 + o) * 384 + c];
    const int mch = 384 * (o + 1) + c; const float m0 = cw[mch], m1 = cw[1152 + mch], m2 = cw[2304 + mch], mb = cb[mch];
    constexpr int EB = NTW;
#pragma unroll
    for (int i0 = 0; i0 < NTW; i0 += EB) {
        v2u xr[EB], ur[EB]; unsigned xl[EB], xh[EB];
#pragma unroll
        for (int q = 0; q < EB; ++q) { const int t = T0 + 16 * (i0 + q) + 4 * fq;
            const bool hl = GRID ? ((t & 63) != 0) : (t > 0), hr = GRID ? (((t + 3) & 63) != 63) : (t + 4 < LL);
            const bf16* p = mulrow + colb + t; xr[q] = *(const v2u*)p; xl[q] = hl ? (unsigned)p[-1] : 0u; xh[q] = hr ? (unsigned)p[4] : 0u;
            ur[q] = *(const v2u*)(inrow + colb + t); }
#pragma unroll
        for (int q = 0; q < EB; ++q) { const int i = i0 + q; const int t = T0 + 16 * i + 4 * fq;
            float x[6], u[4];
            x[0] = bf2f((unsigned short)xl[q]); x[5] = bf2f((unsigned short)xh[q]); x[1] = bf2f(xr[q].x & 0xffffu); x[2] = bf2f(xr[q].x >> 16); x[3] = bf2f(xr[q].y & 0xffffu); x[4] = bf2f(xr[q].y >> 16);
            u[0] = bf2f(ur[q].x & 0xffffu); u[1] = bf2f(ur[q].x >> 16); u[2] = bf2f(ur[q].y & 0xffffu); u[3] = bf2f(ur[q].y >> 16);
            float ov[4];
#pragma unroll
            for (int r = 0; r < 4; ++r) { const float xm = x[r] * m0 + x[r + 1] * m1 + x[r + 2] * m2 + mb; ov[r] = xm * (acc[i][r] + hb * u[r]); }
            *(v2u*)(outrow + colb + t) = (v2u){pk2(ov[0], ov[1]), pk2(ov[2], ov[3])}; }
    }
    __syncthreads();
    PE(4);
}
__device__ __forceinline__ void shortconv_v(Frame& F_, int l) { Frame F = relocal(F_);
    const float* cw = F.in[11] + (size_t)l * 3 * 1152; const float* cb = F.in[12] + (size_t)l * 1152;
    const int ncol8 = (l == 0 ? MT : NL) / 8; const long total = (long)384 * ncol8;
    const long stride = (long)F.G * NTHR;
    for (long it0 = (long)F.vcu * NTHR + F.tid; it0 < total; it0 += 2 * stride) {
        v4u raw[2]; unsigned lft[2], rgt[2]; int cc[2], colv[2]; bool ok[2];
#pragma unroll
        for (int q = 0; q < 2; ++q) { const long it = it0 + q * stride; ok[q] = it < total; cc[q] = 0; colv[q] = 0; raw[q] = (v4u){0u, 0u, 0u, 0u}; lft[q] = 0u; rgt[q] = 0u;
            if (ok[q]) { const int c = (int)(it / ncol8), col = (int)(it % ncol8) * 8; cc[q] = c; colv[q] = col;
                const bf16* p = WSP(bf16, WS_PT) + (size_t)(R_HY + c) * MT + col;
                bool hl, hr; if (col < NL) { hl = (col & 63) != 0; hr = ((col + 7) & 63) != 63; } else { const int t = (col - NL) & (LC - 1); hl = t != 0; hr = t + 8 < LC; }
                raw[q] = *(const v4u*)p; lft[q] = hl ? (unsigned)p[-1] : 0u; rgt[q] = hr ? (unsigned)p[8] : 0u; } }
#pragma unroll
        for (int q = 0; q < 2; ++q) if (ok[q]) { const int c = cc[q]; float qv[10]; qv[0] = bf2f((unsigned short)lft[q]); qv[9] = bf2f((unsigned short)rgt[q]);
            qv[1] = bf2f(raw[q].x & 0xffffu); qv[2] = bf2f(raw[q].x >> 16); qv[3] = bf2f(raw[q].y & 0xffffu); qv[4] = bf2f(raw[q].y >> 16); qv[5] = bf2f(raw[q].z & 0xffffu); qv[6] = bf2f(raw[q].z >> 16); qv[7] = bf2f(raw[q].w & 0xffffu); qv[8] = bf2f(raw[q].w >> 16);
            const float w0 = cw[c], w1 = cw[1152 + c], w2 = cw[2304 + c], bs = cb[c]; float r[8];
#pragma unroll
            for (int j = 0; j < 8; ++j) r[j] = qv[j] * w0 + qv[j + 1] * w1 + qv[j + 2] * w2 + bs;
            *(v4u*)(WSP(bf16, WS_VP) + (size_t)c * MT + colv[q]) = (v4u){pk2(r[0], r[1]), pk2(r[2], r[3]), pk2(r[4], r[5]), pk2(r[6], r[7])}; } }
}
__device__ __forceinline__ void hyena_stage(Frame& F_, int l, int o) { Frame F = relocal(F_);
    const int nlat = 384 * 2, nctx = l == 0 ? 384 : 0;
    for (int u = F.vcu; u < nlat + nctx; u += F.G) {
        if (u < nlat) hyena_job<L, 16, true>(F, l, o, u >> 1, (u & 1) * 2048);
        else hyena_job<LC, 2, false>(F, l, o, u - nlat, 0);
    }
}
__device__ __forceinline__ void hyena_transpose(Frame& F_, int nrows) { Frame F = relocal(F_);
    LAS bf16* T = (LAS bf16*)F.lds; constexpr int PITCH = 258;
    const bf16* PT = WSP(bf16, WS_PT); bf16* Y = WSP(bf16, WS_HMOD); const int tid = F.tid;
    const int nrt = nrows / 256;
    for (int it = F.vcu; it < 6 * nrt; it += F.G) { const int cb = it % 6, rt = it / 6;
        { const int c = tid >> 3, seg = tid & 7; const bf16* src = PT + (size_t)(R_HY + 384 + cb * 64 + c) * MT + rt * 256 + seg * 32;
#pragma unroll
          for (int q = 0; q < 4; ++q) { const v4u v = *(const v4u*)(src + q * 8); LAS unsigned* d = (LAS unsigned*)(T + c * PITCH + seg * 32 + q * 8); d[0] = v.x; d[1] = v.y; d[2] = v.z; d[3] = v.w; } }
        __syncthreads();
        { const int r = tid >> 1, half = tid & 1; unsigned w[16];
#pragma unroll
          for (int q = 0; q < 16; ++q) { const unsigned lo = T[(half * 32 + 2 * q) * PITCH + r], hi = T[(half * 32 + 2 * q + 1) * PITCH + r]; w[q] = lo | (hi << 16); }
          bf16* dst = Y + (size_t)(rt * 256 + r) * D + 256 + cb * 64 + half * 32;
#pragma unroll
          for (int q = 0; q < 4; ++q) *(v4u*)(dst + q * 8) = (v4u){w[4 * q], w[4 * q + 1], w[4 * q + 2], w[4 * q + 3]}; }
        __syncthreads();
    }
}

__device__ __forceinline__ void s5_carry_item(Frame& F, int l, int item) {
    const float* E = (const float*)((unsigned char*)F.out + DO_E); bf16* HS = (bf16*)((unsigned char*)F.out + DO_HS);
    const int id = item * NTHR + F.tid;
    const int p = id & 63, dir = (id >> 6) & 1, g = (id >> 7) % 24, b = id / (128 * 24);
    const size_t ix = (((size_t)l * 2 + dir) * 24 + g) * 64 + p; const float ar = WSP(float, WS_A16)[ix * 2], ai = WSP(float, WS_A16)[ix * 2 + 1];
    const int comp = dir * 128 + 2 * p, q = comp >> 4, i0 = comp & 15;
    float sr = 0.f, si = 0.f;
#pragma unroll 1
    for (int s0 = 0; s0 < 272; s0 += 8) { f32x2 e[8]; int ci[8];
#pragma unroll
        for (int j = 0; j < 8; ++j) { const int step = s0 + j; int cidx;
            if (dir == 0) cidx = step < 16 ? NL / 16 + b * 16 + step : b * 256 + (step - 16);
            else cidx = step < 16 ? NL / 16 + b * 16 + (15 - step) : b * 256 + (255 - (step - 16));
            ci[j] = cidx; e[j] = *(const f32x2*)(E + ((size_t)g * NCHUNK + cidx) * 256 + comp); }
#pragma unroll
        for (int j = 0; j < 8; ++j) { *(unsigned*)(HS + (size_t)(g * 16 + q) * MT + (size_t)ci[j] * 16 + i0) = pk2(sr, si);
            const float nr = ar * sr - ai * si + e[j].x, ni = ar * si + ai * sr + e[j].y; sr = nr; si = ni; } }
}
__device__ __forceinline__ void hyena_stage2_carry(Frame& F_, int l) { Frame F = relocal(F_);
    const int ncar = 96, nlat = 384 * 2, nctx = l == 0 ? 384 : 0, qid = 1 + l;
    for (int u = wq_next(F, qid); u < ncar + nlat + nctx; u = wq_next(F, qid)) {
        if (u < ncar) s5_carry_item(F, l, u);
        else if (u < ncar + nlat) hyena_job<L, 16, true>(F, l, 1, (u - ncar) >> 1, ((u - ncar) & 1) * 2048);
        else hyena_job<LC, 2, false>(F, l, 1, u - ncar - nlat, 0);
    }
}

struct A_WinT { const bf16* w; __device__ __forceinline__ const bf16* operator()(int, int r, int k) const { return w + (size_t)r * D + k; } };
struct E_PT { bf16* pt; __device__ __forceinline__ void operator()(int, int r, int c, f32x4 v0, f32x4 v1) const {
    *(v2u*)(pt + (size_t)r * MT + c) = (v2u){pk2(v0.x, v0.y), pk2(v0.z, v0.w)}; *(v2u*)(pt + (size_t)r * MT + c + 16) = (v2u){pk2(v1.x, v1.y), pk2(v1.z, v1.w)}; } };
struct A_Dft { const bf16* d; int ld; __device__ __forceinline__ const bf16* operator()(int, int r, int k) const { return d + (size_t)r * ld + k; } };
struct B_FnetLat { const bf16* pt; __device__ __forceinline__ const bf16* operator()(int bt, int n, int k) const { return pt + (size_t)((k >> 12) * 256 + n) * MT + bt * L + (k & 4095); } };
struct B_FnetCtx { const bf16* pt; __device__ __forceinline__ const bf16* operator()(int bt, int n, int k) const { return pt + (size_t)((k >> 8) * 256 + n) * MT + NL + bt * LC + (k & 255); } };
struct E_FA { bf16* ab; __device__ __forceinline__ void one(int m, int c, f32x4 v) const { const int b = c >> 14, n = (c >> 6) & 255, s2 = c & 63, pp = m >> 6, t1 = m & 63;
    *(v2u*)(ab + ((((size_t)b * 256 + n) * 64 + t1) * 2 + pp) * 64 + s2) = (v2u){pk2(v.x, v.y), pk2(v.z, v.w)}; }
    __device__ __forceinline__ void operator()(int, int m, int c, f32x4 v0, f32x4 v1) const { if (m >= 128) return; one(m, c, v0); one(m, c + 16, v1); } };
struct E_FB { bf16* y; __device__ __forceinline__ void operator()(int bt, int r, int c, f32x4 v0, f32x4 v1) const { const int t = 4 * (r >> 8) + ((r >> 6) & 3) + 64 * (r & 63);
    bf16* p = y + ((size_t)bt * L + t) * D + c; *(v2u*)p = (v2u){pk2(v0.x, v0.y), pk2(v0.z, v0.w)}; *(v2u*)(p + 16) = (v2u){pk2(v1.x, v1.y), pk2(v1.z, v1.w)}; } };
struct E_Fnet { bf16* y; int rowbase, rows_per; __device__ __forceinline__ void operator()(int bt, int r, int c, f32x4 v0, f32x4 v1) const { bf16* p = y + (size_t)(rowbase + bt * rows_per + r) * D + c;
    *(v2u*)p = (v2u){pk2(v0.x, v0.y), pk2(v0.z, v0.w)}; *(v2u*)(p + 16) = (v2u){pk2(v1.x, v1.y), pk2(v1.z, v1.w)}; } };
struct A_S5 { const bf16* pt; const bf16* hs; __device__ __forceinline__ const bf16* operator()(int g, int r, int k) const {
    return k < 256 ? pt + (size_t)(R_S5 + g * 16 + (k >> 4)) * MT + (size_t)r * 16 + (k & 15) : hs + (size_t)(g * 16 + ((k - 256) >> 4)) * MT + (size_t)r * 16 + (k & 15); } };
struct B_S5 { const bf16* m; int off, ld; __device__ __forceinline__ const bf16* operator()(int g, int n, int k) const { return (const bf16*)((const unsigned char*)m + (size_t)g * S5M_STRIDE) + off + (size_t)n * ld + k; } };
struct E_S5E { float* e; __device__ __forceinline__ void operator()(int g, int r, int c, f32x4 v0, f32x4 v1) const { float* p = e + ((size_t)g * NCHUNK + r) * 256 + c; *(f32x4*)p = v0; *(f32x4*)(p + 16) = v1; } };
struct E_S5O { bf16* ys; __device__ __forceinline__ void operator()(int g, int r, int c, f32x4 v0, f32x4 v1) const {
    { const int j = c >> 4, h = c & 15; bf16* p = ys + ((size_t)r * 16 + j) * 384 + g * 16 + h; *(v2u*)p = (v2u){pk2(gelu_tanh_f(v0.x), gelu_tanh_f(v0.y)), pk2(gelu_tanh_f(v0.z), gelu_tanh_f(v0.w))}; }
    { const int c1 = c + 16, j = c1 >> 4, h = c1 & 15; bf16* p = ys + ((size_t)r * 16 + j) * 384 + g * 16 + h; *(v2u*)p = (v2u){pk2(gelu_tanh_f(v1.x), gelu_tanh_f(v1.y)), pk2(gelu_tanh_f(v1.z), gelu_tanh_f(v1.w))}; } } };
struct E_Glu { const bf16* ys; bf16* y; const float* gb;
    struct Pre { v2u y0, y1; f32x4 b0, b1; };
    __device__ __forceinline__ Pre pre(int, int r, int c) const { Pre p; p.y0 = (v2u){0u, 0u}; p.y1 = p.y0; p.b0 = (f32x4){0.f, 0.f, 0.f, 0.f}; p.b1 = p.b0;
        if (c < 384) { p.y0 = *(const v2u*)(ys + (size_t)r * 384 + c); p.b0 = *(const f32x4*)(gb + c); } if (c + 16 < 384) { p.y1 = *(const v2u*)(ys + (size_t)r * 384 + c + 16); p.b1 = *(const f32x4*)(gb + c + 16); } return p; }
    __device__ __forceinline__ void one(int r, int c, v2u yv, f32x4 b, f32x4 v) const { if (c >= 384) return;
        const float y0 = bf2f(yv.x & 0xffffu), y1 = bf2f(yv.x >> 16), y2 = bf2f(yv.y & 0xffffu), y3 = bf2f(yv.y >> 16);
        *(v2u*)(y + (size_t)r * D + 640 + c) = (v2u){pk2(y0 * sigmoid_f(v.x + b.x), y1 * sigmoid_f(v.y + b.y)), pk2(y2 * sigmoid_f(v.z + b.z), y3 * sigmoid_f(v.w + b.w))}; }
    __device__ __forceinline__ void post(const Pre& p, int, int r, int c, f32x4 v0, f32x4 v1) const { one(r, c, p.y0, p.b0, v0); one(r, c + 16, p.y1, p.b1, v1); } };
template <bool XI16, bool XO16> struct E_Res {
    static constexpr bool RMW = true; const void* xlat; const void* xctx; void* xo; const float* mod; int goff;
    struct Pre { f32x4 x0, x1, g0, g1; };
    __device__ __forceinline__ static f32x4 ld4(const void* base, size_t idx) { if (XI16) { const v2u u = *(const v2u*)((const bf16*)base + idx); return (f32x4){bf2f(u.x & 0xffffu), bf2f(u.x >> 16), bf2f(u.y & 0xffffu), bf2f(u.y >> 16)}; } else return *(const f32x4*)((const float*)base + idx); }
    __device__ __forceinline__ Pre pre(int, int r, int c) const { Pre p; const float* g = mod + (size_t)bidx_of(r) * 6144 + goff + c;
        const void* xb = r < NL ? xlat : xctx; const size_t idx = (size_t)(r < NL ? r : r - NL) * D + c;
        p.x0 = ld4(xb, idx); p.x1 = ld4(xb, idx + 16); p.g0 = *(const f32x4*)g; p.g1 = *(const f32x4*)(g + 16); return p; }
    __device__ __forceinline__ void post(const Pre& p, int, int r, int c, f32x4 v0, f32x4 v1) const { const f32x4 o0 = p.x0 + p.g0 * v0, o1 = p.x1 + p.g1 * v1; const size_t idx = (size_t)r * D + c;
        if (XO16) { *(v2u*)((bf16*)xo + idx) = (v2u){pk2(o0.x, o0.y), pk2(o0.z, o0.w)}; *(v2u*)((bf16*)xo + idx + 16) = (v2u){pk2(o1.x, o1.y), pk2(o1.z, o1.w)}; }
        else { *(f32x4*)((float*)xo + idx) = o0; *(f32x4*)((float*)xo + idx + 16) = o1; } } };
struct E_Swi { bf16* act; int ld; __device__ __forceinline__ void operator()(int, int r, int c, f32x4 v0, f32x4 v1) const {
    const int f = 16 * (c >> 5) + (c & 15); *(v2u*)(act + tiled_idx(r, f, ld / 64)) = (v2u){pk2(silu_f(v0.x) * v1.x, silu_f(v0.y) * v1.y), pk2(silu_f(v0.z) * v1.z, silu_f(v0.w) * v1.w)}; } };
struct A_MoeUp { const bf16* h; const int* idx; __device__ __forceinline__ const bf16* operator()(int, int r, int k) const { int t = idx[r]; t = t < 0 ? 0 : t; return h + (size_t)t * D + k; } };
struct E_MoeDown0 { bf16* o1; const int* idx; const unsigned char* topk; const float* mod;
    __device__ __forceinline__ void operator()(int, int r, int c, f32x4 v0, f32x4 v1) const { const int t = idx[r]; if (t < 0) return; const float w = *(const float*)(topk + (size_t)t * 16 + 4);
        const float* g = mod + (size_t)(t >> 12) * 6144 + 5120 + c; const f32x4 a = *(const f32x4*)g * (v0 * w), b = *(const f32x4*)(g + 16) * (v1 * w);
        bf16* o = o1 + (size_t)t * D + c; *(v2u*)o = (v2u){pk2(a.x, a.y), pk2(a.z, a.w)}; *(v2u*)(o + 16) = (v2u){pk2(b.x, b.y), pk2(b.z, b.w)}; } };
struct E_MoeDown { static constexpr bool RMW = true; float* x; const bf16* o1; const int* idx; const unsigned char* topk; const float* mod; int k;
    struct Pre { f32x4 x0, x1, g0, g1; v2u p0, p1; int t; float w; };
    __device__ __forceinline__ Pre pre(int, int r, int c) const { Pre p; p.t = idx[r]; const int tt = p.t < 0 ? 0 : p.t; p.w = *(const float*)(topk + (size_t)tt * 16 + 4 + 4 * k);
        const float* g = mod + (size_t)(tt >> 12) * 6144 + 5120 + c; const float* xi = x + (size_t)tt * D + c; const bf16* oi = o1 + (size_t)tt * D + c;
        p.x0 = *(const f32x4*)xi; p.x1 = *(const f32x4*)(xi + 16); p.g0 = *(const f32x4*)g; p.g1 = *(const f32x4*)(g + 16); p.p0 = *(const v2u*)oi; p.p1 = *(const v2u*)(oi + 16); return p; }
    __device__ __forceinline__ void post(const Pre& p, int, int r, int c, f32x4 v0, f32x4 v1) const { if (p.t < 0) return; float* o = x + (size_t)p.t * D + c;
        const f32x4 q0 = (f32x4){bf2f(p.p0.x & 0xffffu), bf2f(p.p0.x >> 16), bf2f(p.p0.y & 0xffffu), bf2f(p.p0.y >> 16)}, q1 = (f32x4){bf2f(p.p1.x & 0xffffu), bf2f(p.p1.x >> 16), bf2f(p.p1.y & 0xffffu), bf2f(p.p1.y >> 16)};
        *(f32x4*)o = p.x0 + q0 + p.g0 * (v0 * p.w); *(f32x4*)(o + 16) = p.x1 + q1 + p.g1 * (v1 * p.w); } };

template <class AF, class EP>
__device__ __forceinline__ void gemm_moe(int mtiles, int ntiles, int K, const AF& af, const unsigned char* wbase, size_t woff, int ldb, const int* te, const EP& ep, int vcu, int G) {
    int tid = threadIdx.x; asm volatile("" : "+v"(tid)); asm volatile("" : "+s"(vcu)); const int wid = tid >> 6, lane = tid & 63, wr = wid >> 2, wc = wid & 3, fr = lane & 15, fq = lane >> 4;
    const int nunits = mtiles * ntiles;
    for (int u = vcu; u < nunits; u += G) {
        const int pm = u / ntiles, pn = u - pm * ntiles;
        const int row0 = pm * 128 + wr * 64, col0 = pn * 128 + wc * 32;
        const bf16* B = (const bf16*)(wbase + (size_t)te[pm >> 1] * MOE_E_STRIDE + woff);
        f32x4 acc[4][2];
#pragma unroll
        for (int m = 0; m < 4; ++m) { acc[m][0] = (f32x4){0.f, 0.f, 0.f, 0.f}; acc[m][1] = (f32x4){0.f, 0.f, 0.f, 0.f}; }
#pragma unroll 2
        for (int k = 0; k < K; k += 32) {
            bf16x8 a[4], b[2];
#pragma unroll
            for (int m = 0; m < 4; ++m) a[m] = *(const bf16x8*)af(0, row0 + m * 16 + fr, k + fq * 8);
#pragma unroll
            for (int n = 0; n < 2; ++n) b[n] = *(const bf16x8*)(B + (size_t)(col0 + n * 16 + fr) * ldb + k + fq * 8);
#pragma unroll
            for (int m = 0; m < 4; ++m)
#pragma unroll
                for (int n = 0; n < 2; ++n) acc[m][n] = __builtin_amdgcn_mfma_f32_16x16x32_bf16(b[n], a[m], acc[m][n], 0, 0, 0);
        }
#pragma unroll
        for (int m = 0; m < 4; ++m) ep(0, row0 + m * 16 + fr, col0 + 4 * fq, acc[m][0], acc[m][1]);
    }
}

__device__ __forceinline__ Frame mkframe(const Args& args, unsigned char* ldsp, int wv) {
    Frame F; F.lds = (LAS unsigned char*)ldsp;
    const int t = tid_of(wv); F.tid = t; F.lane = t & 63; F.wave = wv;
    int g = gridDim.x, bx = blockIdx.x; asm volatile("" : "+s"(g), "+s"(bx)); F.G = g; F.vcu = (g % 8 == 0) ? (bx % 8) * (g / 8) + bx / 8 : bx;
    unsigned char* w = args.ws; float* o = args.out; asm volatile("" : "+s"(w), "+s"(o)); F.ws = w; F.out = o; F.in = args.in;
    return F;
}
__global__ void __launch_bounds__(NTHR, 2) mega(Args args) {
    extern __shared__ __attribute__((aligned(16))) unsigned char lds[];
    volatile LAS unsigned* MISC = (volatile LAS unsigned*)((LAS unsigned char*)lds + LDS_MISC);
    const int wv = __builtin_amdgcn_readfirstlane((int)threadIdx.x >> 6);
    if (threadIdx.x < 32) MISC[threadIdx.x] = 0u;
    __syncthreads();
    XcdBarrier bar; bar.bar = (unsigned*)(args.ws + WS_CTL) + 4096; bar.x = 0; bar.st = nullptr; bar.wv = wv;
    const int lo = args.ph_lo, hi = args.ph_hi;
    if (hi - lo > 1) bar = xcd_barrier_post((unsigned*)(args.ws + WS_CTL) + 4096, MISC + 8, wv);
#define IN(k) (lo <= (k) && (k) < hi)
#define SEAM(k) do { if (IN(k) && IN((k) + 1)) xcd_barrier(bar); } while (0)
#if PROBE_SEL >= 100
#define PBG(k) do { if (PROBE_SEL == 100 + (k)) prb_b((LAS unsigned char*)lds, tid_of(wv)); } while (0)
#define PEG(k) do { if (PROBE_SEL == 100 + (k)) prb_e((LAS unsigned char*)lds, tid_of(wv)); } while (0)
#else
#define PBG(k) do { } while (0)
#define PEG(k) do { } while (0)
#endif
#define PHF Frame F = mkframe(args, lds, wv); const int bxi = (int)blockIdx.x; (void)bxi
#define P_MOD (WSP(float, WS_MOD) + (size_t)l * 17 * 6144)
#define P_HM WSP(bf16, WS_HMOD)
#define P_PT WSP(bf16, WS_PT)
#define P_XB WSP(bf16, WS_BUFA)
#define P_E ((float*)((unsigned char*)F.out + DO_E))
#define P_HS ((bf16*)((unsigned char*)F.out + DO_HS))
#define P_YS ((bf16*)((unsigned char*)F.out + DO_YS))

    PBG(PH_P0); if (IN(PH_P0)) { PHF; p0_prologue(F); } SEAM(PH_P0); PEG(PH_P0);
    PBG(PH_P1); if (IN(PH_P1)) { PHF; for (int it = F.vcu; it < 2 * 2 * 24 * 4; it += F.G) p1_item(F, it); } SEAM(PH_P1); PEG(PH_P1);

#pragma unroll 1
    for (int l = 0; l < 2; ++l) {
        const int pb = PH_L + l * PH_PER;
        PBG(pb + S_NORM1); if (IN(pb + S_NORM1)) { PHF;
            if (l == 0) norm_rows(F, F.in[0], F.in[2], MT, F.in[6], P_MOD, 0, 1024, P_HM); else norm_rows_b16(F, P_XB, MT, F.in[6] + D, P_MOD, 0, 1024, P_HM); }
        SEAM(pb + S_NORM1); PEG(pb + S_NORM1);
        PBG(pb + S_G1); if (IN(pb + S_G1)) { PHF; const char* wt = (const char*)(WSP(bf16, WS_WIN) + (size_t)l * PTROWS * D);
            {
                g8::OpRow<true> oa{wt, D * 2, 0}; g8::OpPermB ob{(const char*)P_HM}; g8::Order S; S.init(1, 2, NL / 256, F.G, bxi); E_PT ep{P_PT};
                g8::gemm8(F.lds, F.wave, D / 64, oa, ob, S, ep); }
            int rot = 0;
            if (l == 0) {
                g8::OpRow<true> oa{wt, D * 2, 0}; g8::OpRow<false> ob{(const char*)(P_HM + (size_t)NL * D), D * 2, 0}; g8::Order S; S.init(1, 2, NCX / 256, F.G, bxi); E_PT ep{P_PT + NL};
                g8::gemm8(F.lds, F.wave, D / 64, oa, ob, S, ep); rot = 32; }
            {
                g8::OpRow<true> oa{wt + (size_t)512 * D * 2, D * 2, 0}; g8::OpRow<false> ob{(const char*)P_HM, D * 2, 0}; g8::Order S; S.init(1, 6, MT / 256, F.G, bxi, rot); E_PT ep{P_PT + (size_t)512 * MT};
                g8::gemm8(F.lds, F.wave, D / 64, oa, ob, S, ep); } }
        SEAM(pb + S_G1); PEG(pb + S_G1);
        PBG(pb + S_FNET); if (IN(pb + S_FNET)) { PHF; shortconv_v(F, l);
            {
                g8::OpRow<true> oa{(const char*)WSP(bf16, WS_FAW), 128 * 2, 0}; g8::OpFA ob{(const char*)P_PT}; g8::Order S; S.init(1, 1, 1024, F.G, bxi); E_FA ep{WSP(bf16, WS_ABUF)};
                g8::gemm8(F.lds, F.wave, 2, oa, ob, S, ep); }
            if (l == 0) { g8::OpRow<true> oa{(const char*)WSP(bf16, WS_DFTC), 2 * LC * 2, 0}; g8::OpFnetB ob{(const char*)(P_PT + NL), LC * 2, 2}; g8::Order S; S.init(NB, 1, 1, F.G, bxi);
              E_Fnet ep{P_HM, NL, LC}; g8::gemm8(F.lds, F.wave, 2 * LC / 64, oa, ob, S, ep); }
            {
                E_S5E ep{P_E}; g8::OpS5A oa{(const char*)(P_PT + (size_t)R_S5 * MT), (const char*)P_HS - (const char*)(P_PT + (size_t)R_S5 * MT)}; g8::OpRow<false> ob{(const char*)(F.ws + WS_S5M + (size_t)l * 24 * S5M_STRIDE), 256 * 2, (long)S5M_STRIDE};
                g8::Order S; S.init(24, NCHUNK / 256, 1, F.G, bxi, l == 0 ? 16 : 0); g8::gemm8(F.lds, F.wave, 4, oa, ob, S, ep); } }
        SEAM(pb + S_FNET); PEG(pb + S_FNET);
        { PHF; PB(1); } PBG(pb + S_HY1); if (IN(pb + S_HY1)) { PHF;
            {
                g8::OpRow<true> oa{(const char*)WSP(bf16, WS_FBW), 512 * 2, 0}; g8::OpFB ob{(const char*)WSP(bf16, WS_ABUF)}; g8::Order S; S.init(NB, 16, 1, F.G, bxi); E_FB ep{P_HM};
                g8::gemm8(F.lds, F.wave, 8, oa, ob, S, ep); }
            hyena_stage(F, l, 0); }
        SEAM(pb + S_HY1); PEG(pb + S_HY1); { PHF; PE(1); }
        { PHF; PB(1); } PBG(pb + S_HY2); if (IN(pb + S_HY2)) { PHF; hyena_stage2_carry(F, l); }
        SEAM(pb + S_HY2); PEG(pb + S_HY2); { PHF; PE(1); }
        PBG(pb + S_S5O); if (IN(pb + S_S5O)) { PHF; E_S5O ep{P_YS};
            g8::OpS5A oa{(const char*)(P_PT + (size_t)R_S5 * MT), (const char*)P_HS - (const char*)(P_PT + (size_t)R_S5 * MT)}; g8::OpRow<false> ob{(const char*)(F.ws + WS_S5M + (size_t)l * 24 * S5M_STRIDE) + 256 * 256 * 2, 512 * 2, (long)S5M_STRIDE};
            g8::Order S; S.init(24, NCHUNK / 256, 1, F.G, bxi); g8::gemm8(F.lds, F.wave, 8, oa, ob, S, ep); }
        SEAM(pb + S_S5O); PEG(pb + S_S5O);
        PBG(pb + S_GLU); if (IN(pb + S_GLU)) { PHF; E_Glu ep{P_YS, P_HM, F.in[30] + l * 384};
            g8::OpRow<true> oa{(const char*)P_YS, 384 * 2, 0}; g8::OpRow<false> ob{(const char*)(WSP(bf16, WS_GLU) + (size_t)l * 512 * 384), 384 * 2, 0}; g8::Order S; S.init(1, MT / 256, 2, F.G, bxi);
            g8::gemm8(F.lds, F.wave, 6, oa, ob, S, ep);
            hyena_transpose(F, l == 0 ? MT : NL); }
        SEAM(pb + S_GLU); PEG(pb + S_GLU);
        PBG(pb + S_WOUT); if (IN(pb + S_WOUT)) { PHF;
            g8::OpRow<true> oa{(const char*)P_HM, D * 2, 0}; g8::OpRow<false> ob{(const char*)(WSP(bf16, WS_WOUT) + (size_t)l * D * D), D * 2, 0}; g8::Order S; S.init(1, (l == 0 ? MT : NL) / 256, D / 256, F.G, bxi);
            if (l == 0) { E_Res<false, true> ep{F.in[0], F.in[2], P_XB, P_MOD, 2048}; g8::gemm8(F.lds, F.wave, D / 64, oa, ob, S, ep, STAG(1000)); }
            else { E_Res<true, false> ep{P_XB, P_XB + (size_t)NL * D, F.out, P_MOD, 2048}; g8::gemm8(F.lds, F.wave, D / 64, oa, ob, S, ep, STAG(1000)); } }
        SEAM(pb + S_WOUT); PEG(pb + S_WOUT);
        if (l == 0) {
            PBG(pb + S_NORM2); if (IN(pb + S_NORM2)) { PHF; norm_rows_b16(F, P_XB, MT, F.in[7], P_MOD, 3072, 4096, P_HM); }
            SEAM(pb + S_NORM2); PEG(pb + S_NORM2);
            PBG(pb + S_F0); if (IN(pb + S_F0)) { PHF; E_Swi ep{WSP(bf16, WS_ACT), DFF};
                g8::OpRow<true> oa{(const char*)P_HM, D * 2, 0}; g8::OpRow<false> ob{(const char*)WSP(bf16, WS_FGU), D * 2, 0}; g8::Order S; S.init(1, MT / 256, 2 * DFF / 256, F.G, bxi);
                g8::gemm8<UP_ALIGN>(F.lds, F.wave, D / 64, oa, ob, S, ep, STAG(750)); }
            SEAM(pb + S_F0); PEG(pb + S_F0);
            PBG(pb + S_F1); if (IN(pb + S_F1)) { PHF; E_Res<true, true> ep{P_XB, P_XB + (size_t)NL * D, P_XB, P_MOD, 5120};
                g8::OpTiled<true> oa{(const char*)WSP(bf16, WS_ACT), DFF / 64}; g8::OpTiled<false> ob{(const char*)WSP(bf16, WS_FD), DFF / 64}; g8::Order S; S.init(1, MT / 256, D / 256, F.G, bxi);
                g8::gemm8(F.lds, F.wave, DFF / 64, oa, ob, S, ep, STAG(2200)); }
            SEAM(pb + S_F1); PEG(pb + S_F1);
        } else {
            PBG(pb + S_NORM2); if (IN(pb + S_NORM2)) { PHF; norm2_router(F, F.out, F.in[7] + D, P_MOD, P_HM); moe_transposes(F); }
            SEAM(pb + S_NORM2); PEG(pb + S_NORM2);
            PBG(pb + S_F0); if (IN(pb + S_F0)) { PHF; moe_slots(F); }
            SEAM(pb + S_F0); PEG(pb + S_F0);
#pragma unroll 1
            for (int k = 0; k < 2; ++k) {
                PBG(pb + S_F1 + 2 * k); if (IN(pb + S_F1 + 2 * k)) { PHF; const int* IDX = (const int*)(F.ws + WS_META + META_IDX) + k * MAXSLOT; const int* TE = (const int*)(F.ws + WS_META + META_TE) + k * 272; const int nt = __builtin_amdgcn_readfirstlane(((const int*)(F.ws + WS_META + META_NT))[k]);
                    E_Swi ep{WSP(bf16, WS_ACT2), DFE};
                    LAS int* tel = (LAS int*)(F.lds + LDS_MISC + 1024); if (F.tid < 272) tel[F.tid] = TE[F.tid]; __syncthreads();
                    g8::OpMoeA oa{(const char*)P_HM, IDX}; g8::OpMoeB ob{(const char*)(F.ws + WS_MOEW), tel, D * 2}; g8::Order S; S.init(1, nt, 2 * DFE / 256, F.G, bxi);
                    g8::gemm8<UP_ALIGN>(F.lds, F.wave, D / 64, oa, ob, S, ep, STAG(750)); }
                SEAM(pb + S_F1 + 2 * k); PEG(pb + S_F1 + 2 * k);
                PBG(pb + S_F2 + 2 * k); if (IN(pb + S_F2 + 2 * k)) { PHF; const int* IDX = (const int*)(F.ws + WS_META + META_IDX) + k * MAXSLOT; const int* TE = (const int*)(F.ws + WS_META + META_TE) + k * 272; const int nt = __builtin_amdgcn_readfirstlane(((const int*)(F.ws + WS_META + META_NT))[k]);
                    LAS int* tel = (LAS int*)(F.lds + LDS_MISC + 1024); if (F.tid < 272) tel[F.tid] = TE[F.tid]; __syncthreads();
                    g8::OpTiled<true> oa{(const char*)WSP(bf16, WS_ACT2), DFE / 64}; g8::OpMoeBT ob{(const char*)(F.ws + WS_MOEW + MOE_GU_BYTES), tel, DFE / 64}; g8::Order S; S.init(1, k == 1 ? 256 : nt, D / 256, F.G, bxi);
                    if (k == 0) { E_MoeDown0 ep{WSP(bf16, WS_O1), IDX, F.ws + WS_TOPK, P_MOD}; g8::gemm8(F.lds, F.wave, DFE / 64, oa, ob, S, ep, STAG(2700)); }
                    else { E_MoeDown ep{F.out, WSP(bf16, WS_O1), IDX, F.ws + WS_TOPK, P_MOD, k}; g8::gemm8(F.lds, F.wave, DFE / 64, oa, ob, S, ep, STAG(2700)); } }
                SEAM(pb + S_F2 + 2 * k); PEG(pb + S_F2 + 2 * k);
            }
            PBG(pb + S_F5); if (IN(pb + S_F5)) { PHF; const int k = 1; const int* IDX = (const int*)(F.ws + WS_META + META_IDX) + k * MAXSLOT; const int* TE = (const int*)(F.ws + WS_META + META_TE) + k * 272; const int nt = __builtin_amdgcn_readfirstlane(((const int*)(F.ws + WS_META + META_NT))[k]);
                const int ntl = nt - 256, ntw = ntl * (D / 256);
                if (ntl > 0) { E_MoeDown ep{F.out, WSP(bf16, WS_O1), IDX, F.ws + WS_TOPK, P_MOD, k};
                    LAS int* tel = (LAS int*)(F.lds + LDS_MISC + 1024); if (F.tid < 272) tel[F.tid] = TE[F.tid]; __syncthreads();
                    g8::OpTiled<true> oa{(const char*)WSP(bf16, WS_ACT2), DFE / 64}; g8::OpMoeBT ob{(const char*)(F.ws + WS_MOEW + MOE_GU_BYTES), tel, DFE / 64}; g8::Order S; S.init(1, ntl, D / 256, F.G, bxi); S.pm_off = 256;
                    g8::gemm8(F.lds, F.wave, DFE / 64, oa, ob, S, ep); }
                final_norm_part(F, 0, ntw); }
            SEAM(pb + S_F5); PEG(pb + S_F5);
            PBG(pb + S_F6); if (IN(pb + S_F6)) { PHF; final_norm_part(F, 1, 0); } PEG(pb + S_F6);
        }
    }
#if PROBE_SEL >= 0
    if (blockIdx.x == PROBE_BLK && tid_of(wv) == 0) { const unsigned long long want = *(volatile LAS unsigned long long*)((LAS unsigned char*)lds + LDS_MISC + 72), t0 = __builtin_amdgcn_s_memrealtime();
        while (__builtin_amdgcn_s_memrealtime() - t0 < want) __builtin_amdgcn_s_sleep(8); }
#endif
#undef IN
#undef SEAM
}

extern "C" void kernel_launch(void* const* d_in, const int* in_sizes, int n_in, void* d_out, int out_size, void* d_ws, size_t ws_size, hipStream_t stream) {
    static int grid = 0;
    if (grid == 0) {
        if (n_in != 40 || out_size != NL * D || ws_size < WS_END) { fprintf(stderr, "kernel_launch: unexpected shapes n_in %d out %d ws %zu (need %zu)\n", n_in, out_size, ws_size, (size_t)WS_END); grid = -1; return; }
        int dev = 0, cus = 0, per_cu = 0;
        if (hipGetDevice(&dev) != hipSuccess || hipDeviceGetAttribute(&cus, hipDeviceAttributeMultiprocessorCount, dev) != hipSuccess) { grid = -1; return; }
        if (hipFuncSetAttribute((const void*)mega, hipFuncAttributeMaxDynamicSharedMemorySize, LDS_BYTES) != hipSuccess) { fprintf(stderr, "kernel_launch: hipFuncSetAttribute failed\n"); grid = -1; return; }
        if (hipOccupancyMaxActiveBlocksPerMultiprocessor(&per_cu, (const void*)mega, NTHR, LDS_BYTES) != hipSuccess || per_cu < 1) fprintf(stderr, "kernel_launch: occupancy query says %d\n", per_cu);
        (void)hipGetLastError();
        grid = cus;
    }
    if (grid < 0) return;
    (void)hipMemsetAsync((char*)d_ws + WS_CTL, 0, CTL_ZERO_BYTES, stream);
    Args a{};
    for (int i = 0; i < 40; ++i) a.in[i] = (const float*)d_in[i];
    a.out = (float*)d_out; a.ws = (unsigned char*)d_ws;
#if MK_ONE_LAUNCH
    a.ph_lo = 0; a.ph_hi = N_PHASES;
    hipLaunchKernelGGL(mega, dim3(grid), dim3(NTHR), LDS_BYTES, stream, a);
#else
    for (int ph = 0; ph < N_PHASES; ++ph) {
        const int s = ph - PH_L;
        if (ph >= PH_L && s < PH_PER && s > S_F1) continue;
        if (ph >= PH_L + PH_PER && (ph - PH_L - PH_PER) > S_F5) continue;
        a.ph_lo = ph; a.ph_hi = ph + 1;
        hipLaunchKernelGGL(mega, dim3(grid), dim3(NTHR), LDS_BYTES, stream, a);
    }
#endif
}
```

```cpp
#include <hip/hip_runtime.h>
#include <cstdio>
#include <cstdint>

#ifndef G8_ALL
#define G8_ALL 1
#endif
#define G8_G1 G8_ALL
#define G8_FNET G8_ALL
#define G8_S5 G8_ALL
#define G8_GLU G8_ALL
#define G8_WOUT G8_ALL
#define G8_FFN G8_ALL
#define G8_MOE G8_ALL
#ifndef UP_ALIGN
#define UP_ALIGN false
#endif
#ifndef STAG_ON
#define STAG_ON 0
#endif
#define STAG(x) (STAG_ON ? (x) : 0)
#ifndef MK_ONE_LAUNCH
#define MK_ONE_LAUNCH 1
#endif

#define LAS __attribute__((address_space(3)))
typedef unsigned short bf16;
typedef short bf16x8 __attribute__((ext_vector_type(8)));
typedef float f32x4 __attribute__((ext_vector_type(4)));
typedef float f32x2 __attribute__((ext_vector_type(2)));
typedef unsigned v4u __attribute__((ext_vector_type(4)));
typedef unsigned v2u __attribute__((ext_vector_type(2)));

constexpr int D = 1024, NB = 16, L = 4096, LC = 256, NL = NB * L, NCX = NB * LC, MT = NL + NCX;
constexpr int DIN = 1792, DFF = 2816, NE = 8, DFE = 3584;
constexpr int PTROWS = 2048, R_HY = 512, R_S5 = 1664;
constexpr int NCHUNK = MT / 16;
constexpr int NTHR = 512, NWAVES = 8;
constexpr int MAXSLOT = NL + NE * 256;

constexpr size_t MiB = 1u << 20;
constexpr size_t WS_CTL = 0, CTL_ZERO_BYTES = 1 * MiB;
constexpr size_t WS_MOD = 1 * MiB;
constexpr size_t WS_WIN = 2 * MiB;
constexpr size_t WS_WOUT = 10 * MiB;
constexpr size_t WS_GLU = 14 * MiB;
constexpr size_t WS_FGU = 15 * MiB;
constexpr size_t WS_FD = 26 * MiB;
constexpr size_t WS_FAW = 32 * MiB;
constexpr size_t WS_O1 = 38 * MiB;
constexpr size_t WS_FBW = 33 * MiB;
constexpr size_t WS_DFTC = 96 * MiB;
constexpr size_t WS_S5M = 97 * MiB;
constexpr size_t S5M_STRIDE = 256 * 256 * 2 + 256 * 512 * 2;
constexpr size_t WS_A16 = 115 * MiB;
constexpr size_t WS_KT = 116 * MiB;
constexpr size_t WS_KTC = 164 * MiB;
constexpr size_t WS_PS = 167 * MiB;
constexpr size_t WS_TOPK = 171 * MiB;
constexpr size_t WS_META = 172 * MiB;
constexpr size_t META_CNT = 0, META_IDX = 64 * 1024, META_TE = META_IDX + 2 * MAXSLOT * 4, META_NT = META_TE + 2 * 272 * 4, META_SL1 = 768 * 1024;
static_assert(META_NT + 8 <= META_SL1 && META_SL1 + (size_t)NL * 4 <= MiB, "meta");
constexpr size_t WS_HMOD = 173 * MiB;
constexpr size_t WS_BUFA = 309 * MiB;
constexpr size_t WS_R = 581 * MiB;
constexpr size_t WS_END = 1024 * MiB;
constexpr size_t WS_PT = WS_R;
constexpr size_t WS_HT = WS_R;
constexpr size_t WS_Z1 = WS_R + 272 * MiB;
constexpr size_t WS_ABUF = WS_R + 374 * MiB;
static_assert(WS_ABUF + (size_t)16 * 256 * 64 * 128 * 2 <= WS_END, "abuf");
constexpr size_t WS_VP = WS_R + 323 * MiB;
static_assert(WS_VP + (size_t)384 * MT * 2 <= WS_END, "vp");
constexpr size_t WS_ACT = WS_R;
constexpr size_t WS_MOEW = WS_BUFA;
constexpr size_t MOE_GU_BYTES = (size_t)2 * DFE * D * 2, MOE_D_BYTES = (size_t)D * DFE * 2, MOE_E_STRIDE = MOE_GU_BYTES + MOE_D_BYTES;
constexpr size_t WS_ACT2 = WS_BUFA + 168 * MiB;
static_assert(NE * MOE_E_STRIDE <= 168 * MiB, "moe weights");
static_assert(WS_ACT2 + (size_t)MAXSLOT * DFE * 2 <= WS_END, "act2");
static_assert(WS_PT + (size_t)PTROWS * MT * 2 <= WS_END, "pt");
static_assert(WS_ACT + (size_t)MT * DFF * 2 <= WS_END, "act");
static_assert(WS_HMOD + (size_t)MT * D * 2 <= WS_BUFA && WS_BUFA + (size_t)MT * D * 4 <= WS_R, "bufs");
constexpr size_t DO_E = 0, DO_HS = 102 * MiB, DO_YS = 153 * MiB;
static_assert(DO_YS + (size_t)MT * 384 * 2 <= (size_t)NL * D * 4, "d_out scratch");

constexpr int LDS_BYTES = 147456;
constexpr int LDS_MISC = 131072 + 8192;

__device__ __forceinline__ unsigned f2bf(float f) { unsigned u = __builtin_bit_cast(unsigned, f); return (u + 0x7fffu + ((u >> 16) & 1u)) >> 16; }
__device__ __forceinline__ unsigned pk2(float lo, float hi) { unsigned r; asm("v_cvt_pk_bf16_f32 %0, %1, %2" : "=v"(r) : "v"(lo), "v"(hi)); return r; }
__device__ __forceinline__ float bf2f(unsigned short b) { return __builtin_bit_cast(float, ((unsigned)b) << 16); }
__device__ __forceinline__ float wave_sum(float v, int lane) {
#pragma unroll
    for (int o = 1; o < 64; o <<= 1) v += __builtin_bit_cast(float, __builtin_amdgcn_ds_bpermute((lane ^ o) << 2, __builtin_bit_cast(int, v)));
    return v;
}
__device__ __forceinline__ float silu_f(float x) { return x * __builtin_amdgcn_rcpf(1.0f + __expf(-x)); }
__device__ __forceinline__ float sigmoid_f(float x) { return __builtin_amdgcn_rcpf(1.0f + __expf(-x)); }
__device__ __forceinline__ float gelu_tanh_f(float x) { const float u = 0.7978845608028654f * (x + 0.044715f * x * x * x); return x * __builtin_amdgcn_rcpf(1.0f + __expf(-2.0f * u)); }
__device__ __forceinline__ int bidx_of(int r) { return r < NL ? (r >> 12) : 16; }

__device__ __forceinline__ int lane_id() { return (int)__builtin_amdgcn_mbcnt_hi(~0u, __builtin_amdgcn_mbcnt_lo(~0u, 0u)); }
__device__ __forceinline__ int tid_of(int wv) { int t = (wv << 6) | lane_id(); asm volatile("" : "+v"(t)); return t; }
#define XB_TMO      128
#define XB_XCNT(j)  (256  + 64 * (j))
#define XB_XSUB(j)  (1280 + 64 * (j))
#define XB_XGEN(j)  (2304 + 64 * (j))
#define XB_TOP      3328
#define XB_TOPGEN   3392
#define XCD_BAR_WORDS 3456
#define XB_SPIN_CAP (1u << 22)
__device__ __forceinline__ unsigned xb_ld(unsigned* p)              { return __hip_atomic_load(p, __ATOMIC_RELAXED, __HIP_MEMORY_SCOPE_AGENT); }
__device__ __forceinline__ unsigned xb_add(unsigned* p, unsigned v) { return __hip_atomic_fetch_add(p, v, __ATOMIC_RELAXED, __HIP_MEMORY_SCOPE_AGENT); }
__device__ __forceinline__ unsigned xb_xcc_id() { return (unsigned)__builtin_amdgcn_s_getreg((3 << 11) | 20) & 0xFu; }
#define XB_SPIN(cond, bar) do { unsigned _sp = 0; while (cond) { __builtin_amdgcn_s_sleep(1); \
    if ((++_sp & 255u) == 0u) { if (xb_ld(&(bar)[XB_TMO])) break; if (_sp > XB_SPIN_CAP) { atomicAdd(&(bar)[XB_TMO], 1u); break; } } } } while (0)
struct XcdBarrier { unsigned* bar; unsigned x; volatile LAS unsigned* st; int wv; };
__device__ __forceinline__ XcdBarrier xcd_barrier_post(unsigned* bar, volatile LAS unsigned* st, int wv) {
    XcdBarrier b; b.bar = bar; b.x = xb_xcc_id(); b.st = st; b.wv = wv;
    if (wv == 0 && lane_id() == 0) (void)xb_add(&bar[XB_XCNT(b.x)], 1u);
    return b;
}
__device__ __forceinline__ void xcd_barrier_complete(unsigned* bar, unsigned x, unsigned& nloc, unsigned& nx) {
    const unsigned G = gridDim.x * gridDim.y * gridDim.z;
    unsigned sum, cnt, mine, sp = 0u;
    for (;;) {
        sum = 0u; cnt = 0u; mine = 0u;
#pragma unroll
        for (unsigned j = 0; j < 16; ++j) { const unsigned c = xb_ld(&bar[XB_XCNT(j)]); sum += c; cnt += (c > 0u) ? 1u : 0u; mine = (j == x) ? c : mine; }
        if (sum == G) break;
        __builtin_amdgcn_s_sleep(1);
        if ((++sp & 255u) == 0u) { if (xb_ld(&bar[XB_TMO])) break; if (sp > XB_SPIN_CAP) { atomicAdd(&bar[XB_TMO], 1u); break; } }
    }
    nloc = mine > 0u ? mine : 1u; nx = cnt > 0u ? cnt : 1u;
}
__device__ __noinline__ void xcd_barrier(const XcdBarrier b) {
    asm volatile("s_waitcnt vmcnt(0)" ::: "memory");
    __syncthreads();
    if (b.wv == 0 && lane_id() == 0) {
        unsigned* bar = b.bar;
        __builtin_amdgcn_s_waitcnt(0);
        unsigned nloc = b.st[0], nx = b.st[1];
        if (nloc == 0u) { xcd_barrier_complete(bar, b.x, nloc, nx); b.st[0] = nloc; b.st[1] = nx; }
        const unsigned old = xb_add(&bar[XB_XSUB(b.x)], 1u);
        const unsigned gen = old / nloc;
        if (old + 1u == (gen + 1u) * nloc) {
            __builtin_amdgcn_fence(__ATOMIC_RELEASE, "agent");
            asm volatile("s_waitcnt vmcnt(0)" ::: "memory");
            const unsigned og = xb_add(&bar[XB_TOP], 1u);
            const unsigned tg = og / nx;
            if (og + 1u == (tg + 1u) * nx) xb_add(&bar[XB_TOPGEN], 1u);
            else XB_SPIN(xb_ld(&bar[XB_TOPGEN]) == tg, bar);
            __builtin_amdgcn_fence(__ATOMIC_ACQUIRE, "agent");
            xb_add(&bar[XB_XGEN(b.x)], 1u);
            asm volatile("s_waitcnt vmcnt(0)" ::: "memory");
        } else {
            XB_SPIN(xb_ld(&bar[XB_XGEN(b.x)]) == gen, bar);
            __builtin_amdgcn_fence(__ATOMIC_ACQUIRE, "agent");
            asm volatile("s_waitcnt vmcnt(0)" ::: "memory");
        }
    }
    __syncthreads();
}

__device__ __forceinline__ size_t tiled_idx(int r, int k, int KT) { return ((size_t)(r >> 8) * KT + (k >> 6)) * 16384 + (size_t)(r & 255) * 64 + (k & 63); }
template <class AF, class BF, class EP>
__device__ __forceinline__ void gemm_simple(int nbatch, int mtiles, int ntiles, int K, const AF& af, const BF& bf, const EP& ep, int vcu, int G) {
    int tid = threadIdx.x; asm volatile("" : "+v"(tid)); asm volatile("" : "+s"(vcu)); const int wid = tid >> 6, lane = tid & 63, wr = wid >> 2, wc = wid & 3, fr = lane & 15, fq = lane >> 4;
    const int per = mtiles * ntiles, nunits = nbatch * per;
    for (int u = vcu; u < nunits; u += G) {
        const int bt = u / per, rem = u - bt * per, pm = rem / ntiles, pn = rem - pm * ntiles;
        const int row0 = pm * 128 + wr * 64, col0 = pn * 128 + wc * 32;
        f32x4 acc[4][2];
#pragma unroll
        for (int m = 0; m < 4; ++m) { acc[m][0] = (f32x4){0.f, 0.f, 0.f, 0.f}; acc[m][1] = (f32x4){0.f, 0.f, 0.f, 0.f}; }
#pragma unroll 2
        for (int k = 0; k < K; k += 32) {
            bf16x8 a[4], b[2];
#pragma unroll
            for (int m = 0; m < 4; ++m) a[m] = *(const bf16x8*)af(bt, row0 + m * 16 + fr, k + fq * 8);
#pragma unroll
            for (int n = 0; n < 2; ++n) b[n] = *(const bf16x8*)bf(bt, col0 + n * 16 + fr, k + fq * 8);
#pragma unroll
            for (int m = 0; m < 4; ++m)
#pragma unroll
                for (int n = 0; n < 2; ++n) acc[m][n] = __builtin_amdgcn_mfma_f32_16x16x32_bf16(b[n], a[m], acc[m][n], 0, 0, 0);
        }
#pragma unroll
        for (int m = 0; m < 4; ++m) ep(bt, row0 + m * 16 + fr, col0 + 4 * fq, acc[m][0], acc[m][1]);
    }
}
struct RowMajor { const bf16* p; long ld; __device__ __forceinline__ const bf16* operator()(int, int r, int k) const { return p + (long)r * ld + k; } };

namespace g8 {
constexpr int BM = 256, BK = 64, HALF = 128, HTB = HALF * BK * 2, NXCD = 8, WGM = 8;
__device__ __forceinline__ int lds_byte(int r, int c) { const int st = (r >> 4) * 2 + (c >> 5), rr = r & 15, cc = c & 31, ob = rr * 64 + cc * 2; return st * 1024 + (ob ^ (((ob >> 9) & 1) << 5)); }
__device__ __forceinline__ void stage_rc(int b, int& R, int& C) { const int st = b / 1024, sb = b % 1024, swz = sb ^ (((sb >> 9) & 1) << 5); R = (st >> 1) * 16 + swz / 64; C = (st & 1) * 32 + (swz % 64) / 2; }
struct Unit { int bt, pm, pn; };
struct Order {
    int nM, nN, per, nwg, G, c, pm_off;
    __device__ __forceinline__ void init(int nb, int nM_, int nN_, int G_, int c_, int rot = 0) { nM = nM_; nN = nN_; per = nM_ * nN_; nwg = nb * per; G = G_; c = c_ - rot; if (c < 0) c += G_; pm_off = 0; }
    __device__ __forceinline__ bool next(int i, Unit& u) const {
        const long Lx = (long)i * G + c; if (Lx >= nwg) return false;
        int wgid = (int)Lx; { const int q = nwg / NXCD, r = nwg % NXCD, xcd = wgid % NXCD, off = wgid / NXCD; wgid = (xcd < r ? xcd * (q + 1) : r * (q + 1) + (xcd - r) * q) + off; }
        u.bt = wgid / per; const int rem = wgid - u.bt * per;
        const int nig = WGM * nN, gid = rem / nig, fm = gid * WGM, gsz = (nM - fm) < WGM ? (nM - fm) : WGM;
        u.pm = pm_off + fm + ((rem % nig) % gsz); u.pn = (rem % nig) / gsz; return true;
    }
};
template <bool ISA> struct OpRow {
    static constexpr bool GATHER = false;
    const char* p; long ld2; long bstride;
    __device__ __forceinline__ unsigned off(int R, int C) const { return (unsigned)(R * (int)ld2 + C * 2); }
    __device__ __forceinline__ const char* base(const Unit& u) const { return p + (long)u.bt * bstride + (long)(ISA ? u.pm : u.pn) * 256 * ld2; }
    __device__ __forceinline__ long koff(int t) const { return (long)t * 128; }
    __device__ __forceinline__ long hstep() const { return 128 * ld2; }
};
template <bool ISA> struct OpTiled {
    static constexpr bool GATHER = false;
    const char* p; int KT;
    __device__ __forceinline__ unsigned off(int R, int C) const { return (unsigned)(R * 128 + C * 2); }
    __device__ __forceinline__ const char* base(const Unit& u) const { return p + (long)(ISA ? u.pm : u.pn) * KT * 32768; }
    __device__ __forceinline__ long koff(int t) const { return (long)t * 32768; }
    __device__ __forceinline__ long hstep() const { return 16384; }
};
struct OpMoeBT {
    static constexpr bool GATHER = false;
    const char* w; const LAS int* te; int KT;
    __device__ __forceinline__ unsigned off(int R, int C) const { return (unsigned)(R * 128 + C * 2); }
    __device__ __forceinline__ const char* base(const Unit& u) const { return w + (long)__builtin_amdgcn_readfirstlane(te[u.pm]) * (long)MOE_E_STRIDE + (long)u.pn * KT * 32768; }
    __device__ __forceinline__ long koff(int t) const { return (long)t * 32768; }
    __device__ __forceinline__ long hstep() const { return 16384; }
};
struct OpS5A {
    static constexpr bool GATHER = false;
    const char* ptb; long delta;
    __device__ __forceinline__ unsigned off(int R, int C) const { return (unsigned)((C >> 4) * (MT * 2) + R * 32 + (C & 15) * 2); }
    __device__ __forceinline__ const char* base(const Unit& u) const { return ptb + ((long)u.bt * 16 * MT + (long)u.pm * 4096) * 2; }
    __device__ __forceinline__ long koff(int t) const { return t < 4 ? (long)t * 4 * MT * 2 : delta + (long)(t - 4) * 4 * MT * 2; }
    __device__ __forceinline__ long hstep() const { return 4096; }
};
struct OpFnetB {
    static constexpr bool GATHER = false;
    const char* p; int seq2; int sh;
    __device__ __forceinline__ unsigned off(int R, int C) const { return (unsigned)(R * (MT * 2) + C * 2); }
    __device__ __forceinline__ const char* base(const Unit& u) const { return p + (long)u.bt * seq2 + (long)u.pn * 256 * MT * 2; }
    __device__ __forceinline__ long koff(int t) const { return (long)(t >> sh) * 256 * MT * 2 + (long)(t & ((1 << sh) - 1)) * 128; }
    __device__ __forceinline__ long hstep() const { return (long)128 * MT * 2; }
};
struct OpPermB {
    static constexpr bool GATHER = false;
    const char* p;
    __device__ __forceinline__ unsigned off(int R, int C) const { return (unsigned)((64 * (R & 63) + (R >> 6)) * 2048 + C * 2); }
    __device__ __forceinline__ const char* base(const Unit& u) const { return p + ((long)(u.pn >> 4) * 4096 + (long)(u.pn & 15) * 4) * 2048; }
    __device__ __forceinline__ long koff(int t) const { return (long)t * 128; }
    __device__ __forceinline__ long hstep() const { return 2 * 2048; }
};
struct OpFA {
    static constexpr bool GATHER = false;
    const char* p;
    __device__ __forceinline__ unsigned off(int R, int C) const { return (unsigned)((R >> 6) * (MT * 2) + (R & 63) * 128 + C * 2); }
    __device__ __forceinline__ const char* base(const Unit& u) const { return p + (long)(u.pn & 63) * 4 * MT * 2 + (long)(u.pn >> 6) * 4096 * 2; }
    __device__ __forceinline__ long koff(int t) const { return (long)t * 256 * MT * 2; }
    __device__ __forceinline__ long hstep() const { return (long)2 * MT * 2; }
};
struct OpFB {
    static constexpr bool GATHER = false;
    const char* p;
    __device__ __forceinline__ unsigned off(int R, int C) const { return (unsigned)(R * 16384 + C * 2); }
    __device__ __forceinline__ const char* base(const Unit& u) const { return p + (long)u.bt * 256 * 16384 + (long)u.pm * 1024; }
    __device__ __forceinline__ long koff(int t) const { return (long)t * 128; }
    __device__ __forceinline__ long hstep() const { return (long)128 * 16384; }
};
struct OpMoeA {
    static constexpr bool GATHER = true;
    const char* h; const int* idx;
    __device__ __forceinline__ unsigned off(int, int) const { return 0u; }
    __device__ __forceinline__ unsigned goff(const Unit& u, int R, int C) const { int t = idx[u.pm * 256 + R]; t = t < 0 ? 0 : t; return (unsigned)t * 2048u + (unsigned)C * 2u; }
    __device__ __forceinline__ const char* base(const Unit&) const { return h; }
    __device__ __forceinline__ long koff(int t) const { return (long)t * 128; }
    __device__ __forceinline__ long hstep() const { return 0; }
};
struct OpMoeB {
    static constexpr bool GATHER = false;
    const char* w; const LAS int* te; long ld2;
    __device__ __forceinline__ unsigned off(int R, int C) const { return (unsigned)(R * (int)ld2 + C * 2); }
    __device__ __forceinline__ const char* base(const Unit& u) const { return w + (long)__builtin_amdgcn_readfirstlane(te[u.pm]) * (long)MOE_E_STRIDE + (long)u.pn * 256 * ld2; }
    __device__ __forceinline__ long koff(int t) const { return (long)t * 128; }
    __device__ __forceinline__ long hstep() const { return 128 * ld2; }
};

template <class T, class = void> struct IsRmw { static constexpr bool value = false; };
template <class T> struct IsRmw<T, decltype((void)sizeof(typename T::Pre))> { static constexpr bool value = true; };
template <bool ALIGN = true, class OA, class OB, class Epi>
__device__ __forceinline__ void gemm8(LAS unsigned char* lds, const int wv, const int nt, const OA& oa, const OB& ob, const Order& S, const Epi& E, const int stag = 0) {
    if (stag > 0) {
        const unsigned long long t0 = __builtin_amdgcn_s_memrealtime(), want = (unsigned long long)(((S.c >> 3) & 3) * stag);
        while (__builtin_amdgcn_s_memrealtime() - t0 < want) __builtin_amdgcn_s_sleep(4); }
    const int tid = tid_of(wv);
    const int wid = __builtin_amdgcn_readfirstlane(tid >> 6), lane = tid & 63, wr = wid >> 2, wc = wid & 3, fr = lane & 15, fq = lane >> 4;
    unsigned voffA[2][2], voffB[2];
#pragma unroll
    for (int i = 0; i < 2; ++i) { int R_, C_; stage_rc(tid * 16 + i * 8192, R_, C_); voffB[i] = ob.off(R_, C_); voffA[0][i] = oa.off(R_, C_); voffA[1][i] = 0u; }
    const long hA = oa.hstep(), hB = ob.hstep();
    const unsigned ldsw = (unsigned)wid * 1024u;
    const int aoff = lds_byte(wr * 64 + fr, fq * 8), boff = lds_byte(wc * 32 + fr, fq * 8);
#define G8_SA(b, h) (((b) * 2 + (h)) * HTB)
#define G8_SB(b, h) ((4 + (b) * 2 + (h)) * HTB)
#define G8_STAGE_B(bufoff, gbase) do { _Pragma("unroll") for (int _i = 0; _i < 2; ++_i) \
        __builtin_amdgcn_global_load_lds((const unsigned*)((const char*)(gbase) + voffB[_i]), (LAS unsigned*)(lds + (bufoff) + ldsw + _i * 8192), 16, 0, 0); } while (0)
#define G8_STAGE_A(bufoff, gbase, h) do { _Pragma("unroll") for (int _i = 0; _i < 2; ++_i) \
        __builtin_amdgcn_global_load_lds((const unsigned*)((const char*)(gbase) + (OA::GATHER ? 0 : (h) * hA) + voffA[OA::GATHER ? (h) : 0][_i]), (LAS unsigned*)(lds + (bufoff) + ldsw + _i * 8192), 16, 0, 0); } while (0)
#define G8_LDA(dst, b, h) do { _Pragma("unroll") for (int m = 0; m < 4; ++m) _Pragma("unroll") for (int k = 0; k < 2; ++k) dst[m][k] = *(const LAS bf16x8*)(lds + G8_SA(b, h) + aoff + m * 2048 + k * 1024); } while (0)
#define G8_LDB(dst, b, h) do { _Pragma("unroll") for (int n = 0; n < 2; ++n) _Pragma("unroll") for (int k = 0; k < 2; ++k) dst[n][k] = *(const LAS bf16x8*)(lds + G8_SB(b, h) + boff + n * 2048 + k * 1024); } while (0)
#define G8_MMA(ai, bj, At, Bt) do { __builtin_amdgcn_s_setprio(1); _Pragma("unroll") for (int m = 0; m < 4; ++m) _Pragma("unroll") for (int n = 0; n < 2; ++n) _Pragma("unroll") for (int k = 0; k < 2; ++k) \
        acc[ai][bj][m][n] = __builtin_amdgcn_mfma_f32_16x16x32_bf16(Bt[n][k], At[m][k], acc[ai][bj][m][n], 0, 0, 0); __builtin_amdgcn_s_setprio(0); } while (0)
#define G8_WAIT_V(n) asm volatile("s_waitcnt vmcnt(" #n ")" ::: "memory")
#define G8_WAIT_L(n) asm volatile("s_waitcnt lgkmcnt(" #n ")" ::: "memory")
#define G8_BAR __builtin_amdgcn_s_barrier()
#define G8_SCHED __builtin_amdgcn_sched_barrier(0)
#define G8_GOFF(u) do { if constexpr (OA::GATHER) { const int _tz = tid_of(wv); _Pragma("unroll") for (int _i = 0; _i < 2; ++_i) { int _R, _C; stage_rc(_tz * 16 + _i * 8192, _R, _C); \
        _Pragma("unroll") for (int _h = 0; _h < 2; ++_h) voffA[_h][_i] = oa.goff(u, _R + 128 * _h, _C); } } } while (0)
    Unit cur, nxt; int ui = 0;
    if (!S.next(0, cur)) return;
    f32x4 acc[2][2][4][2];
#pragma unroll
    for (int a = 0; a < 2; ++a)
#pragma unroll
        for (int b = 0; b < 2; ++b)
#pragma unroll
            for (int m = 0; m < 4; ++m)
#pragma unroll
                for (int n = 0; n < 2; ++n) acc[a][b][m][n] = (f32x4){0.f, 0.f, 0.f, 0.f};
    bf16x8 At[4][2], B0[2][2], B1[2][2];
    const char* cA = oa.base(cur); const char* cB = ob.base(cur);
    asm volatile("" : "+s"(cA), "+s"(cB));
    G8_GOFF(cur);
    {   const long ka0 = oa.koff(0), ka1 = oa.koff(1), kb0 = ob.koff(0), kb1 = ob.koff(1);
        G8_STAGE_B(G8_SB(0, 0), cB + kb0); G8_STAGE_B(G8_SB(0, 1), cB + kb0 + hB); G8_STAGE_A(G8_SA(0, 0), cA + ka0, 0); G8_STAGE_A(G8_SA(0, 1), cA + ka0, 1);
        if (wr == 1) G8_BAR;
        G8_WAIT_V(2); G8_BAR;
        G8_STAGE_B(G8_SB(1, 0), cB + kb1); G8_STAGE_A(G8_SA(1, 0), cA + ka1, 0); G8_STAGE_B(G8_SB(1, 1), cB + kb1 + hB);
        G8_WAIT_V(6); G8_BAR; }
    for (;;) {
        const bool has_next = S.next(ui + 1, nxt);
        const char* nA = has_next ? oa.base(nxt) : cA; const char* nB = has_next ? ob.base(nxt) : cB;
        asm volatile("" : "+s"(nA), "+s"(nB));
        for (int t = 0; t < nt; t += 2) {
            const bool last = (t == nt - 2);
            const char* a1 = cA + oa.koff(t + 1);
            const char* a2 = last ? nA + oa.koff(0) : cA + oa.koff(t + 2); const char* b2 = last ? nB + ob.koff(0) : cB + ob.koff(t + 2);
            const char* a3 = last ? nA + oa.koff(1) : cA + oa.koff(t + 3); const char* b3 = last ? nB + ob.koff(1) : cB + ob.koff(t + 3);
            G8_LDB(B0, 0, 0); G8_LDB(B1, 0, 1); G8_SCHED; G8_LDA(At, 0, 0); G8_STAGE_A(G8_SA(1, 1), a1, 1);
            if (last && has_next && nxt.pm != cur.pm) G8_GOFF(nxt);
            G8_WAIT_V(8); G8_WAIT_L(0); G8_BAR; G8_MMA(0, 0, At, B0); G8_MMA(0, 1, At, B1); G8_BAR; G8_SCHED;
            G8_LDA(At, 0, 1); G8_STAGE_B(G8_SB(0, 0), b2); G8_STAGE_B(G8_SB(0, 1), b2 + hB); G8_STAGE_A(G8_SA(0, 0), a2, 0);
            G8_WAIT_V(8); G8_WAIT_L(0); G8_BAR; G8_MMA(1, 0, At, B0); G8_MMA(1, 1, At, B1); G8_BAR; G8_SCHED;
            G8_LDB(B0, 1, 0); G8_LDB(B1, 1, 1); G8_SCHED; G8_LDA(At, 1, 0); G8_STAGE_A(G8_SA(0, 1), a2, 1);
            G8_WAIT_V(8); G8_WAIT_L(0); G8_BAR; G8_MMA(0, 0, At, B0); G8_MMA(0, 1, At, B1); G8_BAR; G8_SCHED;
            G8_LDA(At, 1, 1); G8_STAGE_B(G8_SB(1, 0), b3); G8_STAGE_B(G8_SB(1, 1), b3 + hB); G8_STAGE_A(G8_SA(1, 0), a3, 0);
            G8_WAIT_V(8); G8_WAIT_L(0); G8_BAR; G8_MMA(1, 0, At, B0); G8_MMA(1, 1, At, B1); G8_BAR; G8_SCHED;
        }
        if (ALIGN) { if (wr == 0) G8_BAR; }
        {   const int tz = tid_of(wv); const int wz = tz >> 6, lz = tz & 63;
            const int row0 = cur.pm * BM + (wz >> 2) * 64 + (lz & 15), col0 = cur.pn * BM + (wz & 3) * 32 + 4 * (lz >> 4);
            if constexpr (IsRmw<Epi>::value) {
#pragma unroll
                for (int ai = 0; ai < 2; ++ai)
#pragma unroll
                    for (int mh = 0; mh < 4; mh += 2) { typename Epi::Pre pr[2][2];
#pragma unroll
                        for (int m2 = 0; m2 < 2; ++m2)
#pragma unroll
                            for (int bj = 0; bj < 2; ++bj) pr[m2][bj] = E.pre(cur.bt, row0 + ai * HALF + (mh + m2) * 16, col0 + bj * HALF);
#pragma unroll
                        for (int m2 = 0; m2 < 2; ++m2)
#pragma unroll
                            for (int bj = 0; bj < 2; ++bj) E.post(pr[m2][bj], cur.bt, row0 + ai * HALF + (mh + m2) * 16, col0 + bj * HALF, acc[ai][bj][mh + m2][0], acc[ai][bj][mh + m2][1]); }
            } else {
#pragma unroll
            for (int ai = 0; ai < 2; ++ai)
#pragma unroll
                for (int m = 0; m < 4; ++m)
#pragma unroll
                    for (int bj = 0; bj < 2; ++bj) E(cur.bt, row0 + ai * HALF + m * 16, col0 + bj * HALF, acc[ai][bj][m][0], acc[ai][bj][m][1]); } }
        if (!has_next) break;
#pragma unroll
        for (int a = 0; a < 2; ++a)
#pragma unroll
            for (int b = 0; b < 2; ++b)
#pragma unroll
                for (int m = 0; m < 4; ++m)
#pragma unroll
                    for (int n = 0; n < 2; ++n) acc[a][b][m][n] = (f32x4){0.f, 0.f, 0.f, 0.f};
        cur = nxt; cA = nA; cB = nB; ++ui;
        if (ALIGN) { if (wr == 1) G8_BAR; }
    }
    G8_WAIT_V(0);
    if (!ALIGN) { if (wr == 0) G8_BAR; }
    G8_BAR;
#undef G8_SA
#undef G8_SB
#undef G8_STAGE_A
#undef G8_STAGE_B
#undef G8_LDA
#undef G8_LDB
#undef G8_MMA
#undef G8_WAIT_V
#undef G8_WAIT_L
#undef G8_BAR
#undef G8_SCHED
#undef G8_GOFF
}
}

#ifndef PROBE_SEL
#define PROBE_SEL -1
#endif
#ifndef PROBE_BLK
#define PROBE_BLK 0
#endif
#ifndef PROBE_TID
#define PROBE_TID 0
#endif
#if PROBE_SEL >= 0
__device__ __forceinline__ void prb_b(LAS unsigned char* lds, int tid) { if (tid == PROBE_TID) { asm volatile("s_waitcnt vmcnt(0) lgkmcnt(0)" ::: "memory"); *(volatile LAS unsigned long long*)(lds + LDS_MISC + 64) = __builtin_amdgcn_s_memrealtime(); } }
__device__ __forceinline__ void prb_e(LAS unsigned char* lds, int tid) { if (tid == PROBE_TID) { asm volatile("s_waitcnt vmcnt(0) lgkmcnt(0)" ::: "memory"); volatile LAS unsigned long long* p = (volatile LAS unsigned long long*)(lds + LDS_MISC + 64); p[1] = p[1] + (__builtin_amdgcn_s_memrealtime() - p[0]); } }
#define PB(id) do { if ((id) == PROBE_SEL) prb_b(F.lds, F.tid); } while (0)
#define PE(id) do { if ((id) == PROBE_SEL) prb_e(F.lds, F.tid); } while (0)
#else
#define PB(id) do { } while (0)
#define PE(id) do { } while (0)
#endif
struct Args { const float* in[40]; float* out; unsigned char* ws; int ph_lo, ph_hi; };
struct Frame {
    LAS unsigned char* lds; int tid, lane, wave, vcu, G;
    const float* const* in; float* out; unsigned char* ws;
};
#define WSP(T, off) ((T*)(F.ws + (off)))
__device__ __forceinline__ Frame relocal(const Frame& F0) { Frame F = F0; const int t = tid_of(F0.wave); F.tid = t; F.lane = t & 63; F.wave = F0.wave; int v = F0.vcu; asm volatile("" : "+s"(v)); F.vcu = v; return F; }

constexpr int PH_P0 = 0, PH_P1 = 1, PH_L = 2, PH_PER = 20, N_PHASES = PH_L + 2 * PH_PER;
enum { S_NORM1 = 0, S_G1, S_FNET, S_HY1, S_S5E, S_CARRY, S_HY2, S_S5O, S_GLU, S_HYT, S_WOUT, S_NORM2, S_F0, S_F1, S_F2, S_F3, S_F4, S_F5, S_F6 };

__device__ __forceinline__ int wq_next(Frame& F, int qid) {
    LAS int* slot = (LAS int*)(F.lds + LDS_MISC + 96);
    if (F.tid == 0) *slot = (int)__hip_atomic_fetch_add((unsigned*)(F.ws + WS_CTL) + 8192 + 64 * qid, 1u, __ATOMIC_RELAXED, __HIP_MEMORY_SCOPE_AGENT);
    __syncthreads();
    const int v = *slot;
    __syncthreads();
    return v;
}
__device__ __forceinline__ int rowmap(int mode, int row_off, int n) { return (mode == 0 || mode == 3) ? row_off + n : (32 * (n >> 4) + (n & 15) + (mode == 2 ? 16 : 0)); }
__device__ __forceinline__ void transpose_item(const float* W, int ldw, int col0, int N, bf16* WT, int ldk, int mode, int row_off, LAS float* scr, int item, int lane) {
    const int nblk = N / 32, kb = item / nblk, nb = item % nblk, k0 = 64 * kb, n0 = 32 * nb;
    const int r8 = lane >> 3, c4 = lane & 7;
    f32x4 v[8];
#pragma unroll
    for (int i = 0; i < 8; ++i) v[i] = *(const f32x4*)(W + (size_t)(k0 + 8 * i + r8) * ldw + col0 + n0 + 4 * c4);
#pragma unroll
    for (int i = 0; i < 8; ++i) { LAS float* d = scr + (8 * i + r8) * 33 + 4 * c4; d[0] = v[i].x; d[1] = v[i].y; d[2] = v[i].z; d[3] = v[i].w; }
    asm volatile("s_waitcnt lgkmcnt(0)" ::: "memory");
    const int c = lane & 7;
#pragma unroll
    for (int j = 0; j < 4; ++j) { const int n = (lane >> 3) + 8 * j; const LAS float* s = scr + (8 * c) * 33 + n;
        v4u o; o.x = pk2(s[0 * 33], s[1 * 33]); o.y = pk2(s[2 * 33], s[3 * 33]); o.z = pk2(s[4 * 33], s[5 * 33]); o.w = pk2(s[6 * 33], s[7 * 33]);
        if (mode == 3) *(v4u*)(WT + tiled_idx(row_off + n0 + n, k0 + 8 * c, ldk / 64)) = o; else *(v4u*)(WT + (size_t)rowmap(mode, row_off, n0 + n) * ldk + k0 + 8 * c) = o; }
    asm volatile("s_waitcnt lgkmcnt(0)" ::: "memory");
}

__device__ __forceinline__ void p0_transposes(Frame& F) {
    LAS float* scr = (LAS float*)(F.lds + F.wave * 16384);
    const int gw = F.vcu * NWAVES + F.wave, NGW = F.G * NWAVES;
    constexpr int I_IN = 16 * 48, I_OUT = 16 * 32, I_GLU = 6 * 12, I_FG = 16 * 88, I_FD = 44 * 32;
    constexpr int NIT = 2 * (I_IN + I_OUT + I_GLU) + 2 * I_FG + I_FD;
    for (int it = gw; it < NIT; it += NGW) {
        int r = it;
        if (r < 2 * I_IN) { const int l = r / I_IN; transpose_item(F.in[8] + (size_t)l * D * DIN, DIN, 256, 1536, WSP(bf16, WS_WIN) + (size_t)l * PTROWS * D, D, 0, 512, scr, r % I_IN, F.lane); continue; } r -= 2 * I_IN;
        if (r < 2 * I_OUT) { const int l = r / I_OUT; transpose_item(F.in[9] + (size_t)l * D * D, D, 0, D, WSP(bf16, WS_WOUT) + (size_t)l * D * D, D, 0, 0, scr, r % I_OUT, F.lane); continue; } r -= 2 * I_OUT;
        if (r < 2 * I_GLU) { const int l = r / I_GLU; transpose_item(F.in[29] + (size_t)l * 384 * 384, 384, 0, 384, WSP(bf16, WS_GLU) + (size_t)l * 512 * 384, 384, 0, 0, scr, r % I_GLU, F.lane); continue; } r -= 2 * I_GLU;
        if (r < I_FG) { transpose_item(F.in[31], DFF, 0, DFF, WSP(bf16, WS_FGU), D, 1, 0, scr, r, F.lane); continue; } r -= I_FG;
        if (r < I_FG) { transpose_item(F.in[32], DFF, 0, DFF, WSP(bf16, WS_FGU), D, 2, 0, scr, r, F.lane); continue; } r -= I_FG;
        transpose_item(F.in[33], D, 0, D, WSP(bf16, WS_FD), DFF, 3, 0, scr, r, F.lane);
    }
}
struct TItem { const float* src; int ldw; bf16* dst; int ldk, mode, k0, n0; };
__device__ __forceinline__ void titem_load(const TItem& t, int lane, f32x4 (&v)[8]) { const int r8 = lane >> 3, c4 = lane & 7;
#pragma unroll
    for (int i = 0; i < 8; ++i) v[i] = *(const f32x4*)(t.src + (size_t)(t.k0 + 8 * i + r8) * t.ldw + t.n0 + 4 * c4); }
__device__ __forceinline__ void titem_finish(const TItem& t, int lane, const f32x4 (&v)[8], LAS float* scr) { const int r8 = lane >> 3, c4 = lane & 7;
#pragma unroll
    for (int i = 0; i < 8; ++i) { LAS float* d = scr + (8 * i + r8) * 33 + 4 * c4; d[0] = v[i].x; d[1] = v[i].y; d[2] = v[i].z; d[3] = v[i].w; }
    asm volatile("s_waitcnt lgkmcnt(0)" ::: "memory");
    const int c = lane & 7;
#pragma unroll
    for (int j = 0; j < 4; ++j) { const int n = (lane >> 3) + 8 * j; const LAS float* s = scr + (8 * c) * 33 + n;
        v4u o; o.x = pk2(s[0 * 33], s[1 * 33]); o.y = pk2(s[2 * 33], s[3 * 33]); o.z = pk2(s[4 * 33], s[5 * 33]); o.w = pk2(s[6 * 33], s[7 * 33]);
        if (t.mode == 3) *(v4u*)(t.dst + tiled_idx(t.n0 + n, t.k0 + 8 * c, t.ldk / 64)) = o; else *(v4u*)(t.dst + (size_t)rowmap(t.mode, 0, t.n0 + n) * t.ldk + t.k0 + 8 * c) = o; }
    asm volatile("s_waitcnt lgkmcnt(0)" ::: "memory"); }
__device__ __forceinline__ TItem moe_titem(Frame& F, int it) {
    constexpr int I_G = 16 * 112, I_D = 56 * 32, PER_E = 2 * I_G + I_D;
    const int e = it / PER_E; int r = it % PER_E; TItem t;
    bf16* gu = (bf16*)(F.ws + WS_MOEW + (size_t)e * MOE_E_STRIDE); bf16* dn = (bf16*)(F.ws + WS_MOEW + (size_t)e * MOE_E_STRIDE + MOE_GU_BYTES);
    if (r < 2 * I_G) { const int up = r >= I_G; if (up) r -= I_G; t.src = F.in[36 + up] + (size_t)e * D * DFE; t.ldw = DFE; t.dst = gu; t.ldk = D; t.mode = 1 + up; t.k0 = 64 * (r / 112); t.n0 = 32 * (r % 112); }
    else { r -= 2 * I_G; t.src = F.in[38] + (size_t)e * DFE * D; t.ldw = D; t.dst = dn; t.ldk = DFE; t.mode = 3; t.k0 = 64 * (r / 32); t.n0 = 32 * (r % 32); }
    return t; }
__device__ __forceinline__ void moe_transposes(Frame& F_) { Frame F = relocal(F_);
    LAS float* scr = (LAS float*)(F.lds + F.wave * 16384);
    const int gw = F.vcu * NWAVES + F.wave, NGW = F.G * NWAVES; constexpr int NIT = NE * (2 * 16 * 112 + 56 * 32);
    int it = gw; if (it >= NIT) return;
    TItem cur = moe_titem(F, it); f32x4 va[8], vb[8]; titem_load(cur, F.lane, va);
    for (;;) {
        const int itn = it + NGW; const bool hn = itn < NIT; TItem nx = cur; if (hn) { nx = moe_titem(F, itn); titem_load(nx, F.lane, vb); }
        titem_finish(cur, F.lane, va, scr);
        if (!hn) break;
        const int itn2 = itn + NGW; const bool hn2 = itn2 < NIT; TItem nx2 = nx; if (hn2) { nx2 = moe_titem(F, itn2); titem_load(nx2, F.lane, va); }
        titem_finish(nx, F.lane, vb, scr);
        if (!hn2) break;
        cur = nx2; it = itn2;
    }
}

__device__ __forceinline__ void p0_mod_item(Frame& F, int item) {
    const int l = item / 48, cb = item % 48, tid = tid_of(F.wave), lane = tid & 63;
    LAS float* sc = (LAS float*)F.lds;
    LAS float* red = sc + 17 * 1024;
    for (int i = tid; i < 17 * 1024; i += NTHR) { const int r = i >> 10, k = i & 1023; const float v = r < 16 ? F.in[1][r * D + k] : F.in[3][k]; sc[i] = silu_f(v); }
    __syncthreads();
    const int cq = lane & 31, kg = (lane >> 5) + 2 * F.wave;
    const float* W = F.in[4] + (size_t)l * D * 6144 + cb * 128 + 4 * cq;
    f32x4 acc[17];
#pragma unroll
    for (int r = 0; r < 17; ++r) acc[r] = (f32x4){0.f, 0.f, 0.f, 0.f};
#pragma unroll 1
    for (int k0 = kg * 64; k0 < kg * 64 + 64; k0 += 8) { f32x4 w[8];
#pragma unroll
        for (int j = 0; j < 8; ++j) w[j] = *(const f32x4*)(W + (size_t)(k0 + j) * 6144);
#pragma unroll
        for (int j = 0; j < 8; ++j)
#pragma unroll
            for (int r = 0; r < 17; ++r) acc[r] += w[j] * sc[r * 1024 + k0 + j]; }
    if (lane < 32) {
#pragma unroll
        for (int r = 0; r < 17; ++r) *(LAS f32x4*)(red + (F.wave * 17 + r) * 128 + 4 * cq) = acc[r]; }
    __syncthreads();
    if (lane >= 32) {
#pragma unroll
        for (int r = 0; r < 17; ++r) { LAS f32x4* p = (LAS f32x4*)(red + (F.wave * 17 + r) * 128 + 4 * cq); *p = *p + acc[r]; } }
    __syncthreads();
    for (int i = tid; i < 17 * 128; i += NTHR) { const int r = i >> 7, c = i & 127; float s = 0.f;
#pragma unroll
        for (int w8 = 0; w8 < 8; ++w8) s += red[(w8 * 17 + r) * 128 + c];
        WSP(float, WS_MOD)[((size_t)l * 17 + r) * 6144 + cb * 128 + c] = s + F.in[5][l * 6144 + cb * 128 + c]; }
    __syncthreads();
}
__device__ __forceinline__ void p0_fold_item(Frame& F, int item) {
    const int kb = item & 7, cs = (item >> 3) & 1, h = (item >> 4) & 3, l = item >> 6, tid = tid_of(F.wave);
    LAS float* A = (LAS float*)F.lds;
    LAS float* WF = A + 4096;
    LAS float* WI = WF + 4096;
    LAS float* T = WI + 128 * 65;
    if (tid < 64) T[tid] = cs ? sinpif((float)tid * (1.0f / 32.0f)) : cospif((float)tid * (1.0f / 32.0f));
    const float* wf = F.in[10] + ((size_t)l * 4 + h) * 64 * 64;
    for (int i = tid; i < 4096; i += NTHR) WF[i] = wf[i];
    const float* win = F.in[8] + (size_t)l * D * DIN + (size_t)kb * 128 * DIN + h * 64;
    for (int i = tid; i < 128 * 64; i += NTHR) { const int kk = i >> 6, d = i & 63; WI[kk * 65 + d] = win[(size_t)kk * DIN + d]; }
    __syncthreads();
    for (int i = tid; i < 4096; i += NTHR) { const int d = i >> 6, e2 = i & 63; float s = 0.f;
        for (int e = 0; e < 64; ++e) s += T[(e * d) & 63] * WF[e * 64 + e2];
        A[i] = s * 0.125f; }
    __syncthreads();
    const int e2 = tid & 63;
    bf16* wt = WSP(bf16, WS_WIN) + (size_t)l * PTROWS * D + (size_t)(cs * 256 + h * 64 + e2) * D + kb * 128;
    for (int i = 0; i < 16; ++i) { const int kk = (tid >> 6) + 8 * i; float s = 0.f;
#pragma unroll 8
        for (int d = 0; d < 64; ++d) s += WI[kk * 65 + d] * A[d * 64 + e2];
        wt[kk] = (bf16)f2bf(s); }
    __syncthreads();
}
__device__ __forceinline__ void gen_dft_rows(bf16* dst, int LL, int row0, int nrows, float scale, int tid) {
    const int cpr = 2 * LL / 8;
    for (int i = tid; i < nrows * cpr; i += NTHR) { const int k = row0 + i / cpr, j0 = (i % cpr) * 8; unsigned w[4];
#pragma unroll
        for (int q = 0; q < 4; ++q) { float v[2];
#pragma unroll
            for (int z = 0; z < 2; ++z) { const int j = j0 + 2 * q + z; const int jj = j < LL ? j : j - LL; const int m = (k * jj) & (LL - 1); const float x = (float)m * (2.0f / (float)LL);
                v[z] = (j < LL ? cospif(x) : -sinpif(x)) * scale; }
            w[q] = pk2(v[0], v[1]); }
        *(v4u*)(dst + (size_t)k * 2 * LL + j0) = (v4u){w[0], w[1], w[2], w[3]}; }
}
__device__ __forceinline__ void gen_fft_mats(Frame& F, int item) {
    const int tid = tid_of(F.wave);
    if (item == 64) { bf16* W = WSP(bf16, WS_FAW);
        for (int i = tid; i < 256 * 128; i += NTHR) { const int m = i >> 7, k = i & 127; float v = 0.f;
            if (m < 128) { const int pp = m >> 6, t1 = m & 63, pa = k >> 6, s1 = k & 63; const float x = (float)((t1 * s1) & 63) * (1.0f / 32.0f); const float c = cospif(x) * 0.125f, sn = sinpif(x) * 0.125f;
                v = pp == 0 ? (pa == 0 ? c : -sn) : (pa == 0 ? -sn : -c); }
            W[i] = (bf16)f2bf(v); }
        return; }
    const int grp = item >> 2, q = item & 3; bf16* W = WSP(bf16, WS_FBW) + (size_t)grp * 256 * 512;
    for (int i = q * 32768 + tid; i < (q + 1) * 32768; i += NTHR) { const int r = i >> 9, k = i & 511; const int t1p = r >> 6, t2 = r & 63, t1q = k >> 7, pa = (k >> 6) & 1, s2 = k & 63; float v = 0.f;
        if (t1p == t1q) { const int t = 4 * grp + t1p + 64 * t2; const float x = (float)((s2 * t) & 4095) * (1.0f / 2048.0f); v = (pa == 0 ? cospif(x) : sinpif(x)) * 0.125f; }
        W[i] = (bf16)f2bf(v); }
}
__device__ __forceinline__ void p0_filter_item(Frame& F, int item) {
    const int l = item / 272, pb = item % 272, tid = tid_of(F.wave);
    const int LL = pb < 256 ? L : LC, p0 = pb < 256 ? pb * 16 : (pb - 256) * 16;
    LAS float* z = (LAS float*)F.lds;
    LAS float* h1 = z + 16 * 36;
    LAS float* h2 = h1 + 16 * 64;
    LAS float* W1 = h2 + 16 * 64;
    LAS float* W2 = W1 + 33 * 64;
    for (int i = tid; i < 33 * 64; i += NTHR) W1[i] = F.in[13][(size_t)l * 33 * 64 + i];
    for (int i = tid; i < 64 * 64; i += NTHR) W2[i] = F.in[16][(size_t)l * 64 * 64 + i];
    for (int i = tid; i < 16 * 33; i += NTHR) { const int pp = i / 33, j = i % 33; const int pos = p0 + pp; float v;
        if (j == 0) v = (float)pos / (float)(LL - 1);
        else { const int bj = (j - 1) & 15; const float band = 1e-4f + (float)bj * ((15.0f - 1e-4f) / 15.0f); const float u = 2.0f * band * (float)pos / (float)LL;
            v = j <= 16 ? cospif(u) : -sinpif(u); }
        z[pp * 36 + j] = v; }
    __syncthreads();
    for (int i = tid; i < 1024; i += NTHR) { const int pp = i >> 6, o = i & 63; float s = F.in[14][l * 64 + o];
        for (int j = 0; j < 33; ++j) s += z[pp * 36 + j] * W1[j * 64 + o];
        h1[i] = sinf(F.in[15][l * 64 + o] * s); }
    __syncthreads();
    for (int i = tid; i < 1024; i += NTHR) { const int pp = i >> 6, o = i & 63; float s = F.in[17][l * 64 + o];
        for (int j = 0; j < 64; ++j) s += h1[pp * 64 + j] * W2[j * 64 + o];
        h2[i] = sinf(F.in[18][l * 64 + o] * s); }
    __syncthreads();
    float* HT = WSP(float, WS_HT) + ((size_t)l * 4352 + (pb < 256 ? 0 : 4096)) * 1536;
    float* PS = WSP(float, WS_PS) + ((size_t)l * 272 + pb) * 1536;
    const float* fw3 = F.in[19] + (size_t)l * 64 * 1536;
    const float dmin = 3.0701134573253945f, dstep = (15.350567286626973f - 3.0701134573253945f) / 383.0f;
#pragma unroll 1
    for (int cc = 0; cc < 3; ++cc) { const int col = tid + 512 * cc; float acc[16];
#pragma unroll
        for (int pp = 0; pp < 16; ++pp) acc[pp] = 0.f;
#pragma unroll 1
        for (int j0 = 0; j0 < 64; j0 += 32) { float w[32];
#pragma unroll
            for (int j = 0; j < 32; ++j) w[j] = fw3[(size_t)(j0 + j) * 1536 + col];
#pragma unroll
            for (int pp = 0; pp < 16; ++pp) { float a = acc[pp];
#pragma unroll
                for (int j = 0; j < 32; j += 4) { const f32x4 hv = *(const LAS f32x4*)(h2 + pp * 64 + j0 + j); a += (hv.x * w[j] + hv.y * w[j + 1]) + (hv.z * w[j + 2] + hv.w * w[j + 3]); }
                acc[pp] = a; __builtin_amdgcn_sched_barrier(0); } }
        const int c = col % 384, dir = col / 768; const float delta = dmin + (float)c * dstep; float ps = 0.f;
#pragma unroll
        for (int pp = 0; pp < 16; ++pp) { const int pos = p0 + pp; const float t = (float)pos / (float)(LL - 1); const float v = acc[pp] * __expf(-t * delta);
            HT[(size_t)pos * 1536 + col] = v; if (!(dir == 1 && pos == 0)) ps += fabsf(v); }
        PS[col] = ps; }
    __syncthreads();
}
__device__ __forceinline__ void p0_s5_item(Frame& F, int item2) {
    const int item = item2 >> 1, part = item2 & 1, l = item / 24, g = item % 24, tid = tid_of(F.wave);
    LAS f32x2* apow = (LAS f32x2*)F.lds;
    LAS f32x2* bbar = apow + 2 * 17 * 64;
    LAS f32x2* Cc = bbar + 2 * 64 * 16;
    LAS float* Kd = (LAS float*)(Cc + 2 * 16 * 64);
    if (tid < 128) { const int dir = tid >> 6, p = tid & 63; const size_t ix = (((size_t)l * 2 + dir) * 24 + g) * 64 + p;
        const float are = F.in[21][ix], aim = F.in[22][ix], dt = __expf(F.in[23][((size_t)l * 2 + dir) * 24 + g]);
        const float x = are * dt, yp = aim * dt * 0.3183098861837907f;
        for (int tau = 0; tau <= 16; ++tau) { const float mg = __expf(x * (float)tau), an = yp * (float)tau; apow[(dir * 17 + tau) * 64 + p] = (f32x2){mg * cospif(an), mg * sinpif(an)}; }
        const float sh = sinpif(0.5f * yp), nr = expm1f(x) * cospif(yp) - 2.0f * sh * sh, ni = __expf(x) * sinpif(yp); const float den = are * are + aim * aim;
        const float qr = (nr * are + ni * aim) / den, qi = (ni * are - nr * aim) / den;
        for (int h = 0; h < 16; ++h) { const float br = F.in[24][ix * 16 + h], bi = F.in[25][ix * 16 + h]; bbar[(dir * 64 + p) * 16 + h] = (f32x2){qr * br - qi * bi, qr * bi + qi * br}; }
        const float m16 = __expf(x * 16.0f), a16 = yp * 16.0f;
        WSP(float, WS_A16)[ix * 2 + 0] = m16 * cospif(a16); WSP(float, WS_A16)[ix * 2 + 1] = m16 * sinpif(a16); }
    for (int i = tid; i < 2 * 16 * 64; i += NTHR) { const int dir = i >> 10, h = (i >> 6) & 15, p = i & 63; const size_t ix = ((((size_t)l * 2 + dir) * 24 + g) * 16 + h) * 64 + p;
        Cc[i] = (f32x2){F.in[26][ix], F.in[27][ix]}; }
    __syncthreads();
    for (int i = tid; i < 2 * 16 * 256; i += NTHR) { const int dir = i >> 12, tau = (i >> 8) & 15, h = (i >> 4) & 15, h2 = i & 15; float s = 0.f;
        for (int p = 0; p < 64; ++p) { const f32x2 a = apow[(dir * 17 + tau) * 64 + p], b = bbar[(dir * 64 + p) * 16 + h2], c = Cc[(dir * 16 + h) * 64 + p];
            const float tr = a.x * b.x - a.y * b.y, ti = a.x * b.y + a.y * b.x; s += c.x * tr - c.y * ti; }
        Kd[i] = s; }
    __syncthreads();
    bf16* EST = (bf16*)(F.ws + WS_S5M + (size_t)item * S5M_STRIDE); bf16* MOUT = EST + 256 * 256;
    const float* dsk = F.in[28] + (size_t)l * 384 + g * 16;
    const int e_lo = part == 0 ? 0 : 32768 + 16384, e_hi = part == 0 ? 32768 + 16384 : 32768 + 65536;
    for (int pi = e_lo + tid; pi < e_hi; pi += NTHR) {
        float v2[2];
        if (pi < 32768) { const int n = pi >> 7, k0 = (pi & 127) * 2; const int dir = n >> 7, p = (n >> 1) & 63, ri = n & 1;
#pragma unroll
            for (int z = 0; z < 2; ++z) { const int k = k0 + z, hh = k >> 4, j = k & 15; const int tau = dir == 0 ? 15 - j : j; const f32x2 a = apow[(dir * 17 + tau) * 64 + p], bq = bbar[(dir * 64 + p) * 16 + hh];
                v2[z] = ri == 0 ? a.x * bq.x - a.y * bq.y : a.x * bq.y + a.y * bq.x; }
            *(unsigned*)(EST + (size_t)n * 256 + k0) = pk2(v2[0], v2[1]); }
        else { const int q = pi - 32768, n = q >> 8, k0 = (q & 255) * 2; const int j = n >> 4, h = n & 15;
#pragma unroll
            for (int z = 0; z < 2; ++z) { const int k = k0 + z; float v;
                if (k < 256) { const int hh = k >> 4, ii = k & 15; v = 0.f;
                    if (ii <= j) v += Kd[((0 * 16 + (j - ii)) * 16 + h) * 16 + hh];
                    if (ii >= j) v += Kd[((1 * 16 + (ii - j)) * 16 + h) * 16 + hh];
                    if (ii == j && h == hh) v += dsk[h]; }
                else { const int comp = k - 256, dir = comp >> 7, p = (comp >> 1) & 63, ri = comp & 1; const int tau = dir == 0 ? j + 1 : 16 - j;
                    const f32x2 a = apow[(dir * 17 + tau) * 64 + p], c = Cc[(dir * 16 + h) * 64 + p];
                    v = ri == 0 ? (c.x * a.x - c.y * a.y) : -(c.x * a.y + c.y * a.x); }
                v2[z] = v; }
            *(unsigned*)(MOUT + (size_t)n * 512 + k0) = pk2(v2[0], v2[1]); } }
    __syncthreads();
}
__device__ __forceinline__ void p0_prologue(Frame& F_) { Frame F = relocal(F_);
    PB(10); p0_transposes(F);
    __syncthreads(); PE(10);
    for (int i = F.vcu * NTHR + F.tid; i < 2 * 128 * 384 / 8; i += F.G * NTHR) { const int l = i / (128 * 384 / 8), r = i % (128 * 384 / 8);
        *(v4u*)(WSP(bf16, WS_GLU) + (size_t)l * 512 * 384 + 384 * 384 + (size_t)r * 8) = (v4u){0u, 0u, 0u, 0u}; }
    constexpr int I_S5 = 96, I_MOD = 96, I_FOLD = 128, I_FIL = 544, I_DFT = 65, I_DFTC = 4, NIT = I_S5 + I_MOD + I_FOLD + I_FIL + I_DFT + I_DFTC;
    for (int it = wq_next(F, 0); it < NIT; it = wq_next(F, 0)) {
        int r = it;
        if (r < I_S5) { PB(14); p0_s5_item(F, r); PE(14); continue; } r -= I_S5;
        if (r < I_MOD) { PB(12); p0_mod_item(F, r); PE(12); continue; } r -= I_MOD;
        if (r < I_FOLD) { PB(13); p0_fold_item(F, r); PE(13); continue; } r -= I_FOLD;
        if (r < I_FIL) { PB(11); p0_filter_item(F, r); PE(11); continue; } r -= I_FIL;
        if (r < I_DFT) { PB(15); gen_fft_mats(F, r); PE(15); continue; } r -= I_DFT;
        gen_dft_rows(WSP(bf16, WS_DFTC), LC, r * 64, 64, 1.0f / 16.0f, F.tid);
    }
}
__device__ __forceinline__ void p1_item(Frame& F_, int item) { Frame F = relocal(F_);
    const int qt = item & 3, ocb = (item >> 2) % 24, ls = (item >> 2) / 24, set = ls & 1, l = ls >> 1, o = ocb / 12, cb = ocb % 12, tid = F.tid;
    const int LL = set ? LC : L, nbt = set ? 1 : 4;
    if (set && qt) return;
    LAS float* red = (LAS float*)F.lds;
    LAS float* inv = red + 512;
    LAS float* T = inv + 32;
    const float* PS = WSP(float, WS_PS) + ((size_t)l * 272 + (set ? 256 : 0)) * 1536;
    { const int ch = tid & 31, part = tid >> 5; float s = 0.f; const int nblk = LL / 16;
      for (int b = part; b < nblk; b += 16) s += PS[(size_t)b * 1536 + o * 384 + cb * 32 + ch] + PS[(size_t)b * 1536 + 768 + o * 384 + cb * 32 + ch];
      red[part * 32 + ch] = s; }
    __syncthreads();
    if (tid < 32) { float s = 0.f; for (int p = 0; p < 16; ++p) s += red[p * 32 + tid]; inv[tid] = 1.0f / s; }
    const float* HT = WSP(float, WS_HT) + ((size_t)l * 4352 + (set ? 4096 : 0)) * 1536;
    float* KT = set ? WSP(float, WS_KTC) + ((size_t)(l * 2 + o) * 384) * 512 : WSP(float, WS_KT) + ((size_t)(l * 2 + o) * 384) * 8192;
#pragma unroll 1
    for (int bi = 0; bi < nbt; ++bi) { const int pos0 = (qt * nbt + bi) * 256;
        { const int ch = tid & 31, dir = (tid >> 5) & 1;
#pragma unroll 8
          for (int i = 0; i < 32; ++i) { const int pp = (tid >> 6) + 8 * i; T[(dir * 256 + pp) * 33 + ch] = HT[(size_t)(pos0 + pp) * 1536 + dir * 768 + o * 384 + cb * 32 + ch]; } }
        __syncthreads();
        { const int pp = tid & 255, c0 = tid >> 8;
#pragma unroll 4
          for (int i = 0; i < 16; ++i) { const int ch = c0 + 2 * i; const int pos = pos0 + pp; float* kt = KT + (size_t)(cb * 32 + ch) * 2 * LL;
              kt[LL + pos] = T[(0 * 256 + pp) * 33 + ch] * inv[ch];
              if (pos > 0) kt[LL - pos] = T[(1 * 256 + pp) * 33 + ch] * inv[ch]; else kt[0] = 0.f; } }
        __syncthreads(); }
}

__device__ __forceinline__ void norm_rows(Frame& F_, const float* xlat, const float* xctx, int nrows, const float* gain, const float* mod, int sh_off, int sc_off, bf16* out) { Frame F = relocal(F_);
    const int gw = F.vcu * NWAVES + F.wave, NGW = F.G * NWAVES, lane = F.lane;
    for (int r0 = gw; r0 < nrows; r0 += 2 * NGW) {
        f32x4 v[2][4]; float ss[2];
#pragma unroll
        for (int q = 0; q < 2; ++q) { const int r = r0 + q * NGW; ss[q] = 0.f;
            if (r < nrows) { const float* xr = r < NL ? xlat + (size_t)r * D : xctx + (size_t)(r - NL) * D;
#pragma unroll
                for (int j = 0; j < 4; ++j) v[q][j] = ((const f32x4*)xr)[64 * j + lane]; } }
#pragma unroll
        for (int q = 0; q < 2; ++q) { const int r = r0 + q * NGW;
            if (r < nrows) {
#pragma unroll
                for (int j = 0; j < 4; ++j) ss[q] += (v[q][j].x * v[q][j].x + v[q][j].y * v[q][j].y) + (v[q][j].z * v[q][j].z + v[q][j].w * v[q][j].w);
                const float rstd = 1.0f / sqrtf(wave_sum(ss[q], lane) * (1.0f / D) + 1e-6f);
                const float* md = mod + (size_t)bidx_of(r) * 6144;
#pragma unroll
                for (int j = 0; j < 4; ++j) { const int col = (64 * j + lane) * 4; const f32x4 g4 = *(const f32x4*)(gain + col), sc = *(const f32x4*)(md + sc_off + col), sh = *(const f32x4*)(md + sh_off + col);
                    const f32x4 h = v[q][j] * rstd * g4 * (sc + 1.0f) + sh;
                    *(v2u*)(out + (size_t)r * D + col) = (v2u){pk2(h.x, h.y), pk2(h.z, h.w)}; } } }
    }
}
__device__ __forceinline__ void norm_rows_b16(Frame& F_, const bf16* x, int nrows, const float* gain, const float* mod, int sh_off, int sc_off, bf16* out) { Frame F = relocal(F_);
    const int gw = F.vcu * NWAVES + F.wave, NGW = F.G * NWAVES, lane = F.lane;
    for (int r0 = gw; r0 < nrows; r0 += 2 * NGW) {
        v4u raw[2][2];
#pragma unroll
        for (int q = 0; q < 2; ++q) { const int r = r0 + q * NGW; if (r < nrows) {
#pragma unroll
            for (int j = 0; j < 2; ++j) raw[q][j] = *(const v4u*)(x + (size_t)r * D + 512 * j + 8 * lane); } }
#pragma unroll
        for (int q = 0; q < 2; ++q) { const int r = r0 + q * NGW;
            if (r < nrows) { float v[2][8]; float ss = 0.f;
#pragma unroll
                for (int j = 0; j < 2; ++j) { const v4u u = raw[q][j]; v[j][0] = bf2f(u.x & 0xffffu); v[j][1] = bf2f(u.x >> 16); v[j][2] = bf2f(u.y & 0xffffu); v[j][3] = bf2f(u.y >> 16); v[j][4] = bf2f(u.z & 0xffffu); v[j][5] = bf2f(u.z >> 16); v[j][6] = bf2f(u.w & 0xffffu); v[j][7] = bf2f(u.w >> 16);
#pragma unroll
                    for (int i = 0; i < 8; ++i) ss += v[j][i] * v[j][i]; }
                const float rstd = 1.0f / sqrtf(wave_sum(ss, lane) * (1.0f / D) + 1e-6f);
                const float* md = mod + (size_t)bidx_of(r) * 6144;
#pragma unroll
                for (int j = 0; j < 2; ++j) { const int col = 512 * j + 8 * lane; float h[8];
#pragma unroll
                    for (int i4 = 0; i4 < 2; ++i4) { const f32x4 g4 = *(const f32x4*)(gain + col + 4 * i4), sc = *(const f32x4*)(md + sc_off + col + 4 * i4), sh = *(const f32x4*)(md + sh_off + col + 4 * i4);
                        h[4 * i4 + 0] = v[j][4 * i4 + 0] * rstd * g4.x * (sc.x + 1.0f) + sh.x; h[4 * i4 + 1] = v[j][4 * i4 + 1] * rstd * g4.y * (sc.y + 1.0f) + sh.y;
                        h[4 * i4 + 2] = v[j][4 * i4 + 2] * rstd * g4.z * (sc.z + 1.0f) + sh.z; h[4 * i4 + 3] = v[j][4 * i4 + 3] * rstd * g4.w * (sc.w + 1.0f) + sh.w; }
                    *(v4u*)(out + (size_t)r * D + col) = (v4u){pk2(h[0], h[1]), pk2(h[2], h[3]), pk2(h[4], h[5]), pk2(h[6], h[7])}; } } }
    }
}
__device__ __forceinline__ void norm2_router(Frame& F_, const float* x, const float* gain, const float* mod, bf16* out) { Frame F = relocal(F_);
    LAS int* hist = (LAS int*)F.lds;
    const float* rw = F.in[34]; const float* rb = F.in[35];
    for (int tile = F.vcu; tile < NL / 256; tile += F.G) {
        if (F.tid < 16) hist[F.tid] = 0;
        __syncthreads();
        f32x4 vn[4];
        { const float* xr0 = x + (size_t)(tile * 256 + F.wave * 32) * D;
#pragma unroll
          for (int j = 0; j < 4; ++j) vn[j] = ((const f32x4*)xr0)[64 * j + F.lane]; }
#pragma unroll 1
        for (int i = 0; i < 32; ++i) { const int r = tile * 256 + F.wave * 32 + i, lane = F.lane;
            const float* md = mod + (size_t)(r >> 12) * 6144;
            f32x4 v[4]; float ss = 0.f;
#pragma unroll
            for (int j = 0; j < 4; ++j) v[j] = vn[j];
            if (i + 1 < 32) { const float* xn = x + (size_t)(r + 1) * D;
#pragma unroll
                for (int j = 0; j < 4; ++j) vn[j] = ((const f32x4*)xn)[64 * j + lane]; }
#pragma unroll
            for (int j = 0; j < 4; ++j) ss += (v[j].x * v[j].x + v[j].y * v[j].y) + (v[j].z * v[j].z + v[j].w * v[j].w);
            const float rstd = 1.0f / sqrtf(wave_sum(ss, lane) * (1.0f / D) + 1e-6f);
            float lg[8];
#pragma unroll
            for (int e = 0; e < 8; ++e) lg[e] = 0.f;
#pragma unroll
            for (int j = 0; j < 4; ++j) { const int col = (64 * j + lane) * 4; const f32x4 g4 = *(const f32x4*)(gain + col), sc = *(const f32x4*)(md + 4096 + col), sh = *(const f32x4*)(md + 3072 + col);
                const f32x4 h = v[j] * rstd * g4 * (sc + 1.0f) + sh;
                *(v2u*)(out + (size_t)r * D + col) = (v2u){pk2(h.x, h.y), pk2(h.z, h.w)};
#pragma unroll
                for (int q = 0; q < 4; ++q) { const f32x4 w0 = *(const f32x4*)(rw + (size_t)(col + q) * 8), w1 = *(const f32x4*)(rw + (size_t)(col + q) * 8 + 4); const float hv = h[q];
                    lg[0] += hv * w0.x; lg[1] += hv * w0.y; lg[2] += hv * w0.z; lg[3] += hv * w0.w; lg[4] += hv * w1.x; lg[5] += hv * w1.y; lg[6] += hv * w1.z; lg[7] += hv * w1.w; } }
#pragma unroll
            for (int e = 0; e < 8; ++e) lg[e] = wave_sum(lg[e], lane) + rb[e];
            if (lane == 0) {
                int e1 = 0; float v1 = lg[0];
#pragma unroll
                for (int e = 1; e < 8; ++e) if (lg[e] > v1) { v1 = lg[e]; e1 = e; }
                int e2 = -1; float v2 = -3.4e38f;
#pragma unroll
                for (int e = 0; e < 8; ++e) if (e != e1 && lg[e] > v2) { v2 = lg[e]; e2 = e; }
                const float ex = __expf(v2 - v1), w1 = 1.0f / (1.0f + ex), w2 = ex / (1.0f + ex);
                *(v4u*)(F.ws + WS_TOPK + (size_t)r * 16) = (v4u){(unsigned)(e1 | (e2 << 8)), __builtin_bit_cast(unsigned, w1), __builtin_bit_cast(unsigned, w2), 0u};
                __hip_atomic_fetch_add(hist + e1, 1, __ATOMIC_RELAXED, __HIP_MEMORY_SCOPE_WORKGROUP); __hip_atomic_fetch_add(hist + 8 + e2, 1, __ATOMIC_RELAXED, __HIP_MEMORY_SCOPE_WORKGROUP);
            } }
        __syncthreads();
        if (F.tid < 16) ((int*)(F.ws + WS_META + META_CNT))[tile * 16 + F.tid] = hist[F.tid];
        __syncthreads();
    }
}
__device__ __forceinline__ void moe_slots(Frame& F_) { Frame F = relocal(F_);
    LAS int* tot = (LAS int*)F.lds;
    LAS int* es = tot + 32;
    const int* CNT = (const int*)(F.ws + WS_META + META_CNT); int* IDX = (int*)(F.ws + WS_META + META_IDX); int* TE = (int*)(F.ws + WS_META + META_TE); int* NT = (int*)(F.ws + WS_META + META_NT);
    for (int it = F.vcu; it < 512; it += F.G) { const int k = it >> 8, tile = it & 255, tid = F.tid;
        if (tid < 8) { int t = 0, b = 0; for (int i = 0; i < 256; ++i) { const int c = CNT[i * 16 + k * 8 + tid]; if (i < tile) b += c; t += c; } tot[tid] = t; tot[8 + tid] = b; }
        __syncthreads();
        if (tid == 0) { int s = 0; for (int e = 0; e < 8; ++e) { tot[16 + e] = s; s += (tot[e] + 255) & ~255; } tot[24] = s; }
        if (tid < 256) { const unsigned pk = *(const unsigned*)(F.ws + WS_TOPK + (size_t)(tile * 256 + tid) * 16); es[tid] = k == 0 ? (int)(pk & 255u) : (int)((pk >> 8) & 255u); }
        __syncthreads();
        if (tid < 256) { const int e = es[tid]; int rank = 0; for (int j = 0; j < tid; ++j) rank += (es[j] == e) ? 1 : 0;
            const int slot = tot[16 + e] + tot[8 + e] + rank; IDX[k * MAXSLOT + slot] = tile * 256 + tid; if (k == 1) ((int*)(F.ws + WS_META + META_SL1))[tile * 256 + tid] = slot; }
        if (tile == 0) {
            for (int e = 0; e < 8; ++e) { const int n = tot[e], np = (n + 255) & ~255, sb = tot[16 + e];
                for (int i = n + tid; i < np; i += NTHR) IDX[k * MAXSLOT + sb + i] = -1;
                for (int i = tid; i < np / 256; i += NTHR) TE[k * 272 + sb / 256 + i] = e; }
            if (tid == 0) NT[k] = tot[24] / 256; }
        __syncthreads();
    }
}
__device__ __forceinline__ void final_norm_part(Frame& F_, int part, int ntw) { Frame F = relocal(F_);
    const int bx = (int)blockIdx.x; if (part == 0 && bx < ntw) return;
    const int gw = part == 0 ? (bx - ntw) * NWAVES + F.wave : F.vcu * NWAVES + F.wave, NGW = (part == 0 ? F.G - ntw : F.G) * NWAVES, lane = F.lane; const float* gain = F.in[39];
    const int* SL1 = (const int*)(F.ws + WS_META + META_SL1);
    for (int r0 = gw; r0 < NL; r0 += 2 * NGW) { f32x4 v[2][4]; bool ok[2];
#pragma unroll
        for (int q = 0; q < 2; ++q) { const int r = r0 + q * NGW; ok[q] = r < NL && ((SL1[r < NL ? r : 0] >= NL) == (part == 1)); if (ok[q]) { const float* xr = F.out + (size_t)r * D;
#pragma unroll
            for (int j = 0; j < 4; ++j) v[q][j] = ((const f32x4*)xr)[64 * j + lane]; } }
#pragma unroll
        for (int q = 0; q < 2; ++q) { const int r = r0 + q * NGW; if (ok[q]) { float* xr = F.out + (size_t)r * D; float ss = 0.f;
#pragma unroll
            for (int j = 0; j < 4; ++j) ss += (v[q][j].x * v[q][j].x + v[q][j].y * v[q][j].y) + (v[q][j].z * v[q][j].z + v[q][j].w * v[q][j].w);
            const float rstd = 1.0f / sqrtf(wave_sum(ss, lane) * (1.0f / D) + 1e-6f);
#pragma unroll
            for (int j = 0; j < 4; ++j) { const int col = (64 * j + lane) * 4; ((f32x4*)xr)[64 * j + lane] = v[q][j] * rstd * *(const f32x4*)(gain + col); } } } }
}

__device__ __forceinline__ float sconv(const bf16* prow, int colbase, int t, int LL, bool grid, float w0, float w1, float w2, float bias) {
    const bool hasl = grid ? ((t & 63) != 0) : (t > 0), hasr = grid ? ((t & 63) != 63) : (t < LL - 1);
    const float c = bf2f(prow[colbase + t]), a = hasl ? bf2f(prow[colbase + t - 1]) : 0.f, b = hasr ? bf2f(prow[colbase + t + 1]) : 0.f;
    return a * w0 + c * w1 + b * w2 + bias;
}
template <int LL, int NT, int NBT>
__device__ __forceinline__ void hyena_unit(Frame& F, int l, int o, int c, int b0, bool latent) {
    constexpr int TPB = LL / NT, BG = NTHR / TPB, NBU = BG * NBT;
    LAS float* kk = (LAS float*)F.lds;
    LAS float* us = kk + 2 * LL;
    const int tid = F.tid;
    const bf16* PT = WSP(bf16, WS_PT);
    const float* cw = F.in[11] + (size_t)l * 3 * 1152; const float* cb = F.in[12] + (size_t)l * 1152;
    const int in_row = R_HY + c;
    const int mul_row = R_HY + 384 * (o + 1) + c, mul_ch = 384 * (o + 1) + c;
    const int out_row = o == 0 ? R_HY + c : R_HY + 384 + c;
    const float* KT = latent ? WSP(float, WS_KT) + ((size_t)(l * 2 + o) * 384 + c) * 8192 : WSP(float, WS_KTC) + ((size_t)(l * 2 + o) * 384 + c) * 512;
    for (int i = tid; i < 2 * LL; i += NTHR) kk[i] = KT[i];
    { const float w0 = cw[c], w1 = cw[1152 + c], w2 = cw[2304 + c], bs = cb[c];
      for (int i = tid; i < NBU * LL; i += NTHR) { const int bb = i / LL, t = i % LL; const int colbase = latent ? (b0 + bb) * L : NL + (b0 + bb) * LC;
          us[i] = o == 0 ? sconv(PT + (size_t)in_row * MT, colbase, t, LL, latent, w0, w1, w2, bs) : bf2f(PT[(size_t)in_row * MT + colbase + t]); } }
    __syncthreads();
    float acc[NBT][NT];
#pragma unroll
    for (int bj = 0; bj < NBT; ++bj)
#pragma unroll
        for (int tj = 0; tj < NT; ++tj) acc[bj][tj] = 0.f;
    const int tb = tid % TPB, bg = tid / TPB;
#pragma unroll 4
    for (int s = 0; s < LL; ++s) { float kv[NT], uv[NBT];
#pragma unroll
        for (int tj = 0; tj < NT; ++tj) kv[tj] = kk[LL + tb + TPB * tj - s];
#pragma unroll
        for (int bj = 0; bj < NBT; ++bj) uv[bj] = us[(bg + BG * bj) * LL + s];
#pragma unroll
        for (int bj = 0; bj < NBT; ++bj)
#pragma unroll
            for (int tj = 0; tj < NT; ++tj) acc[bj][tj] += kv[tj] * uv[bj]; }
    const float hb = F.in[20][((size_t)l * 2 + o) * 384 + c];
    const float m0 = cw[mul_ch], m1 = cw[1152 + mul_ch], m2 = cw[2304 + mul_ch], mb = cb[mul_ch];
    bf16* PTw = WSP(bf16, WS_PT);
#pragma unroll
    for (int bj = 0; bj < NBT; ++bj)
#pragma unroll
        for (int tj = 0; tj < NT; ++tj) { const int bb = bg + BG * bj, t = tb + TPB * tj; const int colbase = latent ? (b0 + bb) * L : NL + (b0 + bb) * LC;
            const float uval = us[bb * LL + t]; const float xm = sconv(PT + (size_t)mul_row * MT, colbase, t, LL, latent, m0, m1, m2, mb);
            PTw[(size_t)out_row * MT + colbase + t] = (bf16)f2bf(xm * (acc[bj][tj] + hb * uval)); asm volatile("" ::: "memory"); }
    __syncthreads();
}
template <int LL, int NTW, bool GRID>
__device__ __forceinline__ void hyena_job(Frame& F, int l, int o, int c, int tbase) {
    constexpr int TR = NWAVES * NTW * 16, NENT = LL - 8 + TR, NSG = LL / 128;
    const int tid = F.tid, lane = F.lane, fr = lane & 15, fq = lane >> 4;
    const int mmin = -tbase - TR + 1;
    LAS unsigned char* VT = F.lds;
    PB(2);
    {   const float* KT = GRID ? WSP(float, WS_KT) + ((size_t)(l * 2 + o) * 384 + c) * 8192 : WSP(float, WS_KTC) + ((size_t)(l * 2 + o) * 384 + c) * 512;
        for (int e = tid; e < NENT; e += NTHR) { const int m = mmin + e; float v[8];
#pragma unroll
            for (int j = 0; j < 8; ++j) { const int tau = -(m + j); v[j] = (tau > -LL && tau < LL) ? KT[tau + LL] : 0.f; }
            *(LAS v4u*)(VT + (e ^ (((e >> 4) & 1) << 3)) * 16) = (v4u){pk2(v[0], v[1]), pk2(v[2], v[3]), pk2(v[4], v[5]), pk2(v[6], v[7])}; } }
    __syncthreads();
    PE(2); PB(3);
    const float* cw = F.in[11] + (size_t)l * 3 * 1152; const float* cb = F.in[12] + (size_t)l * 1152;
    const bf16* inrow = (o == 0 ? WSP(bf16, WS_VP) : WSP(bf16, WS_Z1)) + (size_t)c * MT;
    const bf16* mulrow = WSP(bf16, WS_PT) + (size_t)(R_HY + 384 * (o + 1) + c) * MT;
    bf16* outrow = o == 0 ? WSP(bf16, WS_Z1) + (size_t)c * MT : WSP(bf16, WS_PT) + (size_t)(R_HY + 384 + c) * MT;
    const int colb = GRID ? fr * L : NL + fr * LC;
    const int T0 = tbase + F.wave * NTW * 16;
    f32x4 acc[NTW];
#pragma unroll
    for (int i = 0; i < NTW; ++i) acc[i] = (f32x4){0.f, 0.f, 0.f, 0.f};
    const int E0 = 8 * fq - fr - T0 - mmin - 16 * (NTW - 1);
    const int lbA = ((E0 & ~15) | ((E0 & 15) ^ (((E0 >> 4) & 1) << 3))) * 16, lbB = lbA ^ 128;
    const bf16* bp = inrow + colb + 8 * fq;
    v4u ra[4], rb[4];
#pragma unroll
    for (int jj = 0; jj < 4; ++jj) { ra[jj] = *(const v4u*)(bp + jj * 32); rb[jj] = *(const v4u*)(bp + 128 + jj * 32); }
#define HY_GROUP(sg, R) do { bf16x8 Bf[4]; _Pragma("unroll") for (int jj = 0; jj < 4; ++jj) Bf[jj] = __builtin_bit_cast(bf16x8, R[jj]); \
        if ((sg) + 2 < NSG) { _Pragma("unroll") for (int jj = 0; jj < 4; ++jj) R[jj] = *(const v4u*)(bp + ((sg) + 2) * 128 + jj * 32); } \
        const LAS unsigned char* vtA = VT + lbA + (sg) * 2048; const LAS unsigned char* vtB = VT + lbB + (sg) * 2048; \
        bf16x8 Ar[NBUF]; \
        _Pragma("unroll") for (int q = 0; q < NBUF; ++q) Ar[q] = *(const LAS bf16x8*)((((NTW + 5 - q) & 1) ? vtB : vtA) + 256 * (NTW + 5 - q)); \
        _Pragma("unroll") for (int dd = 0; dd < ND; ++dd) { const int e = dd - 6; const bf16x8 A = Ar[dd % NBUF]; \
            _Pragma("unroll") for (int jj = 0; jj < 4; ++jj) { const int i = e + 2 * jj; if (i >= 0 && i < NTW) acc[i] = __builtin_amdgcn_mfma_f32_16x16x32_bf16(A, Bf[jj], acc[i], 0, 0, 0); } \
            if (dd + NBUF < ND) Ar[dd % NBUF] = *(const LAS bf16x8*)((((NTW + 5 - dd - NBUF) & 1) ? vtB : vtA) + 256 * (NTW + 5 - dd - NBUF)); \
            __builtin_amdgcn_sched_barrier(0); } } while (0)
    constexpr int ND = NTW + 6, NBUF = ND < 4 ? ND : 4;
#pragma unroll 1
    for (int sg = 0; sg < NSG; sg += 2) { HY_GROUP(sg, ra); HY_GROUP(sg + 1, rb); }
#undef HY_GROUP
    PE(3); PB(4);
    const float hb = F.in[20][((size_t)l * 2 + o) * 384 + c];
    const int mch = 384 * (o + 1) + c; const float m0 = cw[mch], m1 = cw[1152 + mch], m2 = cw[2304 + mch], mb = cb[mch];
    constexpr int EB = NTW;
#pragma unroll
    for (int i0 = 0; i0 < NTW; i0 += EB) {
        v2u xr[EB], ur[EB]; unsigned xl[EB], xh[EB];
#pragma unroll
        for (int q = 0; q < EB; ++q) { const int t = T0 + 16 * (i0 + q) + 4 * fq;
            const bool hl = GRID ? ((t & 63) != 0) : (t > 0), hr = GRID ? (((t + 3) & 63) != 63) : (t + 4 < LL);
            const bf16* p = mulrow + colb + t; xr[q] = *(const v2u*)p; xl[q] = hl ? (unsigned)p[-1] : 0u; xh[q] = hr ? (unsigned)p[4] : 0u;
            ur[q] = *(const v2u*)(inrow + colb + t); }
#pragma unroll
        for (int q = 0; q < EB; ++q) { const int i = i0 + q; const int t = T0 + 16 * i + 4 * fq;
            float x[6], u[4];
            x[0] = bf2f((unsigned short)xl[q]); x[5] = bf2f((unsigned short)xh[q]); x[1] = bf2f(xr[q].x & 0xffffu); x[2] = bf2f(xr[q].x >> 16); x[3] = bf2f(xr[q].y & 0xffffu); x[4] = bf2f(xr[q].y >> 16);
            u[0] = bf2f(ur[q].x & 0xffffu); u[1] = bf2f(ur[q].x >> 16); u[2] = bf2f(ur[q].y & 0xffffu); u[3] = bf2f(ur[q].y >> 16);
            float ov[4];
#pragma unroll
            for (int r = 0; r < 4; ++r) { const float xm = x[r] * m0 + x[r + 1] * m1 + x[r + 2] * m2 + mb; ov[r] = xm * (acc[i][r] + hb * u[r]); }
            *(v2u*)(outrow + colb + t) = (v2u){pk2(ov[0], ov[1]), pk2(ov[2], ov[3])}; }
    }
    __syncthreads();
    PE(4);
}
__device__ __forceinline__ void shortconv_v(Frame& F_, int l) { Frame F = relocal(F_);
    const float* cw = F.in[11] + (size_t)l * 3 * 1152; const float* cb = F.in[12] + (size_t)l * 1152;
    const int ncol8 = (l == 0 ? MT : NL) / 8; const long total = (long)384 * ncol8;
    const long stride = (long)F.G * NTHR;
    for (long it0 = (long)F.vcu * NTHR + F.tid; it0 < total; it0 += 2 * stride) {
        v4u raw[2]; unsigned lft[2], rgt[2]; int cc[2], colv[2]; bool ok[2];
#pragma unroll
        for (int q = 0; q < 2; ++q) { const long it = it0 + q * stride; ok[q] = it < total; cc[q] = 0; colv[q] = 0; raw[q] = (v4u){0u, 0u, 0u, 0u}; lft[q] = 0u; rgt[q] = 0u;
            if (ok[q]) { const int c = (int)(it / ncol8), col = (int)(it % ncol8) * 8; cc[q] = c; colv[q] = col;
                const bf16* p = WSP(bf16, WS_PT) + (size_t)(R_HY + c) * MT + col;
                bool hl, hr; if (col < NL) { hl = (col & 63) != 0; hr = ((col + 7) & 63) != 63; } else { const int t = (col - NL) & (LC - 1); hl = t != 0; hr = t + 8 < LC; }
                raw[q] = *(const v4u*)p; lft[q] = hl ? (unsigned)p[-1] : 0u; rgt[q] = hr ? (unsigned)p[8] : 0u; } }
#pragma unroll
        for (int q = 0; q < 2; ++q) if (ok[q]) { const int c = cc[q]; float qv[10]; qv[0] = bf2f((unsigned short)lft[q]); qv[9] = bf2f((unsigned short)rgt[q]);
            qv[1] = bf2f(raw[q].x & 0xffffu); qv[2] = bf2f(raw[q].x >> 16); qv[3] = bf2f(raw[q].y & 0xffffu); qv[4] = bf2f(raw[q].y >> 16); qv[5] = bf2f(raw[q].z & 0xffffu); qv[6] = bf2f(raw[q].z >> 16); qv[7] = bf2f(raw[q].w & 0xffffu); qv[8] = bf2f(raw[q].w >> 16);
            const float w0 = cw[c], w1 = cw[1152 + c], w2 = cw[2304 + c], bs = cb[c]; float r[8];
#pragma unroll
            for (int j = 0; j < 8; ++j) r[j] = qv[j] * w0 + qv[j + 1] * w1 + qv[j + 2] * w2 + bs;
            *(v4u*)(WSP(bf16, WS_VP) + (size_t)c * MT + colv[q]) = (v4u){pk2(r[0], r[1]), pk2(r[2], r[3]), pk2(r[4], r[5]), pk2(r[6], r[7])}; } }
}
__device__ __forceinline__ void hyena_stage(Frame& F_, int l, int o) { Frame F = relocal(F_);
    const int nlat = 384 * 2, nctx = l == 0 ? 384 : 0;
    for (int u = F.vcu; u < nlat + nctx; u += F.G) {
        if (u < nlat) hyena_job<L, 16, true>(F, l, o, u >> 1, (u & 1) * 2048);
        else hyena_job<LC, 2, false>(F, l, o, u - nlat, 0);
    }
}
__device__ __forceinline__ void hyena_transpose(Frame& F_, int nrows) { Frame F = relocal(F_);
    LAS bf16* T = (LAS bf16*)F.lds; constexpr int PITCH = 258;
    const bf16* PT = WSP(bf16, WS_PT); bf16* Y = WSP(bf16, WS_HMOD); const int tid = F.tid;
    const int nrt = nrows / 256;
    for (int it = F.vcu; it < 6 * nrt; it += F.G) { const int cb = it % 6, rt = it / 6;
        { const int c = tid >> 3, seg = tid & 7; const bf16* src = PT + (size_t)(R_HY + 384 + cb * 64 + c) * MT + rt * 256 + seg * 32;
#pragma unroll
          for (int q = 0; q < 4; ++q) { const v4u v = *(const v4u*)(src + q * 8); LAS unsigned* d = (LAS unsigned*)(T + c * PITCH + seg * 32 + q * 8); d[0] = v.x; d[1] = v.y; d[2] = v.z; d[3] = v.w; } }
        __syncthreads();
        { const int r = tid >> 1, half = tid & 1; unsigned w[16];
#pragma unroll
          for (int q = 0; q < 16; ++q) { const unsigned lo = T[(half * 32 + 2 * q) * PITCH + r], hi = T[(half * 32 + 2 * q + 1) * PITCH + r]; w[q] = lo | (hi << 16); }
          bf16* dst = Y + (size_t)(rt * 256 + r) * D + 256 + cb * 64 + half * 32;
#pragma unroll
          for (int q = 0; q < 4; ++q) *(v4u*)(dst + q * 8) = (v4u){w[4 * q], w[4 * q + 1], w[4 * q + 2], w[4 * q + 3]}; }
        __syncthreads();
    }
}

__device__ __forceinline__ void s5_carry_item(Frame& F, int l, int item) {
    const float* E = (const float*)((unsigned char*)F.out + DO_E); bf16* HS = (bf16*)((unsigned char*)F.out + DO_HS);
    const int id = item * NTHR + F.tid;
    const int p = id & 63, dir = (id >> 6) & 1, g = (id >> 7) % 24, b = id / (128 * 24);
    const size_t ix = (((size_t)l * 2 + dir) * 24 + g) * 64 + p; const float ar = WSP(float, WS_A16)[ix * 2], ai = WSP(float, WS_A16)[ix * 2 + 1];
    const int comp = dir * 128 + 2 * p, q = comp >> 4, i0 = comp & 15;
    float sr = 0.f, si = 0.f;
#pragma unroll 1
    for (int s0 = 0; s0 < 272; s0 += 8) { f32x2 e[8]; int ci[8];
#pragma unroll
        for (int j = 0; j < 8; ++j) { const int step = s0 + j; int cidx;
            if (dir == 0) cidx = step < 16 ? NL / 16 + b * 16 + step : b * 256 + (step - 16);
            else cidx = step < 16 ? NL / 16 + b * 16 + (15 - step) : b * 256 + (255 - (step - 16));
            ci[j] = cidx; e[j] = *(const f32x2*)(E + ((size_t)g * NCHUNK + cidx) * 256 + comp); }
#pragma unroll
        for (int j = 0; j < 8; ++j) { *(unsigned*)(HS + (size_t)(g * 16 + q) * MT + (size_t)ci[j] * 16 + i0) = pk2(sr, si);
            const float nr = ar * sr - ai * si + e[j].x, ni = ar * si + ai * sr + e[j].y; sr = nr; si = ni; } }
}
__device__ __forceinline__ void hyena_stage2_carry(Frame& F_, int l) { Frame F = relocal(F_);
    const int ncar = 96, nlat = 384 * 2, nctx = l == 0 ? 384 : 0, qid = 1 + l;
    for (int u = wq_next(F, qid); u < ncar + nlat + nctx; u = wq_next(F, qid)) {
        if (u < ncar) s5_carry_item(F, l, u);
        else if (u < ncar + nlat) hyena_job<L, 16, true>(F, l, 1, (u - ncar) >> 1, ((u - ncar) & 1) * 2048);
        else hyena_job<LC, 2, false>(F, l, 1, u - ncar - nlat, 0);
    }
}

struct A_WinT { const bf16* w; __device__ __forceinline__ const bf16* operator()(int, int r, int k) const { return w + (size_t)r * D + k; } };
struct E_PT { bf16* pt; __device__ __forceinline__ void operator()(int, int r, int c, f32x4 v0, f32x4 v1) const {
    *(v2u*)(pt + (size_t)r * MT + c) = (v2u){pk2(v0.x, v0.y), pk2(v0.z, v0.w)}; *(v2u*)(pt + (size_t)r * MT + c + 16) = (v2u){pk2(v1.x, v1.y), pk2(v1.z, v1.w)}; } };
struct A_Dft { const bf16* d; int ld; __device__ __forceinline__ const bf16* operator()(int, int r, int k) const { return d + (size_t)r * ld + k; } };
struct B_FnetLat { const bf16* pt; __device__ __forceinline__ const bf16* operator()(int bt, int n, int k) const { return pt + (size_t)((k >> 12) * 256 + n) * MT + bt * L + (k & 4095); } };
struct B_FnetCtx { const bf16* pt; __device__ __forceinline__ const bf16* operator()(int bt, int n, int k) const { return pt + (size_t)((k >> 8) * 256 + n) * MT + NL + bt * LC + (k & 255); } };
struct E_FA { bf16* ab; __device__ __forceinline__ void one(int m, int c, f32x4 v) const { const int b = c >> 14, n = (c >> 6) & 255, s2 = c & 63, pp = m >> 6, t1 = m & 63;
    *(v2u*)(ab + ((((size_t)b * 256 + n) * 64 + t1) * 2 + pp) * 64 + s2) = (v2u){pk2(v.x, v.y), pk2(v.z, v.w)}; }
    __device__ __forceinline__ void operator()(int, int m, int c, f32x4 v0, f32x4 v1) const { if (m >= 128) return; one(m, c, v0); one(m, c + 16, v1); } };
struct E_FB { bf16* y; __device__ __forceinline__ void operator()(int bt, int r, int c, f32x4 v0, f32x4 v1) const { const int t = 4 * (r >> 8) + ((r >> 6) & 3) + 64 * (r & 63);
    bf16* p = y + ((size_t)bt * L + t) * D + c; *(v2u*)p = (v2u){pk2(v0.x, v0.y), pk2(v0.z, v0.w)}; *(v2u*)(p + 16) = (v2u){pk2(v1.x, v1.y), pk2(v1.z, v1.w)}; } };
struct E_Fnet { bf16* y; int rowbase, rows_per; __device__ __forceinline__ void operator()(int bt, int r, int c, f32x4 v0, f32x4 v1) const { bf16* p = y + (size_t)(rowbase + bt * rows_per + r) * D + c;
    *(v2u*)p = (v2u){pk2(v0.x, v0.y), pk2(v0.z, v0.w)}; *(v2u*)(p + 16) = (v2u){pk2(v1.x, v1.y), pk2(v1.z, v1.w)}; } };
struct A_S5 { const bf16* pt; const bf16* hs; __device__ __forceinline__ const bf16* operator()(int g, int r, int k) const {
    return k < 256 ? pt + (size_t)(R_S5 + g * 16 + (k >> 4)) * MT + (size_t)r * 16 + (k & 15) : hs + (size_t)(g * 16 + ((k - 256) >> 4)) * MT + (size_t)r * 16 + (k & 15); } };
struct B_S5 { const bf16* m; int off, ld; __device__ __forceinline__ const bf16* operator()(int g, int n, int k) const { return (const bf16*)((const unsigned char*)m + (size_t)g * S5M_STRIDE) + off + (size_t)n * ld + k; } };
struct E_S5E { float* e; __device__ __forceinline__ void operator()(int g, int r, int c, f32x4 v0, f32x4 v1) const { float* p = e + ((size_t)g * NCHUNK + r) * 256 + c; *(f32x4*)p = v0; *(f32x4*)(p + 16) = v1; } };
struct E_S5O { bf16* ys; __device__ __forceinline__ void operator()(int g, int r, int c, f32x4 v0, f32x4 v1) const {
    { const int j = c >> 4, h = c & 15; bf16* p = ys + ((size_t)r * 16 + j) * 384 + g * 16 + h; *(v2u*)p = (v2u){pk2(gelu_tanh_f(v0.x), gelu_tanh_f(v0.y)), pk2(gelu_tanh_f(v0.z), gelu_tanh_f(v0.w))}; }
    { const int c1 = c + 16, j = c1 >> 4, h = c1 & 15; bf16* p = ys + ((size_t)r * 16 + j) * 384 + g * 16 + h; *(v2u*)p = (v2u){pk2(gelu_tanh_f(v1.x), gelu_tanh_f(v1.y)), pk2(gelu_tanh_f(v1.z), gelu_tanh_f(v1.w))}; } } };
struct E_Glu { const bf16* ys; bf16* y; const float* gb;
    struct Pre { v2u y0, y1; f32x4 b0, b1; };
    __device__ __forceinline__ Pre pre(int, int r, int c) const { Pre p; p.y0 = (v2u){0u, 0u}; p.y1 = p.y0; p.b0 = (f32x4){0.f, 0.f, 0.f, 0.f}; p.b1 = p.b0;
        if (c < 384) { p.y0 = *(const v2u*)(ys + (size_t)r * 384 + c); p.b0 = *(const f32x4*)(gb + c); } if (c + 16 < 384) { p.y1 = *(const v2u*)(ys + (size_t)r * 384 + c + 16); p.b1 = *(const f32x4*)(gb + c + 16); } return p; }
    __device__ __forceinline__ void one(int r, int c, v2u yv, f32x4 b, f32x4 v) const { if (c >= 384) return;
        const float y0 = bf2f(yv.x & 0xffffu), y1 = bf2f(yv.x >> 16), y2 = bf2f(yv.y & 0xffffu), y3 = bf2f(yv.y >> 16);
        *(v2u*)(y + (size_t)r * D + 640 + c) = (v2u){pk2(y0 * sigmoid_f(v.x + b.x), y1 * sigmoid_f(v.y + b.y)), pk2(y2 * sigmoid_f(v.z + b.z), y3 * sigmoid_f(v.w + b.w))}; }
    __device__ __forceinline__ void post(const Pre& p, int, int r, int c, f32x4 v0, f32x4 v1) const { one(r, c, p.y0, p.b0, v0); one(r, c + 16, p.y1, p.b1, v1); } };
template <bool XI16, bool XO16> struct E_Res {
    static constexpr bool RMW = true; const void* xlat; const void* xctx; void* xo; const float* mod; int goff;
    struct Pre { f32x4 x0, x1, g0, g1; };
    __device__ __forceinline__ static f32x4 ld4(const void* base, size_t idx) { if (XI16) { const v2u u = *(const v2u*)((const bf16*)base + idx); return (f32x4){bf2f(u.x & 0xffffu), bf2f(u.x >> 16), bf2f(u.y & 0xffffu), bf2f(u.y >> 16)}; } else return *(const f32x4*)((const float*)base + idx); }
    __device__ __forceinline__ Pre pre(int, int r, int c) const { Pre p; const float* g = mod + (size_t)bidx_of(r) * 6144 + goff + c;
        const void* xb = r < NL ? xlat : xctx; const size_t idx = (size_t)(r < NL ? r : r - NL) * D + c;
        p.x0 = ld4(xb, idx); p.x1 = ld4(xb, idx + 16); p.g0 = *(const f32x4*)g; p.g1 = *(const f32x4*)(g + 16); return p; }
    __device__ __forceinline__ void post(const Pre& p, int, int r, int c, f32x4 v0, f32x4 v1) const { const f32x4 o0 = p.x0 + p.g0 * v0, o1 = p.x1 + p.g1 * v1; const size_t idx = (size_t)r * D + c;
        if (XO16) { *(v2u*)((bf16*)xo + idx) = (v2u){pk2(o0.x, o0.y), pk2(o0.z, o0.w)}; *(v2u*)((bf16*)xo + idx + 16) = (v2u){pk2(o1.x, o1.y), pk2(o1.z, o1.w)}; }
        else { *(f32x4*)((float*)xo + idx) = o0; *(f32x4*)((float*)xo + idx + 16) = o1; } } };
struct E_Swi { bf16* act; int ld; __device__ __forceinline__ void operator()(int, int r, int c, f32x4 v0, f32x4 v1) const {
    const int f = 16 * (c >> 5) + (c & 15); *(v2u*)(act + tiled_idx(r, f, ld / 64)) = (v2u){pk2(silu_f(v0.x) * v1.x, silu_f(v0.y) * v1.y), pk2(silu_f(v0.z) * v1.z, silu_f(v0.w) * v1.w)}; } };
struct A_MoeUp { const bf16* h; const int* idx; __device__ __forceinline__ const bf16* operator()(int, int r, int k) const { int t = idx[r]; t = t < 0 ? 0 : t; return h + (size_t)t * D + k; } };
struct E_MoeDown0 { bf16* o1; const int* idx; const unsigned char* topk; const float* mod;
    __device__ __forceinline__ void operator()(int, int r, int c, f32x4 v0, f32x4 v1) const { const int t = idx[r]; if (t < 0) return; const float w = *(const float*)(topk + (size_t)t * 16 + 4);
        const float* g = mod + (size_t)(t >> 12) * 6144 + 5120 + c; const f32x4 a = *(const f32x4*)g * (v0 * w), b = *(const f32x4*)(g + 16) * (v1 * w);
        bf16* o = o1 + (size_t)t * D + c; *(v2u*)o = (v2u){pk2(a.x, a.y), pk2(a.z, a.w)}; *(v2u*)(o + 16) = (v2u){pk2(b.x, b.y), pk2(b.z, b.w)}; } };
struct E_MoeDown { static constexpr bool RMW = true; float* x; const bf16* o1; const int* idx; const unsigned char* topk; const float* mod; int k;
    struct Pre { f32x4 x0, x1, g0, g1; v2u p0, p1; int t; float w; };
    __device__ __forceinline__ Pre pre(int, int r, int c) const { Pre p; p.t = idx[r]; const int tt = p.t < 0 ? 0 : p.t; p.w = *(const float*)(topk + (size_t)tt * 16 + 4 + 4 * k);
        const float* g = mod + (size_t)(tt >> 12) * 6144 + 5120 + c; const float* xi = x + (size_t)tt * D + c; const bf16* oi = o1 + (size_t)tt * D + c;
        p.x0 = *(const f32x4*)xi; p.x1 = *(const f32x4*)(xi + 16); p.g0 = *(const f32x4*)g; p.g1 = *(const f32x4*)(g + 16); p.p0 = *(const v2u*)oi; p.p1 = *(const v2u*)(oi + 16); return p; }
    __device__ __forceinline__ void post(const Pre& p, int, int r, int c, f32x4 v0, f32x4 v1) const { if (p.t < 0) return; float* o = x + (size_t)p.t * D + c;
        const f32x4 q0 = (f32x4){bf2f(p.p0.x & 0xffffu), bf2f(p.p0.x >> 16), bf2f(p.p0.y & 0xffffu), bf2f(p.p0.y >> 16)}, q1 = (f32x4){bf2f(p.p1.x & 0xffffu), bf2f(p.p1.x >> 16), bf2f(p.p1.y & 0xffffu), bf2f(p.p1.y >> 16)};
        *(f32x4*)o = p.x0 + q0 + p.g0 * (v0 * p.w); *(f32x4*)(o + 16) = p.x1 + q1 + p.g1 * (v1 * p.w); } };

template <class AF, class EP>
__device__ __forceinline__ void gemm_moe(int mtiles, int ntiles, int K, const AF& af, const unsigned char* wbase, size_t woff, int ldb, const int* te, const EP& ep, int vcu, int G) {
    int tid = threadIdx.x; asm volatile("" : "+v"(tid)); asm volatile("" : "+s"(vcu)); const int wid = tid >> 6, lane = tid & 63, wr = wid >> 2, wc = wid & 3, fr = lane & 15, fq = lane >> 4;
    const int nunits = mtiles * ntiles;
    for (int u = vcu; u < nunits; u += G) {
        const int pm = u / ntiles, pn = u - pm * ntiles;
        const int row0 = pm * 128 + wr * 64, col0 = pn * 128 + wc * 32;
        const bf16* B = (const bf16*)(wbase + (size_t)te[pm >> 1] * MOE_E_STRIDE + woff);
        f32x4 acc[4][2];
#pragma unroll
        for (int m = 0; m < 4; ++m) { acc[m][0] = (f32x4){0.f, 0.f, 0.f, 0.f}; acc[m][1] = (f32x4){0.f, 0.f, 0.f, 0.f}; }
#pragma unroll 2
        for (int k = 0; k < K; k += 32) {
            bf16x8 a[4], b[2];
#pragma unroll
            for (int m = 0; m < 4; ++m) a[m] = *(const bf16x8*)af(0, row0 + m * 16 + fr, k + fq * 8);
#pragma unroll
            for (int n = 0; n < 2; ++n) b[n] = *(const bf16x8*)(B + (size_t)(col0 + n * 16 + fr) * ldb + k + fq * 8);
#pragma unroll
            for (int m = 0; m < 4; ++m)
#pragma unroll
                for (int n = 0; n < 2; ++n) acc[m][n] = __builtin_amdgcn_mfma_f32_16x16x32_bf16(b[n], a[m], acc[m][n], 0, 0, 0);
        }
#pragma unroll
        for (int m = 0; m < 4; ++m) ep(0, row0 + m * 16 + fr, col0 + 4 * fq, acc[m][0], acc[m][1]);
    }
}

__device__ __forceinline__ Frame mkframe(const Args& args, unsigned char* ldsp, int wv) {
    Frame F; F.lds = (LAS unsigned char*)ldsp;
    const int t = tid_of(wv); F.tid = t; F.lane = t & 63; F.wave = wv;
    int g = gridDim.x, bx = blockIdx.x; asm volatile("" : "+s"(g), "+s"(bx)); F.G = g; F.vcu = (g % 8 == 0) ? (bx % 8) * (g / 8) + bx / 8 : bx;
    __attribute__((address_space(1))) unsigned char* w = (__attribute__((address_space(1))) unsigned char*)args.ws; __attribute__((address_space(1))) float* o = (__attribute__((address_space(1))) float*)args.out;
    asm volatile("" : "+s"(w), "+s"(o));
    F.ws = (unsigned char*)w; F.out = (float*)o; F.in = args.in;
    return F;
}
__global__ void __launch_bounds__(NTHR, 2) mega(Args args) {
    extern __shared__ __attribute__((aligned(16))) unsigned char lds[];
    volatile LAS unsigned* MISC = (volatile LAS unsigned*)((LAS unsigned char*)lds + LDS_MISC);
    const int wv = __builtin_amdgcn_readfirstlane((int)threadIdx.x >> 6);
    if (threadIdx.x < 32) MISC[threadIdx.x] = 0u;
    __syncthreads();
    XcdBarrier bar; bar.bar = (unsigned*)(args.ws + WS_CTL) + 4096; bar.x = 0; bar.st = nullptr; bar.wv = wv;
    const int lo = args.ph_lo, hi = args.ph_hi;
    if (hi - lo > 1) bar = xcd_barrier_post((unsigned*)(args.ws + WS_CTL) + 4096, MISC + 8, wv);
#define IN(k) (lo <= (k) && (k) < hi)
#define SEAM(k) do { if (IN(k) && IN((k) + 1)) xcd_barrier(bar); } while (0)
#if PROBE_SEL >= 100
#define PBG(k) do { if (PROBE_SEL == 100 + (k)) prb_b((LAS unsigned char*)lds, tid_of(wv)); } while (0)
#define PEG(k) do { if (PROBE_SEL == 100 + (k)) prb_e((LAS unsigned char*)lds, tid_of(wv)); } while (0)
#else
#define PBG(k) do { } while (0)
#define PEG(k) do { } while (0)
#endif
#define PHF Frame F = mkframe(args, lds, wv); const int bxi = (int)blockIdx.x; (void)bxi
#define P_MOD (WSP(float, WS_MOD) + (size_t)l * 17 * 6144)
#define P_HM WSP(bf16, WS_HMOD)
#define P_PT WSP(bf16, WS_PT)
#define P_XB WSP(bf16, WS_BUFA)
#define P_E ((float*)((unsigned char*)F.out + DO_E))
#define P_HS ((bf16*)((unsigned char*)F.out + DO_HS))
#define P_YS ((bf16*)((unsigned char*)F.out + DO_YS))

    PBG(PH_P0); if (IN(PH_P0)) { PHF; p0_prologue(F); } SEAM(PH_P0); PEG(PH_P0);
    PBG(PH_P1); if (IN(PH_P1)) { PHF; for (int it = F.vcu; it < 2 * 2 * 24 * 4; it += F.G) p1_item(F, it); } SEAM(PH_P1); PEG(PH_P1);

#pragma unroll 1
    for (int l = 0; l < 2; ++l) {
        const int pb = PH_L + l * PH_PER;
        PBG(pb + S_NORM1); if (IN(pb + S_NORM1)) { PHF;
            if (l == 0) norm_rows(F, F.in[0], F.in[2], MT, F.in[6], P_MOD, 0, 1024, P_HM); else norm_rows_b16(F, P_XB, MT, F.in[6] + D, P_MOD, 0, 1024, P_HM); }
        SEAM(pb + S_NORM1); PEG(pb + S_NORM1);
        PBG(pb + S_G1); if (IN(pb + S_G1)) { PHF; const char* wt = (const char*)(WSP(bf16, WS_WIN) + (size_t)l * PTROWS * D);
            {
                g8::OpRow<true> oa{wt, D * 2, 0}; g8::OpPermB ob{(const char*)P_HM}; g8::Order S; S.init(1, 2, NL / 256, F.G, bxi); E_PT ep{P_PT};
                g8::gemm8(F.lds, F.wave, D / 64, oa, ob, S, ep); }
            int rot = 0;
            if (l == 0) {
                g8::OpRow<true> oa{wt, D * 2, 0}; g8::OpRow<false> ob{(const char*)(P_HM + (size_t)NL * D), D * 2, 0}; g8::Order S; S.init(1, 2, NCX / 256, F.G, bxi); E_PT ep{P_PT + NL};
                g8::gemm8(F.lds, F.wave, D / 64, oa, ob, S, ep); rot = 32; }
            {
                g8::OpRow<true> oa{wt + (size_t)512 * D * 2, D * 2, 0}; g8::OpRow<false> ob{(const char*)P_HM, D * 2, 0}; g8::Order S; S.init(1, 6, MT / 256, F.G, bxi, rot); E_PT ep{P_PT + (size_t)512 * MT};
                g8::gemm8(F.lds, F.wave, D / 64, oa, ob, S, ep); } }
        SEAM(pb + S_G1); PEG(pb + S_G1);
        PBG(pb + S_FNET); if (IN(pb + S_FNET)) { PHF; shortconv_v(F, l);
            {
                g8::OpRow<true> oa{(const char*)WSP(bf16, WS_FAW), 128 * 2, 0}; g8::OpFA ob{(const char*)P_PT}; g8::Order S; S.init(1, 1, 1024, F.G, bxi); E_FA ep{WSP(bf16, WS_ABUF)};
                g8::gemm8(F.lds, F.wave, 2, oa, ob, S, ep); }
            if (l == 0) { g8::OpRow<true> oa{(const char*)WSP(bf16, WS_DFTC), 2 * LC * 2, 0}; g8::OpFnetB ob{(const char*)(P_PT + NL), LC * 2, 2}; g8::Order S; S.init(NB, 1, 1, F.G, bxi);
              E_Fnet ep{P_HM, NL, LC}; g8::gemm8(F.lds, F.wave, 2 * LC / 64, oa, ob, S, ep); }
            {
                E_S5E ep{P_E}; g8::OpS5A oa{(const char*)(P_PT + (size_t)R_S5 * MT), (const char*)P_HS - (const char*)(P_PT + (size_t)R_S5 * MT)}; g8::OpRow<false> ob{(const char*)(F.ws + WS_S5M + (size_t)l * 24 * S5M_STRIDE), 256 * 2, (long)S5M_STRIDE};
                g8::Order S; S.init(24, NCHUNK / 256, 1, F.G, bxi, l == 0 ? 16 : 0); g8::gemm8(F.lds, F.wave, 4, oa, ob, S, ep); } }
        SEAM(pb + S_FNET); PEG(pb + S_FNET);
        { PHF; PB(1); } PBG(pb + S_HY1); if (IN(pb + S_HY1)) { PHF;
            {
                g8::OpRow<true> oa{(const char*)WSP(bf16, WS_FBW), 512 * 2, 0}; g8::OpFB ob{(const char*)WSP(bf16, WS_ABUF)}; g8::Order S; S.init(NB, 16, 1, F.G, bxi); E_FB ep{P_HM};
                g8::gemm8(F.lds, F.wave, 8, oa, ob, S, ep); }
            hyena_stage(F, l, 0); }
        SEAM(pb + S_HY1); PEG(pb + S_HY1); { PHF; PE(1); }
        { PHF; PB(1); } PBG(pb + S_HY2); if (IN(pb + S_HY2)) { PHF; hyena_stage2_carry(F, l); }
        SEAM(pb + S_HY2); PEG(pb + S_HY2); { PHF; PE(1); }
        PBG(pb + S_S5O); if (IN(pb + S_S5O)) { PHF; E_S5O ep{P_YS};
            g8::OpS5A oa{(const char*)(P_PT + (size_t)R_S5 * MT), (const char*)P_HS - (const char*)(P_PT + (size_t)R_S5 * MT)}; g8::OpRow<false> ob{(const char*)(F.ws + WS_S5M + (size_t)l * 24 * S5M_STRIDE) + 256 * 256 * 2, 512 * 2, (long)S5M_STRIDE};
            g8::Order S; S.init(24, NCHUNK / 256, 1, F.G, bxi); g8::gemm8(F.lds, F.wave, 8, oa, ob, S, ep); }
        SEAM(pb + S_S5O); PEG(pb + S_S5O);
        PBG(pb + S_GLU); if (IN(pb + S_GLU)) { PHF; E_Glu ep{P_YS, P_HM, F.in[30] + l * 384};
            g8::OpRow<true> oa{(const char*)P_YS, 384 * 2, 0}; g8::OpRow<false> ob{(const char*)(WSP(bf16, WS_GLU) + (size_t)l * 512 * 384), 384 * 2, 0}; g8::Order S; S.init(1, MT / 256, 2, F.G, bxi);
            g8::gemm8(F.lds, F.wave, 6, oa, ob, S, ep);
            hyena_transpose(F, l == 0 ? MT : NL); }
        SEAM(pb + S_GLU); PEG(pb + S_GLU);
        PBG(pb + S_WOUT); if (IN(pb + S_WOUT)) { PHF;
            g8::OpRow<true> oa{(const char*)P_HM, D * 2, 0}; g8::OpRow<false> ob{(const char*)(WSP(bf16, WS_WOUT) + (size_t)l * D * D), D * 2, 0}; g8::Order S; S.init(1, (l == 0 ? MT : NL) / 256, D / 256, F.G, bxi);
            if (l == 0) { E_Res<false, true> ep{F.in[0], F.in[2], P_XB, P_MOD, 2048}; g8::gemm8(F.lds, F.wave, D / 64, oa, ob, S, ep, STAG(1000)); }
            else { E_Res<true, false> ep{P_XB, P_XB + (size_t)NL * D, F.out, P_MOD, 2048}; g8::gemm8(F.lds, F.wave, D / 64, oa, ob, S, ep, STAG(1000)); } }
        SEAM(pb + S_WOUT); PEG(pb + S_WOUT);
        if (l == 0) {
            PBG(pb + S_NORM2); if (IN(pb + S_NORM2)) { PHF; norm_rows_b16(F, P_XB, MT, F.in[7], P_MOD, 3072, 4096, P_HM); }
            SEAM(pb + S_NORM2); PEG(pb + S_NORM2);
            PBG(pb + S_F0); if (IN(pb + S_F0)) { PHF; E_Swi ep{WSP(bf16, WS_ACT), DFF};
                g8::OpRow<true> oa{(const char*)P_HM, D * 2, 0}; g8::OpRow<false> ob{(const char*)WSP(bf16, WS_FGU), D * 2, 0}; g8::Order S; S.init(1, MT / 256, 2 * DFF / 256, F.G, bxi);
                g8::gemm8<UP_ALIGN>(F.lds, F.wave, D / 64, oa, ob, S, ep, STAG(750)); }
            SEAM(pb + S_F0); PEG(pb + S_F0);
            PBG(pb + S_F1); if (IN(pb + S_F1)) { PHF; E_Res<true, true> ep{P_XB, P_XB + (size_t)NL * D, P_XB, P_MOD, 5120};
                g8::OpTiled<true> oa{(const char*)WSP(bf16, WS_ACT), DFF / 64}; g8::OpTiled<false> ob{(const char*)WSP(bf16, WS_FD), DFF / 64}; g8::Order S; S.init(1, MT / 256, D / 256, F.G, bxi);
                g8::gemm8(F.lds, F.wave, DFF / 64, oa, ob, S, ep, STAG(2200)); }
            SEAM(pb + S_F1); PEG(pb + S_F1);
        } else {
            PBG(pb + S_NORM2); if (IN(pb + S_NORM2)) { PHF; norm2_router(F, F.out, F.in[7] + D, P_MOD, P_HM); moe_transposes(F); }
            SEAM(pb + S_NORM2); PEG(pb + S_NORM2);
            PBG(pb + S_F0); if (IN(pb + S_F0)) { PHF; moe_slots(F); }
            SEAM(pb + S_F0); PEG(pb + S_F0);
#pragma unroll 1
            for (int k = 0; k < 2; ++k) {
                PBG(pb + S_F1 + 2 * k); if (IN(pb + S_F1 + 2 * k)) { PHF; const int* IDX = (const int*)(F.ws + WS_META + META_IDX) + k * MAXSLOT; const int* TE = (const int*)(F.ws + WS_META + META_TE) + k * 272; const int nt = __builtin_amdgcn_readfirstlane(((const int*)(F.ws + WS_META + META_NT))[k]);
                    E_Swi ep{WSP(bf16, WS_ACT2), DFE};
                    LAS int* tel = (LAS int*)(F.lds + LDS_MISC + 1024); if (F.tid < 272) tel[F.tid] = TE[F.tid]; __syncthreads();
                    g8::OpMoeA oa{(const char*)P_HM, IDX}; g8::OpMoeB ob{(const char*)(F.ws + WS_MOEW), tel, D * 2}; g8::Order S; S.init(1, nt, 2 * DFE / 256, F.G, bxi);
                    g8::gemm8<UP_ALIGN>(F.lds, F.wave, D / 64, oa, ob, S, ep, STAG(750)); }
                SEAM(pb + S_F1 + 2 * k); PEG(pb + S_F1 + 2 * k);
                PBG(pb + S_F2 + 2 * k); if (IN(pb + S_F2 + 2 * k)) { PHF; const int* IDX = (const int*)(F.ws + WS_META + META_IDX) + k * MAXSLOT; const int* TE = (const int*)(F.ws + WS_META + META_TE) + k * 272; const int nt = __builtin_amdgcn_readfirstlane(((const int*)(F.ws + WS_META + META_NT))[k]);
                    LAS int* tel = (LAS int*)(F.lds + LDS_MISC + 1024); if (F.tid < 272) tel[F.tid] = TE[F.tid]; __syncthreads();
                    g8::OpTiled<true> oa{(const char*)WSP(bf16, WS_ACT2), DFE / 64}; g8::OpMoeBT ob{(const char*)(F.ws + WS_MOEW + MOE_GU_BYTES), tel, DFE / 64}; g8::Order S; S.init(1, k == 1 ? 256 : nt, D / 256, F.G, bxi);
                    if (k == 0) { E_MoeDown0 ep{WSP(bf16, WS_O1), IDX, F.ws + WS_TOPK, P_MOD}; g8::gemm8(F.lds, F.wave, DFE / 64, oa, ob, S, ep, STAG(2700)); }
                    else { E_MoeDown ep{F.out, WSP(bf16, WS_O1), IDX, F.ws + WS_TOPK, P_MOD, k}; g8::gemm8(F.lds, F.wave, DFE / 64, oa, ob, S, ep, STAG(2700)); } }
                SEAM(pb + S_F2 + 2 * k); PEG(pb + S_F2 + 2 * k);
            }
            PBG(pb + S_F5); if (IN(pb + S_F5)) { PHF; const int k = 1; const int* IDX = (const int*)(F.ws + WS_META + META_IDX) + k * MAXSLOT; const int* TE = (const int*)(F.ws + WS_META + META_TE) + k * 272; const int nt = __builtin_amdgcn_readfirstlane(((const int*)(F.ws + WS_META + META_NT))[k]);
                const int ntl = nt - 256, ntw = ntl * (D / 256);
                if (ntl > 0) { E_MoeDown ep{F.out, WSP(bf16, WS_O1), IDX, F.ws + WS_TOPK, P_MOD, k};
                    LAS int* tel = (LAS int*)(F.lds + LDS_MISC + 1024); if (F.tid < 272) tel[F.tid] = TE[F.tid]; __syncthreads();
                    g8::OpTiled<true> oa{(const char*)WSP(bf16, WS_ACT2), DFE / 64}; g8::OpMoeBT ob{(const char*)(F.ws + WS_MOEW + MOE_GU_BYTES), tel, DFE / 64}; g8::Order S; S.init(1, ntl, D / 256, F.G, bxi); S.pm_off = 256;
                    g8::gemm8(F.lds, F.wave, DFE / 64, oa, ob, S, ep); }
                final_norm_part(F, 0, ntw); }
            SEAM(pb + S_F5); PEG(pb + S_F5);
            PBG(pb + S_F6); if (IN(pb + S_F6)) { PHF; final_norm_part(F, 1, 0); } PEG(pb + S_F6);
        }
    }
#if PROBE_SEL >= 0
    if (blockIdx.x == PROBE_BLK && tid_of(wv) == 0) { const unsigned long long want = *(volatile LAS unsigned long long*)((LAS unsigned char*)lds + LDS_MISC + 72), t0 = __builtin_amdgcn_s_memrealtime();
        while (__builtin_amdgcn_s_memrealtime() - t0 < want) __builtin_amdgcn_s_sleep(8); }
#endif
#undef IN
#undef SEAM
}

extern "C" void kernel_launch(void* const* d_in, const int* in_sizes, int n_in, void* d_out, int out_size, void* d_ws, size_t ws_size, hipStream_t stream) {
    static int grid = 0;
    if (grid == 0) {
        if (n_in != 40 || out_size != NL * D || ws_size < WS_END) { fprintf(stderr, "kernel_launch: unexpected shapes n_in %d out %d ws %zu (need %zu)\n", n_in, out_size, ws_size, (size_t)WS_END); grid = -1; return; }
        int dev = 0, cus = 0, per_cu = 0;
        if (hipGetDevice(&dev) != hipSuccess || hipDeviceGetAttribute(&cus, hipDeviceAttributeMultiprocessorCount, dev) != hipSuccess) { grid = -1; return; }
        if (hipFuncSetAttribute((const void*)mega, hipFuncAttributeMaxDynamicSharedMemorySize, LDS_BYTES) != hipSuccess) { fprintf(stderr, "kernel_launch: hipFuncSetAttribute failed\n"); grid = -1; return; }
        if (hipOccupancyMaxActiveBlocksPerMultiprocessor(&per_cu, (const void*)mega, NTHR, LDS_BYTES) != hipSuccess || per_cu < 1) fprintf(stderr, "kernel_launch: occupancy query says %d\n", per_cu);
        (void)hipGetLastError();
        grid = cus;
    }
    if (grid < 0) return;
    (void)hipMemsetAsync((char*)d_ws + WS_CTL, 0, CTL_ZERO_BYTES, stream);
    Args a{};
    for (int i = 0; i < 40; ++i) a.in[i] = (const float*)d_in[i];
    a.out = (float*)d_out; a.ws = (unsigned char*)d_ws;
#if MK_ONE_LAUNCH
    a.ph_lo = 0; a.ph_hi = N_PHASES;
    hipLaunchKernelGGL(mega, dim3(grid), dim3(NTHR), LDS_BYTES, stream, a);
#else
    for (int ph = 0; ph < N_PHASES; ++ph) {
        const int s = ph - PH_L;
        if (ph >= PH_L && s < PH_PER && s > S_F1) continue;
        if (ph >= PH_L + PH_PER && (ph - PH_L - PH_PER) > S_F5) continue;
        a.ph_lo = ph; a.ph_hi = ph + 1;
        hipLaunchKernelGGL(mega, dim3(grid), dim3(NTHR), LDS_BYTES, stream, a);
    }
#endif
}
```

```cpp
#include <hip/hip_runtime.h>
#include <cstdio>
#include <cstdint>

#ifndef G8_ALL
#define G8_ALL 1
#endif
#define G8_G1 G8_ALL
#define G8_FNET G8_ALL
#define G8_S5 G8_ALL
#define G8_GLU G8_ALL
#define G8_WOUT G8_ALL
#define G8_FFN G8_ALL
#define G8_MOE G8_ALL
#ifndef UP_ALIGN
#define UP_ALIGN false
#endif
#ifndef WGM_UP
#define WGM_UP 4
#endif
#ifndef WGM_DOWN
#define WGM_DOWN 4
#endif
#ifndef WGM_G1
#define WGM_G1 8
#endif
#ifndef WGM_WOUT
#define WGM_WOUT 4
#endif
#ifndef STAG_ON
#define STAG_ON 0
#endif
#define STAG(x) (STAG_ON ? (x) : 0)
#ifndef MK_ONE_LAUNCH
#define MK_ONE_LAUNCH 1
#endif

#define LAS __attribute__((address_space(3)))
typedef unsigned short bf16;
typedef short bf16x8 __attribute__((ext_vector_type(8)));
typedef float f32x4 __attribute__((ext_vector_type(4)));
typedef float f32x2 __attribute__((ext_vector_type(2)));
typedef unsigned v4u __attribute__((ext_vector_type(4)));
typedef unsigned v2u __attribute__((ext_vector_type(2)));
struct __attribute__((packed, aligned(2))) U16B { unsigned x, y, z, w; };
struct __attribute__((packed, aligned(4))) U8B { unsigned x, y; };

constexpr int D = 1024, NB = 16, L = 4096, LC = 256, NL = NB * L, NCX = NB * LC, MT = NL + NCX;
constexpr int DIN = 1792, DFF = 2816, NE = 8, DFE = 3584;
constexpr int PTROWS = 2048, R_HY = 512, R_S5 = 1664;
constexpr int NCHUNK = MT / 16;
constexpr int NTHR = 512, NWAVES = 8;
constexpr int MAXSLOT = NL + NE * 256;

constexpr size_t MiB = 1u << 20;
constexpr size_t WS_CTL = 0, CTL_ZERO_BYTES = 64 * 1024;
constexpr size_t WS_MOD = 1 * MiB;
constexpr size_t WS_WIN = 2 * MiB;
constexpr size_t WS_WOUT = 10 * MiB;
constexpr size_t WS_GLU = 14 * MiB;
constexpr size_t WS_FGU = 15 * MiB;
constexpr size_t WS_FD = 26 * MiB;
constexpr size_t WS_FAW = 32 * MiB;
constexpr size_t WS_O1 = 38 * MiB;
constexpr size_t WS_FBW = 33 * MiB;
constexpr size_t WS_DFTC = 96 * MiB;
constexpr size_t WS_S5M = 97 * MiB;
constexpr size_t S5M_STRIDE = 256 * 256 * 2 + 256 * 512 * 2;
constexpr size_t WS_A16 = 115 * MiB;
constexpr size_t WS_KT = 116 * MiB;
constexpr size_t WS_KTC = 164 * MiB;
constexpr size_t WS_PS = 167 * MiB;
constexpr size_t WS_TOPK = 171 * MiB;
constexpr size_t WS_META = 172 * MiB;
constexpr size_t META_CNT = 0, META_IDX = 64 * 1024, META_TE = META_IDX + 2 * MAXSLOT * 4, META_NT = META_TE + 2 * 272 * 4, META_SL1 = 768 * 1024;
static_assert(META_NT + 8 <= META_SL1 && META_SL1 + (size_t)NL * 4 <= MiB, "meta");
constexpr size_t WS_HMOD = 173 * MiB;
constexpr size_t WS_BUFA = 309 * MiB;
constexpr size_t WS_R = 581 * MiB;
constexpr size_t WS_END = 1024 * MiB;
constexpr size_t WS_PT = WS_R;
constexpr size_t WS_HT = WS_R;
constexpr size_t WS_Z1 = WS_R + 272 * MiB;
constexpr size_t WS_ABUF = WS_R + 374 * MiB;
static_assert(WS_ABUF + (size_t)16 * 256 * 64 * 128 * 2 <= WS_END, "abuf");
constexpr size_t WS_VP = WS_R + 323 * MiB;
static_assert(WS_VP + (size_t)384 * MT * 2 <= WS_END, "vp");
constexpr size_t WS_ACT = WS_R;
constexpr size_t WS_MOEW = WS_BUFA;
constexpr size_t MOE_GU_BYTES = (size_t)2 * DFE * D * 2, MOE_D_BYTES = (size_t)D * DFE * 2, MOE_E_STRIDE = MOE_GU_BYTES + MOE_D_BYTES;
constexpr size_t WS_ACT2 = WS_BUFA + 168 * MiB;
static_assert(NE * MOE_E_STRIDE <= 168 * MiB, "moe weights");
static_assert(WS_ACT2 + (size_t)(MAXSLOT + 8 * 256) * DFE * 2 <= WS_END, "act2");
static_assert(WS_PT + (size_t)PTROWS * MT * 2 <= WS_END, "pt");
static_assert(WS_ACT + (size_t)MT * DFF * 2 <= WS_END, "act");
static_assert(WS_HMOD + (size_t)MT * D * 2 <= WS_BUFA && WS_BUFA + (size_t)MT * D * 4 <= WS_R, "bufs");
constexpr size_t DO_E = 0, DO_HS = 102 * MiB, DO_YS = 153 * MiB;
static_assert(DO_YS + (size_t)MT * 384 * 2 <= (size_t)NL * D * 4, "d_out scratch");

constexpr int LDS_BYTES = 147456;
constexpr int LDS_MISC = 131072 + 8192;

__device__ __forceinline__ unsigned f2bf(float f) { unsigned u = __builtin_bit_cast(unsigned, f); return (u + 0x7fffu + ((u >> 16) & 1u)) >> 16; }
__device__ __forceinline__ unsigned pk2(float lo, float hi) { unsigned r; asm("v_cvt_pk_bf16_f32 %0, %1, %2" : "=v"(r) : "v"(lo), "v"(hi)); return r; }
__device__ __forceinline__ float bf2f(unsigned short b) { return __builtin_bit_cast(float, ((unsigned)b) << 16); }
__device__ __forceinline__ float wave_sum(float v, int lane) {
#pragma unroll
    for (int o = 1; o < 64; o <<= 1) v += __builtin_bit_cast(float, __builtin_amdgcn_ds_bpermute((lane ^ o) << 2, __builtin_bit_cast(int, v)));
    return v;
}
__device__ __forceinline__ float silu_f(float x) { return x * __builtin_amdgcn_rcpf(1.0f + __expf(-x)); }
__device__ __forceinline__ float sigmoid_f(float x) { return __builtin_amdgcn_rcpf(1.0f + __expf(-x)); }
__device__ __forceinline__ float gelu_tanh_f(float x) { const float u = 0.7978845608028654f * (x + 0.044715f * x * x * x); return x * __builtin_amdgcn_rcpf(1.0f + __expf(-2.0f * u)); }
__device__ __forceinline__ int bidx_of(int r) { return r < NL ? (r >> 12) : 16; }

__device__ __forceinline__ int lane_id() { return (int)__builtin_amdgcn_mbcnt_hi(~0u, __builtin_amdgcn_mbcnt_lo(~0u, 0u)); }
__device__ __forceinline__ int tid_of(int wv) { int t = (wv << 6) | lane_id(); asm volatile("" : "+v"(t)); return t; }
#define XB_TMO      128
#define XB_XCNT(j)  (256  + 64 * (j))
#define XB_XSUB(j)  (1280 + 64 * (j))
#define XB_XGEN(j)  (2304 + 64 * (j))
#define XB_TOP      3328
#define XB_TOPGEN   3392
#define XCD_BAR_WORDS 3456
#define XB_SPIN_CAP (1u << 22)
__device__ __forceinline__ unsigned xb_ld(unsigned* p)              { return __hip_atomic_load(p, __ATOMIC_RELAXED, __HIP_MEMORY_SCOPE_AGENT); }
__device__ __forceinline__ unsigned xb_add(unsigned* p, unsigned v) { return __hip_atomic_fetch_add(p, v, __ATOMIC_RELAXED, __HIP_MEMORY_SCOPE_AGENT); }
__device__ __forceinline__ unsigned xb_xcc_id() { return (unsigned)__builtin_amdgcn_s_getreg((3 << 11) | 20) & 0xFu; }
#define XB_SPIN(cond, bar) do { unsigned _sp = 0; while (cond) { __builtin_amdgcn_s_sleep(1); \
    if ((++_sp & 255u) == 0u) { if (xb_ld(&(bar)[XB_TMO])) break; if (_sp > XB_SPIN_CAP) { atomicAdd(&(bar)[XB_TMO], 1u); break; } } } } while (0)
struct XcdBarrier { unsigned* bar; unsigned x; volatile LAS unsigned* st; int wv; };
__device__ __forceinline__ XcdBarrier xcd_barrier_post(unsigned* bar, volatile LAS unsigned* st, int wv) {
    XcdBarrier b; b.bar = bar; b.x = xb_xcc_id(); b.st = st; b.wv = wv;
    if (wv == 0 && lane_id() == 0) (void)xb_add(&bar[XB_XCNT(b.x)], 1u);
    return b;
}
__device__ __forceinline__ void xcd_barrier_complete(unsigned* bar, unsigned x, unsigned& nloc, unsigned& nx) {
    const unsigned G = gridDim.x * gridDim.y * gridDim.z;
    unsigned sum, cnt, mine, sp = 0u;
    for (;;) {
        sum = 0u; cnt = 0u; mine = 0u;
#pragma unroll
        for (unsigned j = 0; j < 16; ++j) { const unsigned c = xb_ld(&bar[XB_XCNT(j)]); sum += c; cnt += (c > 0u) ? 1u : 0u; mine = (j == x) ? c : mine; }
        if (sum == G) break;
        __builtin_amdgcn_s_sleep(1);
        if ((++sp & 255u) == 0u) { if (xb_ld(&bar[XB_TMO])) break; if (sp > XB_SPIN_CAP) { atomicAdd(&bar[XB_TMO], 1u); break; } }
    }
    nloc = mine > 0u ? mine : 1u; nx = cnt > 0u ? cnt : 1u;
}
__device__ __noinline__ void xcd_barrier(const XcdBarrier b) {
    asm volatile("s_waitcnt vmcnt(0)" ::: "memory");
    __syncthreads();
    if (b.wv == 0 && lane_id() == 0) {
        unsigned* bar = b.bar;
        __builtin_amdgcn_s_waitcnt(0);
        unsigned nloc = b.st[0], nx = b.st[1];
        if (nloc == 0u) { xcd_barrier_complete(bar, b.x, nloc, nx); b.st[0] = nloc; b.st[1] = nx; }
        const unsigned old = xb_add(&bar[XB_XSUB(b.x)], 1u);
        const unsigned gen = old / nloc;
        if (old + 1u == (gen + 1u) * nloc) {
            __builtin_amdgcn_fence(__ATOMIC_RELEASE, "agent");
            asm volatile("s_waitcnt vmcnt(0)" ::: "memory");
            const unsigned og = xb_add(&bar[XB_TOP], 1u);
            const unsigned tg = og / nx;
            if (og + 1u == (tg + 1u) * nx) xb_add(&bar[XB_TOPGEN], 1u);
            else XB_SPIN(xb_ld(&bar[XB_TOPGEN]) == tg, bar);
            __builtin_amdgcn_fence(__ATOMIC_ACQUIRE, "agent");
            xb_add(&bar[XB_XGEN(b.x)], 1u);
            asm volatile("s_waitcnt vmcnt(0)" ::: "memory");
        } else {
            XB_SPIN(xb_ld(&bar[XB_XGEN(b.x)]) == gen, bar);
            __builtin_amdgcn_fence(__ATOMIC_ACQUIRE, "agent");
            asm volatile("s_waitcnt vmcnt(0)" ::: "memory");
        }
    }
    __syncthreads();
}

__device__ __forceinline__ size_t tiled_idx(int r, int k, int KT) { return ((size_t)(r >> 8) * KT + (k >> 6)) * 16384 + (size_t)(r & 255) * 64 + (k & 63); }
template <class AF, class BF, class EP>
__device__ __forceinline__ void gemm_simple(int nbatch, int mtiles, int ntiles, int K, const AF& af, const BF& bf, const EP& ep, int vcu, int G) {
    int tid = threadIdx.x; asm volatile("" : "+v"(tid)); asm volatile("" : "+s"(vcu)); const int wid = tid >> 6, lane = tid & 63, wr = wid >> 2, wc = wid & 3, fr = lane & 15, fq = lane >> 4;
    const int per = mtiles * ntiles, nunits = nbatch * per;
    for (int u = vcu; u < nunits; u += G) {
        const int bt = u / per, rem = u - bt * per, pm = rem / ntiles, pn = rem - pm * ntiles;
        const int row0 = pm * 128 + wr * 64, col0 = pn * 128 + wc * 32;
        f32x4 acc[4][2];
#pragma unroll
        for (int m = 0; m < 4; ++m) { acc[m][0] = (f32x4){0.f, 0.f, 0.f, 0.f}; acc[m][1] = (f32x4){0.f, 0.f, 0.f, 0.f}; }
#pragma unroll 2
        for (int k = 0; k < K; k += 32) {
            bf16x8 a[4], b[2];
#pragma unroll
            for (int m = 0; m < 4; ++m) a[m] = *(const bf16x8*)af(bt, row0 + m * 16 + fr, k + fq * 8);
#pragma unroll
            for (int n = 0; n < 2; ++n) b[n] = *(const bf16x8*)bf(bt, col0 + n * 16 + fr, k + fq * 8);
#pragma unroll
            for (int m = 0; m < 4; ++m)
#pragma unroll
                for (int n = 0; n < 2; ++n) acc[m][n] = __builtin_amdgcn_mfma_f32_16x16x32_bf16(b[n], a[m], acc[m][n], 0, 0, 0);
        }
#pragma unroll
        for (int m = 0; m < 4; ++m) ep(bt, row0 + m * 16 + fr, col0 + 4 * fq, acc[m][0], acc[m][1]);
    }
}
struct RowMajor { const bf16* p; long ld; __device__ __forceinline__ const bf16* operator()(int, int r, int k) const { return p + (long)r * ld + k; } };

namespace g8 {
constexpr int BM = 256, BK = 64, HALF = 128, HTB = HALF * BK * 2, NXCD = 8, WGM = 4;
__device__ __forceinline__ int lds_byte(int r, int c) { const int st = (r >> 4) * 2 + (c >> 5), rr = r & 15, cc = c & 31, ob = rr * 64 + cc * 2; return st * 1024 + (ob ^ (((ob >> 9) & 1) << 5)); }
__device__ __forceinline__ void stage_rc(int b, int& R, int& C) { const int st = b / 1024, sb = b % 1024, swz = sb ^ (((sb >> 9) & 1) << 5); R = (st >> 1) * 16 + swz / 64; C = (st & 1) * 32 + (swz % 64) / 2; }
struct Unit { int bt, pm, pn; };
struct Order {
    int nM, nN, per, nwg, G, c, pm_off, lx0, lx1, wgm;
    __device__ __forceinline__ void init(int nb, int nM_, int nN_, int G_, int c_, int rot = 0) { nM = nM_; nN = nN_; per = nM_ * nN_; nwg = nb * per; G = G_; c = c_ - rot; if (c < 0) c += G_; pm_off = 0; lx0 = 0; lx1 = nwg; wgm = WGM; }
    __device__ __forceinline__ bool next(int i, Unit& u) const {
        const long Lx = (long)lx0 + (long)i * G + c; if (Lx >= lx1) return false;
        int wgid = (int)Lx; { const int q = nwg / NXCD, r = nwg % NXCD, xcd = wgid % NXCD, off = wgid / NXCD; wgid = (xcd < r ? xcd * (q + 1) : r * (q + 1) + (xcd - r) * q) + off; }
        u.bt = wgid / per; const int rem = wgid - u.bt * per;
        const int nig = wgm * nN, gid = rem / nig, fm = gid * wgm, gsz = (nM - fm) < wgm ? (nM - fm) : wgm;
        u.pm = pm_off + fm + ((rem % nig) % gsz); u.pn = (rem % nig) / gsz; return true;
    }
};
template <bool ISA> struct OpRow {
    static constexpr bool GATHER = false;
    const char* p; long ld2; long bstride;
    __device__ __forceinline__ unsigned off(int R, int C) const { return (unsigned)(R * (int)ld2 + C * 2); }
    __device__ __forceinline__ const char* base(const Unit& u) const { return p + (long)u.bt * bstride + (long)(ISA ? u.pm : u.pn) * 256 * ld2; }
    __device__ __forceinline__ long koff(int t) const { return (long)t * 128; }
    __device__ __forceinline__ long hstep() const { return 128 * ld2; }
};
template <bool ISA> struct OpTiled {
    static constexpr bool GATHER = false;
    const char* p; int KT;
    __device__ __forceinline__ unsigned off(int R, int C) const { return (unsigned)(R * 128 + C * 2); }
    __device__ __forceinline__ const char* base(const Unit& u) const { return p + (long)(ISA ? u.pm : u.pn) * KT * 32768; }
    __device__ __forceinline__ long koff(int t) const { return (long)t * 32768; }
    __device__ __forceinline__ long hstep() const { return 16384; }
};
struct OpMoeBT {
    static constexpr bool GATHER = false;
    const char* w; const LAS int* te; int KT;
    __device__ __forceinline__ unsigned off(int R, int C) const { return (unsigned)(R * 128 + C * 2); }
    __device__ __forceinline__ const char* base(const Unit& u) const { return w + (long)__builtin_amdgcn_readfirstlane(te[u.pm]) * (long)MOE_E_STRIDE + (long)u.pn * KT * 32768; }
    __device__ __forceinline__ long koff(int t) const { return (long)t * 32768; }
    __device__ __forceinline__ long hstep() const { return 16384; }
};
struct OpS5A {
    static constexpr bool GATHER = false;
    const char* ptb; long delta;
    __device__ __forceinline__ unsigned off(int R, int C) const { return (unsigned)((C >> 4) * (MT * 2) + R * 32 + (C & 15) * 2); }
    __device__ __forceinline__ const char* base(const Unit& u) const { return ptb + ((long)u.bt * 16 * MT + (long)u.pm * 4096) * 2; }
    __device__ __forceinline__ long koff(int t) const { return t < 4 ? (long)t * 4 * MT * 2 : delta + (long)(t - 4) * 4 * MT * 2; }
    __device__ __forceinline__ long hstep() const { return 4096; }
};
struct OpFnetB {
    static constexpr bool GATHER = false;
    const char* p; int seq2; int sh;
    __device__ __forceinline__ unsigned off(int R, int C) const { return (unsigned)(R * (MT * 2) + C * 2); }
    __device__ __forceinline__ const char* base(const Unit& u) const { return p + (long)u.bt * seq2 + (long)u.pn * 256 * MT * 2; }
    __device__ __forceinline__ long koff(int t) const { return (long)(t >> sh) * 256 * MT * 2 + (long)(t & ((1 << sh) - 1)) * 128; }
    __device__ __forceinline__ long hstep() const { return (long)128 * MT * 2; }
};
struct OpPermB {
    static constexpr bool GATHER = false;
    const char* p;
    __device__ __forceinline__ unsigned off(int R, int C) const { return (unsigned)((64 * (R & 63) + (R >> 6)) * 2048 + C * 2); }
    __device__ __forceinline__ const char* base(const Unit& u) const { return p + ((long)(u.pn >> 4) * 4096 + (long)(u.pn & 15) * 4) * 2048; }
    __device__ __forceinline__ long koff(int t) const { return (long)t * 128; }
    __device__ __forceinline__ long hstep() const { return 2 * 2048; }
};
struct OpFA {
    static constexpr bool GATHER = false;
    const char* p;
    __device__ __forceinline__ unsigned off(int R, int C) const { return (unsigned)((R >> 6) * (MT * 2) + (R & 63) * 128 + C * 2); }
    __device__ __forceinline__ const char* base(const Unit& u) const { return p + (long)(u.pn & 63) * 4 * MT * 2 + (long)(u.pn >> 6) * 4096 * 2; }
    __device__ __forceinline__ long koff(int t) const { return (long)t * 256 * MT * 2; }
    __device__ __forceinline__ long hstep() const { return (long)2 * MT * 2; }
};
struct OpFB {
    static constexpr bool GATHER = false;
    const char* p;
    __device__ __forceinline__ unsigned off(int R, int C) const { return (unsigned)(R * 16384 + C * 2); }
    __device__ __forceinline__ const char* base(const Unit& u) const { return p + (long)u.bt * 256 * 16384 + (long)u.pm * 1024; }
    __device__ __forceinline__ long koff(int t) const { return (long)t * 128; }
    __device__ __forceinline__ long hstep() const { return (long)128 * 16384; }
};
struct OpMoeA {
    static constexpr bool GATHER = true;
    const char* h; const int* idx;
    __device__ __forceinline__ unsigned off(int, int) const { return 0u; }
    __device__ __forceinline__ unsigned goff(const Unit& u, int R, int C) const { int t = idx[u.pm * 256 + R]; t = t < 0 ? 0 : t; return (unsigned)t * 2048u + (unsigned)C * 2u; }
    __device__ __forceinline__ const char* base(const Unit&) const { return h; }
    __device__ __forceinline__ long koff(int t) const { return (long)t * 128; }
    __device__ __forceinline__ long hstep() const { return 0; }
};
struct OpMoeB {
    static constexpr bool GATHER = false;
    const char* w; const LAS int* te; long ld2;
    __device__ __forceinline__ unsigned off(int R, int C) const { return (unsigned)(R * (int)ld2 + C * 2); }
    __device__ __forceinline__ const char* base(const Unit& u) const { return w + (long)__builtin_amdgcn_readfirstlane(te[u.pm]) * (long)MOE_E_STRIDE + (long)u.pn * 256 * ld2; }
    __device__ __forceinline__ long koff(int t) const { return (long)t * 128; }
    __device__ __forceinline__ long hstep() const { return 128 * ld2; }
};

template <class T, class = void> struct IsRmw { static constexpr bool value = false; };
template <class T> struct IsRmw<T, decltype((void)sizeof(typename T::Pre))> { static constexpr bool value = true; };
template <class T, class = void> struct IsMoeU { static constexpr bool value = false; };
template <class T> struct IsMoeU<T, decltype((void)sizeof(typename T::MoeU))> { static constexpr bool value = true; };
template <class T, class = void> struct IsRmwU { static constexpr bool value = false; };
template <class T> struct IsRmwU<T, decltype((void)sizeof(typename T::Gates))> { static constexpr bool value = true; };
template <bool ALIGN = true, bool PERMB = false, class OA, class OB, class Epi>
__device__ __forceinline__ void gemm8(LAS unsigned char* lds, const int wv, const int nt, const OA& oa, const OB& ob, const Order& S, const Epi& E, const int stag = 0) {
    if (stag > 0) {
        const unsigned long long t0 = __builtin_amdgcn_s_memrealtime(), want = (unsigned long long)(((S.c >> 3) & 3) * stag);
        while (__builtin_amdgcn_s_memrealtime() - t0 < want) __builtin_amdgcn_s_sleep(4); }
    const int tid = tid_of(wv);
    const int wid = __builtin_amdgcn_readfirstlane(tid >> 6), lane = tid & 63, wr = wid >> 2, wc = wid & 3, fr = lane & 15, fq = lane >> 4;
    unsigned voffA[2][2], voffB[2];
#pragma unroll
    for (int i = 0; i < 2; ++i) { int R_, C_; stage_rc(tid * 16 + i * 8192, R_, C_); voffB[i] = ob.off(PERMB ? ((R_ & ~31) | (((R_ >> 2) & 3) << 3) | (((R_ >> 4) & 1) << 2) | (R_ & 3)) : R_, C_); voffA[0][i] = oa.off(R_, C_); voffA[1][i] = 0u; }
    const long hA = oa.hstep(), hB = ob.hstep();
    const unsigned ldsw = (unsigned)wid * 1024u;
    const int aoff = lds_byte(wr * 64 + fr, fq * 8), boff = lds_byte(wc * 32 + fr, fq * 8);
#define G8_SA(b, h) (((b) * 2 + (h)) * HTB)
#define G8_SB(b, h) ((4 + (b) * 2 + (h)) * HTB)
#define G8_STAGE_B(bufoff, gbase) do { _Pragma("unroll") for (int _i = 0; _i < 2; ++_i) \
        __builtin_amdgcn_global_load_lds((const unsigned*)((const char*)(gbase) + voffB[_i]), (LAS unsigned*)(lds + (bufoff) + ldsw + _i * 8192), 16, 0, 0); } while (0)
#define G8_STAGE_A(bufoff, gbase, h) do { _Pragma("unroll") for (int _i = 0; _i < 2; ++_i) \
        __builtin_amdgcn_global_load_lds((const unsigned*)((const char*)(gbase) + (OA::GATHER ? 0 : (h) * hA) + voffA[OA::GATHER ? (h) : 0][_i]), (LAS unsigned*)(lds + (bufoff) + ldsw + _i * 8192), 16, 0, 0); } while (0)
#define G8_LDA(dst, b, h) do { _Pragma("unroll") for (int m = 0; m < 4; ++m) _Pragma("unroll") for (int k = 0; k < 2; ++k) dst[m][k] = *(const LAS bf16x8*)(lds + G8_SA(b, h) + aoff + m * 2048 + k * 1024); } while (0)
#define G8_LDB(dst, b, h) do { _Pragma("unroll") for (int n = 0; n < 2; ++n) _Pragma("unroll") for (int k = 0; k < 2; ++k) dst[n][k] = *(const LAS bf16x8*)(lds + G8_SB(b, h) + boff + n * 2048 + k * 1024); } while (0)
#define G8_MMA(ai, bj, At, Bt) do { __builtin_amdgcn_s_setprio(1); _Pragma("unroll") for (int m = 0; m < 4; ++m) _Pragma("unroll") for (int n = 0; n < 2; ++n) _Pragma("unroll") for (int k = 0; k < 2; ++k) \
        acc[ai][bj][m][n] = __builtin_amdgcn_mfma_f32_16x16x32_bf16(Bt[n][k], At[m][k], acc[ai][bj][m][n], 0, 0, 0); __builtin_amdgcn_s_setprio(0); } while (0)
#define G8_WAIT_V(n) asm volatile("s_waitcnt vmcnt(" #n ")" ::: "memory")
#define G8_WAIT_L(n) asm volatile("s_waitcnt lgkmcnt(" #n ")" ::: "memory")
#define G8_BAR __builtin_amdgcn_s_barrier()
#define G8_SCHED __builtin_amdgcn_sched_barrier(0)
#define G8_GOFF(u) do { if constexpr (OA::GATHER) { const int _tz = tid_of(wv); _Pragma("unroll") for (int _i = 0; _i < 2; ++_i) { int _R, _C; stage_rc(_tz * 16 + _i * 8192, _R, _C); \
        _Pragma("unroll") for (int _h = 0; _h < 2; ++_h) voffA[_h][_i] = oa.goff(u, _R + 128 * _h, _C); } } } while (0)
    Unit cur, nxt; int ui = 0;
    if (!S.next(0, cur)) return;
    f32x4 acc[2][2][4][2];
#pragma unroll
    for (int a = 0; a < 2; ++a)
#pragma unroll
        for (int b = 0; b < 2; ++b)
#pragma unroll
            for (int m = 0; m < 4; ++m)
#pragma unroll
                for (int n = 0; n < 2; ++n) acc[a][b][m][n] = (f32x4){0.f, 0.f, 0.f, 0.f};
    bf16x8 At[4][2], B0[2][2], B1[2][2];
    const char* cA = oa.base(cur); const char* cB = ob.base(cur);
    asm volatile("" : "+s"(cA), "+s"(cB));
    G8_GOFF(cur);
    {   const long ka0 = oa.koff(0), ka1 = oa.koff(1), kb0 = ob.koff(0), kb1 = ob.koff(1);
        G8_STAGE_B(G8_SB(0, 0), cB + kb0); G8_STAGE_B(G8_SB(0, 1), cB + kb0 + hB); G8_STAGE_A(G8_SA(0, 0), cA + ka0, 0); G8_STAGE_A(G8_SA(0, 1), cA + ka0, 1);
        if (wr == 1) G8_BAR;
        G8_WAIT_V(2); G8_BAR;
        G8_STAGE_B(G8_SB(1, 0), cB + kb1); G8_STAGE_A(G8_SA(1, 0), cA + ka1, 0); G8_STAGE_B(G8_SB(1, 1), cB + kb1 + hB);
        G8_WAIT_V(6); G8_BAR; }
    for (;;) {
        const bool has_next = S.next(ui + 1, nxt);
        const char* nA = has_next ? oa.base(nxt) : cA; const char* nB = has_next ? ob.base(nxt) : cB;
        asm volatile("" : "+s"(nA), "+s"(nB));
        for (int t = 0; t < nt; t += 2) {
            const bool last = (t == nt - 2);
            const char* a1 = cA + oa.koff(t + 1);
            const char* a2 = last ? nA + oa.koff(0) : cA + oa.koff(t + 2); const char* b2 = last ? nB + ob.koff(0) : cB + ob.koff(t + 2);
            const char* a3 = last ? nA + oa.koff(1) : cA + oa.koff(t + 3); const char* b3 = last ? nB + ob.koff(1) : cB + ob.koff(t + 3);
            G8_LDB(B0, 0, 0); G8_LDB(B1, 0, 1); G8_SCHED; G8_LDA(At, 0, 0); G8_STAGE_A(G8_SA(1, 1), a1, 1);
            if (last && has_next && nxt.pm != cur.pm) G8_GOFF(nxt);
            G8_WAIT_V(8); G8_WAIT_L(0); G8_BAR; G8_MMA(0, 0, At, B0); G8_MMA(0, 1, At, B1); G8_BAR; G8_SCHED;
            G8_LDA(At, 0, 1); G8_STAGE_B(G8_SB(0, 0), b2); G8_STAGE_B(G8_SB(0, 1), b2 + hB); G8_STAGE_A(G8_SA(0, 0), a2, 0);
            G8_WAIT_V(8); G8_WAIT_L(0); G8_BAR; G8_MMA(1, 0, At, B0); G8_MMA(1, 1, At, B1); G8_BAR; G8_SCHED;
            G8_LDB(B0, 1, 0); G8_LDB(B1, 1, 1); G8_SCHED; G8_LDA(At, 1, 0); G8_STAGE_A(G8_SA(0, 1), a2, 1);
            G8_WAIT_V(8); G8_WAIT_L(0); G8_BAR; G8_MMA(0, 0, At, B0); G8_MMA(0, 1, At, B1); G8_BAR; G8_SCHED;
            G8_LDA(At, 1, 1); G8_STAGE_B(G8_SB(1, 0), b3); G8_STAGE_B(G8_SB(1, 1), b3 + hB); G8_STAGE_A(G8_SA(1, 0), a3, 0);
            G8_WAIT_V(8); G8_WAIT_L(0); G8_BAR; G8_MMA(1, 0, At, B0); G8_MMA(1, 1, At, B1); G8_BAR; G8_SCHED;
        }
        if (ALIGN) { if (wr == 0) G8_BAR; }
        {   const int tz = tid_of(wv); const int wz = tz >> 6, lz = tz & 63;
            const int row0 = cur.pm * BM + (wz >> 2) * 64 + (lz & 15), col0 = cur.pn * BM + (wz & 3) * 32 + (PERMB ? 8 : 4) * (lz >> 4);
            if constexpr (IsMoeU<Epi>::value) {
                constexpr int MB = Epi::M_PER_BATCH, NBT = 8 / MB;
                int tk[MB];
#pragma unroll
                for (int m2 = 0; m2 < MB; ++m2) tk[m2] = E.tok(row0 + m2 * 16);
#pragma unroll
                for (int bt_ = 0; bt_ < NBT; ++bt_) { const int ai = (bt_ * MB) >> 2, mh = (bt_ * MB) & 3; int tkn[MB]; typename Epi::MoeU pr[MB][2];
#pragma unroll
                    for (int m2 = 0; m2 < MB; ++m2) tkn[m2] = (bt_ + 1 < NBT) ? E.tok(row0 + ((((bt_ + 1) * MB) >> 2)) * HALF + ((((bt_ + 1) * MB) & 3) + m2) * 16) : 0;
#pragma unroll
                    for (int m2 = 0; m2 < MB; ++m2)
#pragma unroll
                        for (int bj = 0; bj < 2; ++bj) pr[m2][bj] = E.pre(tk[m2], col0 + bj * HALF);
#pragma unroll
                    for (int m2 = 0; m2 < MB; ++m2)
#pragma unroll
                        for (int bj = 0; bj < 2; ++bj) E.post(pr[m2][bj], tk[m2], col0 + bj * HALF, acc[ai][bj][mh + m2][0], acc[ai][bj][mh + m2][1]);
#pragma unroll
                    for (int m2 = 0; m2 < MB; ++m2) tk[m2] = tkn[m2]; }
            } else if constexpr (IsRmwU<Epi>::value) {
                const typename Epi::Gates gt = E.gates(cur.bt, row0, col0);
                constexpr int AB = Epi::AI_PER_BATCH;
#pragma unroll
                for (int a0 = 0; a0 < 2; a0 += AB) { typename Epi::PreX px[AB][4][2];
#pragma unroll
                    for (int a = 0; a < AB; ++a)
#pragma unroll
                        for (int m = 0; m < 4; ++m)
#pragma unroll
                            for (int bj = 0; bj < 2; ++bj) px[a][m][bj] = E.prex(cur.bt, row0 + (a0 + a) * HALF + m * 16, col0 + bj * HALF);
#pragma unroll
                    for (int a = 0; a < AB; ++a)
#pragma unroll
                        for (int m = 0; m < 4; ++m)
#pragma unroll
                            for (int bj = 0; bj < 2; ++bj) E.postx(gt, bj, px[a][m][bj], cur.bt, row0 + (a0 + a) * HALF + m * 16, col0 + bj * HALF, acc[a0 + a][bj][m][0], acc[a0 + a][bj][m][1]); }
            } else if constexpr (IsRmw<Epi>::value) {
#pragma unroll
                for (int ai = 0; ai < 2; ++ai)
#pragma unroll
                    for (int mh = 0; mh < 4; mh += 2) { typename Epi::Pre pr[2][2];
#pragma unroll
                        for (int m2 = 0; m2 < 2; ++m2)
#pragma unroll
                            for (int bj = 0; bj < 2; ++bj) pr[m2][bj] = E.pre(cur.bt, row0 + ai * HALF + (mh + m2) * 16, col0 + bj * HALF);
#pragma unroll
                        for (int m2 = 0; m2 < 2; ++m2)
#pragma unroll
                            for (int bj = 0; bj < 2; ++bj) E.post(pr[m2][bj], cur.bt, row0 + ai * HALF + (mh + m2) * 16, col0 + bj * HALF, acc[ai][bj][mh + m2][0], acc[ai][bj][mh + m2][1]); }
            } else {
#pragma unroll
            for (int ai = 0; ai < 2; ++ai)
#pragma unroll
                for (int m = 0; m < 4; ++m)
#pragma unroll
                    for (int bj = 0; bj < 2; ++bj) E(cur.bt, row0 + ai * HALF + m * 16, col0 + bj * HALF, acc[ai][bj][m][0], acc[ai][bj][m][1]); } }
        if (!has_next) break;
#pragma unroll
        for (int a = 0; a < 2; ++a)
#pragma unroll
            for (int b = 0; b < 2; ++b)
#pragma unroll
                for (int m = 0; m < 4; ++m)
#pragma unroll
                    for (int n = 0; n < 2; ++n) acc[a][b][m][n] = (f32x4){0.f, 0.f, 0.f, 0.f};
        cur = nxt; cA = nA; cB = nB; ++ui;
        if (ALIGN) { if (wr == 1) G8_BAR; }
    }
    G8_WAIT_V(0);
    if (!ALIGN) { if (wr == 0) G8_BAR; }
    G8_BAR;
#undef G8_SA
#undef G8_SB
#undef G8_STAGE_A
#undef G8_STAGE_B
#undef G8_LDA
#undef G8_LDB
#undef G8_MMA
#undef G8_WAIT_V
#undef G8_WAIT_L
#undef G8_BAR
#undef G8_SCHED
#undef G8_GOFF
}
}

#ifndef PROBE_SEL
#define PROBE_SEL -1
#endif
#ifndef PROBE_BLK
#define PROBE_BLK 0
#endif
#ifndef PROBE_TID
#define PROBE_TID 0
#endif
#if PROBE_SEL >= 0
__device__ __forceinline__ void prb_b(LAS unsigned char* lds, int tid) { if (tid == PROBE_TID) { asm volatile("s_waitcnt vmcnt(0) lgkmcnt(0)" ::: "memory"); *(volatile LAS unsigned long long*)(lds + LDS_MISC + 64) = __builtin_amdgcn_s_memrealtime(); } }
__device__ __forceinline__ void prb_e(LAS unsigned char* lds, int tid) { if (tid == PROBE_TID) { asm volatile("s_waitcnt vmcnt(0) lgkmcnt(0)" ::: "memory"); volatile LAS unsigned long long* p = (volatile LAS unsigned long long*)(lds + LDS_MISC + 64); p[1] = p[1] + (__builtin_amdgcn_s_memrealtime() - p[0]); } }
#define PB(id) do { if ((id) == PROBE_SEL) prb_b(F.lds, F.tid); } while (0)
#define PE(id) do { if ((id) == PROBE_SEL) prb_e(F.lds, F.tid); } while (0)
#else
#define PB(id) do { } while (0)
#define PE(id) do { } while (0)
#endif
struct Args { const float* in[40]; float* out; unsigned char* ws; int ph_lo, ph_hi; };
struct Frame {
    LAS unsigned char* lds; int tid, lane, wave, vcu, G;
    const float* const* in; float* out; unsigned char* ws;
};
#define WSP(T, off) ((T*)(F.ws + (off)))
__device__ __forceinline__ Frame relocal(const Frame& F0) { Frame F = F0; const int t = tid_of(F0.wave); F.tid = t; F.lane = t & 63; F.wave = F0.wave; int v = F0.vcu; asm volatile("" : "+s"(v)); F.vcu = v; return F; }

constexpr int PH_P0 = 0, PH_P1 = 1, PH_L = 2, PH_PER = 20, N_PHASES = PH_L + 2 * PH_PER;
enum { S_NORM1 = 0, S_G1, S_FNET, S_HY1, S_S5E, S_CARRY, S_HY2, S_S5O, S_GLU, S_HYT, S_WOUT, S_NORM2, S_F0, S_F1, S_F2, S_F3, S_F4, S_F5, S_F6 };

__device__ __forceinline__ int wq_next(Frame& F, int qid) {
    LAS int* slot = (LAS int*)(F.lds + LDS_MISC + 96);
    if (F.tid == 0) *slot = (int)__hip_atomic_fetch_add((unsigned*)(F.ws + WS_CTL) + 8192 + 64 * qid, 1u, __ATOMIC_RELAXED, __HIP_MEMORY_SCOPE_AGENT);
    __syncthreads();
    const int v = *slot;
    __syncthreads();
    return v;
}
__device__ __forceinline__ int rowmap(int mode, int row_off, int n) { return (mode == 0 || mode == 3) ? row_off + n : (32 * (n >> 4) + (n & 15) + (mode == 2 ? 16 : 0)); }
__device__ __forceinline__ void transpose_item(const float* W, int ldw, int col0, int N, bf16* WT, int ldk, int mode, int row_off, LAS float* scr, int item, int lane) {
    const int nblk = N / 32, kb = item / nblk, nb = item % nblk, k0 = 64 * kb, n0 = 32 * nb;
    const int r8 = lane >> 3, c4 = lane & 7;
    f32x4 v[8];
#pragma unroll
    for (int i = 0; i < 8; ++i) v[i] = __builtin_nontemporal_load((const f32x4*)(W + (size_t)(k0 + 8 * i + r8) * ldw + col0 + n0 + 4 * c4));
#pragma unroll
    for (int i = 0; i < 8; ++i) { LAS float* d = scr + (8 * i + r8) * 33 + 4 * c4; d[0] = v[i].x; d[1] = v[i].y; d[2] = v[i].z; d[3] = v[i].w; }
    asm volatile("s_waitcnt lgkmcnt(0)" ::: "memory");
    const int c = lane & 7;
#pragma unroll
    for (int j = 0; j < 4; ++j) { const int n = (lane >> 3) + 8 * j; const LAS float* s = scr + (8 * c) * 33 + n;
        v4u o; o.x = pk2(s[0 * 33], s[1 * 33]); o.y = pk2(s[2 * 33], s[3 * 33]); o.z = pk2(s[4 * 33], s[5 * 33]); o.w = pk2(s[6 * 33], s[7 * 33]);
        if (mode == 3) *(v4u*)(WT + tiled_idx(row_off + n0 + n, k0 + 8 * c, ldk / 64)) = o; else *(v4u*)(WT + (size_t)rowmap(mode, row_off, n0 + n) * ldk + k0 + 8 * c) = o; }
    asm volatile("s_waitcnt lgkmcnt(0)" ::: "memory");
}

__device__ __forceinline__ void p0_transposes(Frame& F) {
    LAS float* scr = (LAS float*)(F.lds + F.wave * 16384);
    const int gw = F.vcu * NWAVES + F.wave, NGW = F.G * NWAVES;
    constexpr int I_IN = 16 * 48, I_OUT = 16 * 32, I_GLU = 6 * 12, I_FG = 16 * 88, I_FD = 44 * 32;
    constexpr int NIT = 2 * (I_IN + I_OUT + I_GLU) + 2 * I_FG + I_FD;
    for (int it = gw; it < NIT; it += NGW) {
        int r = it;
        if (r < 2 * I_IN) { const int l = r / I_IN; transpose_item(F.in[8] + (size_t)l * D * DIN, DIN, 256, 1536, WSP(bf16, WS_WIN) + (size_t)l * PTROWS * D, D, 0, 512, scr, r % I_IN, F.lane); continue; } r -= 2 * I_IN;
        if (r < 2 * I_OUT) { const int l = r / I_OUT; transpose_item(F.in[9] + (size_t)l * D * D, D, 0, D, WSP(bf16, WS_WOUT) + (size_t)l * D * D, D, 0, 0, scr, r % I_OUT, F.lane); continue; } r -= 2 * I_OUT;
        if (r < 2 * I_GLU) { const int l = r / I_GLU; transpose_item(F.in[29] + (size_t)l * 384 * 384, 384, 0, 384, WSP(bf16, WS_GLU) + (size_t)l * 512 * 384, 384, 0, 0, scr, r % I_GLU, F.lane); continue; } r -= 2 * I_GLU;
        if (r < I_FG) { transpose_item(F.in[31], DFF, 0, DFF, WSP(bf16, WS_FGU), D, 1, 0, scr, r, F.lane); continue; } r -= I_FG;
        if (r < I_FG) { transpose_item(F.in[32], DFF, 0, DFF, WSP(bf16, WS_FGU), D, 2, 0, scr, r, F.lane); continue; } r -= I_FG;
        transpose_item(F.in[33], D, 0, D, WSP(bf16, WS_FD), DFF, 3, 0, scr, r, F.lane);
    }
}
struct TItem { const float* src; int ldw; bf16* dst; int ldk, mode, k0, n0; };
__device__ __forceinline__ void titem_load(const TItem& t, int lane, f32x4 (&v)[8]) { const int r8 = lane >> 3, c4 = lane & 7;
#pragma unroll
    for (int i = 0; i < 8; ++i) v[i] = __builtin_nontemporal_load((const f32x4*)(t.src + (size_t)(t.k0 + 8 * i + r8) * t.ldw + t.n0 + 4 * c4)); }
__device__ __forceinline__ void titem_finish(const TItem& t, int lane, const f32x4 (&v)[8], LAS float* scr) { const int r8 = lane >> 3, c4 = lane & 7;
#pragma unroll
    for (int i = 0; i < 8; ++i) { LAS float* d = scr + (8 * i + r8) * 33 + 4 * c4; d[0] = v[i].x; d[1] = v[i].y; d[2] = v[i].z; d[3] = v[i].w; }
    asm volatile("s_waitcnt lgkmcnt(0)" ::: "memory");
    const int c = lane & 7;
#pragma unroll
    for (int j = 0; j < 4; ++j) { const int n = (lane >> 3) + 8 * j; const LAS float* s = scr + (8 * c) * 33 + n;
        v4u o; o.x = pk2(s[0 * 33], s[1 * 33]); o.y = pk2(s[2 * 33], s[3 * 33]); o.z = pk2(s[4 * 33], s[5 * 33]); o.w = pk2(s[6 * 33], s[7 * 33]);
        if (t.mode == 3) *(v4u*)(t.dst + tiled_idx(t.n0 + n, t.k0 + 8 * c, t.ldk / 64)) = o; else *(v4u*)(t.dst + (size_t)rowmap(t.mode, 0, t.n0 + n) * t.ldk + t.k0 + 8 * c) = o; }
    asm volatile("s_waitcnt lgkmcnt(0)" ::: "memory"); }
__device__ __forceinline__ TItem moe_titem(Frame& F, int it) {
    constexpr int I_G = 16 * 112, I_D = 56 * 32, PER_E = 2 * I_G + I_D;
    const int e = it / PER_E; int r = it % PER_E; TItem t;
    bf16* gu = (bf16*)(F.ws + WS_MOEW + (size_t)e * MOE_E_STRIDE); bf16* dn = (bf16*)(F.ws + WS_MOEW + (size_t)e * MOE_E_STRIDE + MOE_GU_BYTES);
    if (r < 2 * I_G) { const int up = r >= I_G; if (up) r -= I_G; t.src = F.in[36 + up] + (size_t)e * D * DFE; t.ldw = DFE; t.dst = gu; t.ldk = D; t.mode = 1 + up; t.k0 = 64 * (r / 112); t.n0 = 32 * (r % 112); }
    else { r -= 2 * I_G; t.src = F.in[38] + (size_t)e * DFE * D; t.ldw = D; t.dst = dn; t.ldk = DFE; t.mode = 3; t.k0 = 64 * (r / 32); t.n0 = 32 * (r % 32); }
    return t; }
__device__ __forceinline__ void moe_transposes(Frame& F_) { Frame F = relocal(F_);
    LAS float* scr = (LAS float*)(F.lds + F.wave * 16384);
    const int gw = F.vcu * NWAVES + F.wave, NGW = F.G * NWAVES; constexpr int NIT = NE * (2 * 16 * 112 + 56 * 32);
    int it = gw; if (it >= NIT) return;
    TItem cur = moe_titem(F, it); f32x4 va[8], vb[8]; titem_load(cur, F.lane, va);
    for (;;) {
        const int itn = it + NGW; const bool hn = itn < NIT; TItem nx = cur; if (hn) { nx = moe_titem(F, itn); titem_load(nx, F.lane, vb); }
        titem_finish(cur, F.lane, va, scr);
        if (!hn) break;
        const int itn2 = itn + NGW; const bool hn2 = itn2 < NIT; TItem nx2 = nx; if (hn2) { nx2 = moe_titem(F, itn2); titem_load(nx2, F.lane, va); }
        titem_finish(nx, F.lane, vb, scr);
        if (!hn2) break;
        cur = nx2; it = itn2;
    }
}

__device__ __forceinline__ void p0_mod_item(Frame& F, int item) {
    const int l = item / 48, cb = item % 48, tid = tid_of(F.wave), lane = tid & 63;
    LAS float* sc = (LAS float*)F.lds;
    LAS float* red = sc + 17 * 1024;
    for (int i = tid; i < 17 * 1024; i += NTHR) { const int r = i >> 10, k = i & 1023; const float v = r < 16 ? F.in[1][r * D + k] : F.in[3][k]; sc[i] = silu_f(v); }
    __syncthreads();
    const int cq = lane & 31, kg = (lane >> 5) + 2 * F.wave;
    const float* W = F.in[4] + (size_t)l * D * 6144 + cb * 128 + 4 * cq;
    f32x4 acc[17];
#pragma unroll
    for (int r = 0; r < 17; ++r) acc[r] = (f32x4){0.f, 0.f, 0.f, 0.f};
#pragma unroll 1
    for (int k0 = kg * 64; k0 < kg * 64 + 64; k0 += 8) { f32x4 w[8];
#pragma unroll
        for (int j = 0; j < 8; ++j) w[j] = *(const f32x4*)(W + (size_t)(k0 + j) * 6144);
#pragma unroll
        for (int j = 0; j < 8; ++j)
#pragma unroll
            for (int r = 0; r < 17; ++r) acc[r] += w[j] * sc[r * 1024 + k0 + j]; }
    if (lane < 32) {
#pragma unroll
        for (int r = 0; r < 17; ++r) *(LAS f32x4*)(red + (F.wave * 17 + r) * 128 + 4 * cq) = acc[r]; }
    __syncthreads();
    if (lane >= 32) {
#pragma unroll
        for (int r = 0; r < 17; ++r) { LAS f32x4* p = (LAS f32x4*)(red + (F.wave * 17 + r) * 128 + 4 * cq); *p = *p + acc[r]; } }
    __syncthreads();
    for (int i = tid; i < 17 * 128; i += NTHR) { const int r = i >> 7, c = i & 127; float s = 0.f;
#pragma unroll
        for (int w8 = 0; w8 < 8; ++w8) s += red[(w8 * 17 + r) * 128 + c];
        WSP(float, WS_MOD)[((size_t)l * 17 + r) * 6144 + cb * 128 + c] = s + F.in[5][l * 6144 + cb * 128 + c]; }
    __syncthreads();
}
__device__ __forceinline__ void p0_fold_item(Frame& F, int item) {
    const int kb = item & 7, cs = (item >> 3) & 1, h = (item >> 4) & 3, l = item >> 6, tid = tid_of(F.wave);
    LAS float* A = (LAS float*)F.lds;
    LAS float* WF = A + 4096;
    LAS float* WI = WF + 4096;
    LAS float* T = WI + 128 * 65;
    if (tid < 64) T[tid] = cs ? sinpif((float)tid * (1.0f / 32.0f)) : cospif((float)tid * (1.0f / 32.0f));
    const float* wf = F.in[10] + ((size_t)l * 4 + h) * 64 * 64;
    for (int i = tid; i < 4096; i += NTHR) WF[i] = wf[i];
    const float* win = F.in[8] + (size_t)l * D * DIN + (size_t)kb * 128 * DIN + h * 64;
    for (int i = tid; i < 128 * 64; i += NTHR) { const int kk = i >> 6, d = i & 63; WI[kk * 65 + d] = win[(size_t)kk * DIN + d]; }
    __syncthreads();
    for (int i = tid; i < 4096; i += NTHR) { const int d = i >> 6, e2 = i & 63; float s = 0.f;
        for (int e = 0; e < 64; ++e) s += T[(e * d) & 63] * WF[e * 64 + e2];
        A[i] = s * 0.125f; }
    __syncthreads();
    const int e2 = tid & 63;
    bf16* wt = WSP(bf16, WS_WIN) + (size_t)l * PTROWS * D + (size_t)(cs * 256 + h * 64 + e2) * D + kb * 128;
    for (int i = 0; i < 16; ++i) { const int kk = (tid >> 6) + 8 * i; float s = 0.f;
#pragma unroll 8
        for (int d = 0; d < 64; ++d) s += WI[kk * 65 + d] * A[d * 64 + e2];
        wt[kk] = (bf16)f2bf(s); }
    __syncthreads();
}
__device__ __forceinline__ void gen_dft_rows(bf16* dst, int LL, int row0, int nrows, float scale, int tid) {
    const int cpr = 2 * LL / 8;
    for (int i = tid; i < nrows * cpr; i += NTHR) { const int k = row0 + i / cpr, j0 = (i % cpr) * 8; unsigned w[4];
#pragma unroll
        for (int q = 0; q < 4; ++q) { float v[2];
#pragma unroll
            for (int z = 0; z < 2; ++z) { const int j = j0 + 2 * q + z; const int jj = j < LL ? j : j - LL; const int m = (k * jj) & (LL - 1); const float x = (float)m * (2.0f / (float)LL);
                v[z] = (j < LL ? cospif(x) : -sinpif(x)) * scale; }
            w[q] = pk2(v[0], v[1]); }
        *(v4u*)(dst + (size_t)k * 2 * LL + j0) = (v4u){w[0], w[1], w[2], w[3]}; }
}
__device__ __forceinline__ void gen_fft_mats(Frame& F, int item) {
    const int tid = tid_of(F.wave);
    if (item == 64) { bf16* W = WSP(bf16, WS_FAW);
        for (int i = tid; i < 256 * 128; i += NTHR) { const int m = i >> 7, k = i & 127; float v = 0.f;
            if (m < 128) { const int pp = m >> 6, t1 = m & 63, pa = k >> 6, s1 = k & 63; const float x = (float)((t1 * s1) & 63) * (1.0f / 32.0f); const float c = cospif(x) * 0.125f, sn = sinpif(x) * 0.125f;
                v = pp == 0 ? (pa == 0 ? c : -sn) : (pa == 0 ? -sn : -c); }
            W[i] = (bf16)f2bf(v); }
        return; }
    const int grp = item >> 2, q = item & 3; bf16* W = WSP(bf16, WS_FBW) + (size_t)grp * 256 * 512;
    for (int i = q * 32768 + tid; i < (q + 1) * 32768; i += NTHR) { const int r = i >> 9, k = i & 511; const int t1p = r >> 6, t2 = r & 63, t1q = k >> 7, pa = (k >> 6) & 1, s2 = k & 63; float v = 0.f;
        if (t1p == t1q) { const int t = 4 * grp + t1p + 64 * t2; const float x = (float)((s2 * t) & 4095) * (1.0f / 2048.0f); v = (pa == 0 ? cospif(x) : sinpif(x)) * 0.125f; }
        W[i] = (bf16)f2bf(v); }
}
__device__ __forceinline__ void p0_filter_item(Frame& F, int item) {
    const int l = item / 272, pb = item % 272, tid = tid_of(F.wave);
    const int LL = pb < 256 ? L : LC, p0 = pb < 256 ? pb * 16 : (pb - 256) * 16;
    LAS float* z = (LAS float*)F.lds;
    LAS float* h1 = z + 16 * 36;
    LAS float* h2 = h1 + 16 * 64;
    LAS float* W1 = h2 + 16 * 64;
    LAS float* W2 = W1 + 33 * 64;
    for (int i = tid; i < 33 * 64; i += NTHR) W1[i] = F.in[13][(size_t)l * 33 * 64 + i];
    for (int i = tid; i < 64 * 64; i += NTHR) W2[i] = F.in[16][(size_t)l * 64 * 64 + i];
    for (int i = tid; i < 16 * 33; i += NTHR) { const int pp = i / 33, j = i % 33; const int pos = p0 + pp; float v;
        if (j == 0) v = (float)pos / (float)(LL - 1);
        else { const int bj = (j - 1) & 15; const float band = 1e-4f + (float)bj * ((15.0f - 1e-4f) / 15.0f); const float u = 2.0f * band * (float)pos / (float)LL;
            v = j <= 16 ? cospif(u) : -sinpif(u); }
        z[pp * 36 + j] = v; }
    __syncthreads();
    for (int i = tid; i < 1024; i += NTHR) { const int pp = i >> 6, o = i & 63; float s = F.in[14][l * 64 + o];
        for (int j = 0; j < 33; ++j) s += z[pp * 36 + j] * W1[j * 64 + o];
        h1[i] = sinf(F.in[15][l * 64 + o] * s); }
    __syncthreads();
    for (int i = tid; i < 1024; i += NTHR) { const int pp = i >> 6, o = i & 63; float s = F.in[17][l * 64 + o];
        for (int j = 0; j < 64; ++j) s += h1[pp * 64 + j] * W2[j * 64 + o];
        h2[i] = sinf(F.in[18][l * 64 + o] * s); }
    __syncthreads();
    float* HT = WSP(float, WS_HT) + ((size_t)l * 4352 + (pb < 256 ? 0 : 4096)) * 1536;
    float* PS = WSP(float, WS_PS) + ((size_t)l * 272 + pb) * 1536;
    const float* fw3 = F.in[19] + (size_t)l * 64 * 1536;
    const float dmin = 3.0701134573253945f, dstep = (15.350567286626973f - 3.0701134573253945f) / 383.0f;
#pragma unroll 1
    for (int cc = 0; cc < 3; ++cc) { const int col = tid + 512 * cc; float acc[16];
#pragma unroll
        for (int pp = 0; pp < 16; ++pp) acc[pp] = 0.f;
#pragma unroll 1
        for (int j0 = 0; j0 < 64; j0 += 32) { float w[32];
#pragma unroll
            for (int j = 0; j < 32; ++j) w[j] = fw3[(size_t)(j0 + j) * 1536 + col];
#pragma unroll
            for (int pp = 0; pp < 16; ++pp) { float a = acc[pp];
#pragma unroll
                for (int j = 0; j < 32; j += 4) { const f32x4 hv = *(const LAS f32x4*)(h2 + pp * 64 + j0 + j); a += (hv.x * w[j] + hv.y * w[j + 1]) + (hv.z * w[j + 2] + hv.w * w[j + 3]); }
                acc[pp] = a; __builtin_amdgcn_sched_barrier(0); } }
        const int c = col % 384, dir = col / 768; const float delta = dmin + (float)c * dstep; float ps = 0.f;
#pragma unroll
        for (int pp = 0; pp < 16; ++pp) { const int pos = p0 + pp; const float t = (float)pos / (float)(LL - 1); const float v = acc[pp] * __expf(-t * delta);
            HT[(size_t)pos * 1536 + col] = v; if (!(dir == 1 && pos == 0)) ps += fabsf(v); }
        PS[col] = ps; }
    __syncthreads();
}
__device__ __forceinline__ void p0_s5_item(Frame& F, int item2) {
    const int item = item2 >> 1, part = item2 & 1, l = item / 24, g = item % 24, tid = tid_of(F.wave);
    LAS f32x2* apow = (LAS f32x2*)F.lds;
    LAS f32x2* bbar = apow + 2 * 17 * 64;
    LAS f32x2* Cc = bbar + 2 * 64 * 16;
    LAS float* Kd = (LAS float*)(Cc + 2 * 16 * 64);
    if (tid < 128) { const int dir = tid >> 6, p = tid & 63; const size_t ix = (((size_t)l * 2 + dir) * 24 + g) * 64 + p;
        const float are = F.in[21][ix], aim = F.in[22][ix], dt = __expf(F.in[23][((size_t)l * 2 + dir) * 24 + g]);
        const float x = are * dt, yp = aim * dt * 0.3183098861837907f;
        for (int tau = 0; tau <= 16; ++tau) { const float mg = __expf(x * (float)tau), an = yp * (float)tau; apow[(dir * 17 + tau) * 64 + p] = (f32x2){mg * cospif(an), mg * sinpif(an)}; }
        const float sh = sinpif(0.5f * yp), nr = expm1f(x) * cospif(yp) - 2.0f * sh * sh, ni = __expf(x) * sinpif(yp); const float den = are * are + aim * aim;
        const float qr = (nr * are + ni * aim) / den, qi = (ni * are - nr * aim) / den;
        for (int h = 0; h < 16; ++h) { const float br = F.in[24][ix * 16 + h], bi = F.in[25][ix * 16 + h]; bbar[(dir * 64 + p) * 16 + h] = (f32x2){qr * br - qi * bi, qr * bi + qi * br}; }
        const float m16 = __expf(x * 16.0f), a16 = yp * 16.0f;
        WSP(float, WS_A16)[ix * 2 + 0] = m16 * cospif(a16); WSP(float, WS_A16)[ix * 2 + 1] = m16 * sinpif(a16); }
    for (int i = tid; i < 2 * 16 * 64; i += NTHR) { const int dir = i >> 10, h = (i >> 6) & 15, p = i & 63; const size_t ix = ((((size_t)l * 2 + dir) * 24 + g) * 16 + h) * 64 + p;
        Cc[i] = (f32x2){F.in[26][ix], F.in[27][ix]}; }
    __syncthreads();
    for (int i = tid; i < 2 * 16 * 256; i += NTHR) { const int dir = i >> 12, tau = (i >> 8) & 15, h = (i >> 4) & 15, h2 = i & 15; float s = 0.f;
        for (int p = 0; p < 64; ++p) { const f32x2 a = apow[(dir * 17 + tau) * 64 + p], b = bbar[(dir * 64 + p) * 16 + h2], c = Cc[(dir * 16 + h) * 64 + p];
            const float tr = a.x * b.x - a.y * b.y, ti = a.x * b.y + a.y * b.x; s += c.x * tr - c.y * ti; }
        Kd[i] = s; }
    __syncthreads();
    bf16* EST = (bf16*)(F.ws + WS_S5M + (size_t)item * S5M_STRIDE); bf16* MOUT = EST + 256 * 256;
    const float* dsk = F.in[28] + (size_t)l * 384 + g * 16;
    const int e_lo = part == 0 ? 0 : 32768 + 16384, e_hi = part == 0 ? 32768 + 16384 : 32768 + 65536;
    for (int pi = e_lo + tid; pi < e_hi; pi += NTHR) {
        float v2[2];
        if (pi < 32768) { const int n = pi >> 7, k0 = (pi & 127) * 2; const int dir = n >> 7, p = (n >> 1) & 63, ri = n & 1;
#pragma unroll
            for (int z = 0; z < 2; ++z) { const int k = k0 + z, hh = k >> 4, j = k & 15; const int tau = dir == 0 ? 15 - j : j; const f32x2 a = apow[(dir * 17 + tau) * 64 + p], bq = bbar[(dir * 64 + p) * 16 + hh];
                v2[z] = ri == 0 ? a.x * bq.x - a.y * bq.y : a.x * bq.y + a.y * bq.x; }
            *(unsigned*)(EST + (size_t)n * 256 + k0) = pk2(v2[0], v2[1]); }
        else { const int q = pi - 32768, n = q >> 8, k0 = (q & 255) * 2; const int j = n >> 4, h = n & 15;
#pragma unroll
            for (int z = 0; z < 2; ++z) { const int k = k0 + z; float v;
                if (k < 256) { const int hh = k >> 4, ii = k & 15; v = 0.f;
                    if (ii <= j) v += Kd[((0 * 16 + (j - ii)) * 16 + h) * 16 + hh];
                    if (ii >= j) v += Kd[((1 * 16 + (ii - j)) * 16 + h) * 16 + hh];
                    if (ii == j && h == hh) v += dsk[h]; }
                else { const int comp = k - 256, dir = comp >> 7, p = (comp >> 1) & 63, ri = comp & 1; const int tau = dir == 0 ? j + 1 : 16 - j;
                    const f32x2 a = apow[(dir * 17 + tau) * 64 + p], c = Cc[(dir * 16 + h) * 64 + p];
                    v = ri == 0 ? (c.x * a.x - c.y * a.y) : -(c.x * a.y + c.y * a.x); }
                v2[z] = v; }
            *(unsigned*)(MOUT + (size_t)n * 512 + k0) = pk2(v2[0], v2[1]); } }
    __syncthreads();
}
__device__ __forceinline__ void p0_prologue(Frame& F_) { Frame F = relocal(F_);
    PB(10); p0_transposes(F);
    __syncthreads(); PE(10);
    for (int i = F.vcu * NTHR + F.tid; i < 2 * 128 * 384 / 8; i += F.G * NTHR) { const int l = i / (128 * 384 / 8), r = i % (128 * 384 / 8);
        *(v4u*)(WSP(bf16, WS_GLU) + (size_t)l * 512 * 384 + 384 * 384 + (size_t)r * 8) = (v4u){0u, 0u, 0u, 0u}; }
    constexpr int I_S5 = 96, I_MOD = 96, I_FOLD = 128, I_FIL = 544, I_DFT = 65, I_DFTC = 4, NIT = I_S5 + I_MOD + I_FOLD + I_FIL + I_DFT + I_DFTC;
    for (int it = wq_next(F, 0); it < NIT; it = wq_next(F, 0)) {
        int r = it;
        if (r < I_S5) { PB(14); p0_s5_item(F, r); PE(14); continue; } r -= I_S5;
        if (r < I_MOD) { PB(12); p0_mod_item(F, r); PE(12); continue; } r -= I_MOD;
        if (r < I_FOLD) { PB(13); p0_fold_item(F, r); PE(13); continue; } r -= I_FOLD;
        if (r < I_FIL) { PB(11); p0_filter_item(F, r); PE(11); continue; } r -= I_FIL;
        if (r < I_DFT) { PB(15); gen_fft_mats(F, r); PE(15); continue; } r -= I_DFT;
        gen_dft_rows(WSP(bf16, WS_DFTC), LC, r * 64, 64, 1.0f / 16.0f, F.tid);
    }
}
__device__ __forceinline__ void p1_item(Frame& F_, int item) { Frame F = relocal(F_);
    const int qt = item & 3, ocb = (item >> 2) % 24, ls = (item >> 2) / 24, set = ls & 1, l = ls >> 1, o = ocb / 12, cb = ocb % 12, tid = F.tid;
    const int LL = set ? LC : L, nbt = set ? 1 : 4;
    if (set && qt) return;
    LAS float* red = (LAS float*)F.lds;
    LAS float* inv = red + 512;
    LAS float* T = inv + 32;
    const float* PS = WSP(float, WS_PS) + ((size_t)l * 272 + (set ? 256 : 0)) * 1536;
    { const int ch = tid & 31, part = tid >> 5; float s = 0.f; const int nblk = LL / 16;
      for (int b = part; b < nblk; b += 16) s += PS[(size_t)b * 1536 + o * 384 + cb * 32 + ch] + PS[(size_t)b * 1536 + 768 + o * 384 + cb * 32 + ch];
      red[part * 32 + ch] = s; }
    __syncthreads();
    if (tid < 32) { float s = 0.f; for (int p = 0; p < 16; ++p) s += red[p * 32 + tid]; inv[tid] = 1.0f / s; }
    const float* HT = WSP(float, WS_HT) + ((size_t)l * 4352 + (set ? 4096 : 0)) * 1536;
    bf16* KR = set ? WSP(bf16, WS_KTC) + ((size_t)(l * 2 + o) * 384) * 512 : WSP(bf16, WS_KT) + ((size_t)(l * 2 + o) * 384) * 8192;
#pragma unroll 1
    for (int bi = 0; bi < nbt; ++bi) { const int pos0 = (qt * nbt + bi) * 256;
        { const int ch = tid & 31, dir = (tid >> 5) & 1;
#pragma unroll 8
          for (int i = 0; i < 32; ++i) { const int pp = (tid >> 6) + 8 * i; T[(dir * 256 + pp) * 33 + ch] = HT[(size_t)(pos0 + pp) * 1536 + dir * 768 + o * 384 + cb * 32 + ch]; } }
        __syncthreads();
        { const int pp = tid & 255, c0 = tid >> 8;
#pragma unroll 4
          for (int i = 0; i < 16; ++i) { const int ch = c0 + 2 * i; const int pos = pos0 + pp; bf16* kr = KR + (size_t)(cb * 32 + ch) * 2 * LL;
              kr[LL - 1 - pos] = (bf16)f2bf(T[(0 * 256 + pp) * 33 + ch] * inv[ch]);
              if (pos > 0) kr[LL - 1 + pos] = (bf16)f2bf(T[(1 * 256 + pp) * 33 + ch] * inv[ch]); else kr[2 * LL - 1] = (bf16)0; } }
        __syncthreads(); }
}

__device__ __forceinline__ void norm_rows(Frame& F_, const float* xlat, const float* xctx, int nrows, const float* gain, const float* mod, int sh_off, int sc_off, bf16* out) { Frame F = relocal(F_);
    const int gw = F.vcu * NWAVES + F.wave, NGW = F.G * NWAVES, lane = F.lane;
    const int per = (nrows + NGW - 1) / NGW, rbeg = gw * per, rend = (rbeg + per < nrows) ? rbeg + per : nrows;
    f32x4 g4[4], gs[4], sh[4]; int cb = -1;
#pragma unroll
    for (int j = 0; j < 4; ++j) { g4[j] = *(const f32x4*)(gain + (64 * j + lane) * 4); gs[j] = g4[j]; sh[j] = g4[j]; }
    for (int r0 = rbeg; r0 < rend; r0 += 2) {
        f32x4 v[2][4];
#pragma unroll
        for (int q = 0; q < 2; ++q) { const int r = r0 + q; if (r < rend) { const float* xr = r < NL ? xlat + (size_t)r * D : xctx + (size_t)(r - NL) * D;
#pragma unroll
            for (int j = 0; j < 4; ++j) v[q][j] = __builtin_nontemporal_load(&((const f32x4*)xr)[64 * j + lane]); } }
#pragma unroll
        for (int q = 0; q < 2; ++q) { const int r = r0 + q;
            if (r < rend) { float ss = 0.f;
#pragma unroll
                for (int j = 0; j < 4; ++j) ss += (v[q][j].x * v[q][j].x + v[q][j].y * v[q][j].y) + (v[q][j].z * v[q][j].z + v[q][j].w * v[q][j].w);
                const float rstd = 1.0f / sqrtf(wave_sum(ss, lane) * (1.0f / D) + 1e-6f);
                const int bi = bidx_of(r);
                if (bi != cb) { cb = bi; const float* md = mod + (size_t)bi * 6144;
#pragma unroll
                    for (int j = 0; j < 4; ++j) { const int col = (64 * j + lane) * 4; gs[j] = g4[j] * (*(const f32x4*)(md + sc_off + col) + 1.0f); sh[j] = *(const f32x4*)(md + sh_off + col); } }
#pragma unroll
                for (int j = 0; j < 4; ++j) { const int col = (64 * j + lane) * 4; const f32x4 h = v[q][j] * rstd * gs[j] + sh[j];
                    *(v2u*)(out + (size_t)r * D + col) = (v2u){pk2(h.x, h.y), pk2(h.z, h.w)}; } } }
    }
}
__device__ __forceinline__ void norm_rows_b16(Frame& F_, const bf16* x, int nrows, const float* gain, const float* mod, int sh_off, int sc_off, bf16* out, int row0 = 0) { Frame F = relocal(F_);
    const int gw = F.vcu * NWAVES + F.wave, NGW = F.G * NWAVES, lane = F.lane;
    const int per = (nrows + NGW - 1) / NGW, rbeg = row0 + gw * per, rend = (rbeg + per < row0 + nrows) ? rbeg + per : row0 + nrows;
    float g[2][8], gs[2][8], sh[2][8]; int cb = -1;
#pragma unroll
    for (int j = 0; j < 2; ++j)
#pragma unroll
        for (int i4 = 0; i4 < 2; ++i4) { const f32x4 t = *(const f32x4*)(gain + 512 * j + 8 * lane + 4 * i4); g[j][4 * i4] = t.x; g[j][4 * i4 + 1] = t.y; g[j][4 * i4 + 2] = t.z; g[j][4 * i4 + 3] = t.w; }
#pragma unroll
    for (int j = 0; j < 2; ++j)
#pragma unroll
        for (int i = 0; i < 8; ++i) { gs[j][i] = g[j][i]; sh[j][i] = 0.f; }
    for (int r0 = rbeg; r0 < rend; r0 += 2) {
        v4u raw[2][2];
#pragma unroll
        for (int q = 0; q < 2; ++q) { const int r = r0 + q; if (r < rend) {
#pragma unroll
            for (int j = 0; j < 2; ++j) raw[q][j] = *(const v4u*)(x + (size_t)r * D + 512 * j + 8 * lane); } }
#pragma unroll
        for (int q = 0; q < 2; ++q) { const int r = r0 + q;
            if (r < rend) { float v[2][8]; float ss = 0.f;
#pragma unroll
                for (int j = 0; j < 2; ++j) { const v4u u = raw[q][j]; v[j][0] = bf2f(u.x & 0xffffu); v[j][1] = bf2f(u.x >> 16); v[j][2] = bf2f(u.y & 0xffffu); v[j][3] = bf2f(u.y >> 16); v[j][4] = bf2f(u.z & 0xffffu); v[j][5] = bf2f(u.z >> 16); v[j][6] = bf2f(u.w & 0xffffu); v[j][7] = bf2f(u.w >> 16);
#pragma unroll
                    for (int i = 0; i < 8; ++i) ss += v[j][i] * v[j][i]; }
                const float rstd = 1.0f / sqrtf(wave_sum(ss, lane) * (1.0f / D) + 1e-6f);
                const int bi = bidx_of(r);
                if (bi != cb) { cb = bi; const float* md = mod + (size_t)bi * 6144;
#pragma unroll
                    for (int j = 0; j < 2; ++j)
#pragma unroll
                        for (int i4 = 0; i4 < 2; ++i4) { const int col = 512 * j + 8 * lane + 4 * i4; const f32x4 sc = *(const f32x4*)(md + sc_off + col), sv = *(const f32x4*)(md + sh_off + col);
                            gs[j][4 * i4] = g[j][4 * i4] * (sc.x + 1.0f); gs[j][4 * i4 + 1] = g[j][4 * i4 + 1] * (sc.y + 1.0f); gs[j][4 * i4 + 2] = g[j][4 * i4 + 2] * (sc.z + 1.0f); gs[j][4 * i4 + 3] = g[j][4 * i4 + 3] * (sc.w + 1.0f);
                            sh[j][4 * i4] = sv.x; sh[j][4 * i4 + 1] = sv.y; sh[j][4 * i4 + 2] = sv.z; sh[j][4 * i4 + 3] = sv.w; } }
#pragma unroll
                for (int j = 0; j < 2; ++j) { const int col = 512 * j + 8 * lane; float h[8];
#pragma unroll
                    for (int i = 0; i < 8; ++i) h[i] = v[j][i] * rstd * gs[j][i] + sh[j][i];
                    *(v4u*)(out + (size_t)r * D + col) = (v4u){pk2(h[0], h[1]), pk2(h[2], h[3]), pk2(h[4], h[5]), pk2(h[6], h[7])}; } } }
    }
}
__device__ __forceinline__ float bperm_f(int srclane, float v) { return __builtin_bit_cast(float, __builtin_amdgcn_ds_bpermute(srclane << 2, __builtin_bit_cast(int, v))); }
__device__ __forceinline__ void norm2_router(Frame& F_, const float* x, const float* gain, const float* mod, bf16* out) { Frame F = relocal(F_);
    LAS int* hist = (LAS int*)F.lds;
    const float* rw = F.in[34]; const float* rb = F.in[35]; const int lane = F.lane;
    f32x4 w0[4][4], w1[4][4], g4[4];
#pragma unroll
    for (int j = 0; j < 4; ++j) { const int col = (64 * j + lane) * 4; g4[j] = *(const f32x4*)(gain + col);
#pragma unroll
        for (int q = 0; q < 4; ++q) { w0[j][q] = *(const f32x4*)(rw + (size_t)(col + q) * 8); w1[j][q] = *(const f32x4*)(rw + (size_t)(col + q) * 8 + 4); } }
    float rbv[8];
#pragma unroll
    for (int e = 0; e < 8; ++e) rbv[e] = rb[e];
    const bool h5 = (lane & 32) != 0, h4 = (lane & 16) != 0, h3 = (lane & 8) != 0;
    for (int tile = F.vcu; tile < NL / 256; tile += F.G) {
        if (F.tid < 16) hist[F.tid] = 0;
        __syncthreads();
        const float* md = mod + (size_t)((tile * 256) >> 12) * 6144;
        f32x4 gs[4], sh[4];
#pragma unroll
        for (int j = 0; j < 4; ++j) { const int col = (64 * j + lane) * 4; gs[j] = g4[j] * (*(const f32x4*)(md + 4096 + col) + 1.0f); sh[j] = *(const f32x4*)(md + 3072 + col); }
        f32x4 vn[4];
        { const float* xr0 = x + (size_t)(tile * 256 + F.wave * 32) * D;
#pragma unroll
          for (int j = 0; j < 4; ++j) vn[j] = ((const f32x4*)xr0)[64 * j + lane]; }
#pragma unroll 1
        for (int i = 0; i < 32; ++i) { const int r = tile * 256 + F.wave * 32 + i;
            f32x4 v[4]; float ss = 0.f;
#pragma unroll
            for (int j = 0; j < 4; ++j) v[j] = vn[j];
            if (i + 1 < 32) { const float* xn = x + (size_t)(r + 1) * D;
#pragma unroll
                for (int j = 0; j < 4; ++j) vn[j] = ((const f32x4*)xn)[64 * j + lane]; }
#pragma unroll
            for (int j = 0; j < 4; ++j) ss += (v[j].x * v[j].x + v[j].y * v[j].y) + (v[j].z * v[j].z + v[j].w * v[j].w);
            const float rstd = 1.0f / sqrtf(wave_sum(ss, lane) * (1.0f / D) + 1e-6f);
            f32x4 la = (f32x4){0.f, 0.f, 0.f, 0.f}, lb = la;
#pragma unroll
            for (int j = 0; j < 4; ++j) { const int col = (64 * j + lane) * 4; const f32x4 h = v[j] * rstd * gs[j] + sh[j];
                *(v2u*)(out + (size_t)r * D + col) = (v2u){pk2(h.x, h.y), pk2(h.z, h.w)};
#pragma unroll
                for (int q = 0; q < 4; ++q) { la += w0[j][q] * h[q]; lb += w1[j][q] * h[q]; } }
            f32x4 k4; { const f32x4 snd = h5 ? la : lb, kp = h5 ? lb : la; k4.x = kp.x + bperm_f(lane ^ 32, snd.x); k4.y = kp.y + bperm_f(lane ^ 32, snd.y); k4.z = kp.z + bperm_f(lane ^ 32, snd.z); k4.w = kp.w + bperm_f(lane ^ 32, snd.w); }
            float k2a, k2b; { const float s0 = h4 ? k4.x : k4.z, s1 = h4 ? k4.y : k4.w, p0 = h4 ? k4.z : k4.x, p1 = h4 ? k4.w : k4.y; k2a = p0 + bperm_f(lane ^ 16, s0); k2b = p1 + bperm_f(lane ^ 16, s1); }
            float k1; { const float s0 = h3 ? k2a : k2b, p0 = h3 ? k2b : k2a; k1 = p0 + bperm_f(lane ^ 8, s0); }
            k1 += bperm_f(lane ^ 4, k1); k1 += bperm_f(lane ^ 2, k1); k1 += bperm_f(lane ^ 1, k1);
            float lg[8];
#pragma unroll
            for (int e = 0; e < 8; ++e) lg[e] = __builtin_bit_cast(float, __builtin_amdgcn_readlane(__builtin_bit_cast(int, k1), 8 * e)) + rbv[e];
            int e1 = 0; float v1 = lg[0];
#pragma unroll
            for (int e = 1; e < 8; ++e) if (lg[e] > v1) { v1 = lg[e]; e1 = e; }
            int e2 = -1; float v2 = -3.4e38f;
#pragma unroll
            for (int e = 0; e < 8; ++e) if (e != e1 && lg[e] > v2) { v2 = lg[e]; e2 = e; }
            if (lane == 0) {
                const float ex = __expf(v2 - v1), w1s = 1.0f / (1.0f + ex), w2s = ex / (1.0f + ex);
                *(v4u*)(F.ws + WS_TOPK + (size_t)r * 16) = (v4u){(unsigned)(e1 | (e2 << 8)), __builtin_bit_cast(unsigned, w1s), __builtin_bit_cast(unsigned, w2s), 0u};
                __hip_atomic_fetch_add(hist + e1, 1, __ATOMIC_RELAXED, __HIP_MEMORY_SCOPE_WORKGROUP); __hip_atomic_fetch_add(hist + 8 + e2, 1, __ATOMIC_RELAXED, __HIP_MEMORY_SCOPE_WORKGROUP);
            } }
        __syncthreads();
        if (F.tid < 16) ((int*)(F.ws + WS_META + META_CNT))[tile * 16 + F.tid] = hist[F.tid];
        __syncthreads();
    }
}
__device__ __forceinline__ void moe_slots(Frame& F_) { Frame F = relocal(F_);
    LAS int* tot = (LAS int*)F.lds;
    LAS int* es = tot + 32;
    const int* CNT = (const int*)(F.ws + WS_META + META_CNT); int* IDX = (int*)(F.ws + WS_META + META_IDX); int* TE = (int*)(F.ws + WS_META + META_TE); int* NT = (int*)(F.ws + WS_META + META_NT);
    for (int it = F.vcu; it < 512; it += F.G) { const int k = it >> 8, tile = it & 255, tid = F.tid;
        if (tid < 8) { int t = 0, b = 0; for (int i = 0; i < 256; ++i) { const int c = CNT[i * 16 + k * 8 + tid]; if (i < tile) b += c; t += c; } tot[tid] = t; tot[8 + tid] = b; }
        __syncthreads();
        if (tid == 0) { int s = 0; for (int e = 0; e < 8; ++e) { tot[16 + e] = s; s += (tot[e] + 255) & ~255; } tot[24] = s; }
        if (tid < 256) { const unsigned pk = *(const unsigned*)(F.ws + WS_TOPK + (size_t)(tile * 256 + tid) * 16); es[tid] = k == 0 ? (int)(pk & 255u) : (int)((pk >> 8) & 255u); }
        __syncthreads();
        if (tid < 256) { const int e = es[tid]; int rank = 0; for (int j = 0; j < tid; ++j) rank += (es[j] == e) ? 1 : 0;
            const int slot = tot[16 + e] + tot[8 + e] + rank; IDX[k * MAXSLOT + slot] = tile * 256 + tid; if (k == 1) ((int*)(F.ws + WS_META + META_SL1))[tile * 256 + tid] = slot; }
        if (tile == 0) {
            for (int e = 0; e < 8; ++e) { const int n = tot[e], np = (n + 255) & ~255, sb = tot[16 + e];
                for (int i = n + tid; i < np; i += NTHR) IDX[k * MAXSLOT + sb + i] = -1;
                for (int i = tid; i < np / 256; i += NTHR) TE[k * 272 + sb / 256 + i] = e; }
            if (tid == 0) NT[k] = tot[24] / 256; }
        __syncthreads();
    }
}
__device__ __forceinline__ void final_norm_part(Frame& F_, int part, int ntw) { Frame F = relocal(F_);
    const int bx = (int)blockIdx.x; if (part == 0 && bx < ntw) return;
    const int gw = part == 0 ? (bx - ntw) * NWAVES + F.wave : F.vcu * NWAVES + F.wave, NGW = (part == 0 ? F.G - ntw : F.G) * NWAVES, lane = F.lane; const float* gain = F.in[39];
    const int* SL1 = (const int*)(F.ws + WS_META + META_SL1);
    f32x4 gf[4];
#pragma unroll
    for (int j = 0; j < 4; ++j) gf[j] = *(const f32x4*)(gain + (64 * j + lane) * 4);
    for (int r0 = gw; r0 < NL; r0 += 2 * NGW) { f32x4 v[2][4]; bool ok[2];
#pragma unroll
        for (int q = 0; q < 2; ++q) { const int r = r0 + q * NGW; ok[q] = r < NL && ((SL1[r < NL ? r : 0] >= NL) == (part == 1)); if (ok[q]) { const float* xr = F.out + (size_t)r * D;
#pragma unroll
            for (int j = 0; j < 4; ++j) v[q][j] = ((const f32x4*)xr)[64 * j + lane]; } }
#pragma unroll
        for (int q = 0; q < 2; ++q) { const int r = r0 + q * NGW; if (ok[q]) { float* xr = F.out + (size_t)r * D; float ss = 0.f;
#pragma unroll
            for (int j = 0; j < 4; ++j) ss += (v[q][j].x * v[q][j].x + v[q][j].y * v[q][j].y) + (v[q][j].z * v[q][j].z + v[q][j].w * v[q][j].w);
            const float rstd = 1.0f / sqrtf(wave_sum(ss, lane) * (1.0f / D) + 1e-6f);
#pragma unroll
            for (int j = 0; j < 4; ++j) ((f32x4*)xr)[64 * j + lane] = v[q][j] * rstd * gf[j]; } } }
}

__device__ __forceinline__ float sconv(const bf16* prow, int colbase, int t, int LL, bool grid, float w0, float w1, float w2, float bias) {
    const bool hasl = grid ? ((t & 63) != 0) : (t > 0), hasr = grid ? ((t & 63) != 63) : (t < LL - 1);
    const float c = bf2f(prow[colbase + t]), a = hasl ? bf2f(prow[colbase + t - 1]) : 0.f, b = hasr ? bf2f(prow[colbase + t + 1]) : 0.f;
    return a * w0 + c * w1 + b * w2 + bias;
}
template <int LL, int NTW, bool GRID>
__device__ __forceinline__ void hyena_wave(Frame& F, int l, int o, int c, int T0, int mmin) {
    constexpr int NSG = LL / 128;
    const int lane = F.lane, fr = lane & 15, fq = lane >> 4;
    LAS unsigned char* VT = F.lds;
    const float* cw = F.in[11] + (size_t)l * 3 * 1152; const float* cb = F.in[12] + (size_t)l * 1152;
    const bf16* inrow = (o == 0 ? WSP(bf16, WS_VP) : WSP(bf16, WS_Z1)) + (size_t)c * MT;
    const bf16* mulrow = WSP(bf16, WS_PT) + (size_t)(R_HY + 384 * (o + 1) + c) * MT;
    bf16* outrow = o == 0 ? WSP(bf16, WS_Z1) + (size_t)c * MT : WSP(bf16, WS_PT) + (size_t)(R_HY + 384 + c) * MT;
    const int colb = GRID ? fr * L : NL + fr * LC;
    f32x4 acc[NTW];
#pragma unroll
    for (int i = 0; i < NTW; ++i) acc[i] = (f32x4){0.f, 0.f, 0.f, 0.f};
    const int E0 = 8 * fq - fr - T0 - mmin - 16 * (NTW - 1);
    const int lbA = ((E0 & ~15) | ((E0 & 15) ^ (((E0 >> 4) & 1) << 3))) * 16, lbB = lbA ^ 128;
    const bf16* bp = inrow + colb + 8 * fq;
    v4u ra[4], rb[4];
#pragma unroll
    for (int jj = 0; jj < 4; ++jj) { ra[jj] = *(const v4u*)(bp + jj * 32); rb[jj] = *(const v4u*)(bp + 128 + jj * 32); }
#define HY_GROUP(sg, R) do { bf16x8 Bf[4]; _Pragma("unroll") for (int jj = 0; jj < 4; ++jj) Bf[jj] = __builtin_bit_cast(bf16x8, R[jj]); \
        if ((sg) + 2 < NSG) { _Pragma("unroll") for (int jj = 0; jj < 4; ++jj) R[jj] = *(const v4u*)(bp + ((sg) + 2) * 128 + jj * 32); } \
        const LAS unsigned char* vtA = VT + lbA + (sg) * 2048; const LAS unsigned char* vtB = VT + lbB + (sg) * 2048; \
        bf16x8 Ar[NBUF]; \
        _Pragma("unroll") for (int q = 0; q < NBUF; ++q) Ar[q] = *(const LAS bf16x8*)((((NTW + 5 - q) & 1) ? vtB : vtA) + 256 * (NTW + 5 - q)); \
        _Pragma("unroll") for (int dd = 0; dd < ND; ++dd) { const int e = dd - 6; const bf16x8 A = Ar[dd % NBUF]; \
            _Pragma("unroll") for (int jj = 0; jj < 4; ++jj) { const int i = e + 2 * jj; if (i >= 0 && i < NTW) acc[i] = __builtin_amdgcn_mfma_f32_16x16x32_bf16(A, Bf[jj], acc[i], 0, 0, 0); } \
            if (dd + NBUF < ND) Ar[dd % NBUF] = *(const LAS bf16x8*)((((NTW + 5 - dd - NBUF) & 1) ? vtB : vtA) + 256 * (NTW + 5 - dd - NBUF)); \
            __builtin_amdgcn_sched_barrier(0); } } while (0)
    constexpr int ND = NTW + 6, NBUF = ND < 4 ? ND : 4;
#pragma unroll 1
    for (int sg = 0; sg < NSG; sg += 2) { HY_GROUP(sg, ra); HY_GROUP(sg + 1, rb); }
#undef HY_GROUP
    PE(3); PB(4);
    const float hb = F.in[20][((size_t)l * 2 + o) * 384 + c];
    const int mch = 384 * (o + 1) + c; const float m0 = cw[mch], m1 = cw[1152 + mch], m2 = cw[2304 + mch], mb = cb[mch];
    constexpr int EB = NTW > 16 ? NTW / 2 : NTW;
#pragma unroll
    for (int i0 = 0; i0 < NTW; i0 += EB) {
        v4u xw[EB]; v2u ur[EB];
#pragma unroll
        for (int q = 0; q < EB; ++q) { const int t = T0 + 16 * (i0 + q) + 4 * fq;
            const U16B w = *(const U16B*)(mulrow + colb + t - 2); xw[q] = (v4u){w.x, w.y, w.z, w.w};
            ur[q] = *(const v2u*)(inrow + colb + t); }
#pragma unroll
        for (int q = 0; q < EB; ++q) { const int i = i0 + q; const int t = T0 + 16 * i + 4 * fq;
            float x[6], u[4];
            const bool hl = GRID ? ((t & 63) != 0) : (t > 0), hr = GRID ? (((t + 3) & 63) != 63) : (t + 4 < LL);
            x[0] = hl ? bf2f((unsigned short)(xw[q].x >> 16)) : 0.f; x[5] = hr ? bf2f((unsigned short)(xw[q].w & 0xffffu)) : 0.f; x[1] = bf2f(xw[q].y & 0xffffu); x[2] = bf2f(xw[q].y >> 16); x[3] = bf2f(xw[q].z & 0xffffu); x[4] = bf2f(xw[q].z >> 16);
            u[0] = bf2f(ur[q].x & 0xffffu); u[1] = bf2f(ur[q].x >> 16); u[2] = bf2f(ur[q].y & 0xffffu); u[3] = bf2f(ur[q].y >> 16);
            float ov[4];
#pragma unroll
            for (int r = 0; r < 4; ++r) { const float xm = x[r] * m0 + x[r + 1] * m1 + x[r + 2] * m2 + mb; ov[r] = xm * (acc[i][r] + hb * u[r]); }
            *(v2u*)(outrow + colb + t) = (v2u){pk2(ov[0], ov[1]), pk2(ov[2], ov[3])}; }
    }
}
template <int LL, int NTWA, bool GRID, int NTWB = NTWA>
__device__ __forceinline__ void hyena_job(Frame& F, int l, int o, int c, int tbase) {
    constexpr int TR = (NWAVES / 2) * (NTWA + NTWB) * 16, NENT = LL - 8 + TR;
    const int tid = F.tid, lane = F.lane, fr = lane & 15, fq = lane >> 4;
    const int mmin = -tbase - TR + 1;
    LAS unsigned char* VT = F.lds;
    PB(2);
    {   const bf16* KR = (GRID ? WSP(bf16, WS_KT) + ((size_t)(l * 2 + o) * 384 + c) * 8192 : WSP(bf16, WS_KTC) + ((size_t)(l * 2 + o) * 384 + c) * 512) + (mmin + LL - 1);
        for (int e = tid; e < NENT; e += NTHR) { const U16B u = *(const U16B*)(KR + e);
            *(LAS v4u*)(VT + (e ^ (((e >> 4) & 1) << 3)) * 16) = (v4u){u.x, u.y, u.z, u.w}; } }
    __syncthreads();
    PE(2); PB(3);
    if (NTWA == NTWB) hyena_wave<LL, NTWA, GRID>(F, l, o, c, tbase + F.wave * NTWA * 16, mmin);
    else if (F.wave < 4) hyena_wave<LL, NTWA, GRID>(F, l, o, c, tbase + F.wave * (NTWA + NTWB) * 16, mmin);
    else hyena_wave<LL, NTWB, GRID>(F, l, o, c, tbase + (F.wave - 4) * (NTWA + NTWB) * 16 + NTWA * 16, mmin);
    __syncthreads();
    PE(4);
}
__device__ __forceinline__ void shortconv_v(Frame& F_, int l) { Frame F = relocal(F_);
    const float* cw = F.in[11] + (size_t)l * 3 * 1152; const float* cb = F.in[12] + (size_t)l * 1152;
    const int ncol8 = (l == 0 ? MT : NL) / 8; const long total = (long)384 * ncol8;
    const long stride = (long)F.G * NTHR;
    for (long it0 = (long)F.vcu * NTHR + F.tid; it0 < total; it0 += 2 * stride) {
        v4u raw[2]; v2u nxt[2]; int cc[2], colv[2]; bool ok[2], hls[2], hrs[2];
#pragma unroll
        for (int q = 0; q < 2; ++q) { const long it = it0 + q * stride; ok[q] = it < total; cc[q] = 0; colv[q] = 0; raw[q] = (v4u){0u, 0u, 0u, 0u}; nxt[q] = (v2u){0u, 0u}; hls[q] = false; hrs[q] = false;
            if (ok[q]) { const int c = (int)(it / ncol8), col = (int)(it % ncol8) * 8; cc[q] = c; colv[q] = col;
                const bf16* p = WSP(bf16, WS_PT) + (size_t)(R_HY + c) * MT + col;
                bool hl, hr; if (col < NL) { hl = (col & 63) != 0; hr = ((col + 7) & 63) != 63; } else { const int t = (col - NL) & (LC - 1); hl = t != 0; hr = t + 8 < LC; }
                const U16B a = *(const U16B*)(p - 2); const U8B b = *(const U8B*)(p + 6); raw[q] = (v4u){a.x, a.y, a.z, a.w}; nxt[q] = (v2u){b.x, b.y}; hls[q] = hl; hrs[q] = hr; } }
#pragma unroll
        for (int q = 0; q < 2; ++q) if (ok[q]) { const int c = cc[q]; float qv[10]; qv[0] = hls[q] ? bf2f((unsigned short)(raw[q].x >> 16)) : 0.f; qv[9] = hrs[q] ? bf2f((unsigned short)(nxt[q].y & 0xffffu)) : 0.f;
            qv[1] = bf2f(raw[q].y & 0xffffu); qv[2] = bf2f(raw[q].y >> 16); qv[3] = bf2f(raw[q].z & 0xffffu); qv[4] = bf2f(raw[q].z >> 16); qv[5] = bf2f(raw[q].w & 0xffffu); qv[6] = bf2f(raw[q].w >> 16); qv[7] = bf2f(nxt[q].x & 0xffffu); qv[8] = bf2f(nxt[q].x >> 16);
            const float w0 = cw[c], w1 = cw[1152 + c], w2 = cw[2304 + c], bs = cb[c]; float r[8];
#pragma unroll
            for (int j = 0; j < 8; ++j) r[j] = qv[j] * w0 + qv[j + 1] * w1 + qv[j + 2] * w2 + bs;
            *(v4u*)(WSP(bf16, WS_VP) + (size_t)c * MT + colv[q]) = (v4u){pk2(r[0], r[1]), pk2(r[2], r[3]), pk2(r[4], r[5]), pk2(r[6], r[7])}; } }
}
__device__ __forceinline__ void hyena_stage(Frame& F_, int l, int o) { Frame F = relocal(F_);
    const int nlat = 384 * 2, nctx = l == 0 ? 384 : 0;
    for (int u = F.vcu; u < nlat + nctx; u += F.G) {
        if (u < nlat) hyena_job<L, 20, true, 12>(F, l, o, u >> 1, (u & 1) * 2048);
        else hyena_job<LC, 2, false>(F, l, o, u - nlat, 0);
    }
}
__device__ __forceinline__ void hyena_transpose(Frame& F_, int nrows) { Frame F = relocal(F_);
    LAS bf16* T = (LAS bf16*)F.lds; constexpr int PITCH = 264;
    const bf16* PT = WSP(bf16, WS_PT); bf16* Y = WSP(bf16, WS_HMOD); const int tid = F.tid;
    const int nrt = nrows / 256;
    for (int it = F.vcu; it < 6 * nrt; it += F.G) { const int cb = it % 6, rt = it / 6;
        { const int c = tid >> 3, seg = tid & 7; const bf16* src = PT + (size_t)(R_HY + 384 + cb * 64 + c) * MT + rt * 256 + seg * 32;
#pragma unroll
          for (int q = 0; q < 4; ++q) *(LAS v4u*)(T + c * PITCH + seg * 32 + q * 8) = *(const v4u*)(src + q * 8); }
        __syncthreads();
        { const int tp = tid & 127, cg = tid >> 7; unsigned we[8], wo[8];
          const LAS unsigned* Tw = (const LAS unsigned*)T;
#pragma unroll
          for (int q = 0; q < 8; ++q) { const unsigned d0 = Tw[(cg * 16 + 2 * q) * (PITCH / 2) + tp], d1 = Tw[(cg * 16 + 2 * q + 1) * (PITCH / 2) + tp];
              we[q] = __builtin_amdgcn_perm(d1, d0, 0x05040100u); wo[q] = __builtin_amdgcn_perm(d1, d0, 0x07060302u); }
          bf16* dst = Y + (size_t)(rt * 256 + 2 * tp) * D + 256 + cb * 64 + cg * 16;
          *(v4u*)dst = (v4u){we[0], we[1], we[2], we[3]}; *(v4u*)(dst + 8) = (v4u){we[4], we[5], we[6], we[7]};
          *(v4u*)(dst + D) = (v4u){wo[0], wo[1], wo[2], wo[3]}; *(v4u*)(dst + D + 8) = (v4u){wo[4], wo[5], wo[6], wo[7]}; }
        __syncthreads();
    }
}

__device__ __forceinline__ void s5_carry_item(Frame& F, int l, int item) {
    const float* E = (const float*)((unsigned char*)F.out + DO_E); bf16* HS = (bf16*)((unsigned char*)F.out + DO_HS);
    const int id = item * NTHR + F.tid;
    const int p = id & 63, dir = (id >> 6) & 1, g = (id >> 7) % 24, b = id / (128 * 24);
    const size_t ix = (((size_t)l * 2 + dir) * 24 + g) * 64 + p; const float ar = WSP(float, WS_A16)[ix * 2], ai = WSP(float, WS_A16)[ix * 2 + 1];
    const int comp = dir * 128 + 2 * p, q = comp >> 4, i0 = comp & 15;
    float sr = 0.f, si = 0.f;
#pragma unroll 1
    for (int s0 = 0; s0 < 272; s0 += 8) { f32x2 e[8]; int ci[8];
#pragma unroll
        for (int j = 0; j < 8; ++j) { const int step = s0 + j; int cidx;
            if (dir == 0) cidx = step < 16 ? NL / 16 + b * 16 + step : b * 256 + (step - 16);
            else cidx = step < 16 ? NL / 16 + b * 16 + (15 - step) : b * 256 + (255 - (step - 16));
            ci[j] = cidx; e[j] = *(const f32x2*)(E + ((size_t)g * NCHUNK + cidx) * 256 + comp); }
#pragma unroll
        for (int j = 0; j < 8; ++j) { *(unsigned*)(HS + (size_t)(g * 16 + q) * MT + (size_t)ci[j] * 16 + i0) = pk2(sr, si);
            const float nr = ar * sr - ai * si + e[j].x, ni = ar * si + ai * sr + e[j].y; sr = nr; si = ni; } }
}
__device__ __forceinline__ void hyena_stage2_carry(Frame& F_, int l) { Frame F = relocal(F_);
    const int ncar = 96, nlat = 384 * 2, nctx = l == 0 ? 384 : 0, qid = 1 + l;
    for (int u = wq_next(F, qid); u < ncar + nlat + nctx; u = wq_next(F, qid)) {
        if (u < ncar) s5_carry_item(F, l, u);
        else if (u < ncar + nlat) hyena_job<L, 20, true, 12>(F, l, 1, (u - ncar) >> 1, ((u - ncar) & 1) * 2048);
        else hyena_job<LC, 2, false>(F, l, 1, u - ncar - nlat, 0);
    }
}

struct A_WinT { const bf16* w; __device__ __forceinline__ const bf16* operator()(int, int r, int k) const { return w + (size_t)r * D + k; } };
struct E_PT { bf16* pt; __device__ __forceinline__ void operator()(int, int r, int c, f32x4 v0, f32x4 v1) const {
    *(v2u*)(pt + (size_t)r * MT + c) = (v2u){pk2(v0.x, v0.y), pk2(v0.z, v0.w)}; *(v2u*)(pt + (size_t)r * MT + c + 16) = (v2u){pk2(v1.x, v1.y), pk2(v1.z, v1.w)}; } };
struct E_PT8 { bf16* pt; __device__ __forceinline__ void operator()(int, int r, int c, f32x4 v0, f32x4 v1) const {
    *(v4u*)(pt + (size_t)r * MT + c) = (v4u){pk2(v0.x, v0.y), pk2(v0.z, v0.w), pk2(v1.x, v1.y), pk2(v1.z, v1.w)}; } };
struct A_Dft { const bf16* d; int ld; __device__ __forceinline__ const bf16* operator()(int, int r, int k) const { return d + (size_t)r * ld + k; } };
struct B_FnetLat { const bf16* pt; __device__ __forceinline__ const bf16* operator()(int bt, int n, int k) const { return pt + (size_t)((k >> 12) * 256 + n) * MT + bt * L + (k & 4095); } };
struct B_FnetCtx { const bf16* pt; __device__ __forceinline__ const bf16* operator()(int bt, int n, int k) const { return pt + (size_t)((k >> 8) * 256 + n) * MT + NL + bt * LC + (k & 255); } };
struct E_FA { bf16* ab; __device__ __forceinline__ void one(int m, int c, f32x4 v) const { const int b = c >> 14, n = (c >> 6) & 255, s2 = c & 63, pp = m >> 6, t1 = m & 63;
    *(v2u*)(ab + ((((size_t)b * 256 + n) * 64 + t1) * 2 + pp) * 64 + s2) = (v2u){pk2(v.x, v.y), pk2(v.z, v.w)}; }
    __device__ __forceinline__ void operator()(int, int m, int c, f32x4 v0, f32x4 v1) const { if (m >= 128) return; one(m, c, v0); one(m, c + 16, v1); } };
struct E_FB { bf16* y; __device__ __forceinline__ void operator()(int bt, int r, int c, f32x4 v0, f32x4 v1) const { const int t = 4 * (r >> 8) + ((r >> 6) & 3) + 64 * (r & 63);
    bf16* p = y + ((size_t)bt * L + t) * D + c; *(v2u*)p = (v2u){pk2(v0.x, v0.y), pk2(v0.z, v0.w)}; *(v2u*)(p + 16) = (v2u){pk2(v1.x, v1.y), pk2(v1.z, v1.w)}; } };
struct E_Fnet { bf16* y; int rowbase, rows_per; __device__ __forceinline__ void operator()(int bt, int r, int c, f32x4 v0, f32x4 v1) const { bf16* p = y + (size_t)(rowbase + bt * rows_per + r) * D + c;
    *(v2u*)p = (v2u){pk2(v0.x, v0.y), pk2(v0.z, v0.w)}; *(v2u*)(p + 16) = (v2u){pk2(v1.x, v1.y), pk2(v1.z, v1.w)}; } };
struct A_S5 { const bf16* pt; const bf16* hs; __device__ __forceinline__ const bf16* operator()(int g, int r, int k) const {
    return k < 256 ? pt + (size_t)(R_S5 + g * 16 + (k >> 4)) * MT + (size_t)r * 16 + (k & 15) : hs + (size_t)(g * 16 + ((k - 256) >> 4)) * MT + (size_t)r * 16 + (k & 15); } };
struct B_S5 { const bf16* m; int off, ld; __device__ __forceinline__ const bf16* operator()(int g, int n, int k) const { return (const bf16*)((const unsigned char*)m + (size_t)g * S5M_STRIDE) + off + (size_t)n * ld + k; } };
struct E_S5E { float* e; __device__ __forceinline__ void operator()(int g, int r, int c, f32x4 v0, f32x4 v1) const { float* p = e + ((size_t)g * NCHUNK + r) * 256 + c; *(f32x4*)p = v0; *(f32x4*)(p + 16) = v1; } };
struct E_S5O { bf16* ys; __device__ __forceinline__ void operator()(int g, int r, int c, f32x4 v0, f32x4 v1) const {
    { const int j = c >> 4, h = c & 15; bf16* p = ys + ((size_t)r * 16 + j) * 384 + g * 16 + h; *(v2u*)p = (v2u){pk2(gelu_tanh_f(v0.x), gelu_tanh_f(v0.y)), pk2(gelu_tanh_f(v0.z), gelu_tanh_f(v0.w))}; }
    { const int c1 = c + 16, j = c1 >> 4, h = c1 & 15; bf16* p = ys + ((size_t)r * 16 + j) * 384 + g * 16 + h; *(v2u*)p = (v2u){pk2(gelu_tanh_f(v1.x), gelu_tanh_f(v1.y)), pk2(gelu_tanh_f(v1.z), gelu_tanh_f(v1.w))}; } } };
struct E_Glu { const bf16* ys; bf16* y; const float* gb;
    struct Pre { v2u y0, y1; f32x4 b0, b1; };
    __device__ __forceinline__ Pre pre(int, int r, int c) const { Pre p; p.y0 = (v2u){0u, 0u}; p.y1 = p.y0; p.b0 = (f32x4){0.f, 0.f, 0.f, 0.f}; p.b1 = p.b0;
        if (c < 384) { p.y0 = *(const v2u*)(ys + (size_t)r * 384 + c); p.b0 = *(const f32x4*)(gb + c); } if (c + 16 < 384) { p.y1 = *(const v2u*)(ys + (size_t)r * 384 + c + 16); p.b1 = *(const f32x4*)(gb + c + 16); } return p; }
    __device__ __forceinline__ void one(int r, int c, v2u yv, f32x4 b, f32x4 v) const { if (c >= 384) return;
        const float y0 = bf2f(yv.x & 0xffffu), y1 = bf2f(yv.x >> 16), y2 = bf2f(yv.y & 0xffffu), y3 = bf2f(yv.y >> 16);
        *(v2u*)(y + (size_t)r * D + 640 + c) = (v2u){pk2(y0 * sigmoid_f(v.x + b.x), y1 * sigmoid_f(v.y + b.y)), pk2(y2 * sigmoid_f(v.z + b.z), y3 * sigmoid_f(v.w + b.w))}; }
    __device__ __forceinline__ void post(const Pre& p, int, int r, int c, f32x4 v0, f32x4 v1) const { one(r, c, p.y0, p.b0, v0); one(r, c + 16, p.y1, p.b1, v1); } };
template <bool XI16, bool XO16> struct E_Res {
    const void* xlat; const void* xctx; void* xo; const float* mod; int goff;
    static constexpr int AI_PER_BATCH = XI16 ? 2 : 1;
    struct Gates { f32x4 g[2][2]; };
    struct PreX { v4u u; f32x4 x1; };
    __device__ __forceinline__ Gates gates(int, int r, int c) const { Gates G; const float* g = mod + (size_t)bidx_of(r) * 6144 + goff + c;
        G.g[0][0] = *(const f32x4*)g; G.g[0][1] = *(const f32x4*)(g + 4); G.g[1][0] = *(const f32x4*)(g + 128); G.g[1][1] = *(const f32x4*)(g + 132); return G; }
    __device__ __forceinline__ PreX prex(int, int r, int c) const { PreX p; const void* xb = r < NL ? xlat : xctx; const size_t idx = (size_t)(r < NL ? r : r - NL) * D + c;
        if (XI16) { p.u = *(const v4u*)((const bf16*)xb + idx); p.x1 = (f32x4){0.f, 0.f, 0.f, 0.f}; }
        else { p.u = __builtin_bit_cast(v4u, *(const f32x4*)((const float*)xb + idx)); p.x1 = *(const f32x4*)((const float*)xb + idx + 4); }
        return p; }
    __device__ __forceinline__ void postx(const Gates& G, int bj, const PreX& p, int, int r, int c, f32x4 v0, f32x4 v1) const {
        f32x4 x0, x1;
        if (XI16) { x0 = (f32x4){bf2f(p.u.x & 0xffffu), bf2f(p.u.x >> 16), bf2f(p.u.y & 0xffffu), bf2f(p.u.y >> 16)}; x1 = (f32x4){bf2f(p.u.z & 0xffffu), bf2f(p.u.z >> 16), bf2f(p.u.w & 0xffffu), bf2f(p.u.w >> 16)}; }
        else { x0 = __builtin_bit_cast(f32x4, p.u); x1 = p.x1; }
        const f32x4 o0 = x0 + G.g[bj][0] * v0, o1 = x1 + G.g[bj][1] * v1; const size_t idx = (size_t)r * D + c;
        if (XO16) *(v4u*)((bf16*)xo + idx) = (v4u){pk2(o0.x, o0.y), pk2(o0.z, o0.w), pk2(o1.x, o1.y), pk2(o1.z, o1.w)};
        else { *(f32x4*)((float*)xo + idx) = o0; *(f32x4*)((float*)xo + idx + 4) = o1; } } };
struct E_Swi { bf16* act; int ld; int tail_shift; __device__ __forceinline__ void operator()(int, int r, int c, f32x4 v0, f32x4 v1) const {
    const int f = 16 * (c >> 5) + (c & 15); *(v2u*)(act + tiled_idx(r + (r >= NL ? tail_shift : 0), f, ld / 64)) = (v2u){pk2(silu_f(v0.x) * v1.x, silu_f(v0.y) * v1.y), pk2(silu_f(v0.z) * v1.z, silu_f(v0.w) * v1.w)}; } };
struct A_MoeUp { const bf16* h; const int* idx; __device__ __forceinline__ const bf16* operator()(int, int r, int k) const { int t = idx[r]; t = t < 0 ? 0 : t; return h + (size_t)t * D + k; } };
struct E_MoeDown0 { bf16* o1; const int* idx; const unsigned char* topk; const float* mod;
    static constexpr int M_PER_BATCH = 4;
    struct MoeU { f32x4 g0, g1; float w; };
    __device__ __forceinline__ int tok(int r) const { return idx[r]; }
    __device__ __forceinline__ MoeU pre(int t, int c) const { MoeU p; const int tt = t < 0 ? 0 : t; p.w = *(const float*)(topk + (size_t)tt * 16 + 4);
        const float* g = mod + (size_t)(tt >> 12) * 6144 + 5120 + c; p.g0 = *(const f32x4*)g; p.g1 = *(const f32x4*)(g + 4); return p; }
    __device__ __forceinline__ void post(const MoeU& p, int t, int c, f32x4 v0, f32x4 v1) const { if (t < 0) return; const f32x4 a = p.g0 * (v0 * p.w), b = p.g1 * (v1 * p.w);
        *(v4u*)(o1 + (size_t)t * D + c) = (v4u){pk2(a.x, a.y), pk2(a.z, a.w), pk2(b.x, b.y), pk2(b.z, b.w)}; } };
struct E_MoeDown { float* x; const bf16* o1; const int* idx; const unsigned char* topk; const float* mod; int k;
    static constexpr int M_PER_BATCH = 2;
    struct MoeU { f32x4 x0, x1, g0, g1; v4u p; float w; };
    __device__ __forceinline__ int tok(int r) const { return idx[r]; }
    __device__ __forceinline__ MoeU pre(int t, int c) const { MoeU p; const int tt = t < 0 ? 0 : t; p.w = *(const float*)(topk + (size_t)tt * 16 + 4 + 4 * k);
        const float* g = mod + (size_t)(tt >> 12) * 6144 + 5120 + c; const float* xi = x + (size_t)tt * D + c;
        p.x0 = *(const f32x4*)xi; p.x1 = *(const f32x4*)(xi + 4); p.g0 = *(const f32x4*)g; p.g1 = *(const f32x4*)(g + 4); p.p = *(const v4u*)(o1 + (size_t)tt * D + c); return p; }
    __device__ __forceinline__ void post(const MoeU& p, int t, int c, f32x4 v0, f32x4 v1) const { if (t < 0) return; float* o = x + (size_t)t * D + c;
        const f32x4 q0 = (f32x4){bf2f(p.p.x & 0xffffu), bf2f(p.p.x >> 16), bf2f(p.p.y & 0xffffu), bf2f(p.p.y >> 16)}, q1 = (f32x4){bf2f(p.p.z & 0xffffu), bf2f(p.p.z >> 16), bf2f(p.p.w & 0xffffu), bf2f(p.p.w >> 16)};
        *(f32x4*)o = p.x0 + q0 + p.g0 * (v0 * p.w); *(f32x4*)(o + 4) = p.x1 + q1 + p.g1 * (v1 * p.w); } };

template <class AF, class EP>
__device__ __forceinline__ void gemm_moe(int mtiles, int ntiles, int K, const AF& af, const unsigned char* wbase, size_t woff, int ldb, const int* te, const EP& ep, int vcu, int G) {
    int tid = threadIdx.x; asm volatile("" : "+v"(tid)); asm volatile("" : "+s"(vcu)); const int wid = tid >> 6, lane = tid & 63, wr = wid >> 2, wc = wid & 3, fr = lane & 15, fq = lane >> 4;
    const int nunits = mtiles * ntiles;
    for (int u = vcu; u < nunits; u += G) {
        const int pm = u / ntiles, pn = u - pm * ntiles;
        const int row0 = pm * 128 + wr * 64, col0 = pn * 128 + wc * 32;
        const bf16* B = (const bf16*)(wbase + (size_t)te[pm >> 1] * MOE_E_STRIDE + woff);
        f32x4 acc[4][2];
#pragma unroll
        for (int m = 0; m < 4; ++m) { acc[m][0] = (f32x4){0.f, 0.f, 0.f, 0.f}; acc[m][1] = (f32x4){0.f, 0.f, 0.f, 0.f}; }
#pragma unroll 2
        for (int k = 0; k < K; k += 32) {
            bf16x8 a[4], b[2];
#pragma unroll
            for (int m = 0; m < 4; ++m) a[m] = *(const bf16x8*)af(0, row0 + m * 16 + fr, k + fq * 8);
#pragma unroll
            for (int n = 0; n < 2; ++n) b[n] = *(const bf16x8*)(B + (size_t)(col0 + n * 16 + fr) * ldb + k + fq * 8);
#pragma unroll
            for (int m = 0; m < 4; ++m)
#pragma unroll
                for (int n = 0; n < 2; ++n) acc[m][n] = __builtin_amdgcn_mfma_f32_16x16x32_bf16(b[n], a[m], acc[m][n], 0, 0, 0);
        }
#pragma unroll
        for (int m = 0; m < 4; ++m) ep(0, row0 + m * 16 + fr, col0 + 4 * fq, acc[m][0], acc[m][1]);
    }
}

__device__ __forceinline__ Frame mkframe(const Args& args, unsigned char* ldsp, int wv) {
    Frame F; F.lds = (LAS unsigned char*)ldsp;
    const int t = tid_of(wv); F.tid = t; F.lane = t & 63; F.wave = wv;
    int g = gridDim.x, bx = blockIdx.x; asm volatile("" : "+s"(g), "+s"(bx)); F.G = g; F.vcu = (g % 8 == 0) ? (bx % 8) * (g / 8) + bx / 8 : bx;
    __attribute__((address_space(1))) unsigned char* w = (__attribute__((address_space(1))) unsigned char*)args.ws; __attribute__((address_space(1))) float* o = (__attribute__((address_space(1))) float*)args.out;
    asm volatile("" : "+s"(w), "+s"(o));
    F.ws = (unsigned char*)w; F.out = (float*)o; F.in = args.in;
    return F;
}
__global__ void __launch_bounds__(NTHR, 2) mega(Args args) {
    extern __shared__ __attribute__((aligned(16))) unsigned char lds[];
    volatile LAS unsigned* MISC = (volatile LAS unsigned*)((LAS unsigned char*)lds + LDS_MISC);
    const int wv = __builtin_amdgcn_readfirstlane((int)threadIdx.x >> 6);
    if (threadIdx.x < 32) MISC[threadIdx.x] = 0u;
    __syncthreads();
    XcdBarrier bar; bar.bar = (unsigned*)(args.ws + WS_CTL) + 4096; bar.x = 0; bar.st = nullptr; bar.wv = wv;
    const int lo = args.ph_lo, hi = args.ph_hi;
    if (hi - lo > 1) bar = xcd_barrier_post((unsigned*)(args.ws + WS_CTL) + 4096, MISC + 8, wv);
#define IN(k) (lo <= (k) && (k) < hi)
#define SEAM(k) do { if (IN(k) && IN((k) + 1)) xcd_barrier(bar); } while (0)
#if PROBE_SEL >= 100
#define PBG(k) do { if (PROBE_SEL == 100 + (k)) prb_b((LAS unsigned char*)lds, tid_of(wv)); } while (0)
#define PEG(k) do { if (PROBE_SEL == 100 + (k)) prb_e((LAS unsigned char*)lds, tid_of(wv)); } while (0)
#else
#define PBG(k) do { } while (0)
#define PEG(k) do { } while (0)
#endif
#define PHF Frame F = mkframe(args, lds, wv); const int bxi = (int)blockIdx.x; (void)bxi
#define P_MOD (WSP(float, WS_MOD) + (size_t)l * 17 * 6144)
#define P_HM WSP(bf16, WS_HMOD)
#define P_PT WSP(bf16, WS_PT)
#define P_XB WSP(bf16, WS_BUFA)
#define P_E ((float*)((unsigned char*)F.out + DO_E))
#define P_HS ((bf16*)((unsigned char*)F.out + DO_HS))
#define P_YS ((bf16*)((unsigned char*)F.out + DO_YS))

    PBG(PH_P0); if (IN(PH_P0)) { PHF; p0_prologue(F); } SEAM(PH_P0); PEG(PH_P0);
    PBG(PH_P1); if (IN(PH_P1)) { PHF;
        for (int it = F.vcu; it < 240; it += F.G) { const int item = it < 192 ? (((it / 96) * 2) * 24 + (it % 96) / 4) * 4 + (it & 3) : ((((it - 192) / 24) * 2 + 1) * 24 + (it - 192) % 24) * 4; p1_item(F, item); } } SEAM(PH_P1); PEG(PH_P1);

#pragma unroll 1
    for (int l = 0; l < 2; ++l) {
        const int pb = PH_L + l * PH_PER;
        PBG(pb + S_NORM1); if (IN(pb + S_NORM1)) { PHF;
            if (l == 0) norm_rows(F, F.in[0], F.in[2], MT, F.in[6], P_MOD, 0, 1024, P_HM);
            else if (F.G == 256) norm_rows_b16(F, P_XB, NCX, F.in[6] + D, P_MOD, 0, 1024, P_HM, NL);
            else norm_rows_b16(F, P_XB, MT, F.in[6] + D, P_MOD, 0, 1024, P_HM); }
        SEAM(pb + S_NORM1); PEG(pb + S_NORM1);
        PBG(pb + S_G1); if (IN(pb + S_G1)) { PHF; const char* wt = (const char*)(WSP(bf16, WS_WIN) + (size_t)l * PTROWS * D);
            {
                g8::OpRow<true> oa{wt, D * 2, 0}; g8::OpPermB ob{(const char*)P_HM}; g8::Order S; S.init(1, 2, NL / 256, F.G, bxi); S.wgm = WGM_G1; E_PT8 ep{P_PT};
                g8::gemm8<true, true>(F.lds, F.wave, D / 64, oa, ob, S, ep); }
            int rot = 0;
            if (l == 0) {
                g8::OpRow<true> oa{wt, D * 2, 0}; g8::OpRow<false> ob{(const char*)(P_HM + (size_t)NL * D), D * 2, 0}; g8::Order S; S.init(1, 2, NCX / 256, F.G, bxi); E_PT8 ep{P_PT + NL};
                g8::gemm8<true, true>(F.lds, F.wave, D / 64, oa, ob, S, ep); rot = 32; }
            {
                g8::OpRow<true> oa{wt + (size_t)512 * D * 2, D * 2, 0}; g8::OpRow<false> ob{(const char*)P_HM, D * 2, 0}; g8::Order S; S.init(1, 6, MT / 256, F.G, bxi, rot); S.wgm = WGM_G1; E_PT8 ep{P_PT + (size_t)512 * MT};
                g8::gemm8<true, true>(F.lds, F.wave, D / 64, oa, ob, S, ep); } }
        SEAM(pb + S_G1); PEG(pb + S_G1);
        PBG(pb + S_FNET); if (IN(pb + S_FNET)) { PHF; shortconv_v(F, l);
            {
                g8::OpRow<true> oa{(const char*)WSP(bf16, WS_FAW), 128 * 2, 0}; g8::OpFA ob{(const char*)P_PT}; g8::Order S; S.init(1, 1, 1024, F.G, bxi); E_FA ep{WSP(bf16, WS_ABUF)};
                g8::gemm8(F.lds, F.wave, 2, oa, ob, S, ep); }
            if (l == 0) { g8::OpRow<true> oa{(const char*)WSP(bf16, WS_DFTC), 2 * LC * 2, 0}; g8::OpFnetB ob{(const char*)(P_PT + NL), LC * 2, 2}; g8::Order S; S.init(NB, 1, 1, F.G, bxi);
              E_Fnet ep{P_HM, NL, LC}; g8::gemm8(F.lds, F.wave, 2 * LC / 64, oa, ob, S, ep); }
            {
                E_S5E ep{P_E}; g8::OpS5A oa{(const char*)(P_PT + (size_t)R_S5 * MT), (const char*)P_HS - (const char*)(P_PT + (size_t)R_S5 * MT)}; g8::OpRow<false> ob{(const char*)(F.ws + WS_S5M + (size_t)l * 24 * S5M_STRIDE), 256 * 2, (long)S5M_STRIDE};
                g8::Order S; S.init(24, NCHUNK / 256, 1, F.G, bxi, l == 0 ? 16 : 0); g8::gemm8(F.lds, F.wave, 4, oa, ob, S, ep); } }
        SEAM(pb + S_FNET); PEG(pb + S_FNET);
        { PHF; PB(1); } PBG(pb + S_HY1); if (IN(pb + S_HY1)) { PHF;
            {
                g8::OpRow<true> oa{(const char*)WSP(bf16, WS_FBW), 512 * 2, 0}; g8::OpFB ob{(const char*)WSP(bf16, WS_ABUF)}; g8::Order S; S.init(NB, 16, 1, F.G, bxi); E_FB ep{P_HM};
                g8::gemm8(F.lds, F.wave, 8, oa, ob, S, ep); }
            hyena_stage(F, l, 0); }
        SEAM(pb + S_HY1); PEG(pb + S_HY1); { PHF; PE(1); }
        { PHF; PB(1); } PBG(pb + S_HY2); if (IN(pb + S_HY2)) { PHF; hyena_stage2_carry(F, l); }
        SEAM(pb + S_HY2); PEG(pb + S_HY2); { PHF; PE(1); }
        PBG(pb + S_S5O); if (IN(pb + S_S5O)) { PHF; E_S5O ep{P_YS};
            g8::OpS5A oa{(const char*)(P_PT + (size_t)R_S5 * MT), (const char*)P_HS - (const char*)(P_PT + (size_t)R_S5 * MT)}; g8::OpRow<false> ob{(const char*)(F.ws + WS_S5M + (size_t)l * 24 * S5M_STRIDE) + 256 * 256 * 2, 512 * 2, (long)S5M_STRIDE};
            g8::Order S; S.init(24, NCHUNK / 256, 1, F.G, bxi); g8::gemm8(F.lds, F.wave, 8, oa, ob, S, ep); }
        SEAM(pb + S_S5O); PEG(pb + S_S5O);
        PBG(pb + S_GLU); if (IN(pb + S_GLU)) { PHF; E_Glu ep{P_YS, P_HM, F.in[30] + l * 384};
            g8::OpRow<true> oa{(const char*)P_YS, 384 * 2, 0}; g8::OpRow<false> ob{(const char*)(WSP(bf16, WS_GLU) + (size_t)l * 512 * 384), 384 * 2, 0}; g8::Order S; S.init(1, (l == 0 ? MT : NL) / 256, 2, F.G, bxi);
            g8::gemm8(F.lds, F.wave, 6, oa, ob, S, ep);
            hyena_transpose(F, l == 0 ? MT : NL); }
        SEAM(pb + S_GLU); PEG(pb + S_GLU);
        PBG(pb + S_WOUT); if (IN(pb + S_WOUT)) { PHF;
            g8::OpRow<true> oa{(const char*)P_HM, D * 2, 0}; g8::OpRow<false> ob{(const char*)(WSP(bf16, WS_WOUT) + (size_t)l * D * D), D * 2, 0}; g8::Order S; S.init(1, (l == 0 ? MT : NL) / 256, D / 256, F.G, bxi); S.wgm = WGM_WOUT;
            if (l == 0) { E_Res<false, true> ep{F.in[0], F.in[2], P_XB, P_MOD, 2048}; g8::gemm8<true, true>(F.lds, F.wave, D / 64, oa, ob, S, ep, STAG(1000)); }
            else { E_Res<true, false> ep{P_XB, P_XB + (size_t)NL * D, F.out, P_MOD, 2048}; g8::gemm8<true, true>(F.lds, F.wave, D / 64, oa, ob, S, ep, STAG(1000)); } }
        SEAM(pb + S_WOUT); PEG(pb + S_WOUT);
        if (l == 0) {
            PBG(pb + S_NORM2); if (IN(pb + S_NORM2)) { PHF; norm_rows_b16(F, P_XB, MT, F.in[7], P_MOD, 3072, 4096, P_HM); }
            SEAM(pb + S_NORM2); PEG(pb + S_NORM2);
            PBG(pb + S_F0); if (IN(pb + S_F0)) { PHF; E_Swi ep{WSP(bf16, WS_ACT), DFF, 0};
                g8::OpRow<true> oa{(const char*)P_HM, D * 2, 0}; g8::OpRow<false> ob{(const char*)WSP(bf16, WS_FGU), D * 2, 0}; g8::Order S; S.init(1, MT / 256, 2 * DFF / 256, F.G, bxi); S.wgm = WGM_UP;
                g8::gemm8<UP_ALIGN>(F.lds, F.wave, D / 64, oa, ob, S, ep, STAG(750)); }
            SEAM(pb + S_F0); PEG(pb + S_F0);
#pragma unroll 1
            for (int part = 0; part < 2; ++part) {
                PBG(pb + S_F1 + part); if (IN(pb + S_F1 + part)) { PHF; const bool split = F.G == 256;
                    if (part == 0 || (split && bxi < 64)) { E_Res<true, true> ep{P_XB, P_XB + (size_t)NL * D, P_XB, P_MOD, 5120};
                        g8::OpTiled<true> oa{(const char*)WSP(bf16, WS_ACT), DFF / 64}; g8::OpTiled<false> ob{(const char*)WSP(bf16, WS_FD), DFF / 64}; g8::Order S; S.init(1, (part == 0 ? (split ? NL : MT) : NCX) / 256, D / 256, F.G, bxi); S.wgm = WGM_DOWN; S.pm_off = part == 0 ? 0 : NL / 256;
                        g8::gemm8<true, true>(F.lds, F.wave, DFF / 64, oa, ob, S, ep, STAG(2200)); }
                    else if (split) { Frame Fs = F; Fs.vcu = bxi - 64; Fs.G = 192;
                        norm_rows_b16(Fs, P_XB, NL, F.in[6] + D, WSP(float, WS_MOD) + (size_t)17 * 6144, 0, 1024, P_HM); } }
                SEAM(pb + S_F1 + part); PEG(pb + S_F1 + part);
            }
            SEAM(pb + S_F1); PEG(pb + S_F1);
        } else {
            PBG(pb + S_NORM2); if (IN(pb + S_NORM2)) { PHF; norm2_router(F, F.out, F.in[7] + D, P_MOD, P_HM); moe_transposes(F); }
            SEAM(pb + S_NORM2); PEG(pb + S_NORM2);
            PBG(pb + S_F0); if (IN(pb + S_F0)) { PHF; moe_slots(F); }
            SEAM(pb + S_F0); PEG(pb + S_F0);
#pragma unroll 1
            for (int step = 0; step < 4; ++step) {
                PBG(pb + S_F1 + step); if (IN(pb + S_F1 + step)) { PHF;
                    const int* IDX0 = (const int*)(F.ws + WS_META + META_IDX); const int* IDX1 = IDX0 + MAXSLOT; const int* TE0 = (const int*)(F.ws + WS_META + META_TE); const int* TE1 = TE0 + 272;
                    const int nt0 = __builtin_amdgcn_readfirstlane(((const int*)(F.ws + WS_META + META_NT))[0]), nt1 = __builtin_amdgcn_readfirstlane(((const int*)(F.ws + WS_META + META_NT))[1]);
                    const bool split = F.G == 256; const int ntl0 = split ? nt0 - 256 : 0, T8 = (ntl0 * (D / 256) + 7) & ~7;
                    LAS int* tel0 = (LAS int*)(F.lds + LDS_MISC + 1024); LAS int* tel1 = (LAS int*)(F.lds + LDS_MISC + 2560); if (F.tid < 272) { tel0[F.tid] = TE0[F.tid]; tel1[F.tid] = TE1[F.tid]; } __syncthreads();
                    if (step == 1 || (step == 2 && ntl0 > 0)) {
                        g8::OpTiled<true> oa{(const char*)WSP(bf16, WS_ACT2) + (step == 2 ? (size_t)8 * (DFE / 64) * 32768 : (size_t)0), DFE / 64}; g8::OpMoeBT ob{(const char*)(F.ws + WS_MOEW + MOE_GU_BYTES), tel0, DFE / 64}; g8::Order S;
                        if (step == 1) { S.init(1, split ? 256 : nt0, D / 256, F.G, bxi); S.wgm = WGM_DOWN; }
                        else { const int cc = bxi - (F.G - T8); S.init(1, ntl0, D / 256, F.G, cc >= 0 ? cc : 0); S.pm_off = 256; if (cc < 0) S.lx1 = 0; }
                        E_MoeDown0 ep{WSP(bf16, WS_O1), IDX0, F.ws + WS_TOPK, P_MOD}; g8::gemm8<true, true>(F.lds, F.wave, DFE / 64, oa, ob, S, ep, STAG(2700)); }
                    if (step == 0 || step == 2) { const int k = step >> 1, nt = k ? nt1 : nt0, U = nt * (2 * DFE / 256), Tx = k ? T8 : 0;
                        const int n0 = Tx > 0 ? (U / F.G - 2) * F.G : 0;
                        E_Swi ep{WSP(bf16, WS_ACT2), DFE, (k == 0 && split) ? 8 * 256 : 0};
                        g8::OpMoeA oa{(const char*)P_HM, k ? IDX1 : IDX0}; g8::OpMoeB ob{(const char*)(F.ws + WS_MOEW), k ? tel1 : tel0, D * 2};
#pragma unroll 1
                        for (int seg = 0; seg < 2; ++seg) { g8::Order S; S.init(1, nt, 2 * DFE / 256, seg == 0 ? F.G : F.G - Tx, bxi); S.wgm = WGM_UP; S.lx0 = seg == 0 ? 0 : n0; S.lx1 = seg == 0 ? n0 : U; if (seg == 1 && bxi >= F.G - Tx) S.lx1 = S.lx0;
                            g8::gemm8<UP_ALIGN>(F.lds, F.wave, D / 64, oa, ob, S, ep, STAG(750)); } }
                    if (step == 3) {
                        g8::OpTiled<true> oa{(const char*)WSP(bf16, WS_ACT2), DFE / 64}; g8::OpMoeBT ob{(const char*)(F.ws + WS_MOEW + MOE_GU_BYTES), tel1, DFE / 64}; g8::Order S; S.init(1, 256, D / 256, F.G, bxi); S.wgm = WGM_DOWN;
                        E_MoeDown ep{F.out, WSP(bf16, WS_O1), IDX1, F.ws + WS_TOPK, P_MOD, 1}; g8::gemm8<true, true>(F.lds, F.wave, DFE / 64, oa, ob, S, ep, STAG(2700)); } }
                SEAM(pb + S_F1 + step); PEG(pb + S_F1 + step);
            }
            PBG(pb + S_F5); if (IN(pb + S_F5)) { PHF; const int k = 1; const int* IDX = (const int*)(F.ws + WS_META + META_IDX) + k * MAXSLOT; const int* TE = (const int*)(F.ws + WS_META + META_TE) + k * 272; const int nt = __builtin_amdgcn_readfirstlane(((const int*)(F.ws + WS_META + META_NT))[k]);
                const int ntl = nt - 256, ntw = ntl * (D / 256);
                if (ntl > 0) { E_MoeDown ep{F.out, WSP(bf16, WS_O1), IDX, F.ws + WS_TOPK, P_MOD, k};
                    LAS int* tel = (LAS int*)(F.lds + LDS_MISC + 1024); if (F.tid < 272) tel[F.tid] = TE[F.tid]; __syncthreads();
                    g8::OpTiled<true> oa{(const char*)WSP(bf16, WS_ACT2), DFE / 64}; g8::OpMoeBT ob{(const char*)(F.ws + WS_MOEW + MOE_GU_BYTES), tel, DFE / 64}; g8::Order S; S.init(1, ntl, D / 256, F.G, bxi); S.pm_off = 256;
                    g8::gemm8<true, true>(F.lds, F.wave, DFE / 64, oa, ob, S, ep); }
                final_norm_part(F, 0, ntw); }
            SEAM(pb + S_F5); PEG(pb + S_F5);
            PBG(pb + S_F6); if (IN(pb + S_F6)) { PHF; final_norm_part(F, 1, 0); } PEG(pb + S_F6);
        }
    }
#if PROBE_SEL >= 0
    if (blockIdx.x == PROBE_BLK && tid_of(wv) == 0) { const unsigned long long want = *(volatile LAS unsigned long long*)((LAS unsigned char*)lds + LDS_MISC + 72), t0 = __builtin_amdgcn_s_memrealtime();
        while (__builtin_amdgcn_s_memrealtime() - t0 < want) __builtin_amdgcn_s_sleep(8); }
#endif
#undef IN
#undef SEAM
}

extern "C" void kernel_launch(void* const* d_in, const int* in_sizes, int n_in, void* d_out, int out_size, void* d_ws, size_t ws_size, hipStream_t stream) {
    static int grid = 0;
    if (grid == 0) {
        if (n_in != 40 || out_size != NL * D || ws_size < WS_END) { fprintf(stderr, "kernel_launch: unexpected shapes n_in %d out %d ws %zu (need %zu)\n", n_in, out_size, ws_size, (size_t)WS_END); grid = -1; return; }
        int dev = 0, cus = 0, per_cu = 0;
        if (hipGetDevice(&dev) != hipSuccess || hipDeviceGetAttribute(&cus, hipDeviceAttributeMultiprocessorCount, dev) != hipSuccess) { grid = -1; return; }
        if (hipFuncSetAttribute((const void*)mega, hipFuncAttributeMaxDynamicSharedMemorySize, LDS_BYTES) != hipSuccess) { fprintf(stderr, "kernel_launch: hipFuncSetAttribute failed\n"); grid = -1; return; }
        if (hipOccupancyMaxActiveBlocksPerMultiprocessor(&per_cu, (const void*)mega, NTHR, LDS_BYTES) != hipSuccess || per_cu < 1) fprintf(stderr, "kernel_launch: occupancy query says %d\n", per_cu);
        (void)hipGetLastError();
        grid = cus;
    }
    if (grid < 0) return;
    (void)hipMemsetAsync((char*)d_ws + WS_CTL, 0, CTL_ZERO_BYTES, stream);
    Args a{};
    for (int i = 0; i < 40; ++i) a.in[i] = (const float*)d_in[i];
    a.out = (float*)d_out; a.ws = (unsigned char*)d_ws;
#if MK_ONE_LAUNCH
    a.ph_lo = 0; a.ph_hi = N_PHASES;
    hipLaunchKernelGGL(mega, dim3(grid), dim3(NTHR), LDS_BYTES, stream, a);
#else
    for (int ph = 0; ph < N_PHASES; ++ph) {
        const int s = ph - PH_L;
        if (ph >= PH_L && s < PH_PER && s > S_F2) continue;
        if (ph >= PH_L + PH_PER && (ph - PH_L - PH_PER) > S_F5) continue;
        a.ph_lo = ph; a.ph_hi = ph + 1;
        hipLaunchKernelGGL(mega, dim3(grid), dim3(NTHR), LDS_BYTES, stream, a);
    }
#endif
}
```
